# Optimizing an MI355X kernel written in HIP

```python
import jax, jax.numpy as jnp
from jax import lax
import numpy as np

D_MODEL = 1024
BATCH = 4
SEQ = 4096
DEPTH = 2

HEAD_DIM = 64
A_HEADS = D_MODEL // 256
B_HEADS = D_MODEL // 256
C_HEADS = D_MODEL // 128
A_WIDTH = A_HEADS * HEAD_DIM
B_WIDTH = B_HEADS * HEAD_DIM
C_WIDTH = C_HEADS * HEAD_DIM
D_MIX = A_WIDTH + B_WIDTH + C_WIDTH
CHUNK = 128
LN_EPS = 1e-5
RW_DECAY_LORA = 64
RW_A_LORA = 64
RW_GATE_LORA = 128
GN_EPS = 64e-5
C_KV_GROUPS = 2
C_Q_PER_GROUP = C_HEADS // C_KV_GROUPS
C_KV_WIDTH = C_KV_GROUPS * HEAD_DIM
CMP_BLOCK = 32
CMP_STRIDE = 16
CMP_HIDDEN = 2 * HEAD_DIM
SLC_BLOCK = 64
SLC_TOPK = 16
WINDOW = 512
Q_BLOCK = 128
NEG_INF = -1e30
FORCE = 1e4
ROPE_THETA = 500000.0
ROPE_DIM = HEAD_DIM // 4
D_FF = 2816
N_EXPERTS = 8
TOP_K = 2
PLE_DIM = 256
RMS_EPS = 1e-6
N_DENSE = (DEPTH + 1) // 2
N_MOE = DEPTH // 2
A_SIZES = (A_WIDTH, A_WIDTH)
B_SIZES = (B_WIDTH, B_WIDTH, B_WIDTH, RW_DECAY_LORA, RW_A_LORA, RW_GATE_LORA)
C_SIZES = (C_WIDTH,) + (C_KV_WIDTH,) * 6 + (3 * C_HEADS,)
A_COLS = 2 * A_WIDTH
B_COLS = 3 * B_WIDTH + RW_DECAY_LORA + RW_A_LORA + RW_GATE_LORA
C_COLS = C_WIDTH + 6 * C_KV_WIDTH + 3 * C_HEADS
D_IN = A_COLS + B_COLS + C_COLS

kernel_name = "hybrid_gmlp_rwkv7_nsa_moe_block"


def split_cols(z, sizes):
    out, off = [], 0
    for s in sizes:
        out.append(z[..., off:off + s])
        off += s
    return out


def rms_norm(x, g):
    xf = x.astype(jnp.float32)
    y = xf * lax.rsqrt(jnp.mean(xf * xf, axis=-1, keepdims=True) + RMS_EPS)
    return (y * g.astype(jnp.float32)).astype(x.dtype)


def layer_norm(x, g, b, eps):
    xf = x.astype(jnp.float32)
    mu = jnp.mean(xf, axis=-1, keepdims=True)
    var = jnp.mean(jnp.square(xf - mu), axis=-1, keepdims=True)
    return ((xf - mu) * lax.rsqrt(var + eps) * g.astype(jnp.float32) + b.astype(jnp.float32)).astype(x.dtype)


def rope_tables(positions):
    inv = 1.0 / (ROPE_THETA ** (jnp.arange(0, ROPE_DIM, 2, dtype=jnp.float32) / ROPE_DIM))
    ang = positions.astype(jnp.float32)[..., None] * inv
    return jnp.cos(ang), jnp.sin(ang)


def apply_partial_rope(x, cos, sin):
    bshape = cos.shape[:2] + (1,) * (x.ndim - 3) + cos.shape[-1:]
    c = cos.reshape(bshape).astype(x.dtype)
    s = sin.reshape(bshape).astype(x.dtype)
    half = ROPE_DIM // 2
    x1, x2, xp = x[..., :half], x[..., half:ROPE_DIM], x[..., ROPE_DIM:]
    return jnp.concatenate([x1 * c - x2 * s, x1 * s + x2 * c, xp], axis=-1)


def masked_softmax(s, mask):
    s32 = jnp.where(mask, s.astype(jnp.float32), NEG_INF)
    pr = jax.nn.softmax(s32, axis=-1)
    return jnp.where(mask, pr, 0.0).astype(s.dtype)


def swiglu(x, w1, w3, w2):
    return (jax.nn.silu(x @ w1) * (x @ w3)) @ w2


def chunked_spatial_gating(z_a, ln_g, ln_b, w_s, b_s):
    Bn, S, _ = z_a.shape
    nc = S // CHUNK
    u, v = split_cols(jax.nn.gelu(z_a), A_SIZES)
    u = u.reshape(Bn, nc, CHUNK, A_HEADS, HEAD_DIM)
    v = layer_norm(v.reshape(Bn, nc, CHUNK, A_HEADS, HEAD_DIM), ln_g, ln_b, LN_EPS)
    causal = jnp.tril(jnp.ones((CHUNK, CHUNK), dtype=bool))
    w = jnp.where(causal[None], w_s, 0.0).astype(v.dtype)
    mixed = jnp.einsum('hts,bnshd->bnthd', w, v) + b_s.T[None, None, :, :, None]
    return (u * mixed).reshape(Bn, S, A_WIDTH)


def rwkv7_time_mix(z_b, mu, w0, w_up, a0, a_up, g_up, k_k, k_a, r_k, gn_g, gn_b):
    Bn, S, _ = z_b.shape
    f32 = jnp.float32
    z_prev = jnp.pad(z_b[:, :-1], ((0, 0), (1, 0), (0, 0)))
    z = z_b + (z_prev - z_b) * mu
    r, k, v, wd, ad, gd = split_cols(z, B_SIZES)
    w_logit = -jax.nn.softplus(-(w0 + jnp.tanh(wd) @ w_up).astype(f32)) - 0.5
    decay = jnp.exp(-jnp.exp(w_logit))
    a = jax.nn.sigmoid((a0 + ad @ a_up).astype(f32))
    g = jax.nn.sigmoid(gd) @ g_up
    hs = lambda t: t.astype(f32).reshape(Bn, S, B_HEADS, HEAD_DIM)
    kk = hs(k * k_k)
    kk = kk * lax.rsqrt(jnp.maximum(jnp.sum(kk * kk, axis=-1, keepdims=True), 1e-24))
    k_a_h = k_a.astype(f32).reshape(B_HEADS, HEAD_DIM)
    k = hs(k) * (1.0 + (hs(a) - 1.0) * k_a_h)
    r_h, v_h, a_h, w_h = hs(r), hs(v), hs(a), hs(decay)

    def step(state, inp):
        r_t, w_t, k_t, v_t, kk_t, a_t = inp
        sa = jnp.einsum('bhvk,bhk->bhv', state, -kk_t)
        state = (state * w_t[:, :, None, :] + sa[..., None] * (kk_t * a_t)[:, :, None, :]
                 + v_t[..., None] * k_t[:, :, None, :])
        return state, jnp.einsum('bhvk,bhk->bhv', state, r_t)

    xs = tuple(jnp.moveaxis(t, 1, 0) for t in (r_h, w_h, k, v_h, kk, a_h))
    s0 = jnp.zeros((Bn, B_HEADS, HEAD_DIM, HEAD_DIM), f32)
    _, ys = lax.scan(step, s0, xs)
    y = jnp.moveaxis(ys, 0, 1)
    mu_y = jnp.mean(y, axis=-1, keepdims=True)
    var_y = jnp.mean(jnp.square(y - mu_y), axis=-1, keepdims=True)
    y = ((y - mu_y) * lax.rsqrt(var_y + GN_EPS)).reshape(Bn, S, B_WIDTH)
    y = y * gn_g.astype(f32) + gn_b.astype(f32)
    bonus = jnp.sum(r_h * k * r_k.astype(f32), axis=-1, keepdims=True) * v_h
    y = y + bonus.reshape(Bn, S, B_WIDTH)
    return (y * g.astype(f32)).astype(z_b.dtype)


def nsa_attention(z_c, cos, sin, cmp_pos, kc_w1, kc_w2, vc_w1, vc_w2):
    Bn, S, _ = z_c.shape
    G, J, Dh = C_KV_GROUPS, C_Q_PER_GROUP, HEAD_DIM
    scale = HEAD_DIM ** -0.5
    q, kc, vc, ks, vs, kw, vw, gates = split_cols(z_c, C_SIZES)
    q = q.reshape(Bn, S, G, J, Dh)
    kv = lambda t: t.reshape(Bn, S, G, Dh)
    kc, vc, ks, vs, kw, vw = map(kv, (kc, vc, ks, vs, kw, vw))
    gates = jax.nn.sigmoid(gates.astype(jnp.float32)).astype(z_c.dtype).reshape(Bn, S, G, J, 3)
    q_rot = apply_partial_rope(q, cos, sin)
    ks = apply_partial_rope(ks, cos, sin)
    kw = apply_partial_rope(kw, cos, sin)

    n_cmp = (S - CMP_BLOCK) // CMP_STRIDE + 1
    cmp_idx = np.arange(n_cmp)[:, None] * CMP_STRIDE + np.arange(CMP_BLOCK)[None, :]
    cmp_end = jnp.asarray(cmp_idx[:, -1])

    def compress(t, w1, w2):
        blk = t[:, cmp_idx] + cmp_pos[None, None, :, None, :]
        blk = blk.transpose(0, 1, 3, 2, 4).reshape(Bn, n_cmp, G, CMP_BLOCK * Dh)
        return jax.nn.gelu(blk @ w1) @ w2

    k_cmp = compress(kc, kc_w1, kc_w2)
    v_cmp = compress(vc, vc_w1, vc_w2)

    n_slc = S // SLC_BLOCK
    n_sel = min(SLC_TOPK, n_slc)
    slc_start = np.arange(n_slc) * SLC_BLOCK
    overlap = jnp.asarray(((cmp_idx[:, :1] < slc_start[None, :] + SLC_BLOCK)
                           & (cmp_idx[:, -1:] >= slc_start[None, :])).astype(np.float32))
    ks_blk = ks.reshape(Bn, n_slc, SLC_BLOCK, G, Dh).transpose(0, 3, 1, 2, 4)
    vs_blk = vs.reshape(Bn, n_slc, SLC_BLOCK, G, Dh).transpose(0, 3, 1, 2, 4)
    kw_pad = jnp.pad(kw, ((0, 0), (WINDOW, 0), (0, 0), (0, 0)))
    vw_pad = jnp.pad(vw, ((0, 0), (WINDOW, 0), (0, 0), (0, 0)))
    bi = jnp.arange(Bn)[:, None, None, None]
    gi = jnp.arange(G)[None, :, None, None]
    m_ids = jnp.arange(n_slc)

    def query_block(qb):
        start = qb * Q_BLOCK
        t = start + jnp.arange(Q_BLOCK)
        q_raw = lax.dynamic_slice_in_dim(q, start, Q_BLOCK, axis=1)
        q_r = lax.dynamic_slice_in_dim(q_rot, start, Q_BLOCK, axis=1)
        g_t = lax.dynamic_slice_in_dim(gates, start, Q_BLOCK, axis=1)
        s_c = jnp.einsum('btgjd,bngd->bgjtn', q_raw, k_cmp) * scale
        p_c = masked_softmax(s_c, cmp_end[None, :] <= t[:, None])
        o_c = jnp.einsum('bgjtn,bngd->btgjd', p_c, v_cmp)
        imp = jnp.einsum('bgjtn,nm->bgtm', p_c.astype(jnp.float32), overlap)
        blk_t = (t // SLC_BLOCK)[:, None]
        valid = m_ids[None, :] <= blk_t
        forced = (m_ids[None, :] == 0) | (m_ids[None, :] == blk_t) | (m_ids[None, :] == blk_t - 1)
        imp = jnp.where(valid, imp + FORCE * forced.astype(jnp.float32), -FORCE)
        top_v, top_i = lax.top_k(imp, n_sel)
        sel_ok = top_v > -0.5 * FORCE
        k_sel = ks_blk[bi, gi, top_i]
        v_sel = vs_blk[bi, gi, top_i]
        kpos = top_i[..., None] * SLC_BLOCK + jnp.arange(SLC_BLOCK)
        m_s = (sel_ok[..., None] & (kpos <= t[None, None, :, None, None]))
        m_s = m_s.reshape(Bn, G, 1, Q_BLOCK, n_sel * SLC_BLOCK)
        s_s = jnp.einsum('btgjd,bgtksd->bgjtks', q_r, k_sel) * scale
        p_s = masked_softmax(s_s.reshape(Bn, G, J, Q_BLOCK, n_sel * SLC_BLOCK), m_s)
        p_s = p_s.reshape(Bn, G, J, Q_BLOCK, n_sel, SLC_BLOCK)
        o_s = jnp.einsum('bgjtks,bgtksd->btgjd', p_s, v_sel)
        k_win = lax.dynamic_slice_in_dim(kw_pad, start, WINDOW + Q_BLOCK, axis=1)
        v_win = lax.dynamic_slice_in_dim(vw_pad, start, WINDOW + Q_BLOCK, axis=1)
        kpos_w = start - WINDOW + jnp.arange(WINDOW + Q_BLOCK)
        m_w = ((kpos_w[None, :] <= t[:, None]) & (kpos_w[None, :] > t[:, None] - WINDOW)
               & (kpos_w[None, :] >= 0))
        s_w = jnp.einsum('btgjd,bkgd->bgjtk', q_r, k_win) * scale
        p_w = masked_softmax(s_w, m_w)
        o_w = jnp.einsum('bgjtk,bkgd->btgjd', p_w, v_win)
        o = g_t[..., 0:1] * o_c + g_t[..., 1:2] * o_s + g_t[..., 2:3] * o_w
        return o.reshape(Bn, Q_BLOCK, C_WIDTH)

    out = lax.map(query_block, jnp.arange(S // Q_BLOCK))
    return out.transpose(1, 0, 2, 3).reshape(Bn, S, C_WIDTH)


def moe_swiglu(x, router_w, router_b, w1, w3, w2):
    logits = (x @ router_w + router_b).astype(jnp.float32)
    top_v, top_i = lax.top_k(logits, TOP_K)
    top_p = jax.nn.softmax(top_v, axis=-1)
    gate = jnp.sum(jax.nn.one_hot(top_i, N_EXPERTS, dtype=jnp.float32) * top_p[..., None], axis=-2)
    gate = gate.astype(x.dtype)
    out = jnp.zeros_like(x)
    for e in range(N_EXPERTS):
        out = out + gate[..., e:e + 1] * swiglu(x, w1[e], w3[e], w2[e])
    return out


def setup_inputs(seed: int = 0) -> dict:
    key = jax.random.key(seed)
    ks = iter(jax.random.split(key, 64))
    f32 = jnp.float32

    def nrm(shape, scale):
        return scale * jax.random.normal(next(ks), shape, f32)

    def gain(shape):
        return 1.0 + 0.1 * jax.random.normal(next(ks), shape, f32)

    L = DEPTH
    x = nrm((BATCH, SEQ, D_MODEL), 1.0)
    p = nrm((DEPTH, BATCH, SEQ, PLE_DIM), 1.0)
    offset = jax.random.randint(next(ks), (BATCH, 1), 0, 1024, dtype=jnp.int32)
    positions = offset + jnp.arange(SEQ, dtype=jnp.int32)[None, :]
    return {
        "x": x, "p": p, "positions": positions,
        "g_mix": gain((L, D_MODEL)),
        "w_in": nrm((L, D_MODEL, D_IN), D_MODEL ** -0.5),
        "w_out": nrm((L, D_MIX, D_MODEL), D_MIX ** -0.5),
        "gm_ln_g": gain((L, A_HEADS, HEAD_DIM)),
        "gm_ln_b": nrm((L, A_HEADS, HEAD_DIM), 0.1),
        "gm_ws": nrm((L, A_HEADS, CHUNK, CHUNK), CHUNK ** -0.5),
        "gm_bs": gain((L, A_HEADS, CHUNK)),
        "rw_mu": jax.random.uniform(next(ks), (L, B_COLS), f32),
        "rw_w0": nrm((L, B_WIDTH), 0.5),
        "rw_w_up": nrm((L, RW_DECAY_LORA, B_WIDTH), 0.1),
        "rw_a0": nrm((L, B_WIDTH), 0.5),
        "rw_a_up": nrm((L, RW_A_LORA, B_WIDTH), RW_A_LORA ** -0.5),
        "rw_g_up": nrm((L, RW_GATE_LORA, B_WIDTH), RW_GATE_LORA ** -0.5),
        "rw_k_k": 0.85 + nrm((L, B_WIDTH), 0.1),
        "rw_k_a": gain((L, B_WIDTH)),
        "rw_r_k": nrm((L, B_HEADS, HEAD_DIM), 0.1),
        "rw_gn_g": gain((L, B_WIDTH)),
        "rw_gn_b": nrm((L, B_WIDTH), 0.1),
        "nsa_cmp_pos": nrm((L, CMP_BLOCK, HEAD_DIM), 0.1),
        "nsa_kc_w1": nrm((L, CMP_BLOCK * HEAD_DIM, CMP_HIDDEN), (CMP_BLOCK * HEAD_DIM) ** -0.5),
        "nsa_kc_w2": nrm((L, CMP_HIDDEN, HEAD_DIM), CMP_HIDDEN ** -0.5),
        "nsa_vc_w1": nrm((L, CMP_BLOCK * HEAD_DIM, CMP_HIDDEN), (CMP_BLOCK * HEAD_DIM) ** -0.5),
        "nsa_vc_w2": nrm((L, CMP_HIDDEN, HEAD_DIM), CMP_HIDDEN ** -0.5),
        "g_ffn": gain((L, D_MODEL)),
        "ffn_w1": nrm((N_DENSE, D_MODEL, D_FF), D_MODEL ** -0.5),
        "ffn_w3": nrm((N_DENSE, D_MODEL, D_FF), D_MODEL ** -0.5),
        "ffn_w2": nrm((N_DENSE, D_FF, D_MODEL), D_FF ** -0.5),
        "router_w": nrm((N_MOE, D_MODEL, N_EXPERTS), D_MODEL ** -0.5),
        "router_b": nrm((N_MOE, N_EXPERTS), 0.01),
        "moe_w1": nrm((N_MOE, N_EXPERTS, D_MODEL, D_FF), D_MODEL ** -0.5),
        "moe_w3": nrm((N_MOE, N_EXPERTS, D_MODEL, D_FF), D_MODEL ** -0.5),
        "moe_w2": nrm((N_MOE, N_EXPERTS, D_FF, D_MODEL), D_FF ** -0.5),
        "g_ple": gain((L, D_MODEL)),
        "ple_gate_w": nrm((L, D_MODEL, D_MODEL), D_MODEL ** -0.5),
        "ple_proj_w": nrm((L, PLE_DIM, D_MODEL), PLE_DIM ** -0.5),
        "g_final": gain((D_MODEL,)),
    }


def reference(x, p, positions, g_mix, w_in, w_out, gm_ln_g, gm_ln_b, gm_ws, gm_bs,
              rw_mu, rw_w0, rw_w_up, rw_a0, rw_a_up, rw_g_up, rw_k_k, rw_k_a, rw_r_k, rw_gn_g, rw_gn_b,
              nsa_cmp_pos, nsa_kc_w1, nsa_kc_w2, nsa_vc_w1, nsa_vc_w2,
              g_ffn, ffn_w1, ffn_w3, ffn_w2, router_w, router_b, moe_w1, moe_w3, moe_w2,
              g_ple, ple_gate_w, ple_proj_w, g_final):
    cos, sin = rope_tables(positions)
    h = x
    for i in range(DEPTH):
        hn = rms_norm(h, g_mix[i])
        z = hn @ w_in[i]
        z_a, z_b, z_c = split_cols(z, (A_COLS, B_COLS, C_COLS))
        y_a = chunked_spatial_gating(z_a, gm_ln_g[i], gm_ln_b[i], gm_ws[i], gm_bs[i])
        y_b = rwkv7_time_mix(z_b, rw_mu[i], rw_w0[i], rw_w_up[i], rw_a0[i], rw_a_up[i], rw_g_up[i],
                             rw_k_k[i], rw_k_a[i], rw_r_k[i], rw_gn_g[i], rw_gn_b[i])
        y_c = nsa_attention(z_c, cos, sin, nsa_cmp_pos[i], nsa_kc_w1[i], nsa_kc_w2[i],
                            nsa_vc_w1[i], nsa_vc_w2[i])
        h = h + jnp.concatenate([y_a, y_b, y_c], axis=-1) @ w_out[i]
        hn = rms_norm(h, g_ffn[i])
        if i % 2 == 0:
            j = i // 2
            f = swiglu(hn, ffn_w1[j], ffn_w3[j], ffn_w2[j])
        else:
            j = i // 2
            f = moe_swiglu(hn, router_w[j], router_b[j], moe_w1[j], moe_w3[j], moe_w2[j])
        h = h + f
        gate = jax.nn.sigmoid(rms_norm(h, g_ple[i]) @ ple_gate_w[i])
        h = h + (p[i] @ ple_proj_w[i]) * gate
    return rms_norm(h, g_final)
```

```cpp
#include <hip/hip_runtime.h>
#include <cstdio>
#include <cstdint>

#ifndef MK_ONE_LAUNCH
#define MK_ONE_LAUNCH 0
#endif

#define LAS __attribute__((address_space(3)))
#define GAS __attribute__((address_space(1)))
typedef unsigned short bf16;
typedef short bf16x8 __attribute__((ext_vector_type(8)));
typedef float f32x4 __attribute__((ext_vector_type(4)));
typedef float f32x2 __attribute__((ext_vector_type(2)));
typedef unsigned u32x4 __attribute__((ext_vector_type(4)));
typedef unsigned u32x2 __attribute__((ext_vector_type(2)));

constexpr int NB = 4, SEQ = 4096, DM = 1024, MT = NB * SEQ;
constexpr int DIN = 2840, ZLD = 3072;
constexpr int DFF = 2816, NEXP = 8;
constexpr int ZC_U = 0, ZC_V = 256, ZC_B = 512, ZC_Q = 1536, ZC_KC = 2048, ZC_VC = 2176, ZC_KS = 2304, ZC_VS = 2432, ZC_KW = 2560, ZC_VW = 2688, ZC_GT = 2816;
constexpr int NCMP = 255;
constexpr int NWAVES = 8, NTHR = 512;

__device__ __forceinline__ unsigned f2bf(float f) { unsigned u = __builtin_bit_cast(unsigned, f); return (u + 0x7fffu + ((u >> 16) & 1u)) >> 16; }
__device__ __forceinline__ float bf2f(unsigned b) { return __builtin_bit_cast(float, b << 16); }
__device__ __forceinline__ unsigned pk2(float lo, float hi) { return f2bf(lo) | (f2bf(hi) << 16); }
__device__ __forceinline__ float bflo(unsigned w) { return __builtin_bit_cast(float, w << 16); }
__device__ __forceinline__ float bfhi(unsigned w) { return __builtin_bit_cast(float, w & 0xffff0000u); }
__device__ __forceinline__ float sigmoidf_(float x) { return 1.0f / (1.0f + __expf(-x)); }
__device__ __forceinline__ float gelu_tanh(float x) { const float u = 0.7978845608028654f * (x + 0.044715f * x * x * x); const float e = __expf(-2.0f * fabsf(u)); float t = (1.0f - e) / (1.0f + e); t = u < 0.f ? -t : t; return 0.5f * x * (1.0f + t); }
__device__ __forceinline__ float wave_sum(float v) {
#pragma unroll
    for (int o = 1; o < 64; o <<= 1) v += __shfl_xor(v, o);
    return v;
}
__device__ __forceinline__ int opaque_tid() { int t = threadIdx.x; asm volatile("" : "+v"(t)); return t; }
#define LDS_WAIT() asm volatile("s_waitcnt lgkmcnt(0)" ::: "memory")
#define VM_WAIT() asm volatile("s_waitcnt vmcnt(0)" ::: "memory")

namespace pg8 {
constexpr int BM = 256, BK = 64, HALF = 128, HTB = HALF * BK * 2  , STAGE_BYTES = 8 * HTB, NXCD = 8, WGM = 8;
__host__ __device__ __forceinline__ int lds_byte(int r, int c) { const int st = (r >> 4) * 2 + (c >> 5), rr = r & 15, cc = c & 31, ob = rr * 64 + cc * 2; return st * 1024 + (ob ^ (((ob >> 9) & 1) << 5)); }
__host__ __device__ __forceinline__ void stage_rc(int b, int& R, int& C) { const int st = b / 1024, sb = b % 1024, swz = sb ^ (((sb >> 9) & 1) << 5); R = (st >> 1) * 16 + swz / 64; C = (st & 1) * 32 + (swz % 64) / 2; }
__host__ __device__ __forceinline__ int perm32(int rho) { const int n = rho >> 4, i = rho & 15; return 8 * (i >> 2) + 4 * n + (i & 3); }

struct Unit { int pm, pn, aux; };

struct StaticOrder {
    const char* A; const char* Bt; int K; int nM, nN, nwg, G, c;
    __device__ void init(const void* A_, const void* Bt_, int M, int N, int K_, int G_, int c_) { A = (const char*)A_; Bt = (const char*)Bt_; K = K_; nM = M / BM; nN = N / BM; nwg = nM * nN; G = G_; c = c_; }
    __device__ bool next(int i, Unit& u) const {
        const long L = (long)i * G + c; if (L >= nwg) return false;
        int wgid = (int)L; { const int q = nwg / NXCD, r = nwg % NXCD, xcd = wgid % NXCD, off = wgid / NXCD; wgid = (xcd < r ? xcd * (q + 1) : r * (q + 1) + (xcd - r) * q) + off; }
        const int nig = WGM * nN, gid = wgid / nig, fm = gid * WGM, gsz = (nM - fm) < WGM ? (nM - fm) : WGM;
        u.pm = fm + ((wgid % nig) % gsz); u.pn = (wgid % nig) / gsz; u.aux = 0; return true;
    }
    __device__ __forceinline__ const char* abase(const Unit& u) const { return A + (size_t)u.pm * ((size_t)BM * K * 2); }
    __device__ __forceinline__ const char* bbase(const Unit& u) const { return Bt + (size_t)u.pn * ((size_t)BM * K * 2); }
};

__device__ __forceinline__ unsigned cvt_pk_bf16(float lo, float hi) { unsigned r; asm volatile("v_cvt_pk_bf16_f32 %0, %1, %2" : "=v"(r) : "v"(lo), "v"(hi)); return r; }

struct EpiBf16Store {
    static constexpr bool PERM = true;
    bf16* O; int ldc;
    __device__ __forceinline__ void operator()(const f32x4 (&acc)[2][2][4][2], const Unit& u, int wr, int wc, int fr, int fq) const {
        const int row0 = u.pm * BM + wr * 64 + fr, col0 = u.pn * BM + wc * 32 + 8 * fq;
#pragma unroll
        for (int ai = 0; ai < 2; ++ai)
#pragma unroll
            for (int m = 0; m < 4; ++m) { bf16* rowp = O + (size_t)(row0 + ai * HALF + m * 16) * ldc + col0;
#pragma unroll
                for (int bj = 0; bj < 2; ++bj) { const f32x4 v0 = acc[ai][bj][m][0], v1 = acc[ai][bj][m][1];
                    u32x4 w; w.x = cvt_pk_bf16(v0[0], v0[1]); w.y = cvt_pk_bf16(v0[2], v0[3]); w.z = cvt_pk_bf16(v1[0], v1[1]); w.w = cvt_pk_bf16(v1[2], v1[3]);
                    *(u32x4*)(rowp + bj * HALF) = w; } }
    }
};
struct EpiResAdd {
    static constexpr bool PERM = false;
    float* H; int ldc;
    __device__ __forceinline__ void operator()(const f32x4 (&acc)[2][2][4][2], const Unit& u, int wr, int wc, int fr, int fq) const {
        const int row0 = u.pm * BM + wr * 64 + fr, col0 = u.pn * BM + wc * 32 + 4 * fq;
#pragma unroll
        for (int ai = 0; ai < 2; ++ai)
#pragma unroll
            for (int m = 0; m < 4; ++m) { float* rowp = H + (size_t)(row0 + ai * HALF + m * 16) * ldc + col0;
#pragma unroll
                for (int bj = 0; bj < 2; ++bj)
#pragma unroll
                    for (int n = 0; n < 2; ++n) { f32x4* p = (f32x4*)(rowp + bj * HALF + n * 16); *p = *p + acc[ai][bj][m][n]; } }
    }
};
struct EpiSwiglu {
    static constexpr bool PERM = true;
    bf16* O; int ldc;
    __device__ __forceinline__ void operator()(const f32x4 (&acc)[2][2][4][2], const Unit& u, int wr, int wc, int fr, int fq) const {
        const int row0 = u.pm * BM + wr * 64 + fr, col0 = u.pn * HALF + wc * 32 + 8 * fq;
#pragma unroll
        for (int ai = 0; ai < 2; ++ai)
#pragma unroll
            for (int m = 0; m < 4; ++m) { bf16* rowp = O + (size_t)(row0 + ai * HALF + m * 16) * ldc + col0;
                float o[8];
#pragma unroll
                for (int n = 0; n < 2; ++n)
#pragma unroll
                    for (int i = 0; i < 4; ++i) { const float a = acc[ai][0][m][n][i], b = acc[ai][1][m][n][i]; o[n * 4 + i] = a * b / (1.0f + __expf(-a)); }
                u32x4 w; w.x = cvt_pk_bf16(o[0], o[1]); w.y = cvt_pk_bf16(o[2], o[3]); w.z = cvt_pk_bf16(o[4], o[5]); w.w = cvt_pk_bf16(o[6], o[7]);
                *(u32x4*)rowp = w; __builtin_amdgcn_sched_barrier(0); }
    }
};
struct EpiPle {
    static constexpr bool PERM = false;
    float* H; const bf16* PP; int ldc;
    __device__ __forceinline__ void operator()(const f32x4 (&acc)[2][2][4][2], const Unit& u, int wr, int wc, int fr, int fq) const {
        const int row0 = u.pm * BM + wr * 64 + fr, col0 = u.pn * BM + wc * 32 + 4 * fq;
#pragma unroll
        for (int ai = 0; ai < 2; ++ai)
#pragma unroll
            for (int m = 0; m < 4; ++m) { const size_t off = (size_t)(row0 + ai * HALF + m * 16) * ldc + col0;
#pragma unroll
                for (int bj = 0; bj < 2; ++bj)
#pragma unroll
                    for (int n = 0; n < 2; ++n) { const size_t o2 = off + bj * HALF + n * 16; const u32x2 pw = *(const u32x2*)(PP + o2); const f32x4 a = acc[ai][bj][m][n];
                        f32x4 g; g[0] = bflo(pw.x) * sigmoidf_(a[0]); g[1] = bfhi(pw.x) * sigmoidf_(a[1]); g[2] = bflo(pw.y) * sigmoidf_(a[2]); g[3] = bfhi(pw.y) * sigmoidf_(a[3]);
                        f32x4* p = (f32x4*)(H + o2); *p = *p + g; }
                __builtin_amdgcn_sched_barrier(0); }
    }
};
struct EpiMoe2 {
    static constexpr bool PERM = false;
    float* H; const int* slot_tok; const float* slot_gate; int ldc;
    __device__ __forceinline__ void operator()(const f32x4 (&acc)[2][2][4][2], const Unit& u, int wr, int wc, int fr, int fq) const {
        const int row0 = u.pm * BM + wr * 64 + fr, col0 = u.pn * BM + wc * 32 + 4 * fq;
#pragma unroll
        for (int ai = 0; ai < 2; ++ai)
#pragma unroll
            for (int m = 0; m < 4; ++m) { const int slot = row0 + ai * HALF + m * 16; const int tok = slot_tok[slot]; const float gt = slot_gate[slot];
                if (tok >= 0) { float* rowp = H + (size_t)tok * ldc + col0;
#pragma unroll
                    for (int bj = 0; bj < 2; ++bj)
#pragma unroll
                        for (int n = 0; n < 2; ++n) { f32x4* p = (f32x4*)(rowp + bj * HALF + n * 16); *p = *p + acc[ai][bj][m][n] * gt; } }
                __builtin_amdgcn_sched_barrier(0); }
    }
};

template <class Epi, class Sched, bool ALIGN_EPI = true, bool SP2 = true>
__device__ __forceinline__ void gemm_phase(LAS unsigned char* lds, const int K, const Sched& S, const Epi& E) {
    int tid = threadIdx.x; asm volatile("" : "+v"(tid));
    const int wid = __builtin_amdgcn_readfirstlane(tid >> 6), lane = tid & 63, wr = wid >> 2, wc = wid & 3, fr = lane & 15, fq = lane >> 4;
    const int nt = K / BK;
    unsigned voffA[2], voffB[2];
#pragma unroll
    for (int i = 0; i < 2; ++i) { int R, C; stage_rc(tid * 16 + i * 8192, R, C); const int Rb = Epi::PERM ? ((R & ~31) + perm32(R & 31)) : R;
        voffA[i] = (unsigned)(R * K + C) * 2u; voffB[i] = (unsigned)(Rb * K + C) * 2u; }
    const size_t kstep = (size_t)(BK * 2);
    const size_t hstep = (size_t)HALF * K * 2;
    const unsigned ldsw = (unsigned)wid * 1024u;
    const int aoff = lds_byte(wr * 64 + fr, fq * 8), boff = lds_byte(wc * 32 + fr, fq * 8);
#define PG8_SA(b, h) (((b) * 2 + (h)) * HTB)
#define PG8_SB(b, h) ((4 + (b) * 2 + (h)) * HTB)
#define PG8_STAGE(bufoff, gbase, voff) do { _Pragma("unroll") for (int _i = 0; _i < 2; ++_i) \
        __builtin_amdgcn_global_load_lds((const unsigned*)((const char*)(gbase) + (voff)[_i]), (LAS unsigned*)(lds + (bufoff) + ldsw + _i * 8192), 16, 0, 0); } while (0)
#define PG8_LDA(dst, b, h) do { _Pragma("unroll") for (int m = 0; m < 4; ++m) _Pragma("unroll") for (int k = 0; k < 2; ++k) dst[m][k] = *(const LAS bf16x8*)(lds + PG8_SA(b, h) + aoff + m * 2048 + k * 1024); } while (0)
#define PG8_LDB(dst, b, h) do { _Pragma("unroll") for (int n = 0; n < 2; ++n) _Pragma("unroll") for (int k = 0; k < 2; ++k) dst[n][k] = *(const LAS bf16x8*)(lds + PG8_SB(b, h) + boff + n * 2048 + k * 1024); } while (0)
#define PG8_MMA(ai, bj, At, Bt) do { __builtin_amdgcn_s_setprio(1); _Pragma("unroll") for (int m = 0; m < 4; ++m) _Pragma("unroll") for (int n = 0; n < 2; ++n) _Pragma("unroll") for (int k = 0; k < 2; ++k) \
        acc[ai][bj][m][n] = __builtin_amdgcn_mfma_f32_16x16x32_bf16(Bt[n][k], At[m][k], acc[ai][bj][m][n], 0, 0, 0); __builtin_amdgcn_s_setprio(0); } while (0)
#define PG8_WAIT_V(n) asm volatile("s_waitcnt vmcnt(" #n ")" ::: "memory")
#define PG8_WAIT_L(n) asm volatile("s_waitcnt lgkmcnt(" #n ")" ::: "memory")
#define PG8_BAR __builtin_amdgcn_s_barrier()
#define PG8_SCHED __builtin_amdgcn_sched_barrier(0)
    Unit cur, nxt; int ui = 0;
    if (!S.next(0, cur)) return;
    f32x4 acc[2][2][4][2];
#pragma unroll
    for (int a = 0; a < 2; ++a)
#pragma unroll
        for (int b = 0; b < 2; ++b)
#pragma unroll
            for (int m = 0; m < 4; ++m)
#pragma unroll
                for (int n = 0; n < 2; ++n) acc[a][b][m][n] = (f32x4){0.f, 0.f, 0.f, 0.f};
    bf16x8 At[4][2], B0[2][2], B1[2][2];
    const char* cA = S.abase(cur); const char* cB = S.bbase(cur);
    if constexpr (SP2) {
        PG8_STAGE(PG8_SB(0, 0), cB, voffB); PG8_STAGE(PG8_SB(0, 1), cB + hstep, voffB); PG8_STAGE(PG8_SA(0, 0), cA, voffA); PG8_STAGE(PG8_SA(0, 1), cA + hstep, voffA);
        if (wr == 1) PG8_BAR;
        PG8_WAIT_V(2); PG8_BAR;
        PG8_STAGE(PG8_SB(1, 0), cB + kstep, voffB); PG8_STAGE(PG8_SA(1, 0), cA + kstep, voffA); PG8_STAGE(PG8_SB(1, 1), cB + hstep + kstep, voffB);
        PG8_WAIT_V(6); PG8_BAR;
    } else {
        PG8_STAGE(PG8_SB(0, 0), cB, voffB); PG8_STAGE(PG8_SA(0, 0), cA, voffA); PG8_STAGE(PG8_SB(0, 1), cB + hstep, voffB); PG8_STAGE(PG8_SA(0, 1), cA + hstep, voffA);
        if (wr == 1) PG8_BAR;
        PG8_WAIT_V(4); PG8_BAR;
        PG8_STAGE(PG8_SB(1, 0), cB + kstep, voffB); PG8_STAGE(PG8_SA(1, 0), cA + kstep, voffA); PG8_STAGE(PG8_SB(1, 1), cB + hstep + kstep, voffB);
        PG8_WAIT_V(6); PG8_BAR;
    }
    for (;;) {
        const bool has_next = S.next(ui + 1, nxt);
        const char* nA = has_next ? S.abase(nxt) : cA; const char* nB = has_next ? S.bbase(nxt) : cB;
        for (int t = 0; t < nt; t += 2) {
            const bool last = (t == nt - 2);
            const char* a1 = cA + (size_t)(t + 1) * kstep;
            const char* a2 = last ? nA : cA + (size_t)(t + 2) * kstep; const char* b2 = last ? nB : cB + (size_t)(t + 2) * kstep;
            const char* a3 = a2 + kstep; const char* b3 = b2 + kstep;
            if constexpr (SP2) {
            PG8_LDB(B0, 0, 0); PG8_LDB(B1, 0, 1); PG8_SCHED; PG8_LDA(At, 0, 0); PG8_STAGE(PG8_SA(1, 1), a1 + hstep, voffA);
            PG8_WAIT_V(8); PG8_WAIT_L(0); PG8_BAR; PG8_MMA(0, 0, At, B0); PG8_MMA(0, 1, At, B1); PG8_BAR; PG8_SCHED;
            PG8_LDA(At, 0, 1); PG8_STAGE(PG8_SB(0, 0), b2, voffB); PG8_STAGE(PG8_SB(0, 1), b2 + hstep, voffB); PG8_STAGE(PG8_SA(0, 0), a2, voffA);
            PG8_WAIT_V(8); PG8_WAIT_L(0); PG8_BAR; PG8_MMA(1, 0, At, B0); PG8_MMA(1, 1, At, B1); PG8_BAR; PG8_SCHED;
            PG8_LDB(B0, 1, 0); PG8_LDB(B1, 1, 1); PG8_SCHED; PG8_LDA(At, 1, 0); PG8_STAGE(PG8_SA(0, 1), a2 + hstep, voffA);
            PG8_WAIT_V(8); PG8_WAIT_L(0); PG8_BAR; PG8_MMA(0, 0, At, B0); PG8_MMA(0, 1, At, B1); PG8_BAR; PG8_SCHED;
            PG8_LDA(At, 1, 1); PG8_STAGE(PG8_SB(1, 0), b3, voffB); PG8_STAGE(PG8_SB(1, 1), b3 + hstep, voffB); PG8_STAGE(PG8_SA(1, 0), a3, voffA);
            PG8_WAIT_V(8); PG8_WAIT_L(0); PG8_BAR; PG8_MMA(1, 0, At, B0); PG8_MMA(1, 1, At, B1); PG8_BAR; PG8_SCHED;
            } else {
            PG8_LDB(B0, 0, 0); PG8_SCHED; PG8_LDA(At, 0, 0); PG8_STAGE(PG8_SA(1, 1), a1 + hstep, voffA);
            PG8_WAIT_L(8); PG8_BAR; PG8_WAIT_L(0); PG8_MMA(0, 0, At, B0); PG8_BAR; PG8_SCHED;
            PG8_LDB(B1, 0, 1); PG8_STAGE(PG8_SB(0, 0), b2, voffB);
            PG8_BAR; PG8_WAIT_L(0); PG8_MMA(0, 1, At, B1); PG8_BAR;
            PG8_LDA(At, 0, 1); PG8_STAGE(PG8_SA(0, 0), a2, voffA);
            PG8_BAR; PG8_WAIT_L(0); PG8_MMA(1, 0, At, B0); PG8_BAR; PG8_SCHED;
            PG8_STAGE(PG8_SB(0, 1), b2 + hstep, voffB);
            PG8_WAIT_V(6); PG8_BAR; PG8_MMA(1, 1, At, B1); PG8_BAR;
            PG8_LDB(B0, 1, 0); PG8_SCHED; PG8_LDA(At, 1, 0); PG8_STAGE(PG8_SA(0, 1), a2 + hstep, voffA);
            PG8_WAIT_L(8); PG8_BAR; PG8_WAIT_L(0); PG8_MMA(0, 0, At, B0); PG8_BAR; PG8_SCHED;
            PG8_LDB(B1, 1, 1); PG8_STAGE(PG8_SB(1, 0), b3, voffB);
            PG8_BAR; PG8_WAIT_L(0); PG8_MMA(0, 1, At, B1); PG8_BAR;
            PG8_LDA(At, 1, 1); PG8_STAGE(PG8_SA(1, 0), a3, voffA);
            PG8_BAR; PG8_WAIT_L(0); PG8_MMA(1, 0, At, B0); PG8_BAR; PG8_SCHED;
            PG8_STAGE(PG8_SB(1, 1), b3 + hstep, voffB);
            PG8_WAIT_V(6); PG8_BAR; PG8_MMA(1, 1, At, B1); PG8_BAR;
            }
        }
        if constexpr (ALIGN_EPI) { if (wr == 0) PG8_BAR; }
        E(acc, cur, wr, wc, fr, fq);
        if (!has_next) break;
#pragma unroll
        for (int a = 0; a < 2; ++a)
#pragma unroll
            for (int b = 0; b < 2; ++b)
#pragma unroll
                for (int m = 0; m < 4; ++m)
#pragma unroll
                    for (int n = 0; n < 2; ++n) acc[a][b][m][n] = (f32x4){0.f, 0.f, 0.f, 0.f};
        cur = nxt; cA = nA; cB = nB; ++ui;
        if constexpr (ALIGN_EPI) { if (wr == 1) PG8_BAR; }
    }
    PG8_WAIT_V(0);
    if constexpr (!ALIGN_EPI) { if (wr == 0) PG8_BAR; }
    PG8_BAR;
#undef PG8_SA
#undef PG8_SB
#undef PG8_STAGE
#undef PG8_LDA
#undef PG8_LDB
#undef PG8_MMA
#undef PG8_WAIT_V
#undef PG8_WAIT_L
#undef PG8_BAR
#undef PG8_SCHED
}
}

constexpr size_t MiB = 1u << 20;
constexpr size_t WS_CTL = 0, CTL_ZERO_BYTES = 65536;
constexpr size_t WS_WIN = 1 * MiB;
constexpr size_t WS_WOUT = 13 * MiB;
constexpr size_t WS_W13 = 17 * MiB;
constexpr size_t WS_W2 = 28 * MiB;
constexpr size_t WS_WG = 34 * MiB;
constexpr size_t WS_WP = 38 * MiB;
constexpr size_t WS_CW1 = 39 * MiB;
constexpr size_t WS_LORA = 41 * MiB;
constexpr size_t WS_ROPE = 41 * MiB + 512 * 1024;
constexpr size_t WS_CBIAS = 42 * MiB + 512 * 1024;
constexpr size_t WS_PB = 43 * MiB;
constexpr size_t WS_HN = 60 * MiB;
constexpr size_t WS_Z = 92 * MiB;
constexpr size_t WS_YCAT = 188 * MiB;
constexpr size_t WS_QROT = 220 * MiB;
constexpr size_t WS_KSR = 236 * MiB, WS_KWR = 240 * MiB, WS_VST = 244 * MiB, WS_VWT = 248 * MiB;
constexpr size_t WS_KCMP = 252 * MiB, WS_VCMPT = 252 * MiB + 512 * 1024;
constexpr size_t WS_REC = 253 * MiB;
constexpr size_t WS_G = 349 * MiB;
constexpr size_t WS_YRAW = 365 * MiB;
constexpr size_t WS_BONUS = 381 * MiB;
constexpr size_t WS_ACT = 92 * MiB;
constexpr size_t WS_HNS = 92 * MiB;
constexpr size_t WS_ACTM = 128 * MiB;
constexpr size_t WS_MW13 = 227 * MiB;
constexpr size_t WS_MW2 = 315 * MiB;
constexpr size_t WS_SLOT = 359 * MiB;
constexpr size_t WS_PP = 92 * MiB;
constexpr size_t WS_END = 382 * MiB;
constexpr int MOE_SLOTS = 18432;
constexpr size_t SL_TOK = 0;
constexpr size_t SL_GATE = SL_TOK + 2 * MOE_SLOTS * 4;
constexpr size_t SL_TOKE = SL_GATE + 2 * MOE_SLOTS * 4;
constexpr size_t SL_TOKG = SL_TOKE + (size_t)MT * 2 * 4;
constexpr size_t SL_TOKS = SL_TOKG + (size_t)MT * 2 * 4;
constexpr size_t SL_BCNT = SL_TOKS + (size_t)MT * 2 * 4;
constexpr size_t SL_TST = SL_BCNT + 256 * 16 * 4;
static_assert(SL_TST + 128 <= 1 * MiB, "slot tables");
constexpr int CW_BAR = 4096;
constexpr int CW_Q = 8192;

constexpr int RING_BYTES = 131072;
constexpr int MISC_OFF = RING_BYTES;
constexpr int LDS_BYTES = 147456;

#define XB_TMO      128
#define XB_XCNT(j)  (256  + 64 * (j))
#define XB_XSUB(j)  (1280 + 64 * (j))
#define XB_XGEN(j)  (2304 + 64 * (j))
#define XB_TOP      3328
#define XB_TOPGEN   3392
#define XCD_BAR_WORDS 3456
#define XB_SPIN_CAP (1u << 18)
__device__ __forceinline__ unsigned xb_ld(unsigned* p)              { return __hip_atomic_load(p, __ATOMIC_RELAXED, __HIP_MEMORY_SCOPE_AGENT); }
__device__ __forceinline__ unsigned xb_add(unsigned* p, unsigned v) { return __hip_atomic_fetch_add(p, v, __ATOMIC_RELAXED, __HIP_MEMORY_SCOPE_AGENT); }
__device__ __forceinline__ unsigned xb_xcc_id() { return (unsigned)__builtin_amdgcn_s_getreg((3 << 11) | 20) & 0xFu; }
#define XB_SPIN(cond, bar) do { unsigned _sp = 0; while (cond) { __builtin_amdgcn_s_sleep(1); \
    if ((++_sp & 255u) == 0u) { if (xb_ld(&(bar)[XB_TMO])) break; if (_sp > XB_SPIN_CAP) { atomicAdd(&(bar)[XB_TMO], 1u); break; } } } } while (0)
struct XcdBarrier { unsigned* bar; unsigned x; volatile LAS unsigned* st; };
__device__ __forceinline__ XcdBarrier xcd_barrier_post(unsigned* bar, volatile LAS unsigned* st) {
    XcdBarrier b; b.bar = bar; b.x = xb_xcc_id(); b.st = st;
    if (threadIdx.x == 0) (void)xb_add(&bar[XB_XCNT(b.x)], 1u);
    return b;
}
__device__ __forceinline__ void xcd_barrier_complete(unsigned* bar, unsigned x, unsigned& nloc, unsigned& nx) {
    const unsigned G = gridDim.x * gridDim.y * gridDim.z;
    unsigned sum, cnt, mine, sp = 0u;
    for (;;) {
        sum = 0u; cnt = 0u; mine = 0u;
#pragma unroll
        for (unsigned j = 0; j < 16; ++j) { const unsigned c = xb_ld(&bar[XB_XCNT(j)]); sum += c; cnt += (c > 0u) ? 1u : 0u; mine = (j == x) ? c : mine; }
        if (sum == G) break;
        __builtin_amdgcn_s_sleep(1);
        if ((++sp & 255u) == 0u) { if (xb_ld(&bar[XB_TMO])) break; if (sp > XB_SPIN_CAP) { atomicAdd(&bar[XB_TMO], 1u); break; } }
    }
    nloc = mine > 0u ? mine : 1u; nx = cnt > 0u ? cnt : 1u;
}
__device__ __forceinline__ void xcd_barrier(const XcdBarrier& b) {
    asm volatile("s_waitcnt vmcnt(0)" ::: "memory");
    __syncthreads();
    if (threadIdx.x == 0) {
        unsigned* bar = b.bar;
        __builtin_amdgcn_s_waitcnt(0);
        unsigned nloc = b.st[0], nx = b.st[1];
        if (nloc == 0u) { xcd_barrier_complete(bar, b.x, nloc, nx); b.st[0] = nloc; b.st[1] = nx; }
        const unsigned old = xb_add(&bar[XB_XSUB(b.x)], 1u);
        const unsigned gen = old / nloc;
        if (old + 1u == (gen + 1u) * nloc) {
            __builtin_amdgcn_fence(__ATOMIC_RELEASE, "agent");
            asm volatile("s_waitcnt vmcnt(0)" ::: "memory");
            const unsigned og = xb_add(&bar[XB_TOP], 1u);
            const unsigned tg = og / nx;
            if (og + 1u == (tg + 1u) * nx) xb_add(&bar[XB_TOPGEN], 1u);
            else XB_SPIN(xb_ld(&bar[XB_TOPGEN]) == tg, bar);
            __builtin_amdgcn_fence(__ATOMIC_ACQUIRE, "agent");
            xb_add(&bar[XB_XGEN(b.x)], 1u);
            asm volatile("s_waitcnt vmcnt(0)" ::: "memory");
        } else {
            XB_SPIN(xb_ld(&bar[XB_XGEN(b.x)]) == gen, bar);
            __builtin_amdgcn_fence(__ATOMIC_ACQUIRE, "agent");
            asm volatile("s_waitcnt vmcnt(0)" ::: "memory");
        }
    }
    __syncthreads();
}

enum { IN_X = 0, IN_P, IN_POS, IN_GMIX, IN_WIN, IN_WOUT, IN_GMLNG, IN_GMLNB, IN_GMWS, IN_GMBS, IN_RWMU, IN_RWW0, IN_RWWUP, IN_RWA0, IN_RWAUP, IN_RWGUP,
       IN_RWKK, IN_RWKA, IN_RWRK, IN_RWGNG, IN_RWGNB, IN_CMPPOS, IN_KCW1, IN_KCW2, IN_VCW1, IN_VCW2, IN_GFFN, IN_FW1, IN_FW3, IN_FW2, IN_RTW, IN_RTB,
       IN_MW1, IN_MW3, IN_MW2, IN_GPLE, IN_PLEG, IN_PLEP, IN_GFINAL, N_INPUTS };
struct Args { const void* in[N_INPUTS]; float* out; unsigned char* ws; int ph_lo, ph_hi; };
constexpr int PTAB_OFF = 131072 + 256;
__device__ __forceinline__ const void* ldptr(int k) {
    extern __shared__ __attribute__((aligned(16))) unsigned char lds_raw[];
    const LAS unsigned* t = (const LAS unsigned*)((LAS unsigned char*)lds_raw + PTAB_OFF) + 2 * k;
    const unsigned lo = __builtin_amdgcn_readfirstlane(t[0]), hi = __builtin_amdgcn_readfirstlane(t[1]);
    return (const void*)(((unsigned long long)hi << 32) | lo);
}
#define INF(k) ((const float*)ldptr(k))

__device__ __forceinline__ void transpose_item(const float* W, int ldw, int k0, int n0, int nvalid, bf16* dst, int dld, int drow0, LAS float* scr, int lane) {
    const bool ok = (lane & 31) < nvalid;
#pragma unroll 8
    for (int i = 0; i < 32; ++i) { const int kk = 2 * i + (lane >> 5); scr[kk * 33 + (lane & 31)] = ok ? W[(size_t)(k0 + kk) * ldw + n0 + (lane & 31)] : 0.f; }
    LDS_WAIT(); asm volatile("" ::: "memory");
    const int c = lane & 7;
#pragma unroll
    for (int j = 0; j < 4; ++j) { const int n = (lane >> 3) + 8 * j; const LAS float* s = scr + (8 * c) * 33 + n;
        u32x4 o; o.x = pk2(s[0 * 33], s[1 * 33]); o.y = pk2(s[2 * 33], s[3 * 33]); o.z = pk2(s[4 * 33], s[5 * 33]); o.w = pk2(s[6 * 33], s[7 * 33]);
        if (n < nvalid) *(u32x4*)(dst + (size_t)(drow0 + n) * dld + k0 + 8 * c) = o; }
    LDS_WAIT(); asm volatile("" ::: "memory");
}
__device__ __forceinline__ void conv_matrix(const float* W, int K, int N, bf16* dst, int mode, int gw, int NGW, LAS float* scr, int lane) {
    const int nblk = (N + 31) / 32, nit = (K / 64) * nblk;
    for (int it = gw; it < nit; it += NGW) {
        const int kb = it / nblk, nb = it % nblk, n0 = nb * 32; const int nv = (N - n0) < 32 ? (N - n0) : 32;
        const int drow0 = mode == 0 ? n0 : ((n0 >> 7) * 256 + (n0 & 127) + (mode == 2 ? 128 : 0));
        transpose_item(W, N, kb * 64, n0, nv, dst, K, drow0, scr, lane);
    }
}
__device__ __forceinline__ void rms_row_bf16(const float* xrow, const float* g, bf16* orow, float* cp, int lane) {
    const f32x4* xr = (const f32x4*)xrow + lane; f32x4 v[4]; float s = 0.f;
#pragma unroll
    for (int j = 0; j < 4; ++j) { v[j] = xr[64 * j]; s += (v[j].x * v[j].x + v[j].y * v[j].y) + (v[j].z * v[j].z + v[j].w * v[j].w); }
    const float rs = 1.0f / sqrtf(wave_sum(s) * (1.0f / 1024.0f) + 1e-6f);
    if (cp) {
#pragma unroll
        for (int j = 0; j < 4; ++j) ((f32x4*)cp + lane)[64 * j] = v[j]; }
    u32x2* o8 = (u32x2*)orow + lane;
#pragma unroll
    for (int j = 0; j < 4; ++j) { const f32x4 gg = ((const f32x4*)g + lane)[64 * j]; u32x2 w; w.x = pk2(v[j].x * rs * gg.x, v[j].y * rs * gg.y); w.y = pk2(v[j].z * rs * gg.z, v[j].w * rs * gg.w); o8[64 * j] = w; }
}

__device__ __forceinline__ void phase_prologue(const Args& a, LAS unsigned char* lds) {
    const int tid = opaque_tid(), lane = tid & 63, wave = __builtin_amdgcn_readfirstlane(tid >> 6);
    const int G = gridDim.x, gw = blockIdx.x * NWAVES + wave, NGW = G * NWAVES;
    const size_t gt = (size_t)blockIdx.x * NTHR + tid, NGT = (size_t)G * NTHR;
    unsigned char* ws = a.ws;
    LAS float* scr = (LAS float*)(lds + wave * 16384);
    for (int l = 0; l < 2; ++l) {
        conv_matrix(INF(IN_WIN) + (size_t)l * DM * DIN, DM, DIN, (bf16*)(ws + WS_WIN) + (size_t)l * ZLD * DM, 0, gw, NGW, scr, lane);
        conv_matrix(INF(IN_WOUT) + (size_t)l * DM * DM, DM, DM, (bf16*)(ws + WS_WOUT) + (size_t)l * DM * DM, 0, gw, NGW, scr, lane);
        conv_matrix(INF(IN_PLEG) + (size_t)l * DM * DM, DM, DM, (bf16*)(ws + WS_WG) + (size_t)l * DM * DM, 0, gw, NGW, scr, lane);
        conv_matrix(INF(IN_PLEP) + (size_t)l * 256 * DM, 256, DM, (bf16*)(ws + WS_WP) + (size_t)l * DM * 256, 0, gw, NGW, scr, lane);
        conv_matrix(INF(IN_KCW1) + (size_t)l * 2048 * 128, 2048, 128, (bf16*)(ws + WS_CW1) + (size_t)(l * 2 + 0) * 128 * 2048, 0, gw, NGW, scr, lane);
        conv_matrix(INF(IN_VCW1) + (size_t)l * 2048 * 128, 2048, 128, (bf16*)(ws + WS_CW1) + (size_t)(l * 2 + 1) * 128 * 2048, 0, gw, NGW, scr, lane);
        bf16* lora = (bf16*)(ws + WS_LORA) + (size_t)l * 65536;
        conv_matrix(INF(IN_RWWUP) + (size_t)l * 64 * 256, 64, 256, lora, 0, gw, NGW, scr, lane);
        conv_matrix(INF(IN_RWAUP) + (size_t)l * 64 * 256, 64, 256, lora + 16384, 0, gw, NGW, scr, lane);
        conv_matrix(INF(IN_RWGUP) + (size_t)l * 128 * 256, 128, 256, lora + 32768, 0, gw, NGW, scr, lane);
        { u32x4* zr = (u32x4*)((bf16*)(ws + WS_WIN) + ((size_t)l * ZLD + DIN) * DM); const size_t n16 = (size_t)(ZLD - DIN) * DM * 2 / 16;
          for (size_t i = gt; i < n16; i += NGT) zr[i] = (u32x4){0u, 0u, 0u, 0u}; }
    }
    conv_matrix(INF(IN_FW1), DM, DFF, (bf16*)(ws + WS_W13), 1, gw, NGW, scr, lane);
    conv_matrix(INF(IN_FW3), DM, DFF, (bf16*)(ws + WS_W13), 2, gw, NGW, scr, lane);
    conv_matrix(INF(IN_FW2), DFF, DM, (bf16*)(ws + WS_W2), 0, gw, NGW, scr, lane);
    { const f32x4* src = (const f32x4*)INF(IN_P); u32x2* dst = (u32x2*)(ws + WS_PB); const size_t n4 = (size_t)2 * MT * 256 / 4;
      for (size_t i = gt; i < n4; i += NGT) { const f32x4 v = src[i]; u32x2 w; w.x = pk2(v.x, v.y); w.y = pk2(v.z, v.w); dst[i] = w; } }
    { const int* pos = (const int*)ldptr(IN_POS); float* ct = (float*)(ws + WS_ROPE); float* st = ct + (size_t)MT * 8;
      const float inv[8] = {1.0f, 0.1939227432012558f, 0.03760603070259094f, 0.007292664609849453f, 0.0014142135623842478f, 0.00027424818836152554f, 5.3182957344688475e-05f, 1.0313385246263351e-05f};
      for (size_t i = gt; i < (size_t)MT * 8; i += NGT) { const int m = (int)(i >> 3), k = (int)(i & 7);
          float iv = inv[0];
#pragma unroll
          for (int q = 1; q < 8; ++q) iv = (k == q) ? inv[q] : iv;
          const float ang = (float)pos[m] * iv;
          const double ad = (double)ang; const double kq = __builtin_rint(ad * 0.15915494309189535); const float red = (float)(ad - kq * 6.283185307179586);
          ct[i] = __cosf(red); st[i] = __sinf(red); } }
    if (blockIdx.x < 4) {
        const int l = blockIdx.x >> 1, kv = blockIdx.x & 1; const float* W1 = INF(kv ? IN_VCW1 : IN_KCW1) + (size_t)l * 2048 * 128; const float* pos = INF(IN_CMPPOS) + (size_t)l * 2048;
        LAS float* red = (LAS float*)(lds + 8448);
        const int hid = tid & 127, part = tid >> 7; float s = 0.f;
        for (int k = part * 512; k < part * 512 + 512; ++k) s += pos[k] * W1[(size_t)k * 128 + hid];
        red[part * 128 + hid] = s; __syncthreads();
        if (tid < 128) ((float*)(ws + WS_CBIAS))[(l * 2 + kv) * 128 + tid] = red[tid] + red[128 + tid] + red[256 + tid] + red[384 + tid];
    }
    for (int m = gw; m < MT; m += NGW) rms_row_bf16(INF(IN_X) + (size_t)m * DM, INF(IN_GMIX), (bf16*)(ws + WS_HN) + (size_t)m * DM, a.out + (size_t)m * DM, lane);
}

template <int MODE>
__device__ __forceinline__ void phase_norm(const Args& a, LAS unsigned char* lds, const float* g) {
    const int tid = opaque_tid(), lane = tid & 63, wave = __builtin_amdgcn_readfirstlane(tid >> 6);
    unsigned char* ws = a.ws;
    LAS int* lcnt = (LAS int*)lds;
    if (MODE == 1) { if (tid < 16) lcnt[tid] = 0; __syncthreads(); }
    for (int rb = blockIdx.x; rb < MT / 64; rb += gridDim.x) {
        for (int i = 0; i < 8; ++i) {
            const int m = rb * 64 + wave * 8 + i;
            float* hrow = a.out + (size_t)m * DM;
            const f32x4* xr = (const f32x4*)hrow + lane; f32x4 v[4]; float s = 0.f;
#pragma unroll
            for (int j = 0; j < 4; ++j) { v[j] = xr[64 * j]; s += (v[j].x * v[j].x + v[j].y * v[j].y) + (v[j].z * v[j].z + v[j].w * v[j].w); }
            const float rs = 1.0f / sqrtf(wave_sum(s) * (1.0f / 1024.0f) + 1e-6f);
#pragma unroll
            for (int j = 0; j < 4; ++j) { const f32x4 gg = ((const f32x4*)g + lane)[64 * j]; v[j].x *= rs * gg.x; v[j].y *= rs * gg.y; v[j].z *= rs * gg.z; v[j].w *= rs * gg.w; }
            if (MODE == 2) {
#pragma unroll
                for (int j = 0; j < 4; ++j) ((f32x4*)hrow + lane)[64 * j] = v[j];
            } else {
                u32x2* o8 = (u32x2*)((bf16*)(ws + WS_HN) + (size_t)m * DM) + lane;
#pragma unroll
                for (int j = 0; j < 4; ++j) { u32x2 w; w.x = pk2(v[j].x, v[j].y); w.y = pk2(v[j].z, v[j].w); o8[64 * j] = w; }
            }
            if (MODE == 1) {
                const float* rw = INF(IN_RTW); float lg[8];
#pragma unroll
                for (int e = 0; e < 8; ++e) lg[e] = 0.f;
#pragma unroll
                for (int j = 0; j < 4; ++j)
#pragma unroll
                    for (int c = 0; c < 4; ++c) { const int k = 4 * (lane + 64 * j) + c; const f32x4 w0 = *(const f32x4*)(rw + (size_t)k * 8), w1 = *(const f32x4*)(rw + (size_t)k * 8 + 4); const float x = v[j][c];
                        lg[0] += x * w0.x; lg[1] += x * w0.y; lg[2] += x * w0.z; lg[3] += x * w0.w; lg[4] += x * w1.x; lg[5] += x * w1.y; lg[6] += x * w1.z; lg[7] += x * w1.w; }
#pragma unroll
                for (int e = 0; e < 8; ++e) lg[e] = wave_sum(lg[e]) + INF(IN_RTB)[e];
                int e0 = 0; float v0 = lg[0];
#pragma unroll
                for (int e = 1; e < 8; ++e) if (lg[e] > v0) { v0 = lg[e]; e0 = e; }
                int e1 = -1; float v1 = -3.0e38f;
#pragma unroll
                for (int e = 0; e < 8; ++e) if (e != e0 && lg[e] > v1) { v1 = lg[e]; e1 = e; }
                const float p1 = 1.0f / (1.0f + __expf(v0 - v1)), p0 = 1.0f - p1;
                if (lane == 0) { int* te = (int*)(ws + WS_SLOT + SL_TOKE); float* tg = (float*)(ws + WS_SLOT + SL_TOKG); te[2 * m] = e0; te[2 * m + 1] = e1; tg[2 * m] = p0; tg[2 * m + 1] = p1;
                    atomicAdd((int*)&lcnt[e0], 1); atomicAdd((int*)&lcnt[8 + e1], 1); }
            }
        }
        if (MODE == 1) { __syncthreads(); if (tid < 16) { ((int*)(ws + WS_SLOT + SL_BCNT))[rb * 16 + tid] = lcnt[tid]; lcnt[tid] = 0; } __syncthreads(); }
    }
}

__device__ __forceinline__ bf16x8 ld_bf8(const bf16* p) { return *(const bf16x8*)p; }
__device__ __forceinline__ float tanhf_(float x) { const float e = __expf(2.0f * x); return 1.0f - 2.0f / (e + 1.0f); }

__device__ __forceinline__ void rw_shift8(const bf16* z, const float* mu, int m, int tpos, int c, float (&o)[8]) {
    const u32x4 cur = *(const u32x4*)(z + (size_t)m * ZLD + ZC_B + c);
    u32x4 prv = (u32x4){0u, 0u, 0u, 0u}; if (tpos > 0) prv = *(const u32x4*)(z + (size_t)(m - 1) * ZLD + ZC_B + c);
    const f32x4 m0 = *(const f32x4*)(mu + c), m1 = *(const f32x4*)(mu + c + 4);
    float cu[8] = {bflo(cur.x), bfhi(cur.x), bflo(cur.y), bfhi(cur.y), bflo(cur.z), bfhi(cur.z), bflo(cur.w), bfhi(cur.w)};
    float pv[8] = {bflo(prv.x), bfhi(prv.x), bflo(prv.y), bfhi(prv.y), bflo(prv.z), bfhi(prv.z), bflo(prv.w), bfhi(prv.w)};
    float mm[8] = {m0.x, m0.y, m0.z, m0.w, m1.x, m1.y, m1.z, m1.w};
#pragma unroll
    for (int j = 0; j < 8; ++j) o[j] = cu[j] + (pv[j] - cu[j]) * mm[j];
}
__device__ __forceinline__ void rw_shift4(const bf16* z, const float* mu, int m, int tpos, int c, float (&o)[4]) {
    const u32x2 cur = *(const u32x2*)(z + (size_t)m * ZLD + ZC_B + c);
    u32x2 prv = (u32x2){0u, 0u}; if (tpos > 0) prv = *(const u32x2*)(z + (size_t)(m - 1) * ZLD + ZC_B + c);
    const f32x4 m0 = *(const f32x4*)(mu + c);
    o[0] = bflo(cur.x) + (bflo(prv.x) - bflo(cur.x)) * m0.x; o[1] = bfhi(cur.x) + (bfhi(prv.x) - bfhi(cur.x)) * m0.y;
    o[2] = bflo(cur.y) + (bflo(prv.y) - bflo(cur.y)) * m0.z; o[3] = bfhi(cur.y) + (bfhi(prv.y) - bfhi(cur.y)) * m0.w;
}
__device__ __forceinline__ bf16x8 pack8(const float (&x)[8]) {
    u32x4 w; w.x = pk2(x[0], x[1]); w.y = pk2(x[2], x[3]); w.z = pk2(x[4], x[5]); w.w = pk2(x[6], x[7]);
    return __builtin_bit_cast(bf16x8, w);
}

__device__ __forceinline__ void rwkv_prep_tile(const Args& a, int layer, int m0, int lane) {
    unsigned char* ws = a.ws;
    const bf16* z = (const bf16*)(ws + WS_Z);
    const float* mu = INF(IN_RWMU) + (size_t)layer * 1024;
    const bf16* lora = (const bf16*)(ws + WS_LORA) + (size_t)layer * 65536;
    const bf16* wupT = lora; const bf16* aupT = lora + 16384; const bf16* gupT = lora + 32768;
    const int fq = lane >> 4, fr = lane & 15;
    const int m = m0 + fr, tpos = m & (SEQ - 1), bb = m >> 12;
    bf16x8 wdB[2], adB[2], gdB[4];
#pragma unroll
    for (int ks = 0; ks < 2; ++ks) { float x[8]; rw_shift8(z, mu, m, tpos, 768 + 32 * ks + 8 * fq, x);
#pragma unroll
        for (int j = 0; j < 8; ++j) x[j] = tanhf_(x[j]);
        wdB[ks] = pack8(x);
        rw_shift8(z, mu, m, tpos, 832 + 32 * ks + 8 * fq, x); adB[ks] = pack8(x); }
#pragma unroll
    for (int ks = 0; ks < 4; ++ks) { float x[8]; rw_shift8(z, mu, m, tpos, 896 + 32 * ks + 8 * fq, x);
#pragma unroll
        for (int j = 0; j < 8; ++j) x[j] = sigmoidf_(x[j]);
        gdB[ks] = pack8(x); }
    const float* w0p = INF(IN_RWW0) + layer * 256; const float* a0p = INF(IN_RWA0) + layer * 256; const float* kkp = INF(IN_RWKK) + layer * 256;
    const float* kap = INF(IN_RWKA) + layer * 256; const float* rkp = INF(IN_RWRK) + layer * 256;
    float* rec = (float*)(ws + WS_REC); float* gbuf = (float*)(ws + WS_G); float* bonus = (float*)(ws + WS_BONUS);
    float ss = 0.f, bs = 0.f, inv = 0.f;
#pragma unroll 1
    for (int hc = 0; hc < 16; ++hc) {
        const int h = hc >> 2, ct = hc & 3;
        if (ct == 0) {
            ss = 0.f; bs = 0.f;
#pragma unroll
            for (int c2 = 0; c2 < 4; ++c2) { const int c0 = h * 64 + 16 * c2 + 4 * fq; float k4[4]; rw_shift4(z, mu, m, tpos, 256 + c0, k4); const f32x4 k_k = *(const f32x4*)(kkp + c0);
#pragma unroll
                for (int i = 0; i < 4; ++i) { const float kx = k4[i] * k_k[i]; ss += kx * kx; } }
            ss += __shfl_xor(ss, 16); ss += __shfl_xor(ss, 32);
            inv = 1.0f / sqrtf(fmaxf(ss, 1e-24f));
        }
        f32x4 aw = (f32x4){0.f, 0.f, 0.f, 0.f}, aa = aw, ag = aw;
        const int chr = h * 64 + 16 * ct + fr;
#pragma unroll
        for (int ks = 0; ks < 2; ++ks) { const bf16x8 A1 = ld_bf8(wupT + chr * 64 + 32 * ks + 8 * fq), A2 = ld_bf8(aupT + chr * 64 + 32 * ks + 8 * fq);
            aw = __builtin_amdgcn_mfma_f32_16x16x32_bf16(A1, wdB[ks], aw, 0, 0, 0); aa = __builtin_amdgcn_mfma_f32_16x16x32_bf16(A2, adB[ks], aa, 0, 0, 0); }
#pragma unroll
        for (int ks = 0; ks < 4; ++ks) { const bf16x8 A3 = ld_bf8(gupT + chr * 128 + 32 * ks + 8 * fq); ag = __builtin_amdgcn_mfma_f32_16x16x32_bf16(A3, gdB[ks], ag, 0, 0, 0); }
        float* rp = rec + ((size_t)(bb * 4 + h) * SEQ + tpos) * 384;
        const int c0 = h * 64 + 16 * ct + 4 * fq, d0 = 16 * ct + 4 * fq;
        float r4[4], k4[4], v4[4]; rw_shift4(z, mu, m, tpos, c0, r4); rw_shift4(z, mu, m, tpos, 256 + c0, k4); rw_shift4(z, mu, m, tpos, 512 + c0, v4);
        const f32x4 w0 = *(const f32x4*)(w0p + c0), a0 = *(const f32x4*)(a0p + c0), k_k = *(const f32x4*)(kkp + c0), k_a = *(const f32x4*)(kap + c0), r_k = *(const f32x4*)(rkp + c0);
        f32x4 odw, okk, ob, okp;
#pragma unroll
        for (int i = 0; i < 4; ++i) {
            const float wl = w0[i] + aw[i]; const float nx = -wl; const float sp = fmaxf(nx, 0.f) + log1pf(__expf(-fabsf(nx)));
            const float wlog = -sp - 0.5f; odw[i] = __expf(-__expf(wlog));
            const float aval = sigmoidf_(a0[i] + aa[i]);
            const float kkn = k4[i] * k_k[i] * inv; okk[i] = kkn; ob[i] = kkn * aval;
            const float kpv = k4[i] * (1.0f + (aval - 1.0f) * k_a[i]); okp[i] = kpv;
            bs += r4[i] * kpv * r_k[i];
        }
        *(f32x4*)(rp + d0) = odw; *(f32x4*)(rp + 64 + d0) = okk; *(f32x4*)(rp + 128 + d0) = ob; *(f32x4*)(rp + 192 + d0) = okp;
        *(f32x4*)(rp + 256 + d0) = (f32x4){r4[0], r4[1], r4[2], r4[3]}; *(f32x4*)(rp + 320 + d0) = (f32x4){v4[0], v4[1], v4[2], v4[3]};
        *(f32x4*)(gbuf + (size_t)m * 256 + c0) = ag;
        if (ct == 3) { float b2 = bs; b2 += __shfl_xor(b2, 16); b2 += __shfl_xor(b2, 32); if (fq == 0) bonus[(size_t)m * 4 + h] = b2; }
    }
}

__device__ __forceinline__ void nsa_prep_item(const Args& a, LAS unsigned char* lds, int b, int tt) {
    unsigned char* ws = a.ws; const int tid = opaque_tid();
    const bf16* z = (const bf16*)(ws + WS_Z);
    const float* ct = (const float*)(ws + WS_ROPE); const float* st = ct + (size_t)MT * 8;
    const int mb = b * SEQ + tt * 64;
    for (int task = tid; task < 64 * 12; task += NTHR) {
        const int tok = task / 12, unit = task % 12, m = mb + tok;
        const bf16* src; bf16* dst;
        if (unit < 8) { src = z + (size_t)m * ZLD + ZC_Q + unit * 64; dst = (bf16*)(ws + WS_QROT) + (size_t)m * 512 + unit * 64; }
        else if (unit < 10) { src = z + (size_t)m * ZLD + ZC_KS + (unit - 8) * 64; dst = (bf16*)(ws + WS_KSR) + (size_t)m * 128 + (unit - 8) * 64; }
        else { src = z + (size_t)m * ZLD + ZC_KW + (unit - 10) * 64; dst = (bf16*)(ws + WS_KWR) + (size_t)m * 128 + (unit - 10) * 64; }
        u32x4 v[8];
#pragma unroll
        for (int i = 0; i < 8; ++i) v[i] = ((const u32x4*)src)[i];
        const f32x4 c0 = *(const f32x4*)(ct + (size_t)m * 8), c1 = *(const f32x4*)(ct + (size_t)m * 8 + 4), s0 = *(const f32x4*)(st + (size_t)m * 8), s1 = *(const f32x4*)(st + (size_t)m * 8 + 4);
        const float cc[8] = {c0.x, c0.y, c0.z, c0.w, c1.x, c1.y, c1.z, c1.w}, sn[8] = {s0.x, s0.y, s0.z, s0.w, s1.x, s1.y, s1.z, s1.w};
        const float x1[8] = {bflo(v[0].x), bfhi(v[0].x), bflo(v[0].y), bfhi(v[0].y), bflo(v[0].z), bfhi(v[0].z), bflo(v[0].w), bfhi(v[0].w)};
        const float x2[8] = {bflo(v[1].x), bfhi(v[1].x), bflo(v[1].y), bfhi(v[1].y), bflo(v[1].z), bfhi(v[1].z), bflo(v[1].w), bfhi(v[1].w)};
        float o1[8], o2[8];
#pragma unroll
        for (int i = 0; i < 8; ++i) { o1[i] = x1[i] * cc[i] - x2[i] * sn[i]; o2[i] = x1[i] * sn[i] + x2[i] * cc[i]; }
        v[0] = (u32x4){pk2(o1[0], o1[1]), pk2(o1[2], o1[3]), pk2(o1[4], o1[5]), pk2(o1[6], o1[7])};
        v[1] = (u32x4){pk2(o2[0], o2[1]), pk2(o2[2], o2[3]), pk2(o2[4], o2[5]), pk2(o2[6], o2[7])};
#pragma unroll
        for (int i = 0; i < 8; ++i) ((u32x4*)dst)[i] = v[i];
    }
    LAS bf16* tile = (LAS bf16*)lds;
    { const int tok = tid >> 3, ch = tid & 7;
#pragma unroll
      for (int mi = 0; mi < 4; ++mi) { const int col = (mi < 2 ? ZC_VS : ZC_VW) + (mi & 1) * 64;
          *(LAS u32x4*)(tile + mi * 4608 + tok * 72 + ch * 8) = *(const u32x4*)(z + (size_t)(mb + tok) * ZLD + col + ch * 8); } }
    __syncthreads();
    { const int d = tid >> 3, tc = tid & 7;
#pragma unroll
      for (int mi = 0; mi < 4; ++mi) { unsigned e[8];
#pragma unroll
          for (int j = 0; j < 8; ++j) e[j] = tile[mi * 4608 + (tc * 8 + j) * 72 + d];
          u32x4 w; w.x = e[0] | (e[1] << 16); w.y = e[2] | (e[3] << 16); w.z = e[4] | (e[5] << 16); w.w = e[6] | (e[7] << 16);
          bf16* dst = (bf16*)(ws + (mi < 2 ? WS_VST : WS_VWT)) + ((size_t)(b * 2 + (mi & 1)) * 64 + d) * SEQ + tt * 64 + tc * 8;
          *(u32x4*)dst = w; } }
    __syncthreads();
}

__device__ __forceinline__ void nsa_compress_item(const Args& a, int layer, LAS unsigned char* lds, int b, int g, int kv, int nt) {
    unsigned char* ws = a.ws; const int tid = opaque_tid(), lane = tid & 63, wave = __builtin_amdgcn_readfirstlane(tid >> 6), fq = lane >> 4, fr = lane & 15;
    const bf16* z = (const bf16*)(ws + WS_Z);
    const bf16* w1t = (const bf16*)(ws + WS_CW1) + (size_t)(layer * 2 + kv) * 128 * 2048;
    const int colb = (kv ? ZC_VC : ZC_KC) + g * 64;
    f32x4 acc[8];
#pragma unroll
    for (int ht = 0; ht < 8; ++ht) acc[ht] = (f32x4){0.f, 0.f, 0.f, 0.f};
    for (int li = 0; li < 4; ++li) { const int l = wave * 4 + li;
        int tok = 256 * nt + 16 * fr + l; tok = tok > SEQ - 1 ? SEQ - 1 : tok;
#pragma unroll
        for (int hf = 0; hf < 2; ++hf) {
            const bf16x8 B = ld_bf8(z + (size_t)(b * SEQ + tok) * ZLD + colb + 32 * hf + 8 * fq);
#pragma unroll
            for (int ht = 0; ht < 8; ++ht) { const bf16x8 A = ld_bf8(w1t + (size_t)(16 * ht + fr) * 2048 + 64 * l + 32 * hf + 8 * fq);
                acc[ht] = __builtin_amdgcn_mfma_f32_16x16x32_bf16(A, B, acc[ht], 0, 0, 0); } } }
    LAS float* part = (LAS float*)lds;
    LAS float* hid = (LAS float*)(lds + 65536);
#pragma unroll
    for (int ht = 0; ht < 8; ++ht)
#pragma unroll
        for (int r = 0; r < 4; ++r) part[(wave * 128 + 16 * ht + 4 * fq + r) * 16 + fr] = acc[ht][r];
    __syncthreads();
    { const int hh = tid >> 2, nq = tid & 3; f32x4 s = (f32x4){0.f, 0.f, 0.f, 0.f};
#pragma unroll
      for (int w = 0; w < 8; ++w) s = s + *(LAS f32x4*)(part + (w * 128 + hh) * 16 + 4 * nq);
      const float cb = ((const float*)(ws + WS_CBIAS))[(layer * 2 + kv) * 128 + hh];
      f32x4 o; o.x = gelu_tanh(s.x + cb); o.y = gelu_tanh(s.y + cb); o.z = gelu_tanh(s.z + cb); o.w = gelu_tanh(s.w + cb);
      *(LAS f32x4*)(hid + hh * 16 + 4 * nq) = o; }
    __syncthreads();
    { const float* W2 = INF(kv ? IN_VCW2 : IN_KCW2) + (size_t)layer * 128 * 64; const int n = tid & 15, dg = tid >> 4; float o0 = 0.f, o1 = 0.f;
      for (int hh = 0; hh < 128; ++hh) { const float x = hid[hh * 16 + n]; o0 += x * W2[hh * 64 + dg]; o1 += x * W2[hh * 64 + dg + 32]; }
      const int ng = 16 * nt + n; if (ng >= NCMP) { o0 = 0.f; o1 = 0.f; }
      if (kv == 0) { bf16* kc = (bf16*)(ws + WS_KCMP) + ((size_t)(b * 2 + g) * 256 + ng) * 64; kc[dg] = (bf16)f2bf(o0); kc[dg + 32] = (bf16)f2bf(o1); }
      else { bf16* vc = (bf16*)(ws + WS_VCMPT) + (size_t)(b * 2 + g) * 64 * 256; vc[(size_t)dg * 256 + ng] = (bf16)f2bf(o0); vc[(size_t)(dg + 32) * 256 + ng] = (bf16)f2bf(o1); } }
    __syncthreads();
}

__device__ __forceinline__ void phase_prep(const Args& a, int layer, LAS unsigned char* lds) {
    const int tid = opaque_tid(), lane = tid & 63, wave = __builtin_amdgcn_readfirstlane(tid >> 6);
#ifndef NO_RWP
    if (wave < 4) for (int tile = blockIdx.x * 4 + wave; tile < MT / 16; tile += gridDim.x * 4) rwkv_prep_tile(a, layer, tile * 16, lane);
#endif
#ifndef NO_NSAP
    for (int it = blockIdx.x; it < NB * 64; it += gridDim.x) nsa_prep_item(a, lds, it >> 6, it & 63);
#endif
#ifndef NO_CMP
    for (int it = blockIdx.x; it < NB * 2 * 2 * 16; it += gridDim.x) nsa_compress_item(a, layer, lds, it >> 6, (it >> 5) & 1, (it >> 4) & 1, it & 15);
#endif
}

__device__ __forceinline__ float dpp_xor1(float x) { return __builtin_bit_cast(float, __builtin_amdgcn_update_dpp(0, __builtin_bit_cast(int, x), 0xB1, 0xf, 0xf, true)); }
__device__ __forceinline__ float dpp_xor2(float x) { return __builtin_bit_cast(float, __builtin_amdgcn_update_dpp(0, __builtin_bit_cast(int, x), 0x4E, 0xf, 0xf, true)); }
__device__ __forceinline__ float dpp_hmir(float x) { return __builtin_bit_cast(float, __builtin_amdgcn_update_dpp(0, __builtin_bit_cast(int, x), 0x141, 0xf, 0xf, true)); }
__device__ __forceinline__ float red8(float x) { x += dpp_xor1(x); x += dpp_xor2(x); x += dpp_hmir(x); return x; }

__device__ __forceinline__ void rwkv_scan(const Args& a, LAS unsigned char* lds, int bh) {
    unsigned char* ws = a.ws; const int tid = opaque_tid(), lane = tid & 63, wave = __builtin_amdgcn_readfirstlane(tid >> 6);
    const int row = wave * 8 + (lane >> 3), kq = lane & 7;
    const f32x4* rec4 = (const f32x4*)(ws + WS_REC) + (size_t)bh * SEQ * 96;
    float* yraw = (float*)(ws + WS_YRAW) + (size_t)(bh >> 2) * SEQ * 256 + (bh & 3) * 64 + row;
    LAS f32x4* buf = (LAS f32x4*)lds;
    float s[8];
#pragma unroll
    for (int j = 0; j < 8; ++j) s[j] = 0.f;
    { f32x4 p0 = rec4[tid], p1 = rec4[tid + 512], p2 = rec4[tid + 1024]; buf[tid] = p0; buf[tid + 512] = p1; buf[tid + 1024] = p2; }
    __syncthreads();
    for (int c = 0; c < SEQ / 16; ++c) {
        const int p = c & 1;
        f32x4 n0, n1, n2; const bool more = (c + 1 < SEQ / 16);
        if (more) { const f32x4* src = rec4 + (size_t)(c + 1) * 1536; n0 = src[tid]; n1 = src[tid + 512]; n2 = src[tid + 1024]; }
        const LAS f32x4* bp = buf + p * 1536;
#pragma unroll 4
        for (int st = 0; st < 16; ++st) {
            const LAS f32x4* sp = bp + st * 96;
            const f32x4 w0 = sp[2 * kq], w1 = sp[2 * kq + 1], k0 = sp[16 + 2 * kq], k1 = sp[16 + 2 * kq + 1], b0 = sp[32 + 2 * kq], b1 = sp[32 + 2 * kq + 1];
            const f32x4 q0 = sp[48 + 2 * kq], q1 = sp[48 + 2 * kq + 1], r0 = sp[64 + 2 * kq], r1 = sp[64 + 2 * kq + 1];
            const float vv = ((const LAS float*)(sp + 80))[row];
            const float wv[8] = {w0.x, w0.y, w0.z, w0.w, w1.x, w1.y, w1.z, w1.w}, kk[8] = {k0.x, k0.y, k0.z, k0.w, k1.x, k1.y, k1.z, k1.w};
            const float bv[8] = {b0.x, b0.y, b0.z, b0.w, b1.x, b1.y, b1.z, b1.w}, kp[8] = {q0.x, q0.y, q0.z, q0.w, q1.x, q1.y, q1.z, q1.w};
            const float rr[8] = {r0.x, r0.y, r0.z, r0.w, r1.x, r1.y, r1.z, r1.w};
            float d1 = (s[0] * kk[0] + s[1] * kk[1]) + (s[2] * kk[2] + s[3] * kk[3]) + ((s[4] * kk[4] + s[5] * kk[5]) + (s[6] * kk[6] + s[7] * kk[7]));
            d1 = red8(d1);
            const float sa = -d1;
            float d2 = 0.f;
#pragma unroll
            for (int j = 0; j < 8; ++j) { s[j] = s[j] * wv[j] + (sa * bv[j] + vv * kp[j]); d2 += s[j] * rr[j]; }
            d2 = red8(d2);
            if (kq == 0) yraw[(size_t)(c * 16 + st) * 256] = d2;
        }
        if (more) { LAS f32x4* dp = buf + (p ^ 1) * 1536; dp[tid] = n0; dp[tid + 512] = n1; dp[tid + 1024] = n2; }
        __syncthreads();
    }
}

__device__ __forceinline__ void phase_rwpost(const Args& a, int layer) {
    unsigned char* ws = a.ws; const int tid = opaque_tid();
    const float* yraw = (const float*)(ws + WS_YRAW); const float* gbuf = (const float*)(ws + WS_G); const float* bonus = (const float*)(ws + WS_BONUS); const float* rec = (const float*)(ws + WS_REC);
    const float* gng = INF(IN_RWGNG) + layer * 256; const float* gnb = INF(IN_RWGNB) + layer * 256;
    bf16* ycat = (bf16*)(ws + WS_YCAT);
    const size_t total = (size_t)MT * 64;
    for (size_t i = (size_t)blockIdx.x * NTHR + tid; i < total; i += (size_t)gridDim.x * NTHR) {
        const int m = (int)(i >> 6), c0 = (int)(i & 63) * 4, h = c0 >> 6, bb = m >> 12, tpos = m & (SEQ - 1);
        const f32x4 y = *(const f32x4*)(yraw + (size_t)m * 256 + c0);
        float s = (y.x + y.y) + (y.z + y.w);
        s += __shfl_xor(s, 1); s += __shfl_xor(s, 2); s += __shfl_xor(s, 4); s += __shfl_xor(s, 8);
        const float mean = s * (1.0f / 64.0f);
        const f32x4 d = y - mean; float q = (d.x * d.x + d.y * d.y) + (d.z * d.z + d.w * d.w);
        q += __shfl_xor(q, 1); q += __shfl_xor(q, 2); q += __shfl_xor(q, 4); q += __shfl_xor(q, 8);
        const float rstd = 1.0f / sqrtf(q * (1.0f / 64.0f) + 64e-5f);
        const f32x4 gg = *(const f32x4*)(gng + c0), gb = *(const f32x4*)(gnb + c0), gt = *(const f32x4*)(gbuf + (size_t)m * 256 + c0);
        const f32x4 vv = *(const f32x4*)(rec + ((size_t)(bb * 4 + h) * SEQ + tpos) * 384 + 320 + (c0 & 63));
        const float bo = bonus[(size_t)m * 4 + h];
        f32x4 o = (d * rstd * gg + gb + vv * bo) * gt;
        u32x2 w; w.x = pk2(o.x, o.y); w.y = pk2(o.z, o.w);
        *(u32x2*)(ycat + (size_t)m * DM + 256 + c0) = w;
    }
}

__device__ __forceinline__ void gmlp_item(const Args& a, int layer, LAS unsigned char* lds, int b, int n, int h) {
    unsigned char* ws = a.ws; const int tid = opaque_tid(), lane = tid & 63, wave = __builtin_amdgcn_readfirstlane(tid >> 6), fq = lane >> 4, fr = lane & 15;
    const bf16* z = (const bf16*)(ws + WS_Z); bf16* ycat = (bf16*)(ws + WS_YCAT);
    LAS bf16* vt = (LAS bf16*)lds;
    const int mb = b * SEQ + n * 128;
    { const int s = tid >> 2, part = tid & 3; const bf16* src = z + (size_t)(mb + s) * ZLD + ZC_V + h * 64 + part * 16;
      const u32x4 v0 = ((const u32x4*)src)[0], v1 = ((const u32x4*)src)[1];
      float x[16] = {bflo(v0.x), bfhi(v0.x), bflo(v0.y), bfhi(v0.y), bflo(v0.z), bfhi(v0.z), bflo(v0.w), bfhi(v0.w), bflo(v1.x), bfhi(v1.x), bflo(v1.y), bfhi(v1.y), bflo(v1.z), bfhi(v1.z), bflo(v1.w), bfhi(v1.w)};
      float sm = 0.f;
#pragma unroll
      for (int j = 0; j < 16; ++j) { x[j] = gelu_tanh(x[j]); sm += x[j]; }
      sm += __shfl_xor(sm, 1); sm += __shfl_xor(sm, 2);
      const float mean = sm * (1.0f / 64.0f); float q = 0.f;
#pragma unroll
      for (int j = 0; j < 16; ++j) { x[j] -= mean; q += x[j] * x[j]; }
      q += __shfl_xor(q, 1); q += __shfl_xor(q, 2);
      const float rstd = 1.0f / sqrtf(q * (1.0f / 64.0f) + 1e-5f);
      const float* lg = INF(IN_GMLNG) + (layer * 4 + h) * 64 + part * 16; const float* lb = INF(IN_GMLNB) + (layer * 4 + h) * 64 + part * 16;
#pragma unroll
      for (int j = 0; j < 16; ++j) vt[(part * 16 + j) * 136 + s] = (bf16)f2bf(x[j] * rstd * lg[j] + lb[j]); }
    __syncthreads();
    {
        const float* W = INF(IN_GMWS) + ((size_t)(layer * 4 + h) * 128 + 16 * wave + fr) * 128;
        f32x4 acc[4];
#pragma unroll
        for (int dt = 0; dt < 4; ++dt) acc[dt] = (f32x4){0.f, 0.f, 0.f, 0.f};
        const int trow = 16 * wave + fr; const int nks = (wave >> 1) + 1;
        for (int ks = 0; ks < nks; ++ks) {
            const int s0 = 32 * ks + 8 * fq; const f32x4 wa = *(const f32x4*)(W + s0), wb = *(const f32x4*)(W + s0 + 4);
            float wv[8] = {wa.x, wa.y, wa.z, wa.w, wb.x, wb.y, wb.z, wb.w};
#pragma unroll
            for (int j = 0; j < 8; ++j) wv[j] = (s0 + j <= trow) ? wv[j] : 0.f;
            const bf16x8 A = pack8(wv);
#pragma unroll
            for (int dt = 0; dt < 4; ++dt) { const bf16x8 B = *(const LAS bf16x8*)(vt + (16 * dt + fr) * 136 + s0); acc[dt] = __builtin_amdgcn_mfma_f32_16x16x32_bf16(A, B, acc[dt], 0, 0, 0); } }
        const float* bs = INF(IN_GMBS) + (layer * 4 + h) * 128;
#pragma unroll
        for (int r = 0; r < 4; ++r) { const int t = 16 * wave + 4 * fq + r; const float bias = bs[t];
#pragma unroll
            for (int dt = 0; dt < 4; ++dt) { const int d = 16 * dt + fr; const float u = gelu_tanh(bf2f(z[(size_t)(mb + t) * ZLD + ZC_U + h * 64 + d]));
                ycat[(size_t)(mb + t) * DM + h * 64 + d] = (bf16)f2bf(u * (acc[dt][r] + bias)); } }
    }
    __syncthreads();
}

constexpr int NSA_KB = 0, NSA_VB = 18432, NSA_IMP = 36864, NSA_SELM = 53248, NSA_UNI = 53760, NSA_OT = 54272;
struct NsaTileSrc { const bf16* kbase; int kld; const bf16* vbase; int vld; };

__device__ __forceinline__ void nsa_tile_load(const NsaTileSrc& S, int kb, int tid, u32x4& kr, u32x4& vr) {
    const int row = tid >> 3, ch = tid & 7;
    kr = *(const u32x4*)(S.kbase + (size_t)(kb * 64 + row) * S.kld + ch * 8);
    vr = *(const u32x4*)(S.vbase + (size_t)row * S.vld + kb * 64 + ch * 8);
}
__device__ __forceinline__ void nsa_tile_store(LAS unsigned char* lds, int p, int tid, const u32x4& kr, const u32x4& vr) {
    const int row = tid >> 3, ch = tid & 7;
    *(LAS u32x4*)(lds + NSA_KB + p * 9216 + (row * 72 + ch * 8) * 2) = kr;
    *(LAS u32x4*)(lds + NSA_VB + p * 9216 + (row * 72 + ch * 8) * 2) = vr;
}
__device__ __forceinline__ void nsa_scores(LAS unsigned char* lds, int p, const bf16x8 (&Q)[2][2], f32x4 (&sc)[4][2], int fq, int fr) {
#pragma unroll
    for (int kt = 0; kt < 4; ++kt) {
        const LAS unsigned char* kp = lds + NSA_KB + p * 9216 + ((16 * kt + fr) * 72 + 8 * fq) * 2;
        const bf16x8 K0 = *(const LAS bf16x8*)kp, K1 = *(const LAS bf16x8*)(kp + 64);
#pragma unroll
        for (int qg = 0; qg < 2; ++qg) { f32x4 c = (f32x4){0.f, 0.f, 0.f, 0.f};
            c = __builtin_amdgcn_mfma_f32_16x16x32_bf16(K0, Q[qg][0], c, 0, 0, 0); c = __builtin_amdgcn_mfma_f32_16x16x32_bf16(K1, Q[qg][1], c, 0, 0, 0); sc[kt][qg] = c; } }
}
template <int MODE>
__device__ __forceinline__ bool nsa_allowed(int kidx, int t, int kb, unsigned long long selm) {
    if (MODE == 0) return (16 * kidx + 31 <= t) && (kidx < NCMP);
    if (MODE == 1) return (kidx <= t) && ((selm >> kb) & 1ull);
    return (kidx <= t) && (kidx + 512 > t);
}
template <int MODE>
__device__ __forceinline__ void nsa_tile_compute(LAS unsigned char* lds, int p, int kb, const bf16x8 (&Q)[2][2], const int (&tq)[2], const unsigned long long (&selm)[2],
                                                 float (&m_run)[2], float (&l_run)[2], f32x4 (&O)[4][2], int fq, int fr) {
    f32x4 sc[4][2];
    nsa_scores(lds, p, Q, sc, fq, fr);
    const float SC = 0.125f * 1.4426950408889634f;
    bf16x8 P[2][2];
#pragma unroll
    for (int qg = 0; qg < 2; ++qg) {
        float mx = -1e30f;
#pragma unroll
        for (int kt = 0; kt < 4; ++kt)
#pragma unroll
            for (int r = 0; r < 4; ++r) { const int kidx = kb * 64 + 16 * kt + 4 * fq + r;
                const float v = nsa_allowed<MODE>(kidx, tq[qg], kb, selm[qg]) ? sc[kt][qg][r] * SC : -1e30f; sc[kt][qg][r] = v; mx = fmaxf(mx, v); }
        mx = fmaxf(mx, __shfl_xor(mx, 16)); mx = fmaxf(mx, __shfl_xor(mx, 32));
        const float mn = fmaxf(m_run[qg], mx); const float alpha = __builtin_amdgcn_exp2f(m_run[qg] - mn); m_run[qg] = mn;
        float ls = 0.f; float pv[4][4];
#pragma unroll
        for (int kt = 0; kt < 4; ++kt)
#pragma unroll
            for (int r = 0; r < 4; ++r) { const float sv = sc[kt][qg][r]; const float e = (sv > -1e29f) ? __builtin_amdgcn_exp2f(sv - mn) : 0.f; pv[kt][r] = e; ls += e; }
        l_run[qg] = l_run[qg] * alpha + ls;
#pragma unroll
        for (int dt = 0; dt < 4; ++dt) O[dt][qg] = O[dt][qg] * alpha;
#pragma unroll
        for (int s = 0; s < 2; ++s) { u32x4 w; w.x = pk2(pv[2 * s][0], pv[2 * s][1]); w.y = pk2(pv[2 * s][2], pv[2 * s][3]); w.z = pk2(pv[2 * s + 1][0], pv[2 * s + 1][1]); w.w = pk2(pv[2 * s + 1][2], pv[2 * s + 1][3]);
            P[qg][s] = __builtin_bit_cast(bf16x8, w); }
    }
#pragma unroll
    for (int dt = 0; dt < 4; ++dt)
#pragma unroll
        for (int s = 0; s < 2; ++s) {
            const LAS unsigned char* vp = lds + NSA_VB + p * 9216 + ((16 * dt + fr) * 72 + 32 * s + 4 * fq) * 2;
            const u32x2 a0 = *(const LAS u32x2*)vp, a1 = *(const LAS u32x2*)(vp + 32);
            const u32x4 aw = (u32x4){a0.x, a0.y, a1.x, a1.y}; const bf16x8 A = __builtin_bit_cast(bf16x8, aw);
#pragma unroll
            for (int qg = 0; qg < 2; ++qg) O[dt][qg] = __builtin_amdgcn_mfma_f32_16x16x32_bf16(A, P[qg][s], O[dt][qg], 0, 0, 0);
        }
}

template <int MODE>
__device__ __forceinline__ void nsa_branch(LAS unsigned char* lds, const NsaTileSrc& S, int kb_lo, int kb_hi, unsigned long long tilemask, const bf16x8 (&Q)[2][2], const int (&tq)[2],
                                           const unsigned long long (&selm)[2], const float (&gate)[2], const bool first, float (&m_out)[2], float (&l_out)[2], int tid, int fq, int fr) {
    float m_run[2] = {-1e30f, -1e30f}, l_run[2] = {0.f, 0.f}; f32x4 O[4][2];
#pragma unroll
    for (int dt = 0; dt < 4; ++dt)
#pragma unroll
        for (int qg = 0; qg < 2; ++qg) O[dt][qg] = (f32x4){0.f, 0.f, 0.f, 0.f};
    int cur = kb_lo; while (cur <= kb_hi && !((tilemask >> cur) & 1ull)) ++cur;
    if (cur <= kb_hi) {
        u32x4 kr, vr; nsa_tile_load(S, cur, tid, kr, vr); nsa_tile_store(lds, 0, tid, kr, vr);
        __syncthreads();
        int p = 0;
        while (cur <= kb_hi) {
            int nxt = cur + 1; while (nxt <= kb_hi && !((tilemask >> nxt) & 1ull)) ++nxt;
            if (nxt <= kb_hi) nsa_tile_load(S, nxt, tid, kr, vr);
            nsa_tile_compute<MODE>(lds, p, cur, Q, tq, selm, m_run, l_run, O, fq, fr);
            if (nxt <= kb_hi) nsa_tile_store(lds, p ^ 1, tid, kr, vr);
            __syncthreads();
            p ^= 1; cur = nxt;
        }
    }
#pragma unroll
    for (int qg = 0; qg < 2; ++qg) { float l = l_run[qg]; l += __shfl_xor(l, 16); l += __shfl_xor(l, 32); l_out[qg] = l; m_out[qg] = m_run[qg];
        const float sc = l > 0.f ? gate[qg] / l : 0.f;
        LAS float* ot = (LAS float*)(lds + NSA_OT) + tid;
#pragma unroll
        for (int dt = 0; dt < 4; ++dt)
#pragma unroll
            for (int r = 0; r < 4; ++r) { LAS float* pp = ot + ((dt * 2 + qg) * 4 + r) * 512; const float v = O[dt][qg][r] * sc; *pp = first ? v : (*pp + v); } }
}

__device__ __forceinline__ void nsa_item(const Args& a, LAS unsigned char* lds, int b, int g, int T) {
    unsigned char* ws = a.ws; const int tid = opaque_tid(), lane = tid & 63, wave = __builtin_amdgcn_readfirstlane(tid >> 6), fq = lane >> 4, fr = lane & 15;
    const bf16* z = (const bf16*)(ws + WS_Z);
    const int head = g * 4 + (fr & 3);
    int tq[2], mq[2]; bf16x8 Qraw[2][2]; float gt[2][3];
#pragma unroll
    for (int qg = 0; qg < 2; ++qg) { const int tl = 8 * wave + 4 * qg + (fr >> 2); tq[qg] = T * 64 + tl; mq[qg] = b * SEQ + tq[qg];
#pragma unroll
        for (int ks = 0; ks < 2; ++ks) Qraw[qg][ks] = ld_bf8(z + (size_t)mq[qg] * ZLD + ZC_Q + head * 64 + 32 * ks + 8 * fq);
#pragma unroll
        for (int br = 0; br < 3; ++br) gt[qg][br] = sigmoidf_(bf2f(z[(size_t)mq[qg] * ZLD + ZC_GT + head * 3 + br])); }
    if (tid < 64) { ((LAS unsigned long long*)(lds + NSA_SELM))[tid] = 0ull; if (tid < 2) ((LAS unsigned*)(lds + NSA_UNI))[tid] = 0u; }
    const unsigned long long nosel[2] = {0ull, 0ull};
    NsaTileSrc SC_; SC_.kbase = (const bf16*)(ws + WS_KCMP) + (size_t)(b * 2 + g) * 256 * 64; SC_.kld = 64; SC_.vbase = (const bf16*)(ws + WS_VCMPT) + (size_t)(b * 2 + g) * 64 * 256; SC_.vld = 256;
    float mc[2], lc[2];
    { float gc[2] = {gt[0][0], gt[1][0]};
      nsa_branch<0>(lds, SC_, 0, 3, ~0ull, Qraw, tq, nosel, gc, true, mc, lc, tid, fq, fr); }
    {
        LAS float* imp = (LAS float*)(lds + NSA_IMP);
        float carry[2] = {0.f, 0.f}; const float SCL = 0.125f * 1.4426950408889634f;
        float invl[2] = {lc[0] > 0.f ? 1.0f / lc[0] : 0.f, lc[1] > 0.f ? 1.0f / lc[1] : 0.f};
        for (int kb = 0; kb < 4; ++kb) {
            { const int row = tid >> 3, ch = tid & 7; *(LAS u32x4*)(lds + NSA_KB + (row * 72 + ch * 8) * 2) = *(const u32x4*)(SC_.kbase + (size_t)(kb * 64 + row) * 64 + ch * 8); }
            __syncthreads();
            f32x4 sc[4][2]; nsa_scores(lds, 0, Qraw, sc, fq, fr);
#pragma unroll
            for (int kt = 0; kt < 4; ++kt)
#pragma unroll
                for (int qg = 0; qg < 2; ++qg) { float pn[4];
#pragma unroll
                    for (int r = 0; r < 4; ++r) { const int kidx = kb * 64 + 16 * kt + 4 * fq + r; const bool al = nsa_allowed<0>(kidx, tq[qg], kb, 0ull);
                        pn[r] = al ? __builtin_amdgcn_exp2f(sc[kt][qg][r] * SCL - mc[qg]) * invl[qg] : 0.f; }
                    const float y = __shfl(pn[3], (lane + 48) & 63);
                    float v = (pn[0] + pn[1]) + (pn[2] + pn[3]) + (fq == 0 ? carry[qg] : y); carry[qg] = y;
                    v += __shfl_xor(v, 1); v += __shfl_xor(v, 2);
                    if ((fr & 3) == 0) imp[(8 * wave + 4 * qg + (fr >> 2)) * 64 + 16 * kb + 4 * kt + fq] = v; }
            __syncthreads();
        }
    }
    {
        const LAS float* imp = (const LAS float*)(lds + NSA_IMP);
        const int tl = tid >> 3, part = tid & 7; float vm[8]; int cnt[8];
        { const f32x4 x0 = *(const LAS f32x4*)(imp + tl * 64 + part * 8), x1 = *(const LAS f32x4*)(imp + tl * 64 + part * 8 + 4);
          const float xx[8] = {x0.x, x0.y, x0.z, x0.w, x1.x, x1.y, x1.z, x1.w};
#pragma unroll
          for (int j = 0; j < 8; ++j) { const int mi = part * 8 + j; const bool valid = mi <= T; const bool forced = (mi == 0) || (mi == T) || (mi == T - 1);
              vm[j] = valid ? xx[j] + (forced ? 1e4f : 0.f) : -1e4f; cnt[j] = 0; } }
        for (int q4 = 0; q4 < 16; ++q4) { const f32x4 x = *(const LAS f32x4*)(imp + tl * 64 + 4 * q4); const float xq[4] = {x.x, x.y, x.z, x.w};
#pragma unroll
            for (int i = 0; i < 4; ++i) { const int q = 4 * q4 + i; const bool valid = q <= T; const bool forced = (q == 0) || (q == T) || (q == T - 1);
                const float vq = valid ? xq[i] + (forced ? 1e4f : 0.f) : -1e4f;
#pragma unroll
                for (int j = 0; j < 8; ++j) { const int mi = part * 8 + j; cnt[j] += (vq > vm[j] || (vq == vm[j] && q < mi)) ? 1 : 0; } } }
        unsigned bits = 0u;
#pragma unroll
        for (int j = 0; j < 8; ++j) if (cnt[j] < 16 && vm[j] > -5000.f) bits |= 1u << j;
        atomicOr((unsigned*)(lds + NSA_SELM) + tl * 2 + (part >> 2), bits << (8 * (part & 3)));
        atomicOr((unsigned*)(lds + NSA_UNI) + (part >> 2), bits << (8 * (part & 3)));
    }
    __syncthreads();
    bf16x8 Qrot[2][2];
#pragma unroll
    for (int qg = 0; qg < 2; ++qg)
#pragma unroll
        for (int ks = 0; ks < 2; ++ks) Qrot[qg][ks] = ld_bf8((const bf16*)(ws + WS_QROT) + (size_t)mq[qg] * 512 + head * 64 + 32 * ks + 8 * fq);
    unsigned long long selm[2], uni;
    { const LAS unsigned long long* sm = (const LAS unsigned long long*)(lds + NSA_SELM); selm[0] = sm[8 * wave + (fr >> 2)]; selm[1] = sm[8 * wave + 4 + (fr >> 2)]; const LAS unsigned* up = (const LAS unsigned*)(lds + NSA_UNI); uni = ((unsigned long long)(unsigned)__builtin_amdgcn_readfirstlane(up[1]) << 32) | (unsigned)__builtin_amdgcn_readfirstlane(up[0]); }
    { NsaTileSrc SS; SS.kbase = (const bf16*)(ws + WS_KSR) + (size_t)b * SEQ * 128 + g * 64; SS.kld = 128; SS.vbase = (const bf16*)(ws + WS_VST) + (size_t)(b * 2 + g) * 64 * SEQ; SS.vld = SEQ;
      float gs[2] = {gt[0][1], gt[1][1]}, mo[2], lo[2];
      nsa_branch<1>(lds, SS, 0, T, uni, Qrot, tq, selm, gs, false, mo, lo, tid, fq, fr); }
    { NsaTileSrc SW; SW.kbase = (const bf16*)(ws + WS_KWR) + (size_t)b * SEQ * 128 + g * 64; SW.kld = 128; SW.vbase = (const bf16*)(ws + WS_VWT) + (size_t)(b * 2 + g) * 64 * SEQ; SW.vld = SEQ;
      float gw_[2] = {gt[0][2], gt[1][2]}, mo[2], lo[2]; const int lo_kb = T >= 8 ? T - 8 : 0;
      nsa_branch<2>(lds, SW, lo_kb, T, ~0ull, Qrot, tq, nosel, gw_, false, mo, lo, tid, fq, fr); }
    bf16* ycat = (bf16*)(ws + WS_YCAT);
#pragma unroll
    for (int qg = 0; qg < 2; ++qg)
#pragma unroll
        for (int dt = 0; dt < 4; ++dt) { const LAS float* ot = (const LAS float*)(lds + NSA_OT) + tid + ((dt * 2 + qg) * 4) * 512;
            u32x2 w; w.x = pk2(ot[0], ot[512]); w.y = pk2(ot[1024], ot[1536]);
            *(u32x2*)(ycat + (size_t)mq[qg] * DM + 512 + head * 64 + 16 * dt + 4 * fq) = w; }
}

struct MoeOrder {
    const char* A; const char* W; size_t estride; int K, nct, G, c; int tst[9];
    __device__ bool next(int i, pg8::Unit& u) const {
        const long L = (long)i * G + c; if (L >= (long)tst[8] * nct) return false;
        const int rt = (int)(L / nct), ct = (int)(L % nct); int e = 0;
#pragma unroll
        for (int j = 1; j < 8; ++j) e += (rt >= tst[j]) ? 1 : 0;
        u.pm = rt; u.pn = ct; u.aux = e; return true;
    }
    __device__ __forceinline__ const char* abase(const pg8::Unit& u) const { return A + (size_t)u.pm * ((size_t)256 * K * 2); }
    __device__ __forceinline__ const char* bbase(const pg8::Unit& u) const { return W + (size_t)u.aux * estride + (size_t)u.pn * ((size_t)256 * K * 2); }
};
__device__ __forceinline__ void moe_order_init(MoeOrder& S, const Args& a, int rank, const void* A, const void* W, size_t estride, int K, int nct) {
    S.A = (const char*)A; S.W = (const char*)W; S.estride = estride; S.K = K; S.nct = nct; S.G = gridDim.x; S.c = blockIdx.x;
    const int* t = (const int*)(a.ws + WS_SLOT + SL_TST) + rank * 16;
#pragma unroll
    for (int j = 0; j < 9; ++j) S.tst[j] = __builtin_amdgcn_readfirstlane(t[j]);
}
__device__ __forceinline__ void moe_gather(const Args& a, int rb, int r) {
    unsigned char* ws = a.ws; const int tid = opaque_tid();
    const int* toks = (const int*)(ws + WS_SLOT + SL_TOKS);
    const u32x4* hn = (const u32x4*)(ws + WS_HN); u32x4* hns = (u32x4*)(ws + WS_HNS);
    for (int i = tid; i < 64 * 128; i += NTHR) { const int tl = i >> 7, ch = i & 127, m = rb * 64 + tl; const int slot = toks[2 * m + r];
        hns[(size_t)slot * 128 + ch] = hn[(size_t)m * 128 + ch]; }
}
__device__ __forceinline__ void phase_moe_assign(const Args& a, LAS unsigned char* lds) {
    unsigned char* ws = a.ws; const int tid = opaque_tid(), lane = tid & 63, wave = __builtin_amdgcn_readfirstlane(tid >> 6);
    LAS int* cn = (LAS int*)lds;
    LAS int* tot = cn + 4096; LAS int* base = tot + 16; LAS int* pre = base + 16;
    const int* bcnt = (const int*)(ws + WS_SLOT + SL_BCNT);
    for (int i = tid; i < 4096; i += NTHR) cn[i] = bcnt[i];
    __syncthreads();
    if (tid < 16) { int s = 0; for (int bb = 0; bb < 256; ++bb) s += cn[bb * 16 + tid]; tot[tid] = s; }
    __syncthreads();
    if (tid < 2) { int run = 0; int* tstg = (int*)(ws + WS_SLOT + SL_TST) + tid * 16;
        for (int e = 0; e < 8; ++e) { base[tid * 8 + e] = run * 256; if (blockIdx.x == 0) tstg[e] = run; run += (tot[tid * 8 + e] + 255) >> 8; }
        if (blockIdx.x == 0) tstg[8] = run; }
    __syncthreads();
    int* stok = (int*)(ws + WS_SLOT + SL_TOK); float* sgate = (float*)(ws + WS_SLOT + SL_GATE);
    if (blockIdx.x == 0) {
        for (int grp = 0; grp < 16; ++grp) { const int r = grp >> 3, lo = base[grp] + tot[grp], hi = base[grp] + (((tot[grp] + 255) >> 8) << 8);
            for (int s = lo + tid; s < hi; s += NTHR) { stok[r * MOE_SLOTS + s] = -1; sgate[r * MOE_SLOTS + s] = 0.f; } }
    }
    const int* te = (const int*)(ws + WS_SLOT + SL_TOKE); const float* tg = (const float*)(ws + WS_SLOT + SL_TOKG); int* toks = (int*)(ws + WS_SLOT + SL_TOKS);
    for (int rb = blockIdx.x; rb < MT / 64; rb += gridDim.x) {
        __syncthreads();
        if (tid < 16) { int s = 0; for (int bb = 0; bb < rb; ++bb) s += cn[bb * 16 + tid]; pre[tid] = s; }
        __syncthreads();
        if (wave == 0) { const int m = rb * 64 + lane;
#pragma unroll
            for (int r = 0; r < 2; ++r) { const int e = te[2 * m + r]; int slot = 0;
#pragma unroll
                for (int ee = 0; ee < 8; ++ee) { const unsigned long long mk = __ballot(e == ee); const int rk = __popcll(mk & ((1ull << lane) - 1ull)); if (e == ee) slot = base[r * 8 + ee] + pre[r * 8 + ee] + rk; }
                stok[r * MOE_SLOTS + slot] = m; sgate[r * MOE_SLOTS + slot] = tg[2 * m + r]; toks[2 * m + r] = slot; } }
        asm volatile("s_waitcnt vmcnt(0)" ::: "memory");
        __syncthreads();
        moe_gather(a, rb, 0);
    }
}
__device__ __forceinline__ void moe_convert_weights(const Args& a, LAS unsigned char* lds) {
    const int tid = opaque_tid(), lane = tid & 63, wave = __builtin_amdgcn_readfirstlane(tid >> 6);
    const int gw = blockIdx.x * NWAVES + wave, NGW = gridDim.x * NWAVES; LAS float* scr = (LAS float*)(lds + 1024 + wave * 16384);
    for (int e = 0; e < NEXP; ++e) {
        conv_matrix(INF(IN_MW1) + (size_t)e * DM * DFF, DM, DFF, (bf16*)(a.ws + WS_MW13) + (size_t)e * 5632 * DM, 1, gw, NGW, scr, lane);
        conv_matrix(INF(IN_MW3) + (size_t)e * DM * DFF, DM, DFF, (bf16*)(a.ws + WS_MW13) + (size_t)e * 5632 * DM, 2, gw, NGW, scr, lane);
        conv_matrix(INF(IN_MW2) + (size_t)e * DFF * DM, DFF, DM, (bf16*)(a.ws + WS_MW2) + (size_t)e * DM * DFF, 0, gw, NGW, scr, lane);
    }
}

constexpr int NPL = 14, NPHASES = 1 + 2 * NPL;
__host__ __device__ constexpr bool phase_empty(int k) { return k >= 1 && k < 1 + NPL && ((k - 1) >= 8 && (k - 1) <= 10); }

__global__ void __launch_bounds__(NTHR, 2) hybrid_fwd(Args a) {
    extern __shared__ __attribute__((aligned(16))) unsigned char lds_raw[];
    LAS unsigned char* lds = (LAS unsigned char*)lds_raw;
    volatile LAS unsigned* MISC = (volatile LAS unsigned*)(lds + MISC_OFF);
    const int tid = opaque_tid();
    unsigned char* ws = a.ws; unsigned* ctl = (unsigned*)(ws + WS_CTL);
    for (int u = tid; u < (LDS_BYTES - MISC_OFF) / 4; u += NTHR) MISC[u] = 0u;
    __syncthreads();
    if (tid < N_INPUTS) *(LAS unsigned long long*)(lds + PTAB_OFF + 8 * tid) = (unsigned long long)a.in[tid];
    __syncthreads();
    const int lo = a.ph_lo, hi = a.ph_hi;
    const bool multi = (hi - lo) > 1;
    XcdBarrier bar; bar.bar = ctl + CW_BAR; bar.x = 0; bar.st = nullptr;
    if (multi) bar = xcd_barrier_post(ctl + CW_BAR, MISC + 8);
#ifndef PHSEL
#define PHSEL -1
#endif
#define IN(k) (lo <= (k) && (k) < hi)
#define INL(j) ((PHSEL == -1 || PHSEL == (j)) && IN(pb + (j)))
#define SEAM(k) do { if ((k) + 1 < hi) xcd_barrier(bar); } while (0)
    const int G = gridDim.x, bx = blockIdx.x;

    if ((PHSEL == -1 || PHSEL == 100) && IN(0)) { phase_prologue(a, lds); SEAM(0); }

    for (int l = 0; l < 2; ++l) {
        const int pb = 1 + l * NPL;
        if (INL(0)) { pg8::StaticOrder S; S.init(ws + WS_HN, (bf16*)(ws + WS_WIN) + (size_t)l * ZLD * DM, MT, ZLD, DM, G, bx);
            pg8::EpiBf16Store E{(bf16*)(ws + WS_Z), ZLD}; pg8::gemm_phase(lds, DM, S, E); SEAM(pb + 0); }
        if (INL(1)) { phase_prep(a, l, lds); SEAM(pb + 1); }
        if (INL(2)) {
#ifndef NO_SCAN
            for (int bh = bx; bh < 16; bh += G) rwkv_scan(a, lds, bh);
#endif
            unsigned* qn = ctl + CW_Q + 64 * (l * 2), *qg = ctl + CW_Q + 64 * (l * 2 + 1);
#ifndef NO_NSA
            for (;;) { __syncthreads(); if (tid == 0) MISC[16] = __hip_atomic_fetch_add(qn, 1u, __ATOMIC_RELAXED, __HIP_MEMORY_SCOPE_AGENT); __syncthreads();
                const int it = (int)MISC[16]; if (it >= 512) break; nsa_item(a, lds, (it & 7) >> 1, it & 1, 63 - (it >> 3)); }
#endif
#ifndef NO_GMLP
            for (;;) { __syncthreads(); if (tid == 0) MISC[16] = __hip_atomic_fetch_add(qg, 1u, __ATOMIC_RELAXED, __HIP_MEMORY_SCOPE_AGENT); __syncthreads();
                const int it = (int)MISC[16]; if (it >= 512) break; gmlp_item(a, l, lds, it >> 7, (it >> 2) & 31, it & 3); }
#endif
            SEAM(pb + 2); }
        if (INL(3)) { phase_rwpost(a, l); SEAM(pb + 3); }
        if (INL(4)) { pg8::StaticOrder S; S.init(ws + WS_YCAT, (bf16*)(ws + WS_WOUT) + (size_t)l * DM * DM, MT, DM, DM, G, bx);
            pg8::EpiResAdd E{a.out, DM}; pg8::gemm_phase(lds, DM, S, E); SEAM(pb + 4); }
        if (INL(5)) { if (l == 0) phase_norm<0>(a, lds, INF(IN_GFFN)); else { moe_convert_weights(a, lds); __syncthreads(); phase_norm<1>(a, lds, INF(IN_GFFN) + DM); } SEAM(pb + 5); }
        if (l == 0) {
            if (INL(6)) { pg8::StaticOrder S; S.init(ws + WS_HN, ws + WS_W13, MT, 2 * DFF, DM, G, bx); pg8::EpiSwiglu E{(bf16*)(ws + WS_ACT), DFF}; pg8::gemm_phase(lds, DM, S, E); SEAM(pb + 6); }
            if (INL(7)) { pg8::StaticOrder S; S.init(ws + WS_ACT, ws + WS_W2, MT, DM, DFF, G, bx); pg8::EpiResAdd E{a.out, DM}; pg8::gemm_phase(lds, DFF, S, E); if (pb + 11 < hi) xcd_barrier(bar); }
        } else {
            if (INL(6)) { phase_moe_assign(a, lds); SEAM(pb + 6); }
            if (INL(7)) { MoeOrder S; moe_order_init(S, a, 0, ws + WS_HNS, ws + WS_MW13, (size_t)5632 * DM * 2, DM, 22); pg8::EpiSwiglu E{(bf16*)(ws + WS_ACTM), DFF}; pg8::gemm_phase(lds, DM, S, E); SEAM(pb + 7); }
            if (INL(8)) { for (int rb = bx; rb < MT / 64; rb += G) moe_gather(a, rb, 1);
                MoeOrder S; moe_order_init(S, a, 0, ws + WS_ACTM, ws + WS_MW2, (size_t)DM * DFF * 2, DFF, 4);
                pg8::EpiMoe2 E{a.out, (const int*)(ws + WS_SLOT + SL_TOK), (const float*)(ws + WS_SLOT + SL_GATE), DM}; pg8::gemm_phase(lds, DFF, S, E); SEAM(pb + 8); }
            if (INL(9)) { MoeOrder S; moe_order_init(S, a, 1, ws + WS_HNS, ws + WS_MW13, (size_t)5632 * DM * 2, DM, 22); pg8::EpiSwiglu E{(bf16*)(ws + WS_ACTM), DFF}; pg8::gemm_phase(lds, DM, S, E); SEAM(pb + 9); }
            if (INL(10)) { MoeOrder S; moe_order_init(S, a, 1, ws + WS_ACTM, ws + WS_MW2, (size_t)DM * DFF * 2, DFF, 4);
                pg8::EpiMoe2 E{a.out, (const int*)(ws + WS_SLOT + SL_TOK) + MOE_SLOTS, (const float*)(ws + WS_SLOT + SL_GATE) + MOE_SLOTS, DM}; pg8::gemm_phase(lds, DFF, S, E); SEAM(pb + 10); }
        }
        if (INL(11)) { phase_norm<0>(a, lds, INF(IN_GPLE) + l * DM); SEAM(pb + 11); }
        if (INL(12)) {
            { pg8::StaticOrder S; S.init((bf16*)(ws + WS_PB) + (size_t)l * MT * 256, (bf16*)(ws + WS_WP) + (size_t)l * DM * 256, MT, DM, 256, G, bx); pg8::EpiBf16Store E{(bf16*)(ws + WS_PP), DM}; pg8::gemm_phase(lds, 256, S, E); }
            { pg8::StaticOrder S; S.init(ws + WS_HN, (bf16*)(ws + WS_WG) + (size_t)l * DM * DM, MT, DM, DM, G, bx); pg8::EpiPle E{a.out, (const bf16*)(ws + WS_PP), DM}; pg8::gemm_phase(lds, DM, S, E); }
            SEAM(pb + 12); }
        if (INL(13)) { if (l == 0) { phase_norm<0>(a, lds, INF(IN_GMIX) + DM); SEAM(pb + 13); } else phase_norm<2>(a, lds, INF(IN_GFINAL)); }
    }
#undef IN
#undef INL
#undef SEAM
}

extern "C" void kernel_launch(void* const* d_in, const int* in_sizes, int n_in, void* d_out, int out_size, void* d_ws, size_t ws_size, hipStream_t stream) {
    static int grid = 0;
    if (grid == 0) {
        if (n_in != N_INPUTS || out_size != MT * DM || ws_size < WS_END) { fprintf(stderr, "kernel_launch: unexpected shapes (n_in %d, out %d, ws %zu)\n", n_in, out_size, ws_size); grid = -1; return; }
        int dev = 0, cus = 0, per_cu = 0;
        if (hipGetDevice(&dev) != hipSuccess || hipDeviceGetAttribute(&cus, hipDeviceAttributeMultiprocessorCount, dev) != hipSuccess) { grid = -1; return; }
        if (hipFuncSetAttribute((const void*)hybrid_fwd, hipFuncAttributeMaxDynamicSharedMemorySize, LDS_BYTES) != hipSuccess) { fprintf(stderr, "kernel_launch: hipFuncSetAttribute failed\n"); grid = -1; return; }
        if (hipOccupancyMaxActiveBlocksPerMultiprocessor(&per_cu, (const void*)hybrid_fwd, NTHR, LDS_BYTES) != hipSuccess || per_cu < 1) fprintf(stderr, "kernel_launch: occupancy query reports %d\n", per_cu);
        (void)hipGetLastError();
        grid = cus;
    }
    if (grid < 0) return;
    (void)hipMemsetAsync((char*)d_ws + WS_CTL, 0, CTL_ZERO_BYTES, stream);
    Args a{};
    for (int i = 0; i < N_INPUTS; ++i) a.in[i] = d_in[i];
    a.out = (float*)d_out; a.ws = (unsigned char*)d_ws;
#if MK_ONE_LAUNCH
    a.ph_lo = 0; a.ph_hi = NPHASES;
    hipLaunchKernelGGL(hybrid_fwd, dim3(grid), dim3(NTHR), LDS_BYTES, stream, a);
#else
    for (int k = 0; k < NPHASES; ++k) { if (phase_empty(k)) continue; a.ph_lo = k; a.ph_hi = k + 1;
        hipLaunchKernelGGL(hybrid_fwd, dim3(grid), dim3(NTHR), LDS_BYTES, stream, a); }
#endif
}
```

```cpp
#include <hip/hip_runtime.h>
#include <cstdio>
#include <cstdint>

#ifndef MK_ONE_LAUNCH
#define MK_ONE_LAUNCH 1
#endif

#define LAS __attribute__((address_space(3)))
#define GAS __attribute__((address_space(1)))
typedef unsigned short bf16;
typedef short bf16x8 __attribute__((ext_vector_type(8)));
typedef float f32x4 __attribute__((ext_vector_type(4)));
typedef float f32x2 __attribute__((ext_vector_type(2)));
typedef unsigned u32x4 __attribute__((ext_vector_type(4)));
typedef unsigned u32x2 __attribute__((ext_vector_type(2)));

constexpr int NB = 4, SEQ = 4096, DM = 1024, MT = NB * SEQ;
constexpr int DIN = 2840, ZLD = 3072;
constexpr int DFF = 2816, NEXP = 8;
constexpr int ZC_U = 0, ZC_V = 256, ZC_B = 512, ZC_Q = 1536, ZC_KC = 2048, ZC_VC = 2176, ZC_KS = 2304, ZC_VS = 2432, ZC_KW = 2560, ZC_VW = 2688, ZC_GT = 2816;
constexpr int NCMP = 255;
constexpr int NWAVES = 8, NTHR = 512;

__device__ __forceinline__ unsigned f2bf(float f) { unsigned u = __builtin_bit_cast(unsigned, f); return (u + 0x7fffu + ((u >> 16) & 1u)) >> 16; }
__device__ __forceinline__ float bf2f(unsigned b) { return __builtin_bit_cast(float, b << 16); }
__device__ __forceinline__ unsigned pk2(float lo, float hi) { return f2bf(lo) | (f2bf(hi) << 16); }
__device__ __forceinline__ float bflo(unsigned w) { return __builtin_bit_cast(float, w << 16); }
__device__ __forceinline__ float bfhi(unsigned w) { return __builtin_bit_cast(float, w & 0xffff0000u); }
__device__ __forceinline__ float sigmoidf_(float x) { return 1.0f / (1.0f + __expf(-x)); }
__device__ __forceinline__ float gelu_tanh(float x) { const float u = 0.7978845608028654f * (x + 0.044715f * x * x * x); const float e = __expf(-2.0f * fabsf(u)); float t = (1.0f - e) / (1.0f + e); t = u < 0.f ? -t : t; return 0.5f * x * (1.0f + t); }
__device__ __forceinline__ float wave_sum(float v) {
#pragma unroll
    for (int o = 1; o < 64; o <<= 1) v += __shfl_xor(v, o);
    return v;
}
__device__ __forceinline__ int opaque_tid() { int t = threadIdx.x; asm volatile("" : "+v"(t)); return t; }
#define LDS_WAIT() asm volatile("s_waitcnt lgkmcnt(0)" ::: "memory")
#define VM_WAIT() asm volatile("s_waitcnt vmcnt(0)" ::: "memory")

namespace pg8 {
constexpr int BM = 256, BK = 64, HALF = 128, HTB = HALF * BK * 2  , STAGE_BYTES = 8 * HTB, NXCD = 8, WGM = 8;
__host__ __device__ __forceinline__ int lds_byte(int r, int c) { const int st = (r >> 4) * 2 + (c >> 5), rr = r & 15, cc = c & 31, ob = rr * 64 + cc * 2; return st * 1024 + (ob ^ (((ob >> 9) & 1) << 5)); }
__host__ __device__ __forceinline__ void stage_rc(int b, int& R, int& C) { const int st = b / 1024, sb = b % 1024, swz = sb ^ (((sb >> 9) & 1) << 5); R = (st >> 1) * 16 + swz / 64; C = (st & 1) * 32 + (swz % 64) / 2; }
__host__ __device__ __forceinline__ int perm32(int rho) { const int n = rho >> 4, i = rho & 15; return 8 * (i >> 2) + 4 * n + (i & 3); }

struct Unit { int pm, pn, aux; };

struct StaticOrder {
    const char* A; const char* Bt; int K; int nM, nN, nwg, G, c;
    __device__ void init(const void* A_, const void* Bt_, int M, int N, int K_, int G_, int c_) { A = (const char*)A_; Bt = (const char*)Bt_; K = K_; nM = M / BM; nN = N / BM; nwg = nM * nN; G = G_; c = c_; }
    __device__ bool next(int i, Unit& u) const {
        const long L = (long)i * G + c; if (L >= nwg) return false;
        int wgid = (int)L; { const int q = nwg / NXCD, r = nwg % NXCD, xcd = wgid % NXCD, off = wgid / NXCD; wgid = (xcd < r ? xcd * (q + 1) : r * (q + 1) + (xcd - r) * q) + off; }
        const int nig = WGM * nN, gid = wgid / nig, fm = gid * WGM, gsz = (nM - fm) < WGM ? (nM - fm) : WGM;
        u.pm = fm + ((wgid % nig) % gsz); u.pn = (wgid % nig) / gsz; u.aux = 0; return true;
    }
    __device__ __forceinline__ const char* abase(const Unit& u) const { return A + (size_t)u.pm * ((size_t)BM * K * 2); }
    __device__ __forceinline__ const char* bbase(const Unit& u) const { return Bt + (size_t)u.pn * ((size_t)BM * K * 2); }
};

__device__ __forceinline__ unsigned cvt_pk_bf16(float lo, float hi) { unsigned r; asm volatile("v_cvt_pk_bf16_f32 %0, %1, %2" : "=v"(r) : "v"(lo), "v"(hi)); return r; }

struct EpiBf16Store {
    static constexpr bool PERM = true;
    bf16* O; int ldc;
    __device__ __forceinline__ void operator()(const f32x4 (&acc)[2][2][4][2], const Unit& u, int wr, int wc, int fr, int fq) const {
        const int row0 = u.pm * BM + wr * 64 + fr, col0 = u.pn * BM + wc * 32 + 8 * fq;
#pragma unroll
        for (int ai = 0; ai < 2; ++ai)
#pragma unroll
            for (int m = 0; m < 4; ++m) { bf16* rowp = O + (size_t)(row0 + ai * HALF + m * 16) * ldc + col0;
#pragma unroll
                for (int bj = 0; bj < 2; ++bj) { const f32x4 v0 = acc[ai][bj][m][0], v1 = acc[ai][bj][m][1];
                    u32x4 w; w.x = cvt_pk_bf16(v0[0], v0[1]); w.y = cvt_pk_bf16(v0[2], v0[3]); w.z = cvt_pk_bf16(v1[0], v1[1]); w.w = cvt_pk_bf16(v1[2], v1[3]);
                    *(u32x4*)(rowp + bj * HALF) = w; } }
    }
};
struct EpiResAdd {
    static constexpr bool PERM = false;
    float* H; int ldc;
    __device__ __forceinline__ void operator()(const f32x4 (&acc)[2][2][4][2], const Unit& u, int wr, int wc, int fr, int fq) const {
        const int row0 = u.pm * BM + wr * 64 + fr, col0 = u.pn * BM + wc * 32 + 4 * fq;
#pragma unroll
        for (int ai = 0; ai < 2; ++ai)
#pragma unroll
            for (int m = 0; m < 4; ++m) { float* rowp = H + (size_t)(row0 + ai * HALF + m * 16) * ldc + col0;
#pragma unroll
                for (int bj = 0; bj < 2; ++bj)
#pragma unroll
                    for (int n = 0; n < 2; ++n) { f32x4* p = (f32x4*)(rowp + bj * HALF + n * 16); *p = *p + acc[ai][bj][m][n]; } }
    }
};
struct EpiSwiglu {
    static constexpr bool PERM = true;
    bf16* O; int ldc;
    __device__ __forceinline__ void operator()(const f32x4 (&acc)[2][2][4][2], const Unit& u, int wr, int wc, int fr, int fq) const {
        const int row0 = u.pm * BM + wr * 64 + fr, col0 = u.pn * HALF + wc * 32 + 8 * fq;
#pragma unroll
        for (int ai = 0; ai < 2; ++ai)
#pragma unroll
            for (int m = 0; m < 4; ++m) { bf16* rowp = O + (size_t)(row0 + ai * HALF + m * 16) * ldc + col0;
                float o[8];
#pragma unroll
                for (int n = 0; n < 2; ++n)
#pragma unroll
                    for (int i = 0; i < 4; ++i) { const float a = acc[ai][0][m][n][i], b = acc[ai][1][m][n][i]; o[n * 4 + i] = a * b / (1.0f + __expf(-a)); }
                u32x4 w; w.x = cvt_pk_bf16(o[0], o[1]); w.y = cvt_pk_bf16(o[2], o[3]); w.z = cvt_pk_bf16(o[4], o[5]); w.w = cvt_pk_bf16(o[6], o[7]);
                *(u32x4*)rowp = w; __builtin_amdgcn_sched_barrier(0); }
    }
};
struct EpiPle {
    static constexpr bool PERM = false;
    float* H; const bf16* PP; int ldc;
    __device__ __forceinline__ void operator()(const f32x4 (&acc)[2][2][4][2], const Unit& u, int wr, int wc, int fr, int fq) const {
        const int row0 = u.pm * BM + wr * 64 + fr, col0 = u.pn * BM + wc * 32 + 4 * fq;
#pragma unroll
        for (int ai = 0; ai < 2; ++ai)
#pragma unroll
            for (int m = 0; m < 4; ++m) { const size_t off = (size_t)(row0 + ai * HALF + m * 16) * ldc + col0;
#pragma unroll
                for (int bj = 0; bj < 2; ++bj)
#pragma unroll
                    for (int n = 0; n < 2; ++n) { const size_t o2 = off + bj * HALF + n * 16; const u32x2 pw = *(const u32x2*)(PP + o2); const f32x4 a = acc[ai][bj][m][n];
                        f32x4 g; g[0] = bflo(pw.x) * sigmoidf_(a[0]); g[1] = bfhi(pw.x) * sigmoidf_(a[1]); g[2] = bflo(pw.y) * sigmoidf_(a[2]); g[3] = bfhi(pw.y) * sigmoidf_(a[3]);
                        f32x4* p = (f32x4*)(H + o2); *p = *p + g; }
                __builtin_amdgcn_sched_barrier(0); }
    }
};
struct EpiMoe2 {
    static constexpr bool PERM = false;
    float* H; const int* slot_tok; const float* slot_gate; int ldc;
    __device__ __forceinline__ void operator()(const f32x4 (&acc)[2][2][4][2], const Unit& u, int wr, int wc, int fr, int fq) const {
        const int row0 = u.pm * BM + wr * 64 + fr, col0 = u.pn * BM + wc * 32 + 4 * fq;
#pragma unroll
        for (int ai = 0; ai < 2; ++ai)
#pragma unroll
            for (int m = 0; m < 4; ++m) { const int slot = row0 + ai * HALF + m * 16; const int tok = slot_tok[slot]; const float gt = slot_gate[slot];
                if (tok >= 0) { float* rowp = H + (size_t)tok * ldc + col0;
#pragma unroll
                    for (int bj = 0; bj < 2; ++bj)
#pragma unroll
                        for (int n = 0; n < 2; ++n) { f32x4* p = (f32x4*)(rowp + bj * HALF + n * 16); *p = *p + acc[ai][bj][m][n] * gt; } }
                __builtin_amdgcn_sched_barrier(0); }
    }
};

template <class Epi, class Sched, bool ALIGN_EPI = true, bool SP2 = true>
__device__ __forceinline__ void gemm_phase(LAS unsigned char* lds, const int K, const Sched& S, const Epi& E) {
    int tid = threadIdx.x; asm volatile("" : "+v"(tid));
    const int wid = __builtin_amdgcn_readfirstlane(tid >> 6), lane = tid & 63, wr = wid >> 2, wc = wid & 3, fr = lane & 15, fq = lane >> 4;
    const int nt = K / BK;
    unsigned voffA[2], voffB[2];
#pragma unroll
    for (int i = 0; i < 2; ++i) { int R, C; stage_rc(tid * 16 + i * 8192, R, C); const int Rb = Epi::PERM ? ((R & ~31) + perm32(R & 31)) : R;
        voffA[i] = (unsigned)(R * K + C) * 2u; voffB[i] = (unsigned)(Rb * K + C) * 2u; }
    const size_t kstep = (size_t)(BK * 2);
    const size_t hstep = (size_t)HALF * K * 2;
    const unsigned ldsw = (unsigned)wid * 1024u;
    const int aoff = lds_byte(wr * 64 + fr, fq * 8), boff = lds_byte(wc * 32 + fr, fq * 8);
#define PG8_SA(b, h) (((b) * 2 + (h)) * HTB)
#define PG8_SB(b, h) ((4 + (b) * 2 + (h)) * HTB)
#define PG8_STAGE(bufoff, gbase, voff) do { _Pragma("unroll") for (int _i = 0; _i < 2; ++_i) \
        __builtin_amdgcn_global_load_lds((const unsigned*)((const char*)(gbase) + (voff)[_i]), (LAS unsigned*)(lds + (bufoff) + ldsw + _i * 8192), 16, 0, 0); } while (0)
#define PG8_LDA(dst, b, h) do { _Pragma("unroll") for (int m = 0; m < 4; ++m) _Pragma("unroll") for (int k = 0; k < 2; ++k) dst[m][k] = *(const LAS bf16x8*)(lds + PG8_SA(b, h) + aoff + m * 2048 + k * 1024); } while (0)
#define PG8_LDB(dst, b, h) do { _Pragma("unroll") for (int n = 0; n < 2; ++n) _Pragma("unroll") for (int k = 0; k < 2; ++k) dst[n][k] = *(const LAS bf16x8*)(lds + PG8_SB(b, h) + boff + n * 2048 + k * 1024); } while (0)
#define PG8_MMA(ai, bj, At, Bt) do { __builtin_amdgcn_s_setprio(1); _Pragma("unroll") for (int m = 0; m < 4; ++m) _Pragma("unroll") for (int n = 0; n < 2; ++n) _Pragma("unroll") for (int k = 0; k < 2; ++k) \
        acc[ai][bj][m][n] = __builtin_amdgcn_mfma_f32_16x16x32_bf16(Bt[n][k], At[m][k], acc[ai][bj][m][n], 0, 0, 0); __builtin_amdgcn_s_setprio(0); } while (0)
#define PG8_WAIT_V(n) asm volatile("s_waitcnt vmcnt(" #n ")" ::: "memory")
#define PG8_WAIT_L(n) asm volatile("s_waitcnt lgkmcnt(" #n ")" ::: "memory")
#define PG8_BAR __builtin_amdgcn_s_barrier()
#define PG8_SCHED __builtin_amdgcn_sched_barrier(0)
    Unit cur, nxt; int ui = 0;
    if (!S.next(0, cur)) return;
    f32x4 acc[2][2][4][2];
#pragma unroll
    for (int a = 0; a < 2; ++a)
#pragma unroll
        for (int b = 0; b < 2; ++b)
#pragma unroll
            for (int m = 0; m < 4; ++m)
#pragma unroll
                for (int n = 0; n < 2; ++n) acc[a][b][m][n] = (f32x4){0.f, 0.f, 0.f, 0.f};
    bf16x8 At[4][2], B0[2][2], B1[2][2];
    const char* cA = S.abase(cur); const char* cB = S.bbase(cur);
    if constexpr (SP2) {
        PG8_STAGE(PG8_SB(0, 0), cB, voffB); PG8_STAGE(PG8_SB(0, 1), cB + hstep, voffB); PG8_STAGE(PG8_SA(0, 0), cA, voffA); PG8_STAGE(PG8_SA(0, 1), cA + hstep, voffA);
        if (wr == 1) PG8_BAR;
        PG8_WAIT_V(2); PG8_BAR;
        PG8_STAGE(PG8_SB(1, 0), cB + kstep, voffB); PG8_STAGE(PG8_SA(1, 0), cA + kstep, voffA); PG8_STAGE(PG8_SB(1, 1), cB + hstep + kstep, voffB);
        PG8_WAIT_V(6); PG8_BAR;
    } else {
        PG8_STAGE(PG8_SB(0, 0), cB, voffB); PG8_STAGE(PG8_SA(0, 0), cA, voffA); PG8_STAGE(PG8_SB(0, 1), cB + hstep, voffB); PG8_STAGE(PG8_SA(0, 1), cA + hstep, voffA);
        if (wr == 1) PG8_BAR;
        PG8_WAIT_V(4); PG8_BAR;
        PG8_STAGE(PG8_SB(1, 0), cB + kstep, voffB); PG8_STAGE(PG8_SA(1, 0), cA + kstep, voffA); PG8_STAGE(PG8_SB(1, 1), cB + hstep + kstep, voffB);
        PG8_WAIT_V(6); PG8_BAR;
    }
    for (;;) {
        const bool has_next = S.next(ui + 1, nxt);
        const char* nA = has_next ? S.abase(nxt) : cA; const char* nB = has_next ? S.bbase(nxt) : cB;
        for (int t = 0; t < nt; t += 2) {
            const bool last = (t == nt - 2);
            const char* a1 = cA + (size_t)(t + 1) * kstep;
            const char* a2 = last ? nA : cA + (size_t)(t + 2) * kstep; const char* b2 = last ? nB : cB + (size_t)(t + 2) * kstep;
            const char* a3 = a2 + kstep; const char* b3 = b2 + kstep;
            if constexpr (SP2) {
            PG8_LDB(B0, 0, 0); PG8_LDB(B1, 0, 1); PG8_SCHED; PG8_LDA(At, 0, 0); PG8_STAGE(PG8_SA(1, 1), a1 + hstep, voffA);
            PG8_WAIT_V(8); PG8_WAIT_L(0); PG8_BAR; PG8_MMA(0, 0, At, B0); PG8_MMA(0, 1, At, B1); PG8_BAR; PG8_SCHED;
            PG8_LDA(At, 0, 1); PG8_STAGE(PG8_SB(0, 0), b2, voffB); PG8_STAGE(PG8_SB(0, 1), b2 + hstep, voffB); PG8_STAGE(PG8_SA(0, 0), a2, voffA);
            PG8_WAIT_V(8); PG8_WAIT_L(0); PG8_BAR; PG8_MMA(1, 0, At, B0); PG8_MMA(1, 1, At, B1); PG8_BAR; PG8_SCHED;
            PG8_LDB(B0, 1, 0); PG8_LDB(B1, 1, 1); PG8_SCHED; PG8_LDA(At, 1, 0); PG8_STAGE(PG8_SA(0, 1), a2 + hstep, voffA);
            PG8_WAIT_V(8); PG8_WAIT_L(0); PG8_BAR; PG8_MMA(0, 0, At, B0); PG8_MMA(0, 1, At, B1); PG8_BAR; PG8_SCHED;
            PG8_LDA(At, 1, 1); PG8_STAGE(PG8_SB(1, 0), b3, voffB); PG8_STAGE(PG8_SB(1, 1), b3 + hstep, voffB); PG8_STAGE(PG8_SA(1, 0), a3, voffA);
            PG8_WAIT_V(8); PG8_WAIT_L(0); PG8_BAR; PG8_MMA(1, 0, At, B0); PG8_MMA(1, 1, At, B1); PG8_BAR; PG8_SCHED;
            } else {
            PG8_LDB(B0, 0, 0); PG8_SCHED; PG8_LDA(At, 0, 0); PG8_STAGE(PG8_SA(1, 1), a1 + hstep, voffA);
            PG8_WAIT_L(8); PG8_BAR; PG8_WAIT_L(0); PG8_MMA(0, 0, At, B0); PG8_BAR; PG8_SCHED;
            PG8_LDB(B1, 0, 1); PG8_STAGE(PG8_SB(0, 0), b2, voffB);
            PG8_BAR; PG8_WAIT_L(0); PG8_MMA(0, 1, At, B1); PG8_BAR;
            PG8_LDA(At, 0, 1); PG8_STAGE(PG8_SA(0, 0), a2, voffA);
            PG8_BAR; PG8_WAIT_L(0); PG8_MMA(1, 0, At, B0); PG8_BAR; PG8_SCHED;
            PG8_STAGE(PG8_SB(0, 1), b2 + hstep, voffB);
            PG8_WAIT_V(6); PG8_BAR; PG8_MMA(1, 1, At, B1); PG8_BAR;
            PG8_LDB(B0, 1, 0); PG8_SCHED; PG8_LDA(At, 1, 0); PG8_STAGE(PG8_SA(0, 1), a2 + hstep, voffA);
            PG8_WAIT_L(8); PG8_BAR; PG8_WAIT_L(0); PG8_MMA(0, 0, At, B0); PG8_BAR; PG8_SCHED;
            PG8_LDB(B1, 1, 1); PG8_STAGE(PG8_SB(1, 0), b3, voffB);
            PG8_BAR; PG8_WAIT_L(0); PG8_MMA(0, 1, At, B1); PG8_BAR;
            PG8_LDA(At, 1, 1); PG8_STAGE(PG8_SA(1, 0), a3, voffA);
            PG8_BAR; PG8_WAIT_L(0); PG8_MMA(1, 0, At, B0); PG8_BAR; PG8_SCHED;
            PG8_STAGE(PG8_SB(1, 1), b3 + hstep, voffB);
            PG8_WAIT_V(6); PG8_BAR; PG8_MMA(1, 1, At, B1); PG8_BAR;
            }
        }
        if constexpr (ALIGN_EPI) { if (wr == 0) PG8_BAR; }
        E(acc, cur, wr, wc, fr, fq);
        if (!has_next) break;
#pragma unroll
        for (int a = 0; a < 2; ++a)
#pragma unroll
            for (int b = 0; b < 2; ++b)
#pragma unroll
                for (int m = 0; m < 4; ++m)
#pragma unroll
                    for (int n = 0; n < 2; ++n) acc[a][b][m][n] = (f32x4){0.f, 0.f, 0.f, 0.f};
        cur = nxt; cA = nA; cB = nB; ++ui;
        if constexpr (ALIGN_EPI) { if (wr == 1) PG8_BAR; }
    }
    PG8_WAIT_V(0);
    if constexpr (!ALIGN_EPI) { if (wr == 0) PG8_BAR; }
    PG8_BAR;
#undef PG8_SA
#undef PG8_SB
#undef PG8_STAGE
#undef PG8_LDA
#undef PG8_LDB
#undef PG8_MMA
#undef PG8_WAIT_V
#undef PG8_WAIT_L
#undef PG8_BAR
#undef PG8_SCHED
}
}

constexpr size_t MiB = 1u << 20;
constexpr size_t WS_CTL = 0, CTL_ZERO_BYTES = 65536;
constexpr size_t WS_WIN = 1 * MiB;
constexpr size_t WS_WOUT = 13 * MiB;
constexpr size_t WS_W13 = 17 * MiB;
constexpr size_t WS_W2 = 28 * MiB;
constexpr size_t WS_WG = 34 * MiB;
constexpr size_t WS_WP = 38 * MiB;
constexpr size_t WS_CW1 = 39 * MiB;
constexpr size_t WS_LORA = 41 * MiB;
constexpr size_t WS_ROPE = 41 * MiB + 512 * 1024;
constexpr size_t WS_CBIAS = 42 * MiB + 512 * 1024;
constexpr size_t WS_PB = 43 * MiB;
constexpr size_t WS_HN = 60 * MiB;
constexpr size_t WS_Z = 92 * MiB;
constexpr size_t WS_YCAT = 188 * MiB;
constexpr size_t WS_QROT = 220 * MiB;
constexpr size_t WS_KSR = 236 * MiB, WS_KWR = 240 * MiB, WS_VST = 244 * MiB, WS_VWT = 248 * MiB;
constexpr size_t WS_KCMP = 252 * MiB, WS_VCMPT = 252 * MiB + 512 * 1024;
constexpr size_t WS_REC = 253 * MiB;
constexpr size_t WS_G = 349 * MiB;
constexpr size_t WS_YRAW = 365 * MiB;
constexpr size_t WS_BONUS = 381 * MiB;
constexpr size_t WS_ACT = 92 * MiB;
constexpr size_t WS_HNS = 92 * MiB;
constexpr size_t WS_ACTM = 128 * MiB;
constexpr size_t WS_MW13 = 227 * MiB;
constexpr size_t WS_MW2 = 315 * MiB;
constexpr size_t WS_SLOT = 359 * MiB;
constexpr size_t WS_PP = 92 * MiB;
constexpr size_t WS_END = 382 * MiB;
constexpr int MOE_SLOTS = 18432;
constexpr size_t SL_TOK = 0;
constexpr size_t SL_GATE = SL_TOK + 2 * MOE_SLOTS * 4;
constexpr size_t SL_TOKE = SL_GATE + 2 * MOE_SLOTS * 4;
constexpr size_t SL_TOKG = SL_TOKE + (size_t)MT * 2 * 4;
constexpr size_t SL_TOKS = SL_TOKG + (size_t)MT * 2 * 4;
constexpr size_t SL_BCNT = SL_TOKS + (size_t)MT * 2 * 4;
constexpr size_t SL_TST = SL_BCNT + 256 * 16 * 4;
static_assert(SL_TST + 128 <= 1 * MiB, "slot tables");
constexpr int CW_BAR = 4096;
constexpr int CW_Q = 8192;

constexpr int RING_BYTES = 131072;
constexpr int MISC_OFF = RING_BYTES;
constexpr int LDS_BYTES = 147456;

#define XB_TMO      128
#define XB_XCNT(j)  (256  + 64 * (j))
#define XB_XSUB(j)  (1280 + 64 * (j))
#define XB_XGEN(j)  (2304 + 64 * (j))
#define XB_TOP      3328
#define XB_TOPGEN   3392
#define XCD_BAR_WORDS 3456
#define XB_SPIN_CAP (1u << 18)
__device__ __forceinline__ unsigned xb_ld(unsigned* p)              { return __hip_atomic_load(p, __ATOMIC_RELAXED, __HIP_MEMORY_SCOPE_AGENT); }
__device__ __forceinline__ unsigned xb_add(unsigned* p, unsigned v) { return __hip_atomic_fetch_add(p, v, __ATOMIC_RELAXED, __HIP_MEMORY_SCOPE_AGENT); }
__device__ __forceinline__ unsigned xb_xcc_id() { return (unsigned)__builtin_amdgcn_s_getreg((3 << 11) | 20) & 0xFu; }
#define XB_SPIN(cond, bar) do { unsigned _sp = 0; while (cond) { __builtin_amdgcn_s_sleep(1); \
    if ((++_sp & 255u) == 0u) { if (xb_ld(&(bar)[XB_TMO])) break; if (_sp > XB_SPIN_CAP) { atomicAdd(&(bar)[XB_TMO], 1u); break; } } } } while (0)
struct XcdBarrier { unsigned* bar; unsigned x; volatile LAS unsigned* st; };
__device__ __forceinline__ XcdBarrier xcd_barrier_post(unsigned* bar, volatile LAS unsigned* st) {
    XcdBarrier b; b.bar = bar; b.x = xb_xcc_id(); b.st = st;
    if (threadIdx.x == 0) (void)xb_add(&bar[XB_XCNT(b.x)], 1u);
    return b;
}
__device__ __forceinline__ void xcd_barrier_complete(unsigned* bar, unsigned x, unsigned& nloc, unsigned& nx) {
    const unsigned G = gridDim.x * gridDim.y * gridDim.z;
    unsigned sum, cnt, mine, sp = 0u;
    for (;;) {
        sum = 0u; cnt = 0u; mine = 0u;
#pragma unroll
        for (unsigned j = 0; j < 16; ++j) { const unsigned c = xb_ld(&bar[XB_XCNT(j)]); sum += c; cnt += (c > 0u) ? 1u : 0u; mine = (j == x) ? c : mine; }
        if (sum == G) break;
        __builtin_amdgcn_s_sleep(1);
        if ((++sp & 255u) == 0u) { if (xb_ld(&bar[XB_TMO])) break; if (sp > XB_SPIN_CAP) { atomicAdd(&bar[XB_TMO], 1u); break; } }
    }
    nloc = mine > 0u ? mine : 1u; nx = cnt > 0u ? cnt : 1u;
}
__device__ __forceinline__ void xcd_barrier(const XcdBarrier& b) {
    asm volatile("s_waitcnt vmcnt(0)" ::: "memory");
    __syncthreads();
    if (threadIdx.x == 0) {
        unsigned* bar = b.bar;
        __builtin_amdgcn_s_waitcnt(0);
        unsigned nloc = b.st[0], nx = b.st[1];
        if (nloc == 0u) { xcd_barrier_complete(bar, b.x, nloc, nx); b.st[0] = nloc; b.st[1] = nx; }
        const unsigned old = xb_add(&bar[XB_XSUB(b.x)], 1u);
        const unsigned gen = old / nloc;
        if (old + 1u == (gen + 1u) * nloc) {
            __builtin_amdgcn_fence(__ATOMIC_RELEASE, "agent");
            asm volatile("s_waitcnt vmcnt(0)" ::: "memory");
            const unsigned og = xb_add(&bar[XB_TOP], 1u);
            const unsigned tg = og / nx;
            if (og + 1u == (tg + 1u) * nx) xb_add(&bar[XB_TOPGEN], 1u);
            else XB_SPIN(xb_ld(&bar[XB_TOPGEN]) == tg, bar);
            __builtin_amdgcn_fence(__ATOMIC_ACQUIRE, "agent");
            xb_add(&bar[XB_XGEN(b.x)], 1u);
            asm volatile("s_waitcnt vmcnt(0)" ::: "memory");
        } else {
            XB_SPIN(xb_ld(&bar[XB_XGEN(b.x)]) == gen, bar);
            __builtin_amdgcn_fence(__ATOMIC_ACQUIRE, "agent");
            asm volatile("s_waitcnt vmcnt(0)" ::: "memory");
        }
    }
    __syncthreads();
}

enum { IN_X = 0, IN_P, IN_POS, IN_GMIX, IN_WIN, IN_WOUT, IN_GMLNG, IN_GMLNB, IN_GMWS, IN_GMBS, IN_RWMU, IN_RWW0, IN_RWWUP, IN_RWA0, IN_RWAUP, IN_RWGUP,
       IN_RWKK, IN_RWKA, IN_RWRK, IN_RWGNG, IN_RWGNB, IN_CMPPOS, IN_KCW1, IN_KCW2, IN_VCW1, IN_VCW2, IN_GFFN, IN_FW1, IN_FW3, IN_FW2, IN_RTW, IN_RTB,
       IN_MW1, IN_MW3, IN_MW2, IN_GPLE, IN_PLEG, IN_PLEP, IN_GFINAL, N_INPUTS };
struct Args { const void* in[N_INPUTS]; float* out; unsigned char* ws; int ph_lo, ph_hi; };
constexpr int PTAB_OFF = 131072 + 256;
__device__ __forceinline__ const void* ldptr(int k) {
    extern __shared__ __attribute__((aligned(16))) unsigned char lds_raw[];
    const LAS unsigned* t = (const LAS unsigned*)((LAS unsigned char*)lds_raw + PTAB_OFF) + 2 * k;
    const unsigned lo = __builtin_amdgcn_readfirstlane(t[0]), hi = __builtin_amdgcn_readfirstlane(t[1]);
    return (const void*)(((unsigned long long)hi << 32) | lo);
}
#define INF(k) ((const float*)ldptr(k))

__device__ __forceinline__ void transpose_item(const float* W, int ldw, int k0, int n0, int nvalid, bf16* dst, int dld, int drow0, LAS float* scr, int lane) {
    const bool ok = (lane & 31) < nvalid;
#pragma unroll 8
    for (int i = 0; i < 32; ++i) { const int kk = 2 * i + (lane >> 5); scr[kk * 33 + (lane & 31)] = ok ? W[(size_t)(k0 + kk) * ldw + n0 + (lane & 31)] : 0.f; }
    LDS_WAIT(); asm volatile("" ::: "memory");
    const int c = lane & 7;
#pragma unroll
    for (int j = 0; j < 4; ++j) { const int n = (lane >> 3) + 8 * j; const LAS float* s = scr + (8 * c) * 33 + n;
        u32x4 o; o.x = pk2(s[0 * 33], s[1 * 33]); o.y = pk2(s[2 * 33], s[3 * 33]); o.z = pk2(s[4 * 33], s[5 * 33]); o.w = pk2(s[6 * 33], s[7 * 33]);
        if (n < nvalid) *(u32x4*)(dst + (size_t)(drow0 + n) * dld + k0 + 8 * c) = o; }
    LDS_WAIT(); asm volatile("" ::: "memory");
}
__device__ __forceinline__ void conv_matrix(const float* W, int K, int N, bf16* dst, int mode, int gw, int NGW, LAS float* scr, int lane) {
    const int nblk = (N + 31) / 32, nit = (K / 64) * nblk;
    for (int it = gw; it < nit; it += NGW) {
        const int kb = it / nblk, nb = it % nblk, n0 = nb * 32; const int nv = (N - n0) < 32 ? (N - n0) : 32;
        const int drow0 = mode == 0 ? n0 : ((n0 >> 7) * 256 + (n0 & 127) + (mode == 2 ? 128 : 0));
        transpose_item(W, N, kb * 64, n0, nv, dst, K, drow0, scr, lane);
    }
}
__device__ __forceinline__ void rms_row_bf16(const float* xrow, const float* g, bf16* orow, float* cp, int lane) {
    const f32x4* xr = (const f32x4*)xrow + lane; f32x4 v[4]; float s = 0.f;
#pragma unroll
    for (int j = 0; j < 4; ++j) { v[j] = xr[64 * j]; s += (v[j].x * v[j].x + v[j].y * v[j].y) + (v[j].z * v[j].z + v[j].w * v[j].w); }
    const float rs = 1.0f / sqrtf(wave_sum(s) * (1.0f / 1024.0f) + 1e-6f);
    if (cp) {
#pragma unroll
        for (int j = 0; j < 4; ++j) ((f32x4*)cp + lane)[64 * j] = v[j]; }
    u32x2* o8 = (u32x2*)orow + lane;
#pragma unroll
    for (int j = 0; j < 4; ++j) { const f32x4 gg = ((const f32x4*)g + lane)[64 * j]; u32x2 w; w.x = pk2(v[j].x * rs * gg.x, v[j].y * rs * gg.y); w.y = pk2(v[j].z * rs * gg.z, v[j].w * rs * gg.w); o8[64 * j] = w; }
}

__device__ __forceinline__ void phase_prologue(const Args& a, LAS unsigned char* lds) {
    const int tid = opaque_tid(), lane = tid & 63, wave = __builtin_amdgcn_readfirstlane(tid >> 6);
    const int G = gridDim.x, gw = blockIdx.x * NWAVES + wave, NGW = G * NWAVES;
    const size_t gt = (size_t)blockIdx.x * NTHR + tid, NGT = (size_t)G * NTHR;
    unsigned char* ws = a.ws;
    LAS float* scr = (LAS float*)(lds + wave * 16384);
    for (int l = 0; l < 2; ++l) {
        conv_matrix(INF(IN_WIN) + (size_t)l * DM * DIN, DM, DIN, (bf16*)(ws + WS_WIN) + (size_t)l * ZLD * DM, 0, gw, NGW, scr, lane);
        conv_matrix(INF(IN_WOUT) + (size_t)l * DM * DM, DM, DM, (bf16*)(ws + WS_WOUT) + (size_t)l * DM * DM, 0, gw, NGW, scr, lane);
        conv_matrix(INF(IN_PLEG) + (size_t)l * DM * DM, DM, DM, (bf16*)(ws + WS_WG) + (size_t)l * DM * DM, 0, gw, NGW, scr, lane);
        conv_matrix(INF(IN_PLEP) + (size_t)l * 256 * DM, 256, DM, (bf16*)(ws + WS_WP) + (size_t)l * DM * 256, 0, gw, NGW, scr, lane);
        conv_matrix(INF(IN_KCW1) + (size_t)l * 2048 * 128, 2048, 128, (bf16*)(ws + WS_CW1) + (size_t)(l * 2 + 0) * 128 * 2048, 0, gw, NGW, scr, lane);
        conv_matrix(INF(IN_VCW1) + (size_t)l * 2048 * 128, 2048, 128, (bf16*)(ws + WS_CW1) + (size_t)(l * 2 + 1) * 128 * 2048, 0, gw, NGW, scr, lane);
        bf16* lora = (bf16*)(ws + WS_LORA) + (size_t)l * 65536;
        conv_matrix(INF(IN_RWWUP) + (size_t)l * 64 * 256, 64, 256, lora, 0, gw, NGW, scr, lane);
        conv_matrix(INF(IN_RWAUP) + (size_t)l * 64 * 256, 64, 256, lora + 16384, 0, gw, NGW, scr, lane);
        conv_matrix(INF(IN_RWGUP) + (size_t)l * 128 * 256, 128, 256, lora + 32768, 0, gw, NGW, scr, lane);
        { u32x4* zr = (u32x4*)((bf16*)(ws + WS_WIN) + ((size_t)l * ZLD + DIN) * DM); const size_t n16 = (size_t)(ZLD - DIN) * DM * 2 / 16;
          for (size_t i = gt; i < n16; i += NGT) zr[i] = (u32x4){0u, 0u, 0u, 0u}; }
    }
    conv_matrix(INF(IN_FW1), DM, DFF, (bf16*)(ws + WS_W13), 1, gw, NGW, scr, lane);
    conv_matrix(INF(IN_FW3), DM, DFF, (bf16*)(ws + WS_W13), 2, gw, NGW, scr, lane);
    conv_matrix(INF(IN_FW2), DFF, DM, (bf16*)(ws + WS_W2), 0, gw, NGW, scr, lane);
    { const f32x4* src = (const f32x4*)INF(IN_P); u32x2* dst = (u32x2*)(ws + WS_PB); const size_t n4 = (size_t)2 * MT * 256 / 4;
      for (size_t i = gt; i < n4; i += NGT) { const f32x4 v = src[i]; u32x2 w; w.x = pk2(v.x, v.y); w.y = pk2(v.z, v.w); dst[i] = w; } }
    { const int* pos = (const int*)ldptr(IN_POS); float* ct = (float*)(ws + WS_ROPE); float* st = ct + (size_t)MT * 8;
      const float inv[8] = {1.0f, 0.1939227432012558f, 0.03760603070259094f, 0.007292664609849453f, 0.0014142135623842478f, 0.00027424818836152554f, 5.3182957344688475e-05f, 1.0313385246263351e-05f};
      for (size_t i = gt; i < (size_t)MT * 8; i += NGT) { const int m = (int)(i >> 3), k = (int)(i & 7);
          float iv = inv[0];
#pragma unroll
          for (int q = 1; q < 8; ++q) iv = (k == q) ? inv[q] : iv;
          const float ang = (float)pos[m] * iv;
          const double ad = (double)ang; const double kq = __builtin_rint(ad * 0.15915494309189535); const float red = (float)(ad - kq * 6.283185307179586);
          ct[i] = __cosf(red); st[i] = __sinf(red); } }
    if (blockIdx.x < 4) {
        const int l = blockIdx.x >> 1, kv = blockIdx.x & 1; const float* W1 = INF(kv ? IN_VCW1 : IN_KCW1) + (size_t)l * 2048 * 128; const float* pos = INF(IN_CMPPOS) + (size_t)l * 2048;
        LAS float* red = (LAS float*)(lds + 8448);
        const int hid = tid & 127, part = tid >> 7; float s = 0.f;
        for (int k = part * 512; k < part * 512 + 512; ++k) s += pos[k] * W1[(size_t)k * 128 + hid];
        red[part * 128 + hid] = s; __syncthreads();
        if (tid < 128) ((float*)(ws + WS_CBIAS))[(l * 2 + kv) * 128 + tid] = red[tid] + red[128 + tid] + red[256 + tid] + red[384 + tid];
    }
    for (int m = gw; m < MT; m += NGW) rms_row_bf16(INF(IN_X) + (size_t)m * DM, INF(IN_GMIX), (bf16*)(ws + WS_HN) + (size_t)m * DM, a.out + (size_t)m * DM, lane);
}

template <int MODE>
__device__ __forceinline__ void phase_norm(const Args& a, LAS unsigned char* lds, const float* g) {
    const int tid = opaque_tid(), lane = tid & 63, wave = __builtin_amdgcn_readfirstlane(tid >> 6);
    unsigned char* ws = a.ws;
    LAS int* lcnt = (LAS int*)lds;
    if (MODE == 1) { if (tid < 16) lcnt[tid] = 0; __syncthreads(); }
    for (int rb = blockIdx.x; rb < MT / 64; rb += gridDim.x) {
        for (int i = 0; i < 8; ++i) {
            const int m = rb * 64 + wave * 8 + i;
            float* hrow = a.out + (size_t)m * DM;
            const f32x4* xr = (const f32x4*)hrow + lane; f32x4 v[4]; float s = 0.f;
#pragma unroll
            for (int j = 0; j < 4; ++j) { v[j] = xr[64 * j]; s += (v[j].x * v[j].x + v[j].y * v[j].y) + (v[j].z * v[j].z + v[j].w * v[j].w); }
            const float rs = 1.0f / sqrtf(wave_sum(s) * (1.0f / 1024.0f) + 1e-6f);
#pragma unroll
            for (int j = 0; j < 4; ++j) { const f32x4 gg = ((const f32x4*)g + lane)[64 * j]; v[j].x *= rs * gg.x; v[j].y *= rs * gg.y; v[j].z *= rs * gg.z; v[j].w *= rs * gg.w; }
            if (MODE == 2) {
#pragma unroll
                for (int j = 0; j < 4; ++j) ((f32x4*)hrow + lane)[64 * j] = v[j];
            } else {
                u32x2* o8 = (u32x2*)((bf16*)(ws + WS_HN) + (size_t)m * DM) + lane;
#pragma unroll
                for (int j = 0; j < 4; ++j) { u32x2 w; w.x = pk2(v[j].x, v[j].y); w.y = pk2(v[j].z, v[j].w); o8[64 * j] = w; }
            }
            if (MODE == 1) {
                const float* rw = INF(IN_RTW); float lg[8];
#pragma unroll
                for (int e = 0; e < 8; ++e) lg[e] = 0.f;
#pragma unroll
                for (int j = 0; j < 4; ++j)
#pragma unroll
                    for (int c = 0; c < 4; ++c) { const int k = 4 * (lane + 64 * j) + c; const f32x4 w0 = *(const f32x4*)(rw + (size_t)k * 8), w1 = *(const f32x4*)(rw + (size_t)k * 8 + 4); const float x = v[j][c];
                        lg[0] += x * w0.x; lg[1] += x * w0.y; lg[2] += x * w0.z; lg[3] += x * w0.w; lg[4] += x * w1.x; lg[5] += x * w1.y; lg[6] += x * w1.z; lg[7] += x * w1.w; }
#pragma unroll
                for (int e = 0; e < 8; ++e) lg[e] = wave_sum(lg[e]) + INF(IN_RTB)[e];
                int e0 = 0; float v0 = lg[0];
#pragma unroll
                for (int e = 1; e < 8; ++e) if (lg[e] > v0) { v0 = lg[e]; e0 = e; }
                int e1 = -1; float v1 = -3.0e38f;
#pragma unroll
                for (int e = 0; e < 8; ++e) if (e != e0 && lg[e] > v1) { v1 = lg[e]; e1 = e; }
                const float p1 = 1.0f / (1.0f + __expf(v0 - v1)), p0 = 1.0f - p1;
                if (lane == 0) { int* te = (int*)(ws + WS_SLOT + SL_TOKE); float* tg = (float*)(ws + WS_SLOT + SL_TOKG); te[2 * m] = e0; te[2 * m + 1] = e1; tg[2 * m] = p0; tg[2 * m + 1] = p1;
                    atomicAdd((int*)&lcnt[e0], 1); atomicAdd((int*)&lcnt[8 + e1], 1); }
            }
        }
        if (MODE == 1) { __syncthreads(); if (tid < 16) { ((int*)(ws + WS_SLOT + SL_BCNT))[rb * 16 + tid] = lcnt[tid]; lcnt[tid] = 0; } __syncthreads(); }
    }
}

__device__ __forceinline__ bf16x8 ld_bf8(const bf16* p) { return *(const bf16x8*)p; }
__device__ __forceinline__ float tanhf_(float x) { const float e = __expf(2.0f * x); return 1.0f - 2.0f / (e + 1.0f); }

__device__ __forceinline__ void rw_shift8(const bf16* z, const float* mu, int m, int tpos, int c, float (&o)[8]) {
    const u32x4 cur = *(const u32x4*)(z + (size_t)m * ZLD + ZC_B + c);
    u32x4 prv = (u32x4){0u, 0u, 0u, 0u}; if (tpos > 0) prv = *(const u32x4*)(z + (size_t)(m - 1) * ZLD + ZC_B + c);
    const f32x4 m0 = *(const f32x4*)(mu + c), m1 = *(const f32x4*)(mu + c + 4);
    float cu[8] = {bflo(cur.x), bfhi(cur.x), bflo(cur.y), bfhi(cur.y), bflo(cur.z), bfhi(cur.z), bflo(cur.w), bfhi(cur.w)};
    float pv[8] = {bflo(prv.x), bfhi(prv.x), bflo(prv.y), bfhi(prv.y), bflo(prv.z), bfhi(prv.z), bflo(prv.w), bfhi(prv.w)};
    float mm[8] = {m0.x, m0.y, m0.z, m0.w, m1.x, m1.y, m1.z, m1.w};
#pragma unroll
    for (int j = 0; j < 8; ++j) o[j] = cu[j] + (pv[j] - cu[j]) * mm[j];
}
__device__ __forceinline__ void rw_shift4(const bf16* z, const float* mu, int m, int tpos, int c, float (&o)[4]) {
    const u32x2 cur = *(const u32x2*)(z + (size_t)m * ZLD + ZC_B + c);
    u32x2 prv = (u32x2){0u, 0u}; if (tpos > 0) prv = *(const u32x2*)(z + (size_t)(m - 1) * ZLD + ZC_B + c);
    const f32x4 m0 = *(const f32x4*)(mu + c);
    o[0] = bflo(cur.x) + (bflo(prv.x) - bflo(cur.x)) * m0.x; o[1] = bfhi(cur.x) + (bfhi(prv.x) - bfhi(cur.x)) * m0.y;
    o[2] = bflo(cur.y) + (bflo(prv.y) - bflo(cur.y)) * m0.z; o[3] = bfhi(cur.y) + (bfhi(prv.y) - bfhi(cur.y)) * m0.w;
}
__device__ __forceinline__ bf16x8 pack8(const float (&x)[8]) {
    u32x4 w; w.x = pk2(x[0], x[1]); w.y = pk2(x[2], x[3]); w.z = pk2(x[4], x[5]); w.w = pk2(x[6], x[7]);
    return __builtin_bit_cast(bf16x8, w);
}

__device__ __forceinline__ void rwkv_prep_tile(const Args& a, int layer, int m0, int lane) {
    unsigned char* ws = a.ws;
    const bf16* z = (const bf16*)(ws + WS_Z);
    const float* mu = INF(IN_RWMU) + (size_t)layer * 1024;
    const bf16* lora = (const bf16*)(ws + WS_LORA) + (size_t)layer * 65536;
    const bf16* wupT = lora; const bf16* aupT = lora + 16384; const bf16* gupT = lora + 32768;
    const int fq = lane >> 4, fr = lane & 15;
    const int m = m0 + fr, tpos = m & (SEQ - 1), bb = m >> 12;
    bf16x8 wdB[2], adB[2], gdB[4];
#pragma unroll
    for (int ks = 0; ks < 2; ++ks) { float x[8]; rw_shift8(z, mu, m, tpos, 768 + 32 * ks + 8 * fq, x);
#pragma unroll
        for (int j = 0; j < 8; ++j) x[j] = tanhf_(x[j]);
        wdB[ks] = pack8(x);
        rw_shift8(z, mu, m, tpos, 832 + 32 * ks + 8 * fq, x); adB[ks] = pack8(x); }
#pragma unroll
    for (int ks = 0; ks < 4; ++ks) { float x[8]; rw_shift8(z, mu, m, tpos, 896 + 32 * ks + 8 * fq, x);
#pragma unroll
        for (int j = 0; j < 8; ++j) x[j] = sigmoidf_(x[j]);
        gdB[ks] = pack8(x); }
    const float* w0p = INF(IN_RWW0) + layer * 256; const float* a0p = INF(IN_RWA0) + layer * 256; const float* kkp = INF(IN_RWKK) + layer * 256;
    const float* kap = INF(IN_RWKA) + layer * 256; const float* rkp = INF(IN_RWRK) + layer * 256;
    float* rec = (float*)(ws + WS_REC); float* gbuf = (float*)(ws + WS_G); float* bonus = (float*)(ws + WS_BONUS);
    float ss = 0.f, bs = 0.f, inv = 0.f;
#pragma unroll 1
    for (int hc = 0; hc < 16; ++hc) {
        const int h = hc >> 2, ct = hc & 3;
        if (ct == 0) {
            ss = 0.f; bs = 0.f;
#pragma unroll
            for (int c2 = 0; c2 < 4; ++c2) { const int c0 = h * 64 + 16 * c2 + 4 * fq; float k4[4]; rw_shift4(z, mu, m, tpos, 256 + c0, k4); const f32x4 k_k = *(const f32x4*)(kkp + c0);
#pragma unroll
                for (int i = 0; i < 4; ++i) { const float kx = k4[i] * k_k[i]; ss += kx * kx; } }
            ss += __shfl_xor(ss, 16); ss += __shfl_xor(ss, 32);
            inv = 1.0f / sqrtf(fmaxf(ss, 1e-24f));
        }
        f32x4 aw = (f32x4){0.f, 0.f, 0.f, 0.f}, aa = aw, ag = aw;
        const int chr = h * 64 + 16 * ct + fr;
#pragma unroll
        for (int ks = 0; ks < 2; ++ks) { const bf16x8 A1 = ld_bf8(wupT + chr * 64 + 32 * ks + 8 * fq), A2 = ld_bf8(aupT + chr * 64 + 32 * ks + 8 * fq);
            aw = __builtin_amdgcn_mfma_f32_16x16x32_bf16(A1, wdB[ks], aw, 0, 0, 0); aa = __builtin_amdgcn_mfma_f32_16x16x32_bf16(A2, adB[ks], aa, 0, 0, 0); }
#pragma unroll
        for (int ks = 0; ks < 4; ++ks) { const bf16x8 A3 = ld_bf8(gupT + chr * 128 + 32 * ks + 8 * fq); ag = __builtin_amdgcn_mfma_f32_16x16x32_bf16(A3, gdB[ks], ag, 0, 0, 0); }
        float* rp = rec + ((size_t)(bb * 4 + h) * SEQ + tpos) * 384;
        const int c0 = h * 64 + 16 * ct + 4 * fq, d0 = 16 * ct + 4 * fq;
        float r4[4], k4[4], v4[4]; rw_shift4(z, mu, m, tpos, c0, r4); rw_shift4(z, mu, m, tpos, 256 + c0, k4); rw_shift4(z, mu, m, tpos, 512 + c0, v4);
        const f32x4 w0 = *(const f32x4*)(w0p + c0), a0 = *(const f32x4*)(a0p + c0), k_k = *(const f32x4*)(kkp + c0), k_a = *(const f32x4*)(kap + c0), r_k = *(const f32x4*)(rkp + c0);
        f32x4 odw, okk, ob, okp;
#pragma unroll
        for (int i = 0; i < 4; ++i) {
            const float wl = w0[i] + aw[i]; const float nx = -wl; const float sp = fmaxf(nx, 0.f) + log1pf(__expf(-fabsf(nx)));
            const float wlog = -sp - 0.5f; odw[i] = __expf(-__expf(wlog));
            const float aval = sigmoidf_(a0[i] + aa[i]);
            const float kkn = k4[i] * k_k[i] * inv; okk[i] = kkn; ob[i] = kkn * aval;
            const float kpv = k4[i] * (1.0f + (aval - 1.0f) * k_a[i]); okp[i] = kpv;
            bs += r4[i] * kpv * r_k[i];
        }
        *(f32x4*)(rp + d0) = odw; *(f32x4*)(rp + 64 + d0) = okk; *(f32x4*)(rp + 128 + d0) = ob; *(f32x4*)(rp + 192 + d0) = okp;
        *(f32x4*)(rp + 256 + d0) = (f32x4){r4[0], r4[1], r4[2], r4[3]}; *(f32x4*)(rp + 320 + d0) = (f32x4){v4[0], v4[1], v4[2], v4[3]};
        *(f32x4*)(gbuf + (size_t)m * 256 + c0) = ag;
        if (ct == 3) { float b2 = bs; b2 += __shfl_xor(b2, 16); b2 += __shfl_xor(b2, 32); if (fq == 0) bonus[(size_t)m * 4 + h] = b2; }
    }
}

__device__ __forceinline__ void nsa_prep_item(const Args& a, LAS unsigned char* lds, int b, int tt) {
    unsigned char* ws = a.ws; const int tid = opaque_tid();
    const bf16* z = (const bf16*)(ws + WS_Z);
    const float* ct = (const float*)(ws + WS_ROPE); const float* st = ct + (size_t)MT * 8;
    const int mb = b * SEQ + tt * 64;
    for (int task = tid; task < 64 * 12; task += NTHR) {
        const int tok = task / 12, unit = task % 12, m = mb + tok;
        const bf16* src; bf16* dst;
        if (unit < 8) { src = z + (size_t)m * ZLD + ZC_Q + unit * 64; dst = (bf16*)(ws + WS_QROT) + (size_t)m * 512 + unit * 64; }
        else if (unit < 10) { src = z + (size_t)m * ZLD + ZC_KS + (unit - 8) * 64; dst = (bf16*)(ws + WS_KSR) + (size_t)m * 128 + (unit - 8) * 64; }
        else { src = z + (size_t)m * ZLD + ZC_KW + (unit - 10) * 64; dst = (bf16*)(ws + WS_KWR) + (size_t)m * 128 + (unit - 10) * 64; }
        u32x4 v[8];
#pragma unroll
        for (int i = 0; i < 8; ++i) v[i] = ((const u32x4*)src)[i];
        const f32x4 c0 = *(const f32x4*)(ct + (size_t)m * 8), c1 = *(const f32x4*)(ct + (size_t)m * 8 + 4), s0 = *(const f32x4*)(st + (size_t)m * 8), s1 = *(const f32x4*)(st + (size_t)m * 8 + 4);
        const float cc[8] = {c0.x, c0.y, c0.z, c0.w, c1.x, c1.y, c1.z, c1.w}, sn[8] = {s0.x, s0.y, s0.z, s0.w, s1.x, s1.y, s1.z, s1.w};
        const float x1[8] = {bflo(v[0].x), bfhi(v[0].x), bflo(v[0].y), bfhi(v[0].y), bflo(v[0].z), bfhi(v[0].z), bflo(v[0].w), bfhi(v[0].w)};
        const float x2[8] = {bflo(v[1].x), bfhi(v[1].x), bflo(v[1].y), bfhi(v[1].y), bflo(v[1].z), bfhi(v[1].z), bflo(v[1].w), bfhi(v[1].w)};
        float o1[8], o2[8];
#pragma unroll
        for (int i = 0; i < 8; ++i) { o1[i] = x1[i] * cc[i] - x2[i] * sn[i]; o2[i] = x1[i] * sn[i] + x2[i] * cc[i]; }
        v[0] = (u32x4){pk2(o1[0], o1[1]), pk2(o1[2], o1[3]), pk2(o1[4], o1[5]), pk2(o1[6], o1[7])};
        v[1] = (u32x4){pk2(o2[0], o2[1]), pk2(o2[2], o2[3]), pk2(o2[4], o2[5]), pk2(o2[6], o2[7])};
#pragma unroll
        for (int i = 0; i < 8; ++i) ((u32x4*)dst)[i] = v[i];
    }
    LAS bf16* tile = (LAS bf16*)lds;
    { const int tok = tid >> 3, ch = tid & 7;
#pragma unroll
      for (int mi = 0; mi < 4; ++mi) { const int col = (mi < 2 ? ZC_VS : ZC_VW) + (mi & 1) * 64;
          *(LAS u32x4*)(tile + mi * 4608 + tok * 72 + ch * 8) = *(const u32x4*)(z + (size_t)(mb + tok) * ZLD + col + ch * 8); } }
    __syncthreads();
    { const int d = tid >> 3, tc = tid & 7;
#pragma unroll
      for (int mi = 0; mi < 4; ++mi) { unsigned e[8];
#pragma unroll
          for (int j = 0; j < 8; ++j) e[j] = tile[mi * 4608 + (tc * 8 + j) * 72 + d];
          u32x4 w; w.x = e[0] | (e[1] << 16); w.y = e[2] | (e[3] << 16); w.z = e[4] | (e[5] << 16); w.w = e[6] | (e[7] << 16);
          bf16* dst = (bf16*)(ws + (mi < 2 ? WS_VST : WS_VWT)) + ((size_t)(b * 2 + (mi & 1)) * 64 + d) * SEQ + tt * 64 + tc * 8;
          *(u32x4*)dst = w; } }
    __syncthreads();
}

__device__ __forceinline__ void nsa_compress_item(const Args& a, int layer, LAS unsigned char* lds, int b, int g, int kv, int nt) {
    unsigned char* ws = a.ws; const int tid = opaque_tid(), lane = tid & 63, wave = __builtin_amdgcn_readfirstlane(tid >> 6), fq = lane >> 4, fr = lane & 15;
    const bf16* z = (const bf16*)(ws + WS_Z);
    const bf16* w1t = (const bf16*)(ws + WS_CW1) + (size_t)(layer * 2 + kv) * 128 * 2048;
    const int colb = (kv ? ZC_VC : ZC_KC) + g * 64;
    f32x4 acc[8];
#pragma unroll
    for (int ht = 0; ht < 8; ++ht) acc[ht] = (f32x4){0.f, 0.f, 0.f, 0.f};
    for (int li = 0; li < 4; ++li) { const int l = wave * 4 + li;
        int tok = 256 * nt + 16 * fr + l; tok = tok > SEQ - 1 ? SEQ - 1 : tok;
#pragma unroll
        for (int hf = 0; hf < 2; ++hf) {
            const bf16x8 B = ld_bf8(z + (size_t)(b * SEQ + tok) * ZLD + colb + 32 * hf + 8 * fq);
#pragma unroll
            for (int ht = 0; ht < 8; ++ht) { const bf16x8 A = ld_bf8(w1t + (size_t)(16 * ht + fr) * 2048 + 64 * l + 32 * hf + 8 * fq);
                acc[ht] = __builtin_amdgcn_mfma_f32_16x16x32_bf16(A, B, acc[ht], 0, 0, 0); } } }
    LAS float* part = (LAS float*)lds;
    LAS float* hid = (LAS float*)(lds + 65536);
#pragma unroll
    for (int ht = 0; ht < 8; ++ht)
#pragma unroll
        for (int r = 0; r < 4; ++r) part[(wave * 128 + 16 * ht + 4 * fq + r) * 16 + fr] = acc[ht][r];
    __syncthreads();
    { const int hh = tid >> 2, nq = tid & 3; f32x4 s = (f32x4){0.f, 0.f, 0.f, 0.f};
#pragma unroll
      for (int w = 0; w < 8; ++w) s = s + *(LAS f32x4*)(part + (w * 128 + hh) * 16 + 4 * nq);
      const float cb = ((const float*)(ws + WS_CBIAS))[(layer * 2 + kv) * 128 + hh];
      f32x4 o; o.x = gelu_tanh(s.x + cb); o.y = gelu_tanh(s.y + cb); o.z = gelu_tanh(s.z + cb); o.w = gelu_tanh(s.w + cb);
      *(LAS f32x4*)(hid + hh * 16 + 4 * nq) = o; }
    __syncthreads();
    { const float* W2 = INF(kv ? IN_VCW2 : IN_KCW2) + (size_t)layer * 128 * 64; const int n = tid & 15, dg = tid >> 4; float o0 = 0.f, o1 = 0.f;
      for (int hh = 0; hh < 128; ++hh) { const float x = hid[hh * 16 + n]; o0 += x * W2[hh * 64 + dg]; o1 += x * W2[hh * 64 + dg + 32]; }
      const int ng = 16 * nt + n; if (ng >= NCMP) { o0 = 0.f; o1 = 0.f; }
      if (kv == 0) { bf16* kc = (bf16*)(ws + WS_KCMP) + ((size_t)(b * 2 + g) * 256 + ng) * 64; kc[dg] = (bf16)f2bf(o0); kc[dg + 32] = (bf16)f2bf(o1); }
      else { bf16* vc = (bf16*)(ws + WS_VCMPT) + (size_t)(b * 2 + g) * 64 * 256; vc[(size_t)dg * 256 + ng] = (bf16)f2bf(o0); vc[(size_t)(dg + 32) * 256 + ng] = (bf16)f2bf(o1); } }
    __syncthreads();
}

__device__ __forceinline__ void phase_prep(const Args& a, int layer, LAS unsigned char* lds) {
    const int tid = opaque_tid(), lane = tid & 63, wave = __builtin_amdgcn_readfirstlane(tid >> 6);
#ifndef NO_RWP
    if (wave < 4) for (int tile = blockIdx.x * 4 + wave; tile < MT / 16; tile += gridDim.x * 4) rwkv_prep_tile(a, layer, tile * 16, lane);
#endif
#ifndef NO_NSAP
    for (int it = blockIdx.x; it < NB * 64; it += gridDim.x) nsa_prep_item(a, lds, it >> 6, it & 63);
#endif
#ifndef NO_CMP
    for (int it = blockIdx.x; it < NB * 2 * 2 * 16; it += gridDim.x) nsa_compress_item(a, layer, lds, it >> 6, (it >> 5) & 1, (it >> 4) & 1, it & 15);
#endif
}

__device__ __forceinline__ float dpp_xor1(float x) { return __builtin_bit_cast(float, __builtin_amdgcn_update_dpp(0, __builtin_bit_cast(int, x), 0xB1, 0xf, 0xf, true)); }
__device__ __forceinline__ float dpp_xor2(float x) { return __builtin_bit_cast(float, __builtin_amdgcn_update_dpp(0, __builtin_bit_cast(int, x), 0x4E, 0xf, 0xf, true)); }
__device__ __forceinline__ float dpp_hmir(float x) { return __builtin_bit_cast(float, __builtin_amdgcn_update_dpp(0, __builtin_bit_cast(int, x), 0x141, 0xf, 0xf, true)); }
__device__ __forceinline__ float red8(float x) { x += dpp_xor1(x); x += dpp_xor2(x); x += dpp_hmir(x); return x; }

__device__ __forceinline__ void rwkv_scan(const Args& a, LAS unsigned char* lds, int bh) {
    unsigned char* ws = a.ws; const int tid = opaque_tid(), lane = tid & 63, wave = __builtin_amdgcn_readfirstlane(tid >> 6);
    const int row = wave * 8 + (lane >> 3), kq = lane & 7;
    const f32x4* rec4 = (const f32x4*)(ws + WS_REC) + (size_t)bh * SEQ * 96;
    float* yraw = (float*)(ws + WS_YRAW) + (size_t)(bh >> 2) * SEQ * 256 + (bh & 3) * 64 + row;
    LAS f32x4* buf = (LAS f32x4*)lds;
    float s[8];
#pragma unroll
    for (int j = 0; j < 8; ++j) s[j] = 0.f;
    { f32x4 p0 = rec4[tid], p1 = rec4[tid + 512], p2 = rec4[tid + 1024]; buf[tid] = p0; buf[tid + 512] = p1; buf[tid + 1024] = p2; }
    __syncthreads();
    for (int c = 0; c < SEQ / 16; ++c) {
        const int p = c & 1;
        f32x4 n0, n1, n2; const bool more = (c + 1 < SEQ / 16);
        if (more) { const f32x4* src = rec4 + (size_t)(c + 1) * 1536; n0 = src[tid]; n1 = src[tid + 512]; n2 = src[tid + 1024]; }
        const LAS f32x4* bp = buf + p * 1536;
#pragma unroll 4
        for (int st = 0; st < 16; ++st) {
            const LAS f32x4* sp = bp + st * 96;
            const f32x4 w0 = sp[2 * kq], w1 = sp[2 * kq + 1], k0 = sp[16 + 2 * kq], k1 = sp[16 + 2 * kq + 1], b0 = sp[32 + 2 * kq], b1 = sp[32 + 2 * kq + 1];
            const f32x4 q0 = sp[48 + 2 * kq], q1 = sp[48 + 2 * kq + 1], r0 = sp[64 + 2 * kq], r1 = sp[64 + 2 * kq + 1];
            const float vv = ((const LAS float*)(sp + 80))[row];
            const float wv[8] = {w0.x, w0.y, w0.z, w0.w, w1.x, w1.y, w1.z, w1.w}, kk[8] = {k0.x, k0.y, k0.z, k0.w, k1.x, k1.y, k1.z, k1.w};
            const float bv[8] = {b0.x, b0.y, b0.z, b0.w, b1.x, b1.y, b1.z, b1.w}, kp[8] = {q0.x, q0.y, q0.z, q0.w, q1.x, q1.y, q1.z, q1.w};
            const float rr[8] = {r0.x, r0.y, r0.z, r0.w, r1.x, r1.y, r1.z, r1.w};
            float d1 = (s[0] * kk[0] + s[1] * kk[1]) + (s[2] * kk[2] + s[3] * kk[3]) + ((s[4] * kk[4] + s[5] * kk[5]) + (s[6] * kk[6] + s[7] * kk[7]));
            d1 = red8(d1);
            const float sa = -d1;
            float d2 = 0.f;
#pragma unroll
            for (int j = 0; j < 8; ++j) { s[j] = s[j] * wv[j] + (sa * bv[j] + vv * kp[j]); d2 += s[j] * rr[j]; }
            d2 = red8(d2);
            if (kq == 0) yraw[(size_t)(c * 16 + st) * 256] = d2;
        }
        if (more) { LAS f32x4* dp = buf + (p ^ 1) * 1536; dp[tid] = n0; dp[tid + 512] = n1; dp[tid + 1024] = n2; }
        __syncthreads();
    }
}

__device__ __forceinline__ void phase_rwpost(const Args& a, int layer) {
    unsigned char* ws = a.ws; const int tid = opaque_tid();
    const float* yraw = (const float*)(ws + WS_YRAW); const float* gbuf = (const float*)(ws + WS_G); const float* bonus = (const float*)(ws + WS_BONUS); const float* rec = (const float*)(ws + WS_REC);
    const float* gng = INF(IN_RWGNG) + layer * 256; const float* gnb = INF(IN_RWGNB) + layer * 256;
    bf16* ycat = (bf16*)(ws + WS_YCAT);
    const size_t total = (size_t)MT * 64;
    for (size_t i = (size_t)blockIdx.x * NTHR + tid; i < total; i += (size_t)gridDim.x * NTHR) {
        const int m = (int)(i >> 6), c0 = (int)(i & 63) * 4, h = c0 >> 6, bb = m >> 12, tpos = m & (SEQ - 1);
        const f32x4 y = *(const f32x4*)(yraw + (size_t)m * 256 + c0);
        float s = (y.x + y.y) + (y.z + y.w);
        s += __shfl_xor(s, 1); s += __shfl_xor(s, 2); s += __shfl_xor(s, 4); s += __shfl_xor(s, 8);
        const float mean = s * (1.0f / 64.0f);
        const f32x4 d = y - mean; float q = (d.x * d.x + d.y * d.y) + (d.z * d.z + d.w * d.w);
        q += __shfl_xor(q, 1); q += __shfl_xor(q, 2); q += __shfl_xor(q, 4); q += __shfl_xor(q, 8);
        const float rstd = 1.0f / sqrtf(q * (1.0f / 64.0f) + 64e-5f);
        const f32x4 gg = *(const f32x4*)(gng + c0), gb = *(const f32x4*)(gnb + c0), gt = *(const f32x4*)(gbuf + (size_t)m * 256 + c0);
        const f32x4 vv = *(const f32x4*)(rec + ((size_t)(bb * 4 + h) * SEQ + tpos) * 384 + 320 + (c0 & 63));
        const float bo = bonus[(size_t)m * 4 + h];
        f32x4 o = (d * rstd * gg + gb + vv * bo) * gt;
        u32x2 w; w.x = pk2(o.x, o.y); w.y = pk2(o.z, o.w);
        *(u32x2*)(ycat + (size_t)m * DM + 256 + c0) = w;
    }
}

__device__ __forceinline__ void gmlp_item(const Args& a, int layer, LAS unsigned char* lds, int b, int n, int h) {
    unsigned char* ws = a.ws; const int tid = opaque_tid(), lane = tid & 63, wave = __builtin_amdgcn_readfirstlane(tid >> 6), fq = lane >> 4, fr = lane & 15;
    const bf16* z = (const bf16*)(ws + WS_Z); bf16* ycat = (bf16*)(ws + WS_YCAT);
    LAS bf16* vt = (LAS bf16*)lds;
    const int mb = b * SEQ + n * 128;
    { const int s = tid >> 2, part = tid & 3; const bf16* src = z + (size_t)(mb + s) * ZLD + ZC_V + h * 64 + part * 16;
      const u32x4 v0 = ((const u32x4*)src)[0], v1 = ((const u32x4*)src)[1];
      float x[16] = {bflo(v0.x), bfhi(v0.x), bflo(v0.y), bfhi(v0.y), bflo(v0.z), bfhi(v0.z), bflo(v0.w), bfhi(v0.w), bflo(v1.x), bfhi(v1.x), bflo(v1.y), bfhi(v1.y), bflo(v1.z), bfhi(v1.z), bflo(v1.w), bfhi(v1.w)};
      float sm = 0.f;
#pragma unroll
      for (int j = 0; j < 16; ++j) { x[j] = gelu_tanh(x[j]); sm += x[j]; }
      sm += __shfl_xor(sm, 1); sm += __shfl_xor(sm, 2);
      const float mean = sm * (1.0f / 64.0f); float q = 0.f;
#pragma unroll
      for (int j = 0; j < 16; ++j) { x[j] -= mean; q += x[j] * x[j]; }
      q += __shfl_xor(q, 1); q += __shfl_xor(q, 2);
      const float rstd = 1.0f / sqrtf(q * (1.0f / 64.0f) + 1e-5f);
      const float* lg = INF(IN_GMLNG) + (layer * 4 + h) * 64 + part * 16; const float* lb = INF(IN_GMLNB) + (layer * 4 + h) * 64 + part * 16;
#pragma unroll
      for (int j = 0; j < 16; ++j) vt[(part * 16 + j) * 136 + s] = (bf16)f2bf(x[j] * rstd * lg[j] + lb[j]); }
    __syncthreads();
    {
        const float* W = INF(IN_GMWS) + ((size_t)(layer * 4 + h) * 128 + 16 * wave + fr) * 128;
        f32x4 acc[4];
#pragma unroll
        for (int dt = 0; dt < 4; ++dt) acc[dt] = (f32x4){0.f, 0.f, 0.f, 0.f};
        const int trow = 16 * wave + fr; const int nks = (wave >> 1) + 1;
        for (int ks = 0; ks < nks; ++ks) {
            const int s0 = 32 * ks + 8 * fq; const f32x4 wa = *(const f32x4*)(W + s0), wb = *(const f32x4*)(W + s0 + 4);
            float wv[8] = {wa.x, wa.y, wa.z, wa.w, wb.x, wb.y, wb.z, wb.w};
#pragma unroll
            for (int j = 0; j < 8; ++j) wv[j] = (s0 + j <= trow) ? wv[j] : 0.f;
            const bf16x8 A = pack8(wv);
#pragma unroll
            for (int dt = 0; dt < 4; ++dt) { const bf16x8 B = *(const LAS bf16x8*)(vt + (16 * dt + fr) * 136 + s0); acc[dt] = __builtin_amdgcn_mfma_f32_16x16x32_bf16(A, B, acc[dt], 0, 0, 0); } }
        const float* bs = INF(IN_GMBS) + (layer * 4 + h) * 128;
#pragma unroll
        for (int r = 0; r < 4; ++r) { const int t = 16 * wave + 4 * fq + r; const float bias = bs[t];
#pragma unroll
            for (int dt = 0; dt < 4; ++dt) { const int d = 16 * dt + fr; const float u = gelu_tanh(bf2f(z[(size_t)(mb + t) * ZLD + ZC_U + h * 64 + d]));
                ycat[(size_t)(mb + t) * DM + h * 64 + d] = (bf16)f2bf(u * (acc[dt][r] + bias)); } }
    }
    __syncthreads();
}

constexpr int NSA_KB = 0, NSA_VB = 18432, NSA_IMP = 36864, NSA_SELM = 53248, NSA_UNI = 53760, NSA_OT = 54272;
struct NsaTileSrc { const bf16* kbase; int kld; const bf16* vbase; int vld; };

__device__ __forceinline__ void nsa_tile_load(const NsaTileSrc& S, int kb, int tid, u32x4& kr, u32x4& vr) {
    const int row = tid >> 3, ch = tid & 7;
    kr = *(const u32x4*)(S.kbase + (size_t)(kb * 64 + row) * S.kld + ch * 8);
    vr = *(const u32x4*)(S.vbase + (size_t)row * S.vld + kb * 64 + ch * 8);
}
__device__ __forceinline__ void nsa_tile_store(LAS unsigned char* lds, int p, int tid, const u32x4& kr, const u32x4& vr) {
    const int row = tid >> 3, ch = tid & 7;
    *(LAS u32x4*)(lds + NSA_KB + p * 9216 + (row * 72 + ch * 8) * 2) = kr;
    *(LAS u32x4*)(lds + NSA_VB + p * 9216 + (row * 72 + ch * 8) * 2) = vr;
}
__device__ __forceinline__ void nsa_scores(LAS unsigned char* lds, int p, const bf16x8 (&Q)[2][2], f32x4 (&sc)[4][2], int fq, int fr) {
#pragma unroll
    for (int kt = 0; kt < 4; ++kt) {
        const LAS unsigned char* kp = lds + NSA_KB + p * 9216 + ((16 * kt + fr) * 72 + 8 * fq) * 2;
        const bf16x8 K0 = *(const LAS bf16x8*)kp, K1 = *(const LAS bf16x8*)(kp + 64);
#pragma unroll
        for (int qg = 0; qg < 2; ++qg) { f32x4 c = (f32x4){0.f, 0.f, 0.f, 0.f};
            c = __builtin_amdgcn_mfma_f32_16x16x32_bf16(K0, Q[qg][0], c, 0, 0, 0); c = __builtin_amdgcn_mfma_f32_16x16x32_bf16(K1, Q[qg][1], c, 0, 0, 0); sc[kt][qg] = c; } }
}
template <int MODE>
__device__ __forceinline__ bool nsa_allowed(int kidx, int t, int kb, unsigned long long selm) {
    if (MODE == 0) return (16 * kidx + 31 <= t) && (kidx < NCMP);
    if (MODE == 1) return (kidx <= t) && ((selm >> kb) & 1ull);
    return (kidx <= t) && (kidx + 512 > t);
}
template <int MODE>
__device__ __forceinline__ void nsa_tile_compute(LAS unsigned char* lds, int p, int kb, const bf16x8 (&Q)[2][2], const int (&tq)[2], const unsigned long long (&selm)[2],
                                                 float (&m_run)[2], float (&l_run)[2], f32x4 (&O)[4][2], int fq, int fr) {
    f32x4 sc[4][2];
    nsa_scores(lds, p, Q, sc, fq, fr);
    const float SC = 0.125f * 1.4426950408889634f;
    bf16x8 P[2][2];
#pragma unroll
    for (int qg = 0; qg < 2; ++qg) {
        float mx = -1e30f;
#pragma unroll
        for (int kt = 0; kt < 4; ++kt)
#pragma unroll
            for (int r = 0; r < 4; ++r) { const int kidx = kb * 64 + 16 * kt + 4 * fq + r;
                const float v = nsa_allowed<MODE>(kidx, tq[qg], kb, selm[qg]) ? sc[kt][qg][r] * SC : -1e30f; sc[kt][qg][r] = v; mx = fmaxf(mx, v); }
        mx = fmaxf(mx, __shfl_xor(mx, 16)); mx = fmaxf(mx, __shfl_xor(mx, 32));
        const float mn = fmaxf(m_run[qg], mx); const float alpha = __builtin_amdgcn_exp2f(m_run[qg] - mn); m_run[qg] = mn;
        float ls = 0.f; float pv[4][4];
#pragma unroll
        for (int kt = 0; kt < 4; ++kt)
#pragma unroll
            for (int r = 0; r < 4; ++r) { const float sv = sc[kt][qg][r]; const float e = (sv > -1e29f) ? __builtin_amdgcn_exp2f(sv - mn) : 0.f; pv[kt][r] = e; ls += e; }
        l_run[qg] = l_run[qg] * alpha + ls;
#pragma unroll
        for (int dt = 0; dt < 4; ++dt) O[dt][qg] = O[dt][qg] * alpha;
#pragma unroll
        for (int s = 0; s < 2; ++s) { u32x4 w; w.x = pk2(pv[2 * s][0], pv[2 * s][1]); w.y = pk2(pv[2 * s][2], pv[2 * s][3]); w.z = pk2(pv[2 * s + 1][0], pv[2 * s + 1][1]); w.w = pk2(pv[2 * s + 1][2], pv[2 * s + 1][3]);
            P[qg][s] = __builtin_bit_cast(bf16x8, w); }
    }
#pragma unroll
    for (int dt = 0; dt < 4; ++dt)
#pragma unroll
        for (int s = 0; s < 2; ++s) {
            const LAS unsigned char* vp = lds + NSA_VB + p * 9216 + ((16 * dt + fr) * 72 + 32 * s + 4 * fq) * 2;
            const u32x2 a0 = *(const LAS u32x2*)vp, a1 = *(const LAS u32x2*)(vp + 32);
            const u32x4 aw = (u32x4){a0.x, a0.y, a1.x, a1.y}; const bf16x8 A = __builtin_bit_cast(bf16x8, aw);
#pragma unroll
            for (int qg = 0; qg < 2; ++qg) O[dt][qg] = __builtin_amdgcn_mfma_f32_16x16x32_bf16(A, P[qg][s], O[dt][qg], 0, 0, 0);
        }
}

template <int MODE>
__device__ __forceinline__ void nsa_branch(LAS unsigned char* lds, const NsaTileSrc& S, int kb_lo, int kb_hi, unsigned long long tilemask, const bf16x8 (&Q)[2][2], const int (&tq)[2],
                                           const unsigned long long (&selm)[2], const float (&gate)[2], const bool first, float (&m_out)[2], float (&l_out)[2], int tid, int fq, int fr) {
    float m_run[2] = {-1e30f, -1e30f}, l_run[2] = {0.f, 0.f}; f32x4 O[4][2];
#pragma unroll
    for (int dt = 0; dt < 4; ++dt)
#pragma unroll
        for (int qg = 0; qg < 2; ++qg) O[dt][qg] = (f32x4){0.f, 0.f, 0.f, 0.f};
    int cur = kb_lo; while (cur <= kb_hi && !((tilemask >> cur) & 1ull)) ++cur;
    if (cur <= kb_hi) {
        u32x4 kr, vr; nsa_tile_load(S, cur, tid, kr, vr); nsa_tile_store(lds, 0, tid, kr, vr);
        __syncthreads();
        int p = 0;
        while (cur <= kb_hi) {
            int nxt = cur + 1; while (nxt <= kb_hi && !((tilemask >> nxt) & 1ull)) ++nxt;
            if (nxt <= kb_hi) nsa_tile_load(S, nxt, tid, kr, vr);
            nsa_tile_compute<MODE>(lds, p, cur, Q, tq, selm, m_run, l_run, O, fq, fr);
            if (nxt <= kb_hi) nsa_tile_store(lds, p ^ 1, tid, kr, vr);
            __syncthreads();
            p ^= 1; cur = nxt;
        }
    }
#pragma unroll
    for (int qg = 0; qg < 2; ++qg) { float l = l_run[qg]; l += __shfl_xor(l, 16); l += __shfl_xor(l, 32); l_out[qg] = l; m_out[qg] = m_run[qg];
        const float sc = l > 0.f ? gate[qg] / l : 0.f;
        LAS float* ot = (LAS float*)(lds + NSA_OT) + tid;
#pragma unroll
        for (int dt = 0; dt < 4; ++dt)
#pragma unroll
            for (int r = 0; r < 4; ++r) { LAS float* pp = ot + ((dt * 2 + qg) * 4 + r) * 512; const float v = O[dt][qg][r] * sc; *pp = first ? v : (*pp + v); } }
}

__device__ __forceinline__ void nsa_item(const Args& a, LAS unsigned char* lds, int b, int g, int T) {
    unsigned char* ws = a.ws; const int tid = opaque_tid(), lane = tid & 63, wave = __builtin_amdgcn_readfirstlane(tid >> 6), fq = lane >> 4, fr = lane & 15;
    const bf16* z = (const bf16*)(ws + WS_Z);
    const int head = g * 4 + (fr & 3);
    int tq[2], mq[2]; bf16x8 Qraw[2][2]; float gt[2][3];
#pragma unroll
    for (int qg = 0; qg < 2; ++qg) { const int tl = 8 * wave + 4 * qg + (fr >> 2); tq[qg] = T * 64 + tl; mq[qg] = b * SEQ + tq[qg];
#pragma unroll
        for (int ks = 0; ks < 2; ++ks) Qraw[qg][ks] = ld_bf8(z + (size_t)mq[qg] * ZLD + ZC_Q + head * 64 + 32 * ks + 8 * fq);
#pragma unroll
        for (int br = 0; br < 3; ++br) gt[qg][br] = sigmoidf_(bf2f(z[(size_t)mq[qg] * ZLD + ZC_GT + head * 3 + br])); }
    if (tid < 64) { ((LAS unsigned long long*)(lds + NSA_SELM))[tid] = 0ull; if (tid < 2) ((LAS unsigned*)(lds + NSA_UNI))[tid] = 0u; }
    const unsigned long long nosel[2] = {0ull, 0ull};
    NsaTileSrc SC_; SC_.kbase = (const bf16*)(ws + WS_KCMP) + (size_t)(b * 2 + g) * 256 * 64; SC_.kld = 64; SC_.vbase = (const bf16*)(ws + WS_VCMPT) + (size_t)(b * 2 + g) * 64 * 256; SC_.vld = 256;
    float mc[2], lc[2];
    { float gc[2] = {gt[0][0], gt[1][0]};
      nsa_branch<0>(lds, SC_, 0, 3, ~0ull, Qraw, tq, nosel, gc, true, mc, lc, tid, fq, fr); }
    {
        LAS float* imp = (LAS float*)(lds + NSA_IMP);
        float carry[2] = {0.f, 0.f}; const float SCL = 0.125f * 1.4426950408889634f;
        float invl[2] = {lc[0] > 0.f ? 1.0f / lc[0] : 0.f, lc[1] > 0.f ? 1.0f / lc[1] : 0.f};
        for (int kb = 0; kb < 4; ++kb) {
            { const int row = tid >> 3, ch = tid & 7; *(LAS u32x4*)(lds + NSA_KB + (row * 72 + ch * 8) * 2) = *(const u32x4*)(SC_.kbase + (size_t)(kb * 64 + row) * 64 + ch * 8); }
            __syncthreads();
            f32x4 sc[4][2]; nsa_scores(lds, 0, Qraw, sc, fq, fr);
#pragma unroll
            for (int kt = 0; kt < 4; ++kt)
#pragma unroll
                for (int qg = 0; qg < 2; ++qg) { float pn[4];
#pragma unroll
                    for (int r = 0; r < 4; ++r) { const int kidx = kb * 64 + 16 * kt + 4 * fq + r; const bool al = nsa_allowed<0>(kidx, tq[qg], kb, 0ull);
                        pn[r] = al ? __builtin_amdgcn_exp2f(sc[kt][qg][r] * SCL - mc[qg]) * invl[qg] : 0.f; }
                    const float y = __shfl(pn[3], (lane + 48) & 63);
                    float v = (pn[0] + pn[1]) + (pn[2] + pn[3]) + (fq == 0 ? carry[qg] : y); carry[qg] = y;
                    v += __shfl_xor(v, 1); v += __shfl_xor(v, 2);
                    if ((fr & 3) == 0) imp[(8 * wave + 4 * qg + (fr >> 2)) * 64 + 16 * kb + 4 * kt + fq] = v; }
            __syncthreads();
        }
    }
    {
        const LAS float* imp = (const LAS float*)(lds + NSA_IMP);
        const int tl = tid >> 3, part = tid & 7; float vm[8]; int cnt[8];
        { const f32x4 x0 = *(const LAS f32x4*)(imp + tl * 64 + part * 8), x1 = *(const LAS f32x4*)(imp + tl * 64 + part * 8 + 4);
          const float xx[8] = {x0.x, x0.y, x0.z, x0.w, x1.x, x1.y, x1.z, x1.w};
#pragma unroll
          for (int j = 0; j < 8; ++j) { const int mi = part * 8 + j; const bool valid = mi <= T; const bool forced = (mi == 0) || (mi == T) || (mi == T - 1);
              vm[j] = valid ? xx[j] + (forced ? 1e4f : 0.f) : -1e4f; cnt[j] = 0; } }
        for (int q4 = 0; q4 < 16; ++q4) { const f32x4 x = *(const LAS f32x4*)(imp + tl * 64 + 4 * q4); const float xq[4] = {x.x, x.y, x.z, x.w};
#pragma unroll
            for (int i = 0; i < 4; ++i) { const int q = 4 * q4 + i; const bool valid = q <= T; const bool forced = (q == 0) || (q == T) || (q == T - 1);
                const float vq = valid ? xq[i] + (forced ? 1e4f : 0.f) : -1e4f;
#pragma unroll
                for (int j = 0; j < 8; ++j) { const int mi = part * 8 + j; cnt[j] += (vq > vm[j] || (vq == vm[j] && q < mi)) ? 1 : 0; } } }
        unsigned bits = 0u;
#pragma unroll
        for (int j = 0; j < 8; ++j) if (cnt[j] < 16 && vm[j] > -5000.f) bits |= 1u << j;
        atomicOr((unsigned*)(lds + NSA_SELM) + tl * 2 + (part >> 2), bits << (8 * (part & 3)));
        atomicOr((unsigned*)(lds + NSA_UNI) + (part >> 2), bits << (8 * (part & 3)));
    }
    __syncthreads();
    bf16x8 Qrot[2][2];
#pragma unroll
    for (int qg = 0; qg < 2; ++qg)
#pragma unroll
        for (int ks = 0; ks < 2; ++ks) Qrot[qg][ks] = ld_bf8((const bf16*)(ws + WS_QROT) + (size_t)mq[qg] * 512 + head * 64 + 32 * ks + 8 * fq);
    unsigned long long selm[2], uni;
    { const LAS unsigned long long* sm = (const LAS unsigned long long*)(lds + NSA_SELM); selm[0] = sm[8 * wave + (fr >> 2)]; selm[1] = sm[8 * wave + 4 + (fr >> 2)]; const LAS unsigned* up = (const LAS unsigned*)(lds + NSA_UNI); uni = ((unsigned long long)(unsigned)__builtin_amdgcn_readfirstlane(up[1]) << 32) | (unsigned)__builtin_amdgcn_readfirstlane(up[0]); }
    { NsaTileSrc SS; SS.kbase = (const bf16*)(ws + WS_KSR) + (size_t)b * SEQ * 128 + g * 64; SS.kld = 128; SS.vbase = (const bf16*)(ws + WS_VST) + (size_t)(b * 2 + g) * 64 * SEQ; SS.vld = SEQ;
      float gs[2] = {gt[0][1], gt[1][1]}, mo[2], lo[2];
      nsa_branch<1>(lds, SS, 0, T, uni, Qrot, tq, selm, gs, false, mo, lo, tid, fq, fr); }
    { NsaTileSrc SW; SW.kbase = (const bf16*)(ws + WS_KWR) + (size_t)b * SEQ * 128 + g * 64; SW.kld = 128; SW.vbase = (const bf16*)(ws + WS_VWT) + (size_t)(b * 2 + g) * 64 * SEQ; SW.vld = SEQ;
      float gw_[2] = {gt[0][2], gt[1][2]}, mo[2], lo[2]; const int lo_kb = T >= 8 ? T - 8 : 0;
      nsa_branch<2>(lds, SW, lo_kb, T, ~0ull, Qrot, tq, nosel, gw_, false, mo, lo, tid, fq, fr); }
    bf16* ycat = (bf16*)(ws + WS_YCAT);
#pragma unroll
    for (int qg = 0; qg < 2; ++qg)
#pragma unroll
        for (int dt = 0; dt < 4; ++dt) { const LAS float* ot = (const LAS float*)(lds + NSA_OT) + tid + ((dt * 2 + qg) * 4) * 512;
            u32x2 w; w.x = pk2(ot[0], ot[512]); w.y = pk2(ot[1024], ot[1536]);
            *(u32x2*)(ycat + (size_t)mq[qg] * DM + 512 + head * 64 + 16 * dt + 4 * fq) = w; }
}

struct MoeOrder {
    const char* A; const char* W; size_t estride; int K, nct, G, c; int tst[9];
    __device__ bool next(int i, pg8::Unit& u) const {
        const long L = (long)i * G + c; if (L >= (long)tst[8] * nct) return false;
        const int rt = (int)(L / nct), ct = (int)(L % nct); int e = 0;
#pragma unroll
        for (int j = 1; j < 8; ++j) e += (rt >= tst[j]) ? 1 : 0;
        u.pm = rt; u.pn = ct; u.aux = e; return true;
    }
    __device__ __forceinline__ const char* abase(const pg8::Unit& u) const { return A + (size_t)u.pm * ((size_t)256 * K * 2); }
    __device__ __forceinline__ const char* bbase(const pg8::Unit& u) const { return W + (size_t)u.aux * estride + (size_t)u.pn * ((size_t)256 * K * 2); }
};
__device__ __forceinline__ void moe_order_init(MoeOrder& S, const Args& a, int rank, const void* A, const void* W, size_t estride, int K, int nct) {
    S.A = (const char*)A; S.W = (const char*)W; S.estride = estride; S.K = K; S.nct = nct; S.G = gridDim.x; S.c = blockIdx.x;
    const int* t = (const int*)(a.ws + WS_SLOT + SL_TST) + rank * 16;
#pragma unroll
    for (int j = 0; j < 9; ++j) S.tst[j] = __builtin_amdgcn_readfirstlane(t[j]);
}
__device__ __forceinline__ void moe_gather(const Args& a, int rb, int r) {
    unsigned char* ws = a.ws; const int tid = opaque_tid();
    const int* toks = (const int*)(ws + WS_SLOT + SL_TOKS);
    const u32x4* hn = (const u32x4*)(ws + WS_HN); u32x4* hns = (u32x4*)(ws + WS_HNS);
    for (int i = tid; i < 64 * 128; i += NTHR) { const int tl = i >> 7, ch = i & 127, m = rb * 64 + tl; const int slot = toks[2 * m + r];
        hns[(size_t)slot * 128 + ch] = hn[(size_t)m * 128 + ch]; }
}
__device__ __forceinline__ void phase_moe_assign(const Args& a, LAS unsigned char* lds) {
    unsigned char* ws = a.ws; const int tid = opaque_tid(), lane = tid & 63, wave = __builtin_amdgcn_readfirstlane(tid >> 6);
    LAS int* cn = (LAS int*)lds;
    LAS int* tot = cn + 4096; LAS int* base = tot + 16; LAS int* pre = base + 16;
    const int* bcnt = (const int*)(ws + WS_SLOT + SL_BCNT);
    for (int i = tid; i < 4096; i += NTHR) cn[i] = bcnt[i];
    __syncthreads();
    if (tid < 16) { int s = 0; for (int bb = 0; bb < 256; ++bb) s += cn[bb * 16 + tid]; tot[tid] = s; }
    __syncthreads();
    if (tid < 2) { int run = 0; int* tstg = (int*)(ws + WS_SLOT + SL_TST) + tid * 16;
        for (int e = 0; e < 8; ++e) { base[tid * 8 + e] = run * 256; if (blockIdx.x == 0) tstg[e] = run; run += (tot[tid * 8 + e] + 255) >> 8; }
        if (blockIdx.x == 0) tstg[8] = run; }
    __syncthreads();
    int* stok = (int*)(ws + WS_SLOT + SL_TOK); float* sgate = (float*)(ws + WS_SLOT + SL_GATE);
    if (blockIdx.x == 0) {
        for (int grp = 0; grp < 16; ++grp) { const int r = grp >> 3, lo = base[grp] + tot[grp], hi = base[grp] + (((tot[grp] + 255) >> 8) << 8);
            for (int s = lo + tid; s < hi; s += NTHR) { stok[r * MOE_SLOTS + s] = -1; sgate[r * MOE_SLOTS + s] = 0.f; } }
    }
    const int* te = (const int*)(ws + WS_SLOT + SL_TOKE); const float* tg = (const float*)(ws + WS_SLOT + SL_TOKG); int* toks = (int*)(ws + WS_SLOT + SL_TOKS);
    for (int rb = blockIdx.x; rb < MT / 64; rb += gridDim.x) {
        __syncthreads();
        if (tid < 16) { int s = 0; for (int bb = 0; bb < rb; ++bb) s += cn[bb * 16 + tid]; pre[tid] = s; }
        __syncthreads();
        if (wave == 0) { const int m = rb * 64 + lane;
#pragma unroll
            for (int r = 0; r < 2; ++r) { const int e = te[2 * m + r]; int slot = 0;
#pragma unroll
                for (int ee = 0; ee < 8; ++ee) { const unsigned long long mk = __ballot(e == ee); const int rk = __popcll(mk & ((1ull << lane) - 1ull)); if (e == ee) slot = base[r * 8 + ee] + pre[r * 8 + ee] + rk; }
                stok[r * MOE_SLOTS + slot] = m; sgate[r * MOE_SLOTS + slot] = tg[2 * m + r]; toks[2 * m + r] = slot; } }
        asm volatile("s_waitcnt vmcnt(0)" ::: "memory");
        __syncthreads();
        moe_gather(a, rb, 0);
    }
}
__device__ __forceinline__ void moe_convert_weights(const Args& a, LAS unsigned char* lds) {
    const int tid = opaque_tid(), lane = tid & 63, wave = __builtin_amdgcn_readfirstlane(tid >> 6);
    const int gw = blockIdx.x * NWAVES + wave, NGW = gridDim.x * NWAVES; LAS float* scr = (LAS float*)(lds + 1024 + wave * 16384);
    for (int e = 0; e < NEXP; ++e) {
        conv_matrix(INF(IN_MW1) + (size_t)e * DM * DFF, DM, DFF, (bf16*)(a.ws + WS_MW13) + (size_t)e * 5632 * DM, 1, gw, NGW, scr, lane);
        conv_matrix(INF(IN_MW3) + (size_t)e * DM * DFF, DM, DFF, (bf16*)(a.ws + WS_MW13) + (size_t)e * 5632 * DM, 2, gw, NGW, scr, lane);
        conv_matrix(INF(IN_MW2) + (size_t)e * DFF * DM, DFF, DM, (bf16*)(a.ws + WS_MW2) + (size_t)e * DM * DFF, 0, gw, NGW, scr, lane);
    }
}

constexpr int NPL = 14, NPHASES = 1 + 2 * NPL;
__host__ __device__ constexpr bool phase_empty(int k) { return k >= 1 && k < 1 + NPL && ((k - 1) >= 8 && (k - 1) <= 10); }

__global__ void __launch_bounds__(NTHR, 2) hybrid_fwd(Args a) {
    extern __shared__ __attribute__((aligned(16))) unsigned char lds_raw[];
    LAS unsigned char* lds = (LAS unsigned char*)lds_raw;
    volatile LAS unsigned* MISC = (volatile LAS unsigned*)(lds + MISC_OFF);
    const int tid = opaque_tid();
    unsigned char* ws = a.ws; unsigned* ctl = (unsigned*)(ws + WS_CTL);
    for (int u = tid; u < (LDS_BYTES - MISC_OFF) / 4; u += NTHR) MISC[u] = 0u;
    __syncthreads();
    if (tid < N_INPUTS) *(LAS unsigned long long*)(lds + PTAB_OFF + 8 * tid) = (unsigned long long)a.in[tid];
    __syncthreads();
    const int lo = a.ph_lo, hi = a.ph_hi;
    const bool multi = (hi - lo) > 1;
    XcdBarrier bar; bar.bar = ctl + CW_BAR; bar.x = 0; bar.st = nullptr;
    if (multi) bar = xcd_barrier_post(ctl + CW_BAR, MISC + 8);
#ifndef PHSEL
#define PHSEL -1
#endif
#define IN(k) (lo <= (k) && (k) < hi)
#define INL(j) ((PHSEL == -1 || PHSEL == (j)) && IN(pb + (j)))
#define SEAM(k) do { if ((k) + 1 < hi) xcd_barrier(bar); } while (0)
    const int G = gridDim.x, bx = blockIdx.x;

    if ((PHSEL == -1 || PHSEL == 100) && IN(0)) { phase_prologue(a, lds); SEAM(0); }

    for (int l = 0; l < 2; ++l) {
        const int pb = 1 + l * NPL;
        if (INL(0)) { pg8::StaticOrder S; S.init(ws + WS_HN, (bf16*)(ws + WS_WIN) + (size_t)l * ZLD * DM, MT, ZLD, DM, G, bx);
            pg8::EpiBf16Store E{(bf16*)(ws + WS_Z), ZLD}; pg8::gemm_phase(lds, DM, S, E); SEAM(pb + 0); }
        if (INL(1)) { phase_prep(a, l, lds); SEAM(pb + 1); }
        if (INL(2)) {
#ifndef NO_SCAN
            for (int bh = bx; bh < 16; bh += G) rwkv_scan(a, lds, bh);
#endif
            unsigned* qn = ctl + CW_Q + 64 * (l * 2), *qg = ctl + CW_Q + 64 * (l * 2 + 1);
#ifndef NO_NSA
            for (;;) { __syncthreads(); if (tid == 0) MISC[16] = __hip_atomic_fetch_add(qn, 1u, __ATOMIC_RELAXED, __HIP_MEMORY_SCOPE_AGENT); __syncthreads();
                const int it = (int)MISC[16]; if (it >= 512) break; nsa_item(a, lds, (it & 7) >> 1, it & 1, 63 - (it >> 3)); }
#endif
#ifndef NO_GMLP
            for (;;) { __syncthreads(); if (tid == 0) MISC[16] = __hip_atomic_fetch_add(qg, 1u, __ATOMIC_RELAXED, __HIP_MEMORY_SCOPE_AGENT); __syncthreads();
                const int it = (int)MISC[16]; if (it >= 512) break; gmlp_item(a, l, lds, it >> 7, (it >> 2) & 31, it & 3); }
#endif
            SEAM(pb + 2); }
        if (INL(3)) { phase_rwpost(a, l); SEAM(pb + 3); }
        if (INL(4)) { pg8::StaticOrder S; S.init(ws + WS_YCAT, (bf16*)(ws + WS_WOUT) + (size_t)l * DM * DM, MT, DM, DM, G, bx);
            pg8::EpiResAdd E{a.out, DM}; pg8::gemm_phase(lds, DM, S, E); SEAM(pb + 4); }
        if (INL(5)) { if (l == 0) phase_norm<0>(a, lds, INF(IN_GFFN)); else { moe_convert_weights(a, lds); __syncthreads(); phase_norm<1>(a, lds, INF(IN_GFFN) + DM); } SEAM(pb + 5); }
        if (l == 0) {
            if (INL(6)) { pg8::StaticOrder S; S.init(ws + WS_HN, ws + WS_W13, MT, 2 * DFF, DM, G, bx); pg8::EpiSwiglu E{(bf16*)(ws + WS_ACT), DFF}; pg8::gemm_phase(lds, DM, S, E); SEAM(pb + 6); }
            if (INL(7)) { pg8::StaticOrder S; S.init(ws + WS_ACT, ws + WS_W2, MT, DM, DFF, G, bx); pg8::EpiResAdd E{a.out, DM}; pg8::gemm_phase(lds, DFF, S, E); if (pb + 11 < hi) xcd_barrier(bar); }
        } else {
            if (INL(6)) { phase_moe_assign(a, lds); SEAM(pb + 6); }
            if (INL(7)) { MoeOrder S; moe_order_init(S, a, 0, ws + WS_HNS, ws + WS_MW13, (size_t)5632 * DM * 2, DM, 22); pg8::EpiSwiglu E{(bf16*)(ws + WS_ACTM), DFF}; pg8::gemm_phase(lds, DM, S, E); SEAM(pb + 7); }
            if (INL(8)) { for (int rb = bx; rb < MT / 64; rb += G) moe_gather(a, rb, 1);
                MoeOrder S; moe_order_init(S, a, 0, ws + WS_ACTM, ws + WS_MW2, (size_t)DM * DFF * 2, DFF, 4);
                pg8::EpiMoe2 E{a.out, (const int*)(ws + WS_SLOT + SL_TOK), (const float*)(ws + WS_SLOT + SL_GATE), DM}; pg8::gemm_phase(lds, DFF, S, E); SEAM(pb + 8); }
            if (INL(9)) { MoeOrder S; moe_order_init(S, a, 1, ws + WS_HNS, ws + WS_MW13, (size_t)5632 * DM * 2, DM, 22); pg8::EpiSwiglu E{(bf16*)(ws + WS_ACTM), DFF}; pg8::gemm_phase(lds, DM, S, E); SEAM(pb + 9); }
            if (INL(10)) { MoeOrder S; moe_order_init(S, a, 1, ws + WS_ACTM, ws + WS_MW2, (size_t)DM * DFF * 2, DFF, 4);
                pg8::EpiMoe2 E{a.out, (const int*)(ws + WS_SLOT + SL_TOK) + MOE_SLOTS, (const float*)(ws + WS_SLOT + SL_GATE) + MOE_SLOTS, DM}; pg8::gemm_phase(lds, DFF, S, E); SEAM(pb + 10); }
        }
        if (INL(11)) { phase_norm<0>(a, lds, INF(IN_GPLE) + l * DM); SEAM(pb + 11); }
        if (INL(12)) {
            { pg8::StaticOrder S; S.init((bf16*)(ws + WS_PB) + (size_t)l * MT * 256, (bf16*)(ws + WS_WP) + (size_t)l * DM * 256, MT, DM, 256, G, bx); pg8::EpiBf16Store E{(bf16*)(ws + WS_PP), DM}; pg8::gemm_phase(lds, 256, S, E); }
            { pg8::StaticOrder S; S.init(ws + WS_HN, (bf16*)(ws + WS_WG) + (size_t)l * DM * DM, MT, DM, DM, G, bx); pg8::EpiPle E{a.out, (const bf16*)(ws + WS_PP), DM}; pg8::gemm_phase(lds, DM, S, E); }
            SEAM(pb + 12); }
        if (INL(13)) { if (l == 0) { phase_norm<0>(a, lds, INF(IN_GMIX) + DM); SEAM(pb + 13); } else phase_norm<2>(a, lds, INF(IN_GFINAL)); }
    }
#undef IN
#undef INL
#undef SEAM
}

extern "C" void kernel_launch(void* const* d_in, const int* in_sizes, int n_in, void* d_out, int out_size, void* d_ws, size_t ws_size, hipStream_t stream) {
    static int grid = 0;
    if (grid == 0) {
        if (n_in != N_INPUTS || out_size != MT * DM || ws_size < WS_END) { fprintf(stderr, "kernel_launch: unexpected shapes (n_in %d, out %d, ws %zu)\n", n_in, out_size, ws_size); grid = -1; return; }
        int dev = 0, cus = 0, per_cu = 0;
        if (hipGetDevice(&dev) != hipSuccess || hipDeviceGetAttribute(&cus, hipDeviceAttributeMultiprocessorCount, dev) != hipSuccess) { grid = -1; return; }
        if (hipFuncSetAttribute((const void*)hybrid_fwd, hipFuncAttributeMaxDynamicSharedMemorySize, LDS_BYTES) != hipSuccess) { fprintf(stderr, "kernel_launch: hipFuncSetAttribute failed\n"); grid = -1; return; }
        if (hipOccupancyMaxActiveBlocksPerMultiprocessor(&per_cu, (const void*)hybrid_fwd, NTHR, LDS_BYTES) != hipSuccess || per_cu < 1) fprintf(stderr, "kernel_launch: occupancy query reports %d\n", per_cu);
        (void)hipGetLastError();
        grid = cus;
    }
    if (grid < 0) return;
    (void)hipMemsetAsync((char*)d_ws + WS_CTL, 0, CTL_ZERO_BYTES, stream);
    Args a{};
    for (int i = 0; i < N_INPUTS; ++i) a.in[i] = d_in[i];
    a.out = (float*)d_out; a.ws = (unsigned char*)d_ws;
#if MK_ONE_LAUNCH
    a.ph_lo = 0; a.ph_hi = NPHASES;
    hipLaunchKernelGGL(hybrid_fwd, dim3(grid), dim3(NTHR), LDS_BYTES, stream, a);
#else
    for (int k = 0; k < NPHASES; ++k) { if (phase_empty(k)) continue; a.ph_lo = k; a.ph_hi = k + 1;
        hipLaunchKernelGGL(hybrid_fwd, dim3(grid), dim3(NTHR), LDS_BYTES, stream, a); }
#endif
}
```

```cpp
#include <hip/hip_runtime.h>
#include <cstdio>
#include <cstdint>

#ifndef MK_ONE_LAUNCH
#define MK_ONE_LAUNCH 1
#endif

#define LAS __attribute__((address_space(3)))
#define GAS __attribute__((address_space(1)))
typedef unsigned short bf16;
typedef short bf16x8 __attribute__((ext_vector_type(8)));
typedef float f32x4 __attribute__((ext_vector_type(4)));
typedef float f32x2 __attribute__((ext_vector_type(2)));
typedef unsigned u32x4 __attribute__((ext_vector_type(4)));
typedef unsigned u32x2 __attribute__((ext_vector_type(2)));

constexpr int NB = 4, SEQ = 4096, DM = 1024, MT = NB * SEQ;
constexpr int DIN = 2840, ZLD = 3072;
constexpr int DFF = 2816, NEXP = 8;
constexpr int ZC_U = 0, ZC_V = 256, ZC_B = 512, ZC_Q = 1536, ZC_KC = 2048, ZC_VC = 2176, ZC_KS = 2304, ZC_VS = 2432, ZC_KW = 2560, ZC_VW = 2688, ZC_GT = 2816;
constexpr int NCMP = 255;
constexpr int NWAVES = 8, NTHR = 512;

__device__ __forceinline__ unsigned f2bf(float f) { unsigned u = __builtin_bit_cast(unsigned, f); return (u + 0x7fffu + ((u >> 16) & 1u)) >> 16; }
__device__ __forceinline__ float bf2f(unsigned b) { return __builtin_bit_cast(float, b << 16); }
__device__ __forceinline__ unsigned pk2(float lo, float hi) { return f2bf(lo) | (f2bf(hi) << 16); }
__device__ __forceinline__ float bflo(unsigned w) { return __builtin_bit_cast(float, w << 16); }
__device__ __forceinline__ float bfhi(unsigned w) { return __builtin_bit_cast(float, w & 0xffff0000u); }
__device__ __forceinline__ float sigmoidf_(float x) { return 1.0f / (1.0f + __expf(-x)); }
__device__ __forceinline__ float gelu_tanh(float x) { const float u = 0.7978845608028654f * (x + 0.044715f * x * x * x); const float e = __expf(-2.0f * fabsf(u)); float t = (1.0f - e) / (1.0f + e); t = u < 0.f ? -t : t; return 0.5f * x * (1.0f + t); }
__device__ __forceinline__ float wave_sum(float v) {
#pragma unroll
    for (int o = 1; o < 64; o <<= 1) v += __shfl_xor(v, o);
    return v;
}
__device__ __forceinline__ int opaque_tid() { int t = threadIdx.x; asm volatile("" : "+v"(t)); return t; }
#define LDS_WAIT() asm volatile("s_waitcnt lgkmcnt(0)" ::: "memory")
#define VM_WAIT() asm volatile("s_waitcnt vmcnt(0)" ::: "memory")

namespace pg8 {
constexpr int BM = 256, BK = 64, HALF = 128, HTB = HALF * BK * 2  , STAGE_BYTES = 8 * HTB, NXCD = 8, WGM = 8;
__host__ __device__ __forceinline__ int lds_byte(int r, int c) { const int st = (r >> 4) * 2 + (c >> 5), rr = r & 15, cc = c & 31, ob = rr * 64 + cc * 2; return st * 1024 + (ob ^ (((ob >> 9) & 1) << 5)); }
__host__ __device__ __forceinline__ void stage_rc(int b, int& R, int& C) { const int st = b / 1024, sb = b % 1024, swz = sb ^ (((sb >> 9) & 1) << 5); R = (st >> 1) * 16 + swz / 64; C = (st & 1) * 32 + (swz % 64) / 2; }
__host__ __device__ __forceinline__ int perm32(int rho) { const int n = rho >> 4, i = rho & 15; return 8 * (i >> 2) + 4 * n + (i & 3); }

struct Unit { int pm, pn, aux; };

struct StaticOrder {
    const char* A; const char* Bt; int K; int nM, nN, nwg, G, c;
    __device__ void init(const void* A_, const void* Bt_, int M, int N, int K_, int G_, int c_) { A = (const char*)A_; Bt = (const char*)Bt_; K = K_; nM = M / BM; nN = N / BM; nwg = nM * nN; G = G_; c = c_; }
    __device__ bool next(int i, Unit& u) const {
        const long L = (long)i * G + c; if (L >= nwg) return false;
        int wgid = (int)L; { const int q = nwg / NXCD, r = nwg % NXCD, xcd = wgid % NXCD, off = wgid / NXCD; wgid = (xcd < r ? xcd * (q + 1) : r * (q + 1) + (xcd - r) * q) + off; }
        const int nig = WGM * nN, gid = wgid / nig, fm = gid * WGM, gsz = (nM - fm) < WGM ? (nM - fm) : WGM;
        u.pm = fm + ((wgid % nig) % gsz); u.pn = (wgid % nig) / gsz; u.aux = 0; return true;
    }
    __device__ __forceinline__ const char* abase(const Unit& u) const { return A + (size_t)u.pm * ((size_t)BM * K * 2); }
    __device__ __forceinline__ const char* bbase(const Unit& u) const { return Bt + (size_t)u.pn * ((size_t)BM * K * 2); }
};

__device__ __forceinline__ unsigned cvt_pk_bf16(float lo, float hi) { unsigned r; asm volatile("v_cvt_pk_bf16_f32 %0, %1, %2" : "=v"(r) : "v"(lo), "v"(hi)); return r; }

struct EpiBf16Store {
    static constexpr bool PERM = true;
    bf16* O; int ldc;
    __device__ __forceinline__ void operator()(const f32x4 (&acc)[2][2][4][2], const Unit& u, int wr, int wc, int fr, int fq) const {
        const int row0 = u.pm * BM + wr * 64 + fr, col0 = u.pn * BM + wc * 32 + 8 * fq;
#pragma unroll
        for (int ai = 0; ai < 2; ++ai)
#pragma unroll
            for (int m = 0; m < 4; ++m) { bf16* rowp = O + (size_t)(row0 + ai * HALF + m * 16) * ldc + col0;
#pragma unroll
                for (int bj = 0; bj < 2; ++bj) { const f32x4 v0 = acc[ai][bj][m][0], v1 = acc[ai][bj][m][1];
                    u32x4 w; w.x = cvt_pk_bf16(v0[0], v0[1]); w.y = cvt_pk_bf16(v0[2], v0[3]); w.z = cvt_pk_bf16(v1[0], v1[1]); w.w = cvt_pk_bf16(v1[2], v1[3]);
                    *(u32x4*)(rowp + bj * HALF) = w; } }
    }
};
struct EpiResAdd {
    static constexpr bool PERM = false;
    float* H; int ldc;
    __device__ __forceinline__ void operator()(const f32x4 (&acc)[2][2][4][2], const Unit& u, int wr, int wc, int fr, int fq) const {
        const int row0 = u.pm * BM + wr * 64 + fr, col0 = u.pn * BM + wc * 32 + 4 * fq;
#pragma unroll
        for (int ai = 0; ai < 2; ++ai)
#pragma unroll
            for (int m = 0; m < 4; ++m) { float* rowp = H + (size_t)(row0 + ai * HALF + m * 16) * ldc + col0;
#pragma unroll
                for (int bj = 0; bj < 2; ++bj)
#pragma unroll
                    for (int n = 0; n < 2; ++n) { f32x4* p = (f32x4*)(rowp + bj * HALF + n * 16); *p = *p + acc[ai][bj][m][n]; } }
    }
};
struct EpiSwiglu {
    static constexpr bool PERM = true;
    bf16* O; int ldc;
    __device__ __forceinline__ void operator()(const f32x4 (&acc)[2][2][4][2], const Unit& u, int wr, int wc, int fr, int fq) const {
        const int row0 = u.pm * BM + wr * 64 + fr, col0 = u.pn * HALF + wc * 32 + 8 * fq;
#pragma unroll
        for (int ai = 0; ai < 2; ++ai)
#pragma unroll
            for (int m = 0; m < 4; ++m) { bf16* rowp = O + (size_t)(row0 + ai * HALF + m * 16) * ldc + col0;
                float o[8];
#pragma unroll
                for (int n = 0; n < 2; ++n)
#pragma unroll
                    for (int i = 0; i < 4; ++i) { const float a = acc[ai][0][m][n][i], b = acc[ai][1][m][n][i]; o[n * 4 + i] = a * b / (1.0f + __expf(-a)); }
                u32x4 w; w.x = cvt_pk_bf16(o[0], o[1]); w.y = cvt_pk_bf16(o[2], o[3]); w.z = cvt_pk_bf16(o[4], o[5]); w.w = cvt_pk_bf16(o[6], o[7]);
                *(u32x4*)rowp = w; __builtin_amdgcn_sched_barrier(0); }
    }
};
struct EpiPle {
    static constexpr bool PERM = false;
    float* H; const bf16* PP; int ldc;
    __device__ __forceinline__ void operator()(const f32x4 (&acc)[2][2][4][2], const Unit& u, int wr, int wc, int fr, int fq) const {
        const int row0 = u.pm * BM + wr * 64 + fr, col0 = u.pn * BM + wc * 32 + 4 * fq;
#pragma unroll
        for (int ai = 0; ai < 2; ++ai)
#pragma unroll
            for (int m = 0; m < 4; ++m) { const size_t off = (size_t)(row0 + ai * HALF + m * 16) * ldc + col0;
#pragma unroll
                for (int bj = 0; bj < 2; ++bj)
#pragma unroll
                    for (int n = 0; n < 2; ++n) { const size_t o2 = off + bj * HALF + n * 16; const u32x2 pw = *(const u32x2*)(PP + o2); const f32x4 a = acc[ai][bj][m][n];
                        f32x4 g; g[0] = bflo(pw.x) * sigmoidf_(a[0]); g[1] = bfhi(pw.x) * sigmoidf_(a[1]); g[2] = bflo(pw.y) * sigmoidf_(a[2]); g[3] = bfhi(pw.y) * sigmoidf_(a[3]);
                        f32x4* p = (f32x4*)(H + o2); *p = *p + g; }
                __builtin_amdgcn_sched_barrier(0); }
    }
};
struct EpiMoe2 {
    static constexpr bool PERM = false;
    float* H; const int* slot_tok; const float* slot_gate; int ldc;
    __device__ __forceinline__ void operator()(const f32x4 (&acc)[2][2][4][2], const Unit& u, int wr, int wc, int fr, int fq) const {
        const int row0 = u.pm * BM + wr * 64 + fr, col0 = u.pn * BM + wc * 32 + 4 * fq;
#pragma unroll
        for (int ai = 0; ai < 2; ++ai)
#pragma unroll
            for (int m = 0; m < 4; ++m) { const int slot = row0 + ai * HALF + m * 16; const int tok = slot_tok[slot]; const float gt = slot_gate[slot];
                if (tok >= 0) { float* rowp = H + (size_t)tok * ldc + col0;
#pragma unroll
                    for (int bj = 0; bj < 2; ++bj)
#pragma unroll
                        for (int n = 0; n < 2; ++n) { f32x4* p = (f32x4*)(rowp + bj * HALF + n * 16); *p = *p + acc[ai][bj][m][n] * gt; } }
                __builtin_amdgcn_sched_barrier(0); }
    }
};

template <class Epi, class Sched, bool ALIGN_EPI = true, bool SP2 = true>
__device__ __forceinline__ void gemm_phase(LAS unsigned char* lds, const int K, const Sched& S, const Epi& E) {
    int tid = threadIdx.x; asm volatile("" : "+v"(tid));
    const int wid = __builtin_amdgcn_readfirstlane(tid >> 6), lane = tid & 63, wr = wid >> 2, wc = wid & 3, fr = lane & 15, fq = lane >> 4;
    const int nt = K / BK;
    unsigned voffA[2], voffB[2];
#pragma unroll
    for (int i = 0; i < 2; ++i) { int R, C; stage_rc(tid * 16 + i * 8192, R, C); const int Rb = Epi::PERM ? ((R & ~31) + perm32(R & 31)) : R;
        voffA[i] = (unsigned)(R * K + C) * 2u; voffB[i] = (unsigned)(Rb * K + C) * 2u; }
    const size_t kstep = (size_t)(BK * 2);
    const size_t hstep = (size_t)HALF * K * 2;
    const unsigned ldsw = (unsigned)wid * 1024u;
    const int aoff = lds_byte(wr * 64 + fr, fq * 8), boff = lds_byte(wc * 32 + fr, fq * 8);
#define PG8_SA(b, h) (((b) * 2 + (h)) * HTB)
#define PG8_SB(b, h) ((4 + (b) * 2 + (h)) * HTB)
#define PG8_STAGE(bufoff, gbase, voff) do { _Pragma("unroll") for (int _i = 0; _i < 2; ++_i) \
        __builtin_amdgcn_global_load_lds((const unsigned*)((const char*)(gbase) + (voff)[_i]), (LAS unsigned*)(lds + (bufoff) + ldsw + _i * 8192), 16, 0, 0); } while (0)
#define PG8_LDA(dst, b, h) do { _Pragma("unroll") for (int m = 0; m < 4; ++m) _Pragma("unroll") for (int k = 0; k < 2; ++k) dst[m][k] = *(const LAS bf16x8*)(lds + PG8_SA(b, h) + aoff + m * 2048 + k * 1024); } while (0)
#define PG8_LDB(dst, b, h) do { _Pragma("unroll") for (int n = 0; n < 2; ++n) _Pragma("unroll") for (int k = 0; k < 2; ++k) dst[n][k] = *(const LAS bf16x8*)(lds + PG8_SB(b, h) + boff + n * 2048 + k * 1024); } while (0)
#define PG8_MMA(ai, bj, At, Bt) do { __builtin_amdgcn_s_setprio(1); _Pragma("unroll") for (int m = 0; m < 4; ++m) _Pragma("unroll") for (int n = 0; n < 2; ++n) _Pragma("unroll") for (int k = 0; k < 2; ++k) \
        acc[ai][bj][m][n] = __builtin_amdgcn_mfma_f32_16x16x32_bf16(Bt[n][k], At[m][k], acc[ai][bj][m][n], 0, 0, 0); __builtin_amdgcn_s_setprio(0); } while (0)
#define PG8_WAIT_V(n) asm volatile("s_waitcnt vmcnt(" #n ")" ::: "memory")
#define PG8_WAIT_L(n) asm volatile("s_waitcnt lgkmcnt(" #n ")" ::: "memory")
#define PG8_BAR __builtin_amdgcn_s_barrier()
#define PG8_SCHED __builtin_amdgcn_sched_barrier(0)
    Unit cur, nxt; int ui = 0;
    if (!S.next(0, cur)) return;
    f32x4 acc[2][2][4][2];
#pragma unroll
    for (int a = 0; a < 2; ++a)
#pragma unroll
        for (int b = 0; b < 2; ++b)
#pragma unroll
            for (int m = 0; m < 4; ++m)
#pragma unroll
                for (int n = 0; n < 2; ++n) acc[a][b][m][n] = (f32x4){0.f, 0.f, 0.f, 0.f};
    bf16x8 At[4][2], B0[2][2], B1[2][2];
    const char* cA = S.abase(cur); const char* cB = S.bbase(cur);
    if constexpr (SP2) {
        PG8_STAGE(PG8_SB(0, 0), cB, voffB); PG8_STAGE(PG8_SB(0, 1), cB + hstep, voffB); PG8_STAGE(PG8_SA(0, 0), cA, voffA); PG8_STAGE(PG8_SA(0, 1), cA + hstep, voffA);
        if (wr == 1) PG8_BAR;
        PG8_WAIT_V(2); PG8_BAR;
        PG8_STAGE(PG8_SB(1, 0), cB + kstep, voffB); PG8_STAGE(PG8_SA(1, 0), cA + kstep, voffA); PG8_STAGE(PG8_SB(1, 1), cB + hstep + kstep, voffB);
        PG8_WAIT_V(6); PG8_BAR;
    } else {
        PG8_STAGE(PG8_SB(0, 0), cB, voffB); PG8_STAGE(PG8_SA(0, 0), cA, voffA); PG8_STAGE(PG8_SB(0, 1), cB + hstep, voffB); PG8_STAGE(PG8_SA(0, 1), cA + hstep, voffA);
        if (wr == 1) PG8_BAR;
        PG8_WAIT_V(4); PG8_BAR;
        PG8_STAGE(PG8_SB(1, 0), cB + kstep, voffB); PG8_STAGE(PG8_SA(1, 0), cA + kstep, voffA); PG8_STAGE(PG8_SB(1, 1), cB + hstep + kstep, voffB);
        PG8_WAIT_V(6); PG8_BAR;
    }
    for (;;) {
        const bool has_next = S.next(ui + 1, nxt);
        const char* nA = has_next ? S.abase(nxt) : cA; const char* nB = has_next ? S.bbase(nxt) : cB;
        for (int t = 0; t < nt; t += 2) {
            const bool last = (t == nt - 2);
            const char* a1 = cA + (size_t)(t + 1) * kstep;
            const char* a2 = last ? nA : cA + (size_t)(t + 2) * kstep; const char* b2 = last ? nB : cB + (size_t)(t + 2) * kstep;
            const char* a3 = a2 + kstep; const char* b3 = b2 + kstep;
            if constexpr (SP2) {
            PG8_LDB(B0, 0, 0); PG8_LDB(B1, 0, 1); PG8_SCHED; PG8_LDA(At, 0, 0); PG8_STAGE(PG8_SA(1, 1), a1 + hstep, voffA);
            PG8_WAIT_V(8); PG8_WAIT_L(0); PG8_BAR; PG8_MMA(0, 0, At, B0); PG8_MMA(0, 1, At, B1); PG8_BAR; PG8_SCHED;
            PG8_LDA(At, 0, 1); PG8_STAGE(PG8_SB(0, 0), b2, voffB); PG8_STAGE(PG8_SB(0, 1), b2 + hstep, voffB); PG8_STAGE(PG8_SA(0, 0), a2, voffA);
            PG8_WAIT_V(8); PG8_WAIT_L(0); PG8_BAR; PG8_MMA(1, 0, At, B0); PG8_MMA(1, 1, At, B1); PG8_BAR; PG8_SCHED;
            PG8_LDB(B0, 1, 0); PG8_LDB(B1, 1, 1); PG8_SCHED; PG8_LDA(At, 1, 0); PG8_STAGE(PG8_SA(0, 1), a2 + hstep, voffA);
            PG8_WAIT_V(8); PG8_WAIT_L(0); PG8_BAR; PG8_MMA(0, 0, At, B0); PG8_MMA(0, 1, At, B1); PG8_BAR; PG8_SCHED;
            PG8_LDA(At, 1, 1); PG8_STAGE(PG8_SB(1, 0), b3, voffB); PG8_STAGE(PG8_SB(1, 1), b3 + hstep, voffB); PG8_STAGE(PG8_SA(1, 0), a3, voffA);
            PG8_WAIT_V(8); PG8_WAIT_L(0); PG8_BAR; PG8_MMA(1, 0, At, B0); PG8_MMA(1, 1, At, B1); PG8_BAR; PG8_SCHED;
            } else {
            PG8_LDB(B0, 0, 0); PG8_SCHED; PG8_LDA(At, 0, 0); PG8_STAGE(PG8_SA(1, 1), a1 + hstep, voffA);
            PG8_WAIT_L(8); PG8_BAR; PG8_WAIT_L(0); PG8_MMA(0, 0, At, B0); PG8_BAR; PG8_SCHED;
            PG8_LDB(B1, 0, 1); PG8_STAGE(PG8_SB(0, 0), b2, voffB);
            PG8_BAR; PG8_WAIT_L(0); PG8_MMA(0, 1, At, B1); PG8_BAR;
            PG8_LDA(At, 0, 1); PG8_STAGE(PG8_SA(0, 0), a2, voffA);
            PG8_BAR; PG8_WAIT_L(0); PG8_MMA(1, 0, At, B0); PG8_BAR; PG8_SCHED;
            PG8_STAGE(PG8_SB(0, 1), b2 + hstep, voffB);
            PG8_WAIT_V(6); PG8_BAR; PG8_MMA(1, 1, At, B1); PG8_BAR;
            PG8_LDB(B0, 1, 0); PG8_SCHED; PG8_LDA(At, 1, 0); PG8_STAGE(PG8_SA(0, 1), a2 + hstep, voffA);
            PG8_WAIT_L(8); PG8_BAR; PG8_WAIT_L(0); PG8_MMA(0, 0, At, B0); PG8_BAR; PG8_SCHED;
            PG8_LDB(B1, 1, 1); PG8_STAGE(PG8_SB(1, 0), b3, voffB);
            PG8_BAR; PG8_WAIT_L(0); PG8_MMA(0, 1, At, B1); PG8_BAR;
            PG8_LDA(At, 1, 1); PG8_STAGE(PG8_SA(1, 0), a3, voffA);
            PG8_BAR; PG8_WAIT_L(0); PG8_MMA(1, 0, At, B0); PG8_BAR; PG8_SCHED;
            PG8_STAGE(PG8_SB(1, 1), b3 + hstep, voffB);
            PG8_WAIT_V(6); PG8_BAR; PG8_MMA(1, 1, At, B1); PG8_BAR;
            }
        }
        if constexpr (ALIGN_EPI) { if (wr == 0) PG8_BAR; }
        E(acc, cur, wr, wc, fr, fq);
        if (!has_next) break;
#pragma unroll
        for (int a = 0; a < 2; ++a)
#pragma unroll
            for (int b = 0; b < 2; ++b)
#pragma unroll
                for (int m = 0; m < 4; ++m)
#pragma unroll
                    for (int n = 0; n < 2; ++n) acc[a][b][m][n] = (f32x4){0.f, 0.f, 0.f, 0.f};
        cur = nxt; cA = nA; cB = nB; ++ui;
        if constexpr (ALIGN_EPI) { if (wr == 1) PG8_BAR; }
    }
    PG8_WAIT_V(0);
    if constexpr (!ALIGN_EPI) { if (wr == 0) PG8_BAR; }
    PG8_BAR;
#undef PG8_SA
#undef PG8_SB
#undef PG8_STAGE
#undef PG8_LDA
#undef PG8_LDB
#undef PG8_MMA
#undef PG8_WAIT_V
#undef PG8_WAIT_L
#undef PG8_BAR
#undef PG8_SCHED
}
}

constexpr size_t MiB = 1u << 20;
constexpr size_t WS_CTL = 0, CTL_ZERO_BYTES = 65536;
constexpr size_t WS_WIN = 1 * MiB;
constexpr size_t WS_WOUT = 13 * MiB;
constexpr size_t WS_W13 = 17 * MiB;
constexpr size_t WS_W2 = 28 * MiB;
constexpr size_t WS_WG = 34 * MiB;
constexpr size_t WS_WP = 38 * MiB;
constexpr size_t WS_CW1 = 39 * MiB;
constexpr size_t WS_LORA = 41 * MiB;
constexpr size_t WS_ROPE = 41 * MiB + 512 * 1024;
constexpr size_t WS_CBIAS = 42 * MiB + 512 * 1024;
constexpr size_t WS_PB = 43 * MiB;
constexpr size_t WS_HN = 60 * MiB;
constexpr size_t WS_Z = 92 * MiB;
constexpr size_t WS_YCAT = 188 * MiB;
constexpr size_t WS_QROT = 220 * MiB;
constexpr size_t WS_KSR = 236 * MiB, WS_KWR = 240 * MiB, WS_VST = 244 * MiB, WS_VWT = 248 * MiB;
constexpr size_t WS_KCMP = 252 * MiB, WS_VCMPT = 252 * MiB + 512 * 1024;
constexpr size_t WS_REC = 253 * MiB;
constexpr size_t WS_G = 349 * MiB;
constexpr size_t WS_YRAW = 365 * MiB;
constexpr size_t WS_BONUS = 381 * MiB;
constexpr size_t WS_ACT = 92 * MiB;
constexpr size_t WS_HNS = 92 * MiB;
constexpr size_t WS_ACTM = 128 * MiB;
constexpr size_t WS_MW13 = 227 * MiB;
constexpr size_t WS_MW2 = 315 * MiB;
constexpr size_t WS_SLOT = 359 * MiB;
constexpr size_t WS_PP = 92 * MiB;
constexpr size_t WS_YP = 382 * MiB;
constexpr size_t WS_SEGE = 398 * MiB;
constexpr size_t WS_SST = 406 * MiB;
constexpr size_t WS_END = 410 * MiB;
constexpr int NSEG = 16, SEGLEN = SEQ / NSEG;
constexpr int MOE_SLOTS = 18432;
constexpr size_t SL_TOK = 0;
constexpr size_t SL_GATE = SL_TOK + 2 * MOE_SLOTS * 4;
constexpr size_t SL_TOKE = SL_GATE + 2 * MOE_SLOTS * 4;
constexpr size_t SL_TOKG = SL_TOKE + (size_t)MT * 2 * 4;
constexpr size_t SL_TOKS = SL_TOKG + (size_t)MT * 2 * 4;
constexpr size_t SL_BCNT = SL_TOKS + (size_t)MT * 2 * 4;
constexpr size_t SL_TST = SL_BCNT + 256 * 16 * 4;
static_assert(SL_TST + 128 <= 1 * MiB, "slot tables");
constexpr int CW_BAR = 4096;
constexpr int CW_Q = 8192;

constexpr int RING_BYTES = 131072;
constexpr int MISC_OFF = RING_BYTES;
constexpr int LDS_BYTES = 147456;

#define XB_TMO      128
#define XB_XCNT(j)  (256  + 64 * (j))
#define XB_XSUB(j)  (1280 + 64 * (j))
#define XB_XGEN(j)  (2304 + 64 * (j))
#define XB_TOP      3328
#define XB_TOPGEN   3392
#define XCD_BAR_WORDS 3456
#define XB_SPIN_CAP (1u << 18)
__device__ __forceinline__ unsigned xb_ld(unsigned* p)              { return __hip_atomic_load(p, __ATOMIC_RELAXED, __HIP_MEMORY_SCOPE_AGENT); }
__device__ __forceinline__ unsigned xb_add(unsigned* p, unsigned v) { return __hip_atomic_fetch_add(p, v, __ATOMIC_RELAXED, __HIP_MEMORY_SCOPE_AGENT); }
__device__ __forceinline__ unsigned xb_xcc_id() { return (unsigned)__builtin_amdgcn_s_getreg((3 << 11) | 20) & 0xFu; }
#define XB_SPIN(cond, bar) do { unsigned _sp = 0; while (cond) { __builtin_amdgcn_s_sleep(1); \
    if ((++_sp & 255u) == 0u) { if (xb_ld(&(bar)[XB_TMO])) break; if (_sp > XB_SPIN_CAP) { atomicAdd(&(bar)[XB_TMO], 1u); break; } } } } while (0)
struct XcdBarrier { unsigned* bar; unsigned x; volatile LAS unsigned* st; };
__device__ __forceinline__ XcdBarrier xcd_barrier_post(unsigned* bar, volatile LAS unsigned* st) {
    XcdBarrier b; b.bar = bar; b.x = xb_xcc_id(); b.st = st;
    if (threadIdx.x == 0) (void)xb_add(&bar[XB_XCNT(b.x)], 1u);
    return b;
}
__device__ __forceinline__ void xcd_barrier_complete(unsigned* bar, unsigned x, unsigned& nloc, unsigned& nx) {
    const unsigned G = gridDim.x * gridDim.y * gridDim.z;
    unsigned sum, cnt, mine, sp = 0u;
    for (;;) {
        sum = 0u; cnt = 0u; mine = 0u;
#pragma unroll
        for (unsigned j = 0; j < 16; ++j) { const unsigned c = xb_ld(&bar[XB_XCNT(j)]); sum += c; cnt += (c > 0u) ? 1u : 0u; mine = (j == x) ? c : mine; }
        if (sum == G) break;
        __builtin_amdgcn_s_sleep(1);
        if ((++sp & 255u) == 0u) { if (xb_ld(&bar[XB_TMO])) break; if (sp > XB_SPIN_CAP) { atomicAdd(&bar[XB_TMO], 1u); break; } }
    }
    nloc = mine > 0u ? mine : 1u; nx = cnt > 0u ? cnt : 1u;
}
__device__ __forceinline__ void xcd_barrier(const XcdBarrier& b) {
    asm volatile("s_waitcnt vmcnt(0)" ::: "memory");
    __syncthreads();
    if (threadIdx.x == 0) {
        unsigned* bar = b.bar;
        __builtin_amdgcn_s_waitcnt(0);
        unsigned nloc = b.st[0], nx = b.st[1];
        if (nloc == 0u) { xcd_barrier_complete(bar, b.x, nloc, nx); b.st[0] = nloc; b.st[1] = nx; }
        const unsigned old = xb_add(&bar[XB_XSUB(b.x)], 1u);
        const unsigned gen = old / nloc;
        if (old + 1u == (gen + 1u) * nloc) {
            __builtin_amdgcn_fence(__ATOMIC_RELEASE, "agent");
            asm volatile("s_waitcnt vmcnt(0)" ::: "memory");
            const unsigned og = xb_add(&bar[XB_TOP], 1u);
            const unsigned tg = og / nx;
            if (og + 1u == (tg + 1u) * nx) xb_add(&bar[XB_TOPGEN], 1u);
            else XB_SPIN(xb_ld(&bar[XB_TOPGEN]) == tg, bar);
            __builtin_amdgcn_fence(__ATOMIC_ACQUIRE, "agent");
            xb_add(&bar[XB_XGEN(b.x)], 1u);
            asm volatile("s_waitcnt vmcnt(0)" ::: "memory");
        } else {
            XB_SPIN(xb_ld(&bar[XB_XGEN(b.x)]) == gen, bar);
            __builtin_amdgcn_fence(__ATOMIC_ACQUIRE, "agent");
            asm volatile("s_waitcnt vmcnt(0)" ::: "memory");
        }
    }
    __syncthreads();
}

enum { IN_X = 0, IN_P, IN_POS, IN_GMIX, IN_WIN, IN_WOUT, IN_GMLNG, IN_GMLNB, IN_GMWS, IN_GMBS, IN_RWMU, IN_RWW0, IN_RWWUP, IN_RWA0, IN_RWAUP, IN_RWGUP,
       IN_RWKK, IN_RWKA, IN_RWRK, IN_RWGNG, IN_RWGNB, IN_CMPPOS, IN_KCW1, IN_KCW2, IN_VCW1, IN_VCW2, IN_GFFN, IN_FW1, IN_FW3, IN_FW2, IN_RTW, IN_RTB,
       IN_MW1, IN_MW3, IN_MW2, IN_GPLE, IN_PLEG, IN_PLEP, IN_GFINAL, N_INPUTS };
struct Args { const void* in[N_INPUTS]; float* out; unsigned char* ws; int ph_lo, ph_hi; };
constexpr int PTAB_OFF = 131072 + 256;
__device__ __forceinline__ const void* ldptr(int k) {
    extern __shared__ __attribute__((aligned(16))) unsigned char lds_raw[];
    const LAS unsigned* t = (const LAS unsigned*)((LAS unsigned char*)lds_raw + PTAB_OFF) + 2 * k;
    const unsigned lo = __builtin_amdgcn_readfirstlane(t[0]), hi = __builtin_amdgcn_readfirstlane(t[1]);
    return (const void*)(((unsigned long long)hi << 32) | lo);
}
#define INF(k) ((const float*)ldptr(k))

__device__ __forceinline__ void transpose_item(const float* W, int ldw, int k0, int n0, int nvalid, bf16* dst, int dld, int drow0, LAS float* scr, int lane) {
    const bool ok = (lane & 31) < nvalid;
#pragma unroll 8
    for (int i = 0; i < 32; ++i) { const int kk = 2 * i + (lane >> 5); scr[kk * 33 + (lane & 31)] = ok ? W[(size_t)(k0 + kk) * ldw + n0 + (lane & 31)] : 0.f; }
    LDS_WAIT(); asm volatile("" ::: "memory");
    const int c = lane & 7;
#pragma unroll
    for (int j = 0; j < 4; ++j) { const int n = (lane >> 3) + 8 * j; const LAS float* s = scr + (8 * c) * 33 + n;
        u32x4 o; o.x = pk2(s[0 * 33], s[1 * 33]); o.y = pk2(s[2 * 33], s[3 * 33]); o.z = pk2(s[4 * 33], s[5 * 33]); o.w = pk2(s[6 * 33], s[7 * 33]);
        if (n < nvalid) *(u32x4*)(dst + (size_t)(drow0 + n) * dld + k0 + 8 * c) = o; }
    LDS_WAIT(); asm volatile("" ::: "memory");
}
__device__ __forceinline__ void conv_matrix(const float* W, int K, int N, bf16* dst, int mode, int gw, int NGW, LAS float* scr, int lane) {
    const int nblk = (N + 31) / 32, nit = (K / 64) * nblk;
    for (int it = gw; it < nit; it += NGW) {
        const int kb = it / nblk, nb = it % nblk, n0 = nb * 32; const int nv = (N - n0) < 32 ? (N - n0) : 32;
        const int drow0 = mode == 0 ? n0 : ((n0 >> 7) * 256 + (n0 & 127) + (mode == 2 ? 128 : 0));
        transpose_item(W, N, kb * 64, n0, nv, dst, K, drow0, scr, lane);
    }
}
__device__ __forceinline__ void rms_row_bf16(const float* xrow, const float* g, bf16* orow, float* cp, int lane) {
    const f32x4* xr = (const f32x4*)xrow + lane; f32x4 v[4]; float s = 0.f;
#pragma unroll
    for (int j = 0; j < 4; ++j) { v[j] = xr[64 * j]; s += (v[j].x * v[j].x + v[j].y * v[j].y) + (v[j].z * v[j].z + v[j].w * v[j].w); }
    const float rs = 1.0f / sqrtf(wave_sum(s) * (1.0f / 1024.0f) + 1e-6f);
    if (cp) {
#pragma unroll
        for (int j = 0; j < 4; ++j) ((f32x4*)cp + lane)[64 * j] = v[j]; }
    u32x2* o8 = (u32x2*)orow + lane;
#pragma unroll
    for (int j = 0; j < 4; ++j) { const f32x4 gg = ((const f32x4*)g + lane)[64 * j]; u32x2 w; w.x = pk2(v[j].x * rs * gg.x, v[j].y * rs * gg.y); w.y = pk2(v[j].z * rs * gg.z, v[j].w * rs * gg.w); o8[64 * j] = w; }
}

__device__ __forceinline__ void phase_prologue(const Args& a, LAS unsigned char* lds) {
    const int tid = opaque_tid(), lane = tid & 63, wave = __builtin_amdgcn_readfirstlane(tid >> 6);
    const int G = gridDim.x, gw = blockIdx.x * NWAVES + wave, NGW = G * NWAVES;
    const size_t gt = (size_t)blockIdx.x * NTHR + tid, NGT = (size_t)G * NTHR;
    unsigned char* ws = a.ws;
    LAS float* scr = (LAS float*)(lds + wave * 16384);
    for (int l = 0; l < 2; ++l) {
        conv_matrix(INF(IN_WIN) + (size_t)l * DM * DIN, DM, DIN, (bf16*)(ws + WS_WIN) + (size_t)l * ZLD * DM, 0, gw, NGW, scr, lane);
        conv_matrix(INF(IN_WOUT) + (size_t)l * DM * DM, DM, DM, (bf16*)(ws + WS_WOUT) + (size_t)l * DM * DM, 0, gw, NGW, scr, lane);
        conv_matrix(INF(IN_PLEG) + (size_t)l * DM * DM, DM, DM, (bf16*)(ws + WS_WG) + (size_t)l * DM * DM, 0, gw, NGW, scr, lane);
        conv_matrix(INF(IN_PLEP) + (size_t)l * 256 * DM, 256, DM, (bf16*)(ws + WS_WP) + (size_t)l * DM * 256, 0, gw, NGW, scr, lane);
        conv_matrix(INF(IN_KCW1) + (size_t)l * 2048 * 128, 2048, 128, (bf16*)(ws + WS_CW1) + (size_t)(l * 2 + 0) * 128 * 2048, 0, gw, NGW, scr, lane);
        conv_matrix(INF(IN_VCW1) + (size_t)l * 2048 * 128, 2048, 128, (bf16*)(ws + WS_CW1) + (size_t)(l * 2 + 1) * 128 * 2048, 0, gw, NGW, scr, lane);
        bf16* lora = (bf16*)(ws + WS_LORA) + (size_t)l * 65536;
        conv_matrix(INF(IN_RWWUP) + (size_t)l * 64 * 256, 64, 256, lora, 0, gw, NGW, scr, lane);
        conv_matrix(INF(IN_RWAUP) + (size_t)l * 64 * 256, 64, 256, lora + 16384, 0, gw, NGW, scr, lane);
        conv_matrix(INF(IN_RWGUP) + (size_t)l * 128 * 256, 128, 256, lora + 32768, 0, gw, NGW, scr, lane);
        { u32x4* zr = (u32x4*)((bf16*)(ws + WS_WIN) + ((size_t)l * ZLD + DIN) * DM); const size_t n16 = (size_t)(ZLD - DIN) * DM * 2 / 16;
          for (size_t i = gt; i < n16; i += NGT) zr[i] = (u32x4){0u, 0u, 0u, 0u}; }
    }
    conv_matrix(INF(IN_FW1), DM, DFF, (bf16*)(ws + WS_W13), 1, gw, NGW, scr, lane);
    conv_matrix(INF(IN_FW3), DM, DFF, (bf16*)(ws + WS_W13), 2, gw, NGW, scr, lane);
    conv_matrix(INF(IN_FW2), DFF, DM, (bf16*)(ws + WS_W2), 0, gw, NGW, scr, lane);
    { const f32x4* src = (const f32x4*)INF(IN_P); u32x2* dst = (u32x2*)(ws + WS_PB); const size_t n4 = (size_t)2 * MT * 256 / 4;
      for (size_t i = gt; i < n4; i += NGT) { const f32x4 v = src[i]; u32x2 w; w.x = pk2(v.x, v.y); w.y = pk2(v.z, v.w); dst[i] = w; } }
    { const int* pos = (const int*)ldptr(IN_POS); float* ct = (float*)(ws + WS_ROPE); float* st = ct + (size_t)MT * 8;
      const float inv[8] = {1.0f, 0.1939227432012558f, 0.03760603070259094f, 0.007292664609849453f, 0.0014142135623842478f, 0.00027424818836152554f, 5.3182957344688475e-05f, 1.0313385246263351e-05f};
      for (size_t i = gt; i < (size_t)MT * 8; i += NGT) { const int m = (int)(i >> 3), k = (int)(i & 7);
          float iv = inv[0];
#pragma unroll
          for (int q = 1; q < 8; ++q) iv = (k == q) ? inv[q] : iv;
          const float ang = (float)pos[m] * iv;
          const double ad = (double)ang; const double kq = __builtin_rint(ad * 0.15915494309189535); const float red = (float)(ad - kq * 6.283185307179586);
          ct[i] = __cosf(red); st[i] = __sinf(red); } }
    if (blockIdx.x < 4) {
        const int l = blockIdx.x >> 1, kv = blockIdx.x & 1; const float* W1 = INF(kv ? IN_VCW1 : IN_KCW1) + (size_t)l * 2048 * 128; const float* pos = INF(IN_CMPPOS) + (size_t)l * 2048;
        LAS float* red = (LAS float*)(lds + 8448);
        const int hid = tid & 127, part = tid >> 7; float s = 0.f;
        for (int k = part * 512; k < part * 512 + 512; ++k) s += pos[k] * W1[(size_t)k * 128 + hid];
        red[part * 128 + hid] = s; __syncthreads();
        if (tid < 128) ((float*)(ws + WS_CBIAS))[(l * 2 + kv) * 128 + tid] = red[tid] + red[128 + tid] + red[256 + tid] + red[384 + tid];
    }
    for (int m = gw; m < MT; m += NGW) rms_row_bf16(INF(IN_X) + (size_t)m * DM, INF(IN_GMIX), (bf16*)(ws + WS_HN) + (size_t)m * DM, a.out + (size_t)m * DM, lane);
}

template <int MODE>
__device__ __forceinline__ void phase_norm(const Args& a, LAS unsigned char* lds, const float* g) {
    const int tid = opaque_tid(), lane = tid & 63, wave = __builtin_amdgcn_readfirstlane(tid >> 6);
    unsigned char* ws = a.ws;
    LAS int* lcnt = (LAS int*)lds;
    if (MODE == 1) { if (tid < 16) lcnt[tid] = 0; __syncthreads(); }
    for (int rb = blockIdx.x; rb < MT / 64; rb += gridDim.x) {
        for (int i = 0; i < 8; ++i) {
            const int m = rb * 64 + wave * 8 + i;
            float* hrow = a.out + (size_t)m * DM;
            const f32x4* xr = (const f32x4*)hrow + lane; f32x4 v[4]; float s = 0.f;
#pragma unroll
            for (int j = 0; j < 4; ++j) { v[j] = xr[64 * j]; s += (v[j].x * v[j].x + v[j].y * v[j].y) + (v[j].z * v[j].z + v[j].w * v[j].w); }
            const float rs = 1.0f / sqrtf(wave_sum(s) * (1.0f / 1024.0f) + 1e-6f);
#pragma unroll
            for (int j = 0; j < 4; ++j) { const f32x4 gg = ((const f32x4*)g + lane)[64 * j]; v[j].x *= rs * gg.x; v[j].y *= rs * gg.y; v[j].z *= rs * gg.z; v[j].w *= rs * gg.w; }
            if (MODE == 2) {
#pragma unroll
                for (int j = 0; j < 4; ++j) ((f32x4*)hrow + lane)[64 * j] = v[j];
            } else {
                u32x2* o8 = (u32x2*)((bf16*)(ws + WS_HN) + (size_t)m * DM) + lane;
#pragma unroll
                for (int j = 0; j < 4; ++j) { u32x2 w; w.x = pk2(v[j].x, v[j].y); w.y = pk2(v[j].z, v[j].w); o8[64 * j] = w; }
            }
            if (MODE == 1) {
                const float* rw = INF(IN_RTW); float lg[8];
#pragma unroll
                for (int e = 0; e < 8; ++e) lg[e] = 0.f;
#pragma unroll
                for (int j = 0; j < 4; ++j)
#pragma unroll
                    for (int c = 0; c < 4; ++c) { const int k = 4 * (lane + 64 * j) + c; const f32x4 w0 = *(const f32x4*)(rw + (size_t)k * 8), w1 = *(const f32x4*)(rw + (size_t)k * 8 + 4); const float x = v[j][c];
                        lg[0] += x * w0.x; lg[1] += x * w0.y; lg[2] += x * w0.z; lg[3] += x * w0.w; lg[4] += x * w1.x; lg[5] += x * w1.y; lg[6] += x * w1.z; lg[7] += x * w1.w; }
#pragma unroll
                for (int e = 0; e < 8; ++e) lg[e] = wave_sum(lg[e]) + INF(IN_RTB)[e];
                int e0 = 0; float v0 = lg[0];
#pragma unroll
                for (int e = 1; e < 8; ++e) if (lg[e] > v0) { v0 = lg[e]; e0 = e; }
                int e1 = -1; float v1 = -3.0e38f;
#pragma unroll
                for (int e = 0; e < 8; ++e) if (e != e0 && lg[e] > v1) { v1 = lg[e]; e1 = e; }
                const float p1 = 1.0f / (1.0f + __expf(v0 - v1)), p0 = 1.0f - p1;
                if (lane == 0) { int* te = (int*)(ws + WS_SLOT + SL_TOKE); float* tg = (float*)(ws + WS_SLOT + SL_TOKG); te[2 * m] = e0; te[2 * m + 1] = e1; tg[2 * m] = p0; tg[2 * m + 1] = p1;
                    atomicAdd((int*)&lcnt[e0], 1); atomicAdd((int*)&lcnt[8 + e1], 1); }
            }
        }
        if (MODE == 1) { __syncthreads(); if (tid < 16) { ((int*)(ws + WS_SLOT + SL_BCNT))[rb * 16 + tid] = lcnt[tid]; lcnt[tid] = 0; } __syncthreads(); }
    }
}

__device__ __forceinline__ bf16x8 ld_bf8(const bf16* p) { return *(const bf16x8*)p; }
__device__ __forceinline__ float tanhf_(float x) { const float e = __expf(2.0f * x); return 1.0f - 2.0f / (e + 1.0f); }

__device__ __forceinline__ void rw_shift8(const bf16* z, const float* mu, int m, int tpos, int c, float (&o)[8]) {
    const u32x4 cur = *(const u32x4*)(z + (size_t)m * ZLD + ZC_B + c);
    u32x4 prv = (u32x4){0u, 0u, 0u, 0u}; if (tpos > 0) prv = *(const u32x4*)(z + (size_t)(m - 1) * ZLD + ZC_B + c);
    const f32x4 m0 = *(const f32x4*)(mu + c), m1 = *(const f32x4*)(mu + c + 4);
    float cu[8] = {bflo(cur.x), bfhi(cur.x), bflo(cur.y), bfhi(cur.y), bflo(cur.z), bfhi(cur.z), bflo(cur.w), bfhi(cur.w)};
    float pv[8] = {bflo(prv.x), bfhi(prv.x), bflo(prv.y), bfhi(prv.y), bflo(prv.z), bfhi(prv.z), bflo(prv.w), bfhi(prv.w)};
    float mm[8] = {m0.x, m0.y, m0.z, m0.w, m1.x, m1.y, m1.z, m1.w};
#pragma unroll
    for (int j = 0; j < 8; ++j) o[j] = cu[j] + (pv[j] - cu[j]) * mm[j];
}
__device__ __forceinline__ void rw_shift4(const bf16* z, const float* mu, int m, int tpos, int c, float (&o)[4]) {
    const u32x2 cur = *(const u32x2*)(z + (size_t)m * ZLD + ZC_B + c);
    u32x2 prv = (u32x2){0u, 0u}; if (tpos > 0) prv = *(const u32x2*)(z + (size_t)(m - 1) * ZLD + ZC_B + c);
    const f32x4 m0 = *(const f32x4*)(mu + c);
    o[0] = bflo(cur.x) + (bflo(prv.x) - bflo(cur.x)) * m0.x; o[1] = bfhi(cur.x) + (bfhi(prv.x) - bfhi(cur.x)) * m0.y;
    o[2] = bflo(cur.y) + (bflo(prv.y) - bflo(cur.y)) * m0.z; o[3] = bfhi(cur.y) + (bfhi(prv.y) - bfhi(cur.y)) * m0.w;
}
__device__ __forceinline__ bf16x8 pack8(const float (&x)[8]) {
    u32x4 w; w.x = pk2(x[0], x[1]); w.y = pk2(x[2], x[3]); w.z = pk2(x[4], x[5]); w.w = pk2(x[6], x[7]);
    return __builtin_bit_cast(bf16x8, w);
}

__device__ __forceinline__ void rwkv_prep_tile(const Args& a, int layer, int m0, int lane) {
    unsigned char* ws = a.ws;
    const bf16* z = (const bf16*)(ws + WS_Z);
    const float* mu = INF(IN_RWMU) + (size_t)layer * 1024;
    const bf16* lora = (const bf16*)(ws + WS_LORA) + (size_t)layer * 65536;
    const bf16* wupT = lora; const bf16* aupT = lora + 16384; const bf16* gupT = lora + 32768;
    const int fq = lane >> 4, fr = lane & 15;
    const int m = m0 + fr, tpos = m & (SEQ - 1), bb = m >> 12;
    bf16x8 wdB[2], adB[2], gdB[4];
#pragma unroll
    for (int ks = 0; ks < 2; ++ks) { float x[8]; rw_shift8(z, mu, m, tpos, 768 + 32 * ks + 8 * fq, x);
#pragma unroll
        for (int j = 0; j < 8; ++j) x[j] = tanhf_(x[j]);
        wdB[ks] = pack8(x);
        rw_shift8(z, mu, m, tpos, 832 + 32 * ks + 8 * fq, x); adB[ks] = pack8(x); }
#pragma unroll
    for (int ks = 0; ks < 4; ++ks) { float x[8]; rw_shift8(z, mu, m, tpos, 896 + 32 * ks + 8 * fq, x);
#pragma unroll
        for (int j = 0; j < 8; ++j) x[j] = sigmoidf_(x[j]);
        gdB[ks] = pack8(x); }
    const float* w0p = INF(IN_RWW0) + layer * 256; const float* a0p = INF(IN_RWA0) + layer * 256; const float* kkp = INF(IN_RWKK) + layer * 256;
    const float* kap = INF(IN_RWKA) + layer * 256; const float* rkp = INF(IN_RWRK) + layer * 256;
    float* rec = (float*)(ws + WS_REC); float* gbuf = (float*)(ws + WS_G); float* bonus = (float*)(ws + WS_BONUS);
    float ss = 0.f, bs = 0.f, inv = 0.f;
#pragma unroll 1
    for (int hc = 0; hc < 16; ++hc) {
        const int h = hc >> 2, ct = hc & 3;
        if (ct == 0) {
            ss = 0.f; bs = 0.f;
#pragma unroll
            for (int c2 = 0; c2 < 4; ++c2) { const int c0 = h * 64 + 16 * c2 + 4 * fq; float k4[4]; rw_shift4(z, mu, m, tpos, 256 + c0, k4); const f32x4 k_k = *(const f32x4*)(kkp + c0);
#pragma unroll
                for (int i = 0; i < 4; ++i) { const float kx = k4[i] * k_k[i]; ss += kx * kx; } }
            ss += __shfl_xor(ss, 16); ss += __shfl_xor(ss, 32);
            inv = 1.0f / sqrtf(fmaxf(ss, 1e-24f));
        }
        f32x4 aw = (f32x4){0.f, 0.f, 0.f, 0.f}, aa = aw, ag = aw;
        const int chr = h * 64 + 16 * ct + fr;
#pragma unroll
        for (int ks = 0; ks < 2; ++ks) { const bf16x8 A1 = ld_bf8(wupT + chr * 64 + 32 * ks + 8 * fq), A2 = ld_bf8(aupT + chr * 64 + 32 * ks + 8 * fq);
            aw = __builtin_amdgcn_mfma_f32_16x16x32_bf16(A1, wdB[ks], aw, 0, 0, 0); aa = __builtin_amdgcn_mfma_f32_16x16x32_bf16(A2, adB[ks], aa, 0, 0, 0); }
#pragma unroll
        for (int ks = 0; ks < 4; ++ks) { const bf16x8 A3 = ld_bf8(gupT + chr * 128 + 32 * ks + 8 * fq); ag = __builtin_amdgcn_mfma_f32_16x16x32_bf16(A3, gdB[ks], ag, 0, 0, 0); }
        float* rp = rec + ((size_t)(bb * 4 + h) * SEQ + tpos) * 384;
        const int c0 = h * 64 + 16 * ct + 4 * fq, d0 = 16 * ct + 4 * fq;
        float r4[4], k4[4], v4[4]; rw_shift4(z, mu, m, tpos, c0, r4); rw_shift4(z, mu, m, tpos, 256 + c0, k4); rw_shift4(z, mu, m, tpos, 512 + c0, v4);
        const f32x4 w0 = *(const f32x4*)(w0p + c0), a0 = *(const f32x4*)(a0p + c0), k_k = *(const f32x4*)(kkp + c0), k_a = *(const f32x4*)(kap + c0), r_k = *(const f32x4*)(rkp + c0);
        f32x4 odw, okk, ob, okp;
#pragma unroll
        for (int i = 0; i < 4; ++i) {
            const float wl = w0[i] + aw[i]; const float nx = -wl; const float sp = fmaxf(nx, 0.f) + log1pf(__expf(-fabsf(nx)));
            const float wlog = -sp - 0.5f; odw[i] = __expf(-__expf(wlog));
            const float aval = sigmoidf_(a0[i] + aa[i]);
            const float kkn = k4[i] * k_k[i] * inv; okk[i] = kkn; ob[i] = kkn * aval;
            const float kpv = k4[i] * (1.0f + (aval - 1.0f) * k_a[i]); okp[i] = kpv;
            bs += r4[i] * kpv * r_k[i];
        }
        *(f32x4*)(rp + d0) = odw; *(f32x4*)(rp + 64 + d0) = okk; *(f32x4*)(rp + 128 + d0) = ob; *(f32x4*)(rp + 192 + d0) = okp;
        *(f32x4*)(rp + 256 + d0) = (f32x4){r4[0], r4[1], r4[2], r4[3]}; *(f32x4*)(rp + 320 + d0) = (f32x4){v4[0], v4[1], v4[2], v4[3]};
        *(f32x4*)(gbuf + (size_t)m * 256 + c0) = ag;
        if (ct == 3) { float b2 = bs; b2 += __shfl_xor(b2, 16); b2 += __shfl_xor(b2, 32); if (fq == 0) bonus[(size_t)m * 4 + h] = b2; }
    }
}

__device__ __forceinline__ void nsa_prep_item(const Args& a, LAS unsigned char* lds, int b, int tt) {
    unsigned char* ws = a.ws; const int tid = opaque_tid();
    const bf16* z = (const bf16*)(ws + WS_Z);
    const float* ct = (const float*)(ws + WS_ROPE); const float* st = ct + (size_t)MT * 8;
    const int mb = b * SEQ + tt * 64;
    for (int task = tid; task < 64 * 12; task += NTHR) {
        const int tok = task / 12, unit = task % 12, m = mb + tok;
        const bf16* src; bf16* dst;
        if (unit < 8) { src = z + (size_t)m * ZLD + ZC_Q + unit * 64; dst = (bf16*)(ws + WS_QROT) + (size_t)m * 512 + unit * 64; }
        else if (unit < 10) { src = z + (size_t)m * ZLD + ZC_KS + (unit - 8) * 64; dst = (bf16*)(ws + WS_KSR) + (size_t)m * 128 + (unit - 8) * 64; }
        else { src = z + (size_t)m * ZLD + ZC_KW + (unit - 10) * 64; dst = (bf16*)(ws + WS_KWR) + (size_t)m * 128 + (unit - 10) * 64; }
        u32x4 v[8];
#pragma unroll
        for (int i = 0; i < 8; ++i) v[i] = ((const u32x4*)src)[i];
        const f32x4 c0 = *(const f32x4*)(ct + (size_t)m * 8), c1 = *(const f32x4*)(ct + (size_t)m * 8 + 4), s0 = *(const f32x4*)(st + (size_t)m * 8), s1 = *(const f32x4*)(st + (size_t)m * 8 + 4);
        const float cc[8] = {c0.x, c0.y, c0.z, c0.w, c1.x, c1.y, c1.z, c1.w}, sn[8] = {s0.x, s0.y, s0.z, s0.w, s1.x, s1.y, s1.z, s1.w};
        const float x1[8] = {bflo(v[0].x), bfhi(v[0].x), bflo(v[0].y), bfhi(v[0].y), bflo(v[0].z), bfhi(v[0].z), bflo(v[0].w), bfhi(v[0].w)};
        const float x2[8] = {bflo(v[1].x), bfhi(v[1].x), bflo(v[1].y), bfhi(v[1].y), bflo(v[1].z), bfhi(v[1].z), bflo(v[1].w), bfhi(v[1].w)};
        float o1[8], o2[8];
#pragma unroll
        for (int i = 0; i < 8; ++i) { o1[i] = x1[i] * cc[i] - x2[i] * sn[i]; o2[i] = x1[i] * sn[i] + x2[i] * cc[i]; }
        v[0] = (u32x4){pk2(o1[0], o1[1]), pk2(o1[2], o1[3]), pk2(o1[4], o1[5]), pk2(o1[6], o1[7])};
        v[1] = (u32x4){pk2(o2[0], o2[1]), pk2(o2[2], o2[3]), pk2(o2[4], o2[5]), pk2(o2[6], o2[7])};
#pragma unroll
        for (int i = 0; i < 8; ++i) ((u32x4*)dst)[i] = v[i];
    }
    LAS bf16* tile = (LAS bf16*)lds;
    { const int tok = tid >> 3, ch = tid & 7;
#pragma unroll
      for (int mi = 0; mi < 4; ++mi) { const int col = (mi < 2 ? ZC_VS : ZC_VW) + (mi & 1) * 64;
          *(LAS u32x4*)(tile + mi * 4608 + tok * 72 + ch * 8) = *(const u32x4*)(z + (size_t)(mb + tok) * ZLD + col + ch * 8); } }
    __syncthreads();
    { const int d = tid >> 3, tc = tid & 7;
#pragma unroll
      for (int mi = 0; mi < 4; ++mi) { unsigned e[8];
#pragma unroll
          for (int j = 0; j < 8; ++j) e[j] = tile[mi * 4608 + (tc * 8 + j) * 72 + d];
          u32x4 w; w.x = e[0] | (e[1] << 16); w.y = e[2] | (e[3] << 16); w.z = e[4] | (e[5] << 16); w.w = e[6] | (e[7] << 16);
          bf16* dst = (bf16*)(ws + (mi < 2 ? WS_VST : WS_VWT)) + ((size_t)(b * 2 + (mi & 1)) * 64 + d) * SEQ + tt * 64 + tc * 8;
          *(u32x4*)dst = w; } }
    __syncthreads();
}

__device__ __forceinline__ void nsa_compress_item(const Args& a, int layer, LAS unsigned char* lds, int b, int g, int kv, int nt) {
    unsigned char* ws = a.ws; const int tid = opaque_tid(), lane = tid & 63, wave = __builtin_amdgcn_readfirstlane(tid >> 6), fq = lane >> 4, fr = lane & 15;
    const bf16* z = (const bf16*)(ws + WS_Z);
    const bf16* w1t = (const bf16*)(ws + WS_CW1) + (size_t)(layer * 2 + kv) * 128 * 2048;
    const int colb = (kv ? ZC_VC : ZC_KC) + g * 64;
    f32x4 acc[8];
#pragma unroll
    for (int ht = 0; ht < 8; ++ht) acc[ht] = (f32x4){0.f, 0.f, 0.f, 0.f};
    for (int li = 0; li < 4; ++li) { const int l = wave * 4 + li;
        int tok = 256 * nt + 16 * fr + l; tok = tok > SEQ - 1 ? SEQ - 1 : tok;
#pragma unroll
        for (int hf = 0; hf < 2; ++hf) {
            const bf16x8 B = ld_bf8(z + (size_t)(b * SEQ + tok) * ZLD + colb + 32 * hf + 8 * fq);
#pragma unroll
            for (int ht = 0; ht < 8; ++ht) { const bf16x8 A = ld_bf8(w1t + (size_t)(16 * ht + fr) * 2048 + 64 * l + 32 * hf + 8 * fq);
                acc[ht] = __builtin_amdgcn_mfma_f32_16x16x32_bf16(A, B, acc[ht], 0, 0, 0); } } }
    LAS float* part = (LAS float*)lds;
    LAS float* hid = (LAS float*)(lds + 65536);
#pragma unroll
    for (int ht = 0; ht < 8; ++ht)
#pragma unroll
        for (int r = 0; r < 4; ++r) part[(wave * 128 + 16 * ht + 4 * fq + r) * 16 + fr] = acc[ht][r];
    __syncthreads();
    { const int hh = tid >> 2, nq = tid & 3; f32x4 s = (f32x4){0.f, 0.f, 0.f, 0.f};
#pragma unroll
      for (int w = 0; w < 8; ++w) s = s + *(LAS f32x4*)(part + (w * 128 + hh) * 16 + 4 * nq);
      const float cb = ((const float*)(ws + WS_CBIAS))[(layer * 2 + kv) * 128 + hh];
      f32x4 o; o.x = gelu_tanh(s.x + cb); o.y = gelu_tanh(s.y + cb); o.z = gelu_tanh(s.z + cb); o.w = gelu_tanh(s.w + cb);
      *(LAS f32x4*)(hid + hh * 16 + 4 * nq) = o; }
    __syncthreads();
    { const float* W2 = INF(kv ? IN_VCW2 : IN_KCW2) + (size_t)layer * 128 * 64; const int n = tid & 15, dg = tid >> 4; float o0 = 0.f, o1 = 0.f;
      for (int hh = 0; hh < 128; ++hh) { const float x = hid[hh * 16 + n]; o0 += x * W2[hh * 64 + dg]; o1 += x * W2[hh * 64 + dg + 32]; }
      const int ng = 16 * nt + n; if (ng >= NCMP) { o0 = 0.f; o1 = 0.f; }
      if (kv == 0) { bf16* kc = (bf16*)(ws + WS_KCMP) + ((size_t)(b * 2 + g) * 256 + ng) * 64; kc[dg] = (bf16)f2bf(o0); kc[dg + 32] = (bf16)f2bf(o1); }
      else { bf16* vc = (bf16*)(ws + WS_VCMPT) + (size_t)(b * 2 + g) * 64 * 256; vc[(size_t)dg * 256 + ng] = (bf16)f2bf(o0); vc[(size_t)(dg + 32) * 256 + ng] = (bf16)f2bf(o1); } }
    __syncthreads();
}

__device__ __forceinline__ void phase_prep(const Args& a, int layer, LAS unsigned char* lds) {
    const int tid = opaque_tid(), lane = tid & 63, wave = __builtin_amdgcn_readfirstlane(tid >> 6);
#ifndef NO_RWP
    if (wave < 4) for (int tile = blockIdx.x * 4 + wave; tile < MT / 16; tile += gridDim.x * 4) rwkv_prep_tile(a, layer, tile * 16, lane);
#endif
#ifndef NO_NSAP
    for (int it = blockIdx.x; it < NB * 64; it += gridDim.x) nsa_prep_item(a, lds, it >> 6, it & 63);
#endif
#ifndef NO_CMP
    for (int it = blockIdx.x; it < NB * 2 * 2 * 16; it += gridDim.x) nsa_compress_item(a, layer, lds, it >> 6, (it >> 5) & 1, (it >> 4) & 1, it & 15);
#endif
}

__device__ __forceinline__ float dpp_xor1(float x) { return __builtin_bit_cast(float, __builtin_amdgcn_update_dpp(0, __builtin_bit_cast(int, x), 0xB1, 0xf, 0xf, true)); }
__device__ __forceinline__ float dpp_xor2(float x) { return __builtin_bit_cast(float, __builtin_amdgcn_update_dpp(0, __builtin_bit_cast(int, x), 0x4E, 0xf, 0xf, true)); }
__device__ __forceinline__ float dpp_hmir(float x) { return __builtin_bit_cast(float, __builtin_amdgcn_update_dpp(0, __builtin_bit_cast(int, x), 0x141, 0xf, 0xf, true)); }
__device__ __forceinline__ float red8(float x) { x += dpp_xor1(x); x += dpp_xor2(x); x += dpp_hmir(x); return x; }

__device__ __forceinline__ void rwkv_scan_seg(const Args& a, LAS unsigned char* lds, int bh, int seg) {
    unsigned char* ws = a.ws; const int tid = opaque_tid(), lane = tid & 63, wave = __builtin_amdgcn_readfirstlane(tid >> 6);
    const int row = wave * 8 + (lane >> 3), kq = lane & 7;
    const f32x4* rec4 = (const f32x4*)(ws + WS_REC) + ((size_t)bh * SEQ + (size_t)seg * SEGLEN) * 96;
    const size_t yoff = ((size_t)(bh >> 2) * SEQ + (size_t)seg * SEGLEN) * 256 + (bh & 3) * 64 + row;
    float* yraw = (float*)(ws + WS_YRAW) + yoff; float* ypb = (float*)(ws + WS_YP) + yoff;
    LAS f32x4* buf = (LAS f32x4*)lds;
    float s[8], q[8];
#pragma unroll
    for (int j = 0; j < 8; ++j) { s[j] = 0.f; q[j] = (8 * kq + j == row) ? 1.f : 0.f; }
    __syncthreads();
    { f32x4 p0 = rec4[tid], p1 = rec4[tid + 512], p2 = rec4[tid + 1024]; buf[tid] = p0; buf[tid + 512] = p1; buf[tid + 1024] = p2; }
    __syncthreads();
    for (int c = 0; c < SEGLEN / 16; ++c) {
        const int p = c & 1;
        f32x4 n0, n1, n2; const bool more = (c + 1 < SEGLEN / 16);
        if (more) { const f32x4* src = rec4 + (size_t)(c + 1) * 1536; n0 = src[tid]; n1 = src[tid + 512]; n2 = src[tid + 1024]; }
        const LAS f32x4* bp = buf + p * 1536;
#pragma unroll 2
        for (int st = 0; st < 16; ++st) {
            const LAS f32x4* sp = bp + st * 96;
            const f32x4 w0 = sp[2 * kq], w1 = sp[2 * kq + 1], k0 = sp[16 + 2 * kq], k1 = sp[16 + 2 * kq + 1], b0 = sp[32 + 2 * kq], b1 = sp[32 + 2 * kq + 1];
            const f32x4 q0 = sp[48 + 2 * kq], q1 = sp[48 + 2 * kq + 1], r0 = sp[64 + 2 * kq], r1 = sp[64 + 2 * kq + 1];
            const float vv = ((const LAS float*)(sp + 80))[row];
            const float wv[8] = {w0.x, w0.y, w0.z, w0.w, w1.x, w1.y, w1.z, w1.w}, kk[8] = {k0.x, k0.y, k0.z, k0.w, k1.x, k1.y, k1.z, k1.w};
            const float bv[8] = {b0.x, b0.y, b0.z, b0.w, b1.x, b1.y, b1.z, b1.w}, kp[8] = {q0.x, q0.y, q0.z, q0.w, q1.x, q1.y, q1.z, q1.w};
            const float rr[8] = {r0.x, r0.y, r0.z, r0.w, r1.x, r1.y, r1.z, r1.w};
            float d1 = (s[0] * kk[0] + s[1] * kk[1]) + (s[2] * kk[2] + s[3] * kk[3]) + ((s[4] * kk[4] + s[5] * kk[5]) + (s[6] * kk[6] + s[7] * kk[7]));
            float e1 = (q[0] * kk[0] + q[1] * kk[1]) + (q[2] * kk[2] + q[3] * kk[3]) + ((q[4] * kk[4] + q[5] * kk[5]) + (q[6] * kk[6] + q[7] * kk[7]));
            d1 += dpp_xor1(d1); e1 += dpp_xor1(e1); d1 += dpp_xor2(d1); e1 += dpp_xor2(e1); d1 += dpp_hmir(d1); e1 += dpp_hmir(e1);
            const float sa = -d1, sq = -e1;
            float d2 = 0.f, e2 = 0.f;
#pragma unroll
            for (int j = 0; j < 8; ++j) { s[j] = s[j] * wv[j] + (sa * bv[j] + vv * kp[j]); d2 += s[j] * rr[j]; q[j] = q[j] * wv[j] + sq * bv[j]; e2 += q[j] * rr[j]; }
            d2 += dpp_xor1(d2); e2 += dpp_xor1(e2); d2 += dpp_xor2(d2); e2 += dpp_xor2(e2); d2 += dpp_hmir(d2); e2 += dpp_hmir(e2);
            if (kq == 0) { yraw[(size_t)(c * 16 + st) * 256] = d2; ypb[(size_t)(c * 16 + st) * 256] = e2; }
        }
        if (more) { LAS f32x4* dp = buf + (p ^ 1) * 1536; dp[tid] = n0; dp[tid + 512] = n1; dp[tid + 1024] = n2; }
        __syncthreads();
    }
    float* se = (float*)(ws + WS_SEGE) + ((size_t)(bh * NSEG + seg) * 2) * 4096 + row * 64 + 8 * kq;
    *(f32x4*)se = (f32x4){s[0], s[1], s[2], s[3]}; *(f32x4*)(se + 4) = (f32x4){s[4], s[5], s[6], s[7]};
    *(f32x4*)(se + 4096) = (f32x4){q[0], q[1], q[2], q[3]}; *(f32x4*)(se + 4096 + 4) = (f32x4){q[4], q[5], q[6], q[7]};
}

__device__ __forceinline__ void rwkv_chain(const Args& a, LAS unsigned char* lds, int bh) {
    unsigned char* ws = a.ws; const int tid = opaque_tid();
    LAS float* S = (LAS float*)lds;
    LAS float* P = S + 64 * 68;
    const int v = tid >> 3, kg = tid & 7;
    float* sst = (float*)(ws + WS_SST) + (size_t)bh * NSEG * 4096;
    const float* sege = (const float*)(ws + WS_SEGE) + (size_t)bh * NSEG * 2 * 4096;
    __syncthreads();
    for (int i = tid; i < 64 * 68; i += NTHR) S[i] = 0.f;
    for (int i = tid; i < 4096; i += NTHR) sst[i] = 0.f;
    __syncthreads();
    for (int sg = 1; sg < NSEG; ++sg) {
        const float* e0 = sege + (size_t)(sg - 1) * 2 * 4096;
        for (int i = tid; i < 1024; i += NTHR) *(LAS f32x4*)(P + 4 * i) = *(const f32x4*)(e0 + 4096 + 4 * i);
        f32x4 o0 = *(const f32x4*)(e0 + v * 64 + 8 * kg), o1 = *(const f32x4*)(e0 + v * 64 + 8 * kg + 4);
        __syncthreads();
#pragma unroll 4
        for (int i = 0; i < 64; ++i) { const float sv = S[v * 68 + i]; const f32x4 p0 = *(const LAS f32x4*)(P + i * 64 + 8 * kg), p1 = *(const LAS f32x4*)(P + i * 64 + 8 * kg + 4);
            o0 = o0 + p0 * sv; o1 = o1 + p1 * sv; }
        __syncthreads();
        *(LAS f32x4*)(S + v * 68 + 8 * kg) = o0; *(LAS f32x4*)(S + v * 68 + 8 * kg + 4) = o1;
        *(f32x4*)(sst + (size_t)sg * 4096 + v * 64 + 8 * kg) = o0; *(f32x4*)(sst + (size_t)sg * 4096 + v * 64 + 8 * kg + 4) = o1;
        __syncthreads();
    }
}

__device__ __forceinline__ void rwkv_post_item(const Args& a, int layer, LAS unsigned char* lds, int bh, int tile) {
    unsigned char* ws = a.ws; const int tid = opaque_tid();
    const int seg = tile / (SEGLEN / 64), bb = bh >> 2, h = bh & 3;
    LAS float* S = (LAS float*)lds;
    LAS float* YP = S + 64 * 68;
    const float* sst = (const float*)(ws + WS_SST) + (size_t)(bh * NSEG + seg) * 4096;
    const size_t m0 = (size_t)bb * SEQ + (size_t)tile * 64;
    __syncthreads();
    for (int i = tid; i < 1024; i += NTHR) { const int r = i >> 4, c4 = i & 15; *(LAS f32x4*)(S + r * 68 + 4 * c4) = *(const f32x4*)(sst + r * 64 + 4 * c4);
        *(LAS f32x4*)(YP + r * 68 + 4 * c4) = *(const f32x4*)((const float*)(ws + WS_YP) + (m0 + r) * 256 + h * 64 + 4 * c4); }
    __syncthreads();
    const int tok = tid >> 3, vg = tid & 7; const size_t m = m0 + tok; const int c0 = h * 64 + 8 * vg;
    const f32x4 ya = *(const f32x4*)((const float*)(ws + WS_YRAW) + m * 256 + c0), yb = *(const f32x4*)((const float*)(ws + WS_YRAW) + m * 256 + c0 + 4);
    float y[8] = {ya.x, ya.y, ya.z, ya.w, yb.x, yb.y, yb.z, yb.w};
    if (seg > 0) {
#pragma unroll 4
        for (int i = 0; i < 64; i += 4) { const f32x4 yp = *(const LAS f32x4*)(YP + tok * 68 + i);
#pragma unroll
            for (int j = 0; j < 8; ++j) { const f32x4 sr = *(const LAS f32x4*)(S + (8 * vg + j) * 68 + i); y[j] += (sr.x * yp.x + sr.y * yp.y) + (sr.z * yp.z + sr.w * yp.w); } }
    }
    float sm = 0.f;
#pragma unroll
    for (int j = 0; j < 8; ++j) sm += y[j];
    sm += __shfl_xor(sm, 1); sm += __shfl_xor(sm, 2); sm += __shfl_xor(sm, 4);
    const float mean = sm * (1.0f / 64.0f); float qq = 0.f;
#pragma unroll
    for (int j = 0; j < 8; ++j) { y[j] -= mean; qq += y[j] * y[j]; }
    qq += __shfl_xor(qq, 1); qq += __shfl_xor(qq, 2); qq += __shfl_xor(qq, 4);
    const float rstd = 1.0f / sqrtf(qq * (1.0f / 64.0f) + 64e-5f);
    const float* gng = INF(IN_RWGNG) + layer * 256 + c0; const float* gnb = INF(IN_RWGNB) + layer * 256 + c0;
    const float* gt = (const float*)(ws + WS_G) + m * 256 + c0;
    const float* vv = (const float*)(ws + WS_REC) + ((size_t)bh * SEQ + (size_t)tile * 64 + tok) * 384 + 320 + 8 * vg;
    const float bo = ((const float*)(ws + WS_BONUS))[m * 4 + h];
    float o[8];
#pragma unroll
    for (int j = 0; j < 8; ++j) o[j] = (y[j] * rstd * gng[j] + gnb[j] + vv[j] * bo) * gt[j];
    u32x4 w; w.x = pk2(o[0], o[1]); w.y = pk2(o[2], o[3]); w.z = pk2(o[4], o[5]); w.w = pk2(o[6], o[7]);
    *(u32x4*)((bf16*)(ws + WS_YCAT) + m * DM + 256 + c0) = w;
}

__device__ __forceinline__ void gmlp_item(const Args& a, int layer, LAS unsigned char* lds, int b, int n, int h) {
    unsigned char* ws = a.ws; const int tid = opaque_tid(), lane = tid & 63, wave = __builtin_amdgcn_readfirstlane(tid >> 6), fq = lane >> 4, fr = lane & 15;
    const bf16* z = (const bf16*)(ws + WS_Z); bf16* ycat = (bf16*)(ws + WS_YCAT);
    LAS bf16* vt = (LAS bf16*)lds;
    const int mb = b * SEQ + n * 128;
    { const int s = tid >> 2, part = tid & 3; const bf16* src = z + (size_t)(mb + s) * ZLD + ZC_V + h * 64 + part * 16;
      const u32x4 v0 = ((const u32x4*)src)[0], v1 = ((const u32x4*)src)[1];
      float x[16] = {bflo(v0.x), bfhi(v0.x), bflo(v0.y), bfhi(v0.y), bflo(v0.z), bfhi(v0.z), bflo(v0.w), bfhi(v0.w), bflo(v1.x), bfhi(v1.x), bflo(v1.y), bfhi(v1.y), bflo(v1.z), bfhi(v1.z), bflo(v1.w), bfhi(v1.w)};
      float sm = 0.f;
#pragma unroll
      for (int j = 0; j < 16; ++j) { x[j] = gelu_tanh(x[j]); sm += x[j]; }
      sm += __shfl_xor(sm, 1); sm += __shfl_xor(sm, 2);
      const float mean = sm * (1.0f / 64.0f); float q = 0.f;
#pragma unroll
      for (int j = 0; j < 16; ++j) { x[j] -= mean; q += x[j] * x[j]; }
      q += __shfl_xor(q, 1); q += __shfl_xor(q, 2);
      const float rstd = 1.0f / sqrtf(q * (1.0f / 64.0f) + 1e-5f);
      const float* lg = INF(IN_GMLNG) + (layer * 4 + h) * 64 + part * 16; const float* lb = INF(IN_GMLNB) + (layer * 4 + h) * 64 + part * 16;
#pragma unroll
      for (int j = 0; j < 16; ++j) vt[(part * 16 + j) * 136 + s] = (bf16)f2bf(x[j] * rstd * lg[j] + lb[j]); }
    __syncthreads();
    {
        const float* W = INF(IN_GMWS) + ((size_t)(layer * 4 + h) * 128 + 16 * wave + fr) * 128;
        f32x4 acc[4];
#pragma unroll
        for (int dt = 0; dt < 4; ++dt) acc[dt] = (f32x4){0.f, 0.f, 0.f, 0.f};
        const int trow = 16 * wave + fr; const int nks = (wave >> 1) + 1;
        for (int ks = 0; ks < nks; ++ks) {
            const int s0 = 32 * ks + 8 * fq; const f32x4 wa = *(const f32x4*)(W + s0), wb = *(const f32x4*)(W + s0 + 4);
            float wv[8] = {wa.x, wa.y, wa.z, wa.w, wb.x, wb.y, wb.z, wb.w};
#pragma unroll
            for (int j = 0; j < 8; ++j) wv[j] = (s0 + j <= trow) ? wv[j] : 0.f;
            const bf16x8 A = pack8(wv);
#pragma unroll
            for (int dt = 0; dt < 4; ++dt) { const bf16x8 B = *(const LAS bf16x8*)(vt + (16 * dt + fr) * 136 + s0); acc[dt] = __builtin_amdgcn_mfma_f32_16x16x32_bf16(A, B, acc[dt], 0, 0, 0); } }
        const float* bs = INF(IN_GMBS) + (layer * 4 + h) * 128;
#pragma unroll
        for (int r = 0; r < 4; ++r) { const int t = 16 * wave + 4 * fq + r; const float bias = bs[t];
#pragma unroll
            for (int dt = 0; dt < 4; ++dt) { const int d = 16 * dt + fr; const float u = gelu_tanh(bf2f(z[(size_t)(mb + t) * ZLD + ZC_U + h * 64 + d]));
                ycat[(size_t)(mb + t) * DM + h * 64 + d] = (bf16)f2bf(u * (acc[dt][r] + bias)); } }
    }
    __syncthreads();
}

constexpr int NSA_KB = 0, NSA_VB = 18432, NSA_IMP = 36864, NSA_SELM = 53248, NSA_UNI = 53760, NSA_OT = 54272;
struct NsaTileSrc { const bf16* kbase; int kld; const bf16* vbase; int vld; };

__device__ __forceinline__ void nsa_tile_load(const NsaTileSrc& S, int kb, int tid, u32x4& kr, u32x4& vr) {
    const int row = tid >> 3, ch = tid & 7;
    kr = *(const u32x4*)(S.kbase + (size_t)(kb * 64 + row) * S.kld + ch * 8);
    vr = *(const u32x4*)(S.vbase + (size_t)row * S.vld + kb * 64 + ch * 8);
}
__device__ __forceinline__ void nsa_tile_store(LAS unsigned char* lds, int p, int tid, const u32x4& kr, const u32x4& vr) {
    const int row = tid >> 3, ch = tid & 7;
    *(LAS u32x4*)(lds + NSA_KB + p * 9216 + (row * 72 + ch * 8) * 2) = kr;
    *(LAS u32x4*)(lds + NSA_VB + p * 9216 + (row * 72 + ch * 8) * 2) = vr;
}
__device__ __forceinline__ void nsa_scores(LAS unsigned char* lds, int p, const bf16x8 (&Q)[2][2], f32x4 (&sc)[4][2], int fq, int fr) {
#pragma unroll
    for (int kt = 0; kt < 4; ++kt) {
        const LAS unsigned char* kp = lds + NSA_KB + p * 9216 + ((16 * kt + fr) * 72 + 8 * fq) * 2;
        const bf16x8 K0 = *(const LAS bf16x8*)kp, K1 = *(const LAS bf16x8*)(kp + 64);
#pragma unroll
        for (int qg = 0; qg < 2; ++qg) { f32x4 c = (f32x4){0.f, 0.f, 0.f, 0.f};
            c = __builtin_amdgcn_mfma_f32_16x16x32_bf16(K0, Q[qg][0], c, 0, 0, 0); c = __builtin_amdgcn_mfma_f32_16x16x32_bf16(K1, Q[qg][1], c, 0, 0, 0); sc[kt][qg] = c; } }
}
template <int MODE>
__device__ __forceinline__ bool nsa_allowed(int kidx, int t, int kb, unsigned long long selm) {
    if (MODE == 0) return (16 * kidx + 31 <= t) && (kidx < NCMP);
    if (MODE == 1) return (kidx <= t) && ((selm >> kb) & 1ull);
    return (kidx <= t) && (kidx + 512 > t);
}
template <int MODE>
__device__ __forceinline__ void nsa_tile_compute(LAS unsigned char* lds, int p, int kb, const bf16x8 (&Q)[2][2], const int (&tq)[2], const unsigned long long (&selm)[2],
                                                 float (&m_run)[2], float (&l_run)[2], f32x4 (&O)[4][2], int fq, int fr) {
    f32x4 sc[4][2];
    nsa_scores(lds, p, Q, sc, fq, fr);
    const float SC = 0.125f * 1.4426950408889634f;
    bf16x8 P[2][2];
#pragma unroll
    for (int qg = 0; qg < 2; ++qg) {
        float mx = -1e30f;
#pragma unroll
        for (int kt = 0; kt < 4; ++kt)
#pragma unroll
            for (int r = 0; r < 4; ++r) { const int kidx = kb * 64 + 16 * kt + 4 * fq + r;
                const float v = nsa_allowed<MODE>(kidx, tq[qg], kb, selm[qg]) ? sc[kt][qg][r] * SC : -1e30f; sc[kt][qg][r] = v; mx = fmaxf(mx, v); }
        mx = fmaxf(mx, __shfl_xor(mx, 16)); mx = fmaxf(mx, __shfl_xor(mx, 32));
        const float mn = fmaxf(m_run[qg], mx); const float alpha = __builtin_amdgcn_exp2f(m_run[qg] - mn); m_run[qg] = mn;
        float ls = 0.f; float pv[4][4];
#pragma unroll
        for (int kt = 0; kt < 4; ++kt)
#pragma unroll
            for (int r = 0; r < 4; ++r) { const float sv = sc[kt][qg][r]; const float e = (sv > -1e29f) ? __builtin_amdgcn_exp2f(sv - mn) : 0.f; pv[kt][r] = e; ls += e; }
        l_run[qg] = l_run[qg] * alpha + ls;
#pragma unroll
        for (int dt = 0; dt < 4; ++dt) O[dt][qg] = O[dt][qg] * alpha;
#pragma unroll
        for (int s = 0; s < 2; ++s) { u32x4 w; w.x = pk2(pv[2 * s][0], pv[2 * s][1]); w.y = pk2(pv[2 * s][2], pv[2 * s][3]); w.z = pk2(pv[2 * s + 1][0], pv[2 * s + 1][1]); w.w = pk2(pv[2 * s + 1][2], pv[2 * s + 1][3]);
            P[qg][s] = __builtin_bit_cast(bf16x8, w); }
    }
#pragma unroll
    for (int dt = 0; dt < 4; ++dt)
#pragma unroll
        for (int s = 0; s < 2; ++s) {
            const LAS unsigned char* vp = lds + NSA_VB + p * 9216 + ((16 * dt + fr) * 72 + 32 * s + 4 * fq) * 2;
            const u32x2 a0 = *(const LAS u32x2*)vp, a1 = *(const LAS u32x2*)(vp + 32);
            const u32x4 aw = (u32x4){a0.x, a0.y, a1.x, a1.y}; const bf16x8 A = __builtin_bit_cast(bf16x8, aw);
#pragma unroll
            for (int qg = 0; qg < 2; ++qg) O[dt][qg] = __builtin_amdgcn_mfma_f32_16x16x32_bf16(A, P[qg][s], O[dt][qg], 0, 0, 0);
        }
}

template <int MODE>
__device__ __forceinline__ void nsa_branch(LAS unsigned char* lds, const NsaTileSrc& S, int kb_lo, int kb_hi, unsigned long long tilemask, const bf16x8 (&Q)[2][2], const int (&tq)[2],
                                           const unsigned long long (&selm)[2], const float (&gate)[2], const bool first, float (&m_out)[2], float (&l_out)[2], int tid, int fq, int fr) {
    float m_run[2] = {-1e30f, -1e30f}, l_run[2] = {0.f, 0.f}; f32x4 O[4][2];
#pragma unroll
    for (int dt = 0; dt < 4; ++dt)
#pragma unroll
        for (int qg = 0; qg < 2; ++qg) O[dt][qg] = (f32x4){0.f, 0.f, 0.f, 0.f};
    int cur = kb_lo; while (cur <= kb_hi && !((tilemask >> cur) & 1ull)) ++cur;
    if (cur <= kb_hi) {
        u32x4 kr, vr; nsa_tile_load(S, cur, tid, kr, vr); nsa_tile_store(lds, 0, tid, kr, vr);
        __syncthreads();
        int p = 0;
        while (cur <= kb_hi) {
            int nxt = cur + 1; while (nxt <= kb_hi && !((tilemask >> nxt) & 1ull)) ++nxt;
            if (nxt <= kb_hi) nsa_tile_load(S, nxt, tid, kr, vr);
            nsa_tile_compute<MODE>(lds, p, cur, Q, tq, selm, m_run, l_run, O, fq, fr);
            if (nxt <= kb_hi) nsa_tile_store(lds, p ^ 1, tid, kr, vr);
            __syncthreads();
            p ^= 1; cur = nxt;
        }
    }
#pragma unroll
    for (int qg = 0; qg < 2; ++qg) { float l = l_run[qg]; l += __shfl_xor(l, 16); l += __shfl_xor(l, 32); l_out[qg] = l; m_out[qg] = m_run[qg];
        const float sc = l > 0.f ? gate[qg] / l : 0.f;
        LAS float* ot = (LAS float*)(lds + NSA_OT) + tid;
#pragma unroll
        for (int dt = 0; dt < 4; ++dt)
#pragma unroll
            for (int r = 0; r < 4; ++r) { LAS float* pp = ot + ((dt * 2 + qg) * 4 + r) * 512; const float v = O[dt][qg][r] * sc; *pp = first ? v : (*pp + v); } }
}

__device__ __forceinline__ void nsa_item(const Args& a, LAS unsigned char* lds, int b, int g, int T) {
    unsigned char* ws = a.ws; const int tid = opaque_tid(), lane = tid & 63, wave = __builtin_amdgcn_readfirstlane(tid >> 6), fq = lane >> 4, fr = lane & 15;
    const bf16* z = (const bf16*)(ws + WS_Z);
    const int head = g * 4 + (fr & 3);
    int tq[2], mq[2]; bf16x8 Qraw[2][2]; float gt[2][3];
#pragma unroll
    for (int qg = 0; qg < 2; ++qg) { const int tl = 8 * wave + 4 * qg + (fr >> 2); tq[qg] = T * 64 + tl; mq[qg] = b * SEQ + tq[qg];
#pragma unroll
        for (int ks = 0; ks < 2; ++ks) Qraw[qg][ks] = ld_bf8(z + (size_t)mq[qg] * ZLD + ZC_Q + head * 64 + 32 * ks + 8 * fq);
#pragma unroll
        for (int br = 0; br < 3; ++br) gt[qg][br] = sigmoidf_(bf2f(z[(size_t)mq[qg] * ZLD + ZC_GT + head * 3 + br])); }
    if (tid < 64) { ((LAS unsigned long long*)(lds + NSA_SELM))[tid] = 0ull; if (tid < 2) ((LAS unsigned*)(lds + NSA_UNI))[tid] = 0u; }
    const unsigned long long nosel[2] = {0ull, 0ull};
    NsaTileSrc SC_; SC_.kbase = (const bf16*)(ws + WS_KCMP) + (size_t)(b * 2 + g) * 256 * 64; SC_.kld = 64; SC_.vbase = (const bf16*)(ws + WS_VCMPT) + (size_t)(b * 2 + g) * 64 * 256; SC_.vld = 256;
    float mc[2], lc[2];
    { float gc[2] = {gt[0][0], gt[1][0]};
      nsa_branch<0>(lds, SC_, 0, 3, ~0ull, Qraw, tq, nosel, gc, true, mc, lc, tid, fq, fr); }
    {
        LAS float* imp = (LAS float*)(lds + NSA_IMP);
        float carry[2] = {0.f, 0.f}; const float SCL = 0.125f * 1.4426950408889634f;
        float invl[2] = {lc[0] > 0.f ? 1.0f / lc[0] : 0.f, lc[1] > 0.f ? 1.0f / lc[1] : 0.f};
        for (int kb = 0; kb < 4; ++kb) {
            { const int row = tid >> 3, ch = tid & 7; *(LAS u32x4*)(lds + NSA_KB + (row * 72 + ch * 8) * 2) = *(const u32x4*)(SC_.kbase + (size_t)(kb * 64 + row) * 64 + ch * 8); }
            __syncthreads();
            f32x4 sc[4][2]; nsa_scores(lds, 0, Qraw, sc, fq, fr);
#pragma unroll
            for (int kt = 0; kt < 4; ++kt)
#pragma unroll
                for (int qg = 0; qg < 2; ++qg) { float pn[4];
#pragma unroll
                    for (int r = 0; r < 4; ++r) { const int kidx = kb * 64 + 16 * kt + 4 * fq + r; const bool al = nsa_allowed<0>(kidx, tq[qg], kb, 0ull);
                        pn[r] = al ? __builtin_amdgcn_exp2f(sc[kt][qg][r] * SCL - mc[qg]) * invl[qg] : 0.f; }
                    const float y = __shfl(pn[3], (lane + 48) & 63);
                    float v = (pn[0] + pn[1]) + (pn[2] + pn[3]) + (fq == 0 ? carry[qg] : y); carry[qg] = y;
                    v += __shfl_xor(v, 1); v += __shfl_xor(v, 2);
                    if ((fr & 3) == 0) imp[(8 * wave + 4 * qg + (fr >> 2)) * 64 + 16 * kb + 4 * kt + fq] = v; }
            __syncthreads();
        }
    }
    {
        const LAS float* imp = (const LAS float*)(lds + NSA_IMP);
        const int tl = tid >> 3, part = tid & 7; float vm[8]; int cnt[8];
        { const f32x4 x0 = *(const LAS f32x4*)(imp + tl * 64 + part * 8), x1 = *(const LAS f32x4*)(imp + tl * 64 + part * 8 + 4);
          const float xx[8] = {x0.x, x0.y, x0.z, x0.w, x1.x, x1.y, x1.z, x1.w};
#pragma unroll
          for (int j = 0; j < 8; ++j) { const int mi = part * 8 + j; const bool valid = mi <= T; const bool forced = (mi == 0) || (mi == T) || (mi == T - 1);
              vm[j] = valid ? xx[j] + (forced ? 1e4f : 0.f) : -1e4f; cnt[j] = 0; } }
        for (int q4 = 0; q4 < 16; ++q4) { const f32x4 x = *(const LAS f32x4*)(imp + tl * 64 + 4 * q4); const float xq[4] = {x.x, x.y, x.z, x.w};
#pragma unroll
            for (int i = 0; i < 4; ++i) { const int q = 4 * q4 + i; const bool valid = q <= T; const bool forced = (q == 0) || (q == T) || (q == T - 1);
                const float vq = valid ? xq[i] + (forced ? 1e4f : 0.f) : -1e4f;
#pragma unroll
                for (int j = 0; j < 8; ++j) { const int mi = part * 8 + j; cnt[j] += (vq > vm[j] || (vq == vm[j] && q < mi)) ? 1 : 0; } } }
        unsigned bits = 0u;
#pragma unroll
        for (int j = 0; j < 8; ++j) if (cnt[j] < 16 && vm[j] > -5000.f) bits |= 1u << j;
        atomicOr((unsigned*)(lds + NSA_SELM) + tl * 2 + (part >> 2), bits << (8 * (part & 3)));
        atomicOr((unsigned*)(lds + NSA_UNI) + (part >> 2), bits << (8 * (part & 3)));
    }
    __syncthreads();
    bf16x8 Qrot[2][2];
#pragma unroll
    for (int qg = 0; qg < 2; ++qg)
#pragma unroll
        for (int ks = 0; ks < 2; ++ks) Qrot[qg][ks] = ld_bf8((const bf16*)(ws + WS_QROT) + (size_t)mq[qg] * 512 + head * 64 + 32 * ks + 8 * fq);
    unsigned long long selm[2], uni;
    { const LAS unsigned long long* sm = (const LAS unsigned long long*)(lds + NSA_SELM); selm[0] = sm[8 * wave + (fr >> 2)]; selm[1] = sm[8 * wave + 4 + (fr >> 2)]; const LAS unsigned* up = (const LAS unsigned*)(lds + NSA_UNI); uni = ((unsigned long long)(unsigned)__builtin_amdgcn_readfirstlane(up[1]) << 32) | (unsigned)__builtin_amdgcn_readfirstlane(up[0]); }
    { NsaTileSrc SS; SS.kbase = (const bf16*)(ws + WS_KSR) + (size_t)b * SEQ * 128 + g * 64; SS.kld = 128; SS.vbase = (const bf16*)(ws + WS_VST) + (size_t)(b * 2 + g) * 64 * SEQ; SS.vld = SEQ;
      float gs[2] = {gt[0][1], gt[1][1]}, mo[2], lo[2];
      nsa_branch<1>(lds, SS, 0, T, uni, Qrot, tq, selm, gs, false, mo, lo, tid, fq, fr); }
    { NsaTileSrc SW; SW.kbase = (const bf16*)(ws + WS_KWR) + (size_t)b * SEQ * 128 + g * 64; SW.kld = 128; SW.vbase = (const bf16*)(ws + WS_VWT) + (size_t)(b * 2 + g) * 64 * SEQ; SW.vld = SEQ;
      float gw_[2] = {gt[0][2], gt[1][2]}, mo[2], lo[2]; const int lo_kb = T >= 8 ? T - 8 : 0;
      nsa_branch<2>(lds, SW, lo_kb, T, ~0ull, Qrot, tq, nosel, gw_, false, mo, lo, tid, fq, fr); }
    bf16* ycat = (bf16*)(ws + WS_YCAT);
#pragma unroll
    for (int qg = 0; qg < 2; ++qg)
#pragma unroll
        for (int dt = 0; dt < 4; ++dt) { const LAS float* ot = (const LAS float*)(lds + NSA_OT) + tid + ((dt * 2 + qg) * 4) * 512;
            u32x2 w; w.x = pk2(ot[0], ot[512]); w.y = pk2(ot[1024], ot[1536]);
            *(u32x2*)(ycat + (size_t)mq[qg] * DM + 512 + head * 64 + 16 * dt + 4 * fq) = w; }
}

struct MoeOrder {
    const char* A; const char* W; size_t estride; int K, nct, G, c; int tst[9];
    __device__ bool next(int i, pg8::Unit& u) const {
        const long L = (long)i * G + c; if (L >= (long)tst[8] * nct) return false;
        const int rt = (int)(L / nct), ct = (int)(L % nct); int e = 0;
#pragma unroll
        for (int j = 1; j < 8; ++j) e += (rt >= tst[j]) ? 1 : 0;
        u.pm = rt; u.pn = ct; u.aux = e; return true;
    }
    __device__ __forceinline__ const char* abase(const pg8::Unit& u) const { return A + (size_t)u.pm * ((size_t)256 * K * 2); }
    __device__ __forceinline__ const char* bbase(const pg8::Unit& u) const { return W + (size_t)u.aux * estride + (size_t)u.pn * ((size_t)256 * K * 2); }
};
__device__ __forceinline__ void moe_order_init(MoeOrder& S, const Args& a, int rank, const void* A, const void* W, size_t estride, int K, int nct) {
    S.A = (const char*)A; S.W = (const char*)W; S.estride = estride; S.K = K; S.nct = nct; S.G = gridDim.x; S.c = blockIdx.x;
    const int* t = (const int*)(a.ws + WS_SLOT + SL_TST) + rank * 16;
#pragma unroll
    for (int j = 0; j < 9; ++j) S.tst[j] = __builtin_amdgcn_readfirstlane(t[j]);
}
__device__ __forceinline__ void moe_gather(const Args& a, int rb, int r) {
    unsigned char* ws = a.ws; const int tid = opaque_tid();
    const int* toks = (const int*)(ws + WS_SLOT + SL_TOKS);
    const u32x4* hn = (const u32x4*)(ws + WS_HN); u32x4* hns = (u32x4*)(ws + WS_HNS);
    for (int i = tid; i < 64 * 128; i += NTHR) { const int tl = i >> 7, ch = i & 127, m = rb * 64 + tl; const int slot = toks[2 * m + r];
        hns[(size_t)slot * 128 + ch] = hn[(size_t)m * 128 + ch]; }
}
__device__ __forceinline__ void phase_moe_assign(const Args& a, LAS unsigned char* lds) {
    unsigned char* ws = a.ws; const int tid = opaque_tid(), lane = tid & 63, wave = __builtin_amdgcn_readfirstlane(tid >> 6);
    LAS int* cn = (LAS int*)lds;
    LAS int* tot = cn + 4096; LAS int* base = tot + 16; LAS int* pre = base + 16;
    const int* bcnt = (const int*)(ws + WS_SLOT + SL_BCNT);
    for (int i = tid; i < 4096; i += NTHR) cn[i] = bcnt[i];
    __syncthreads();
    if (tid < 16) { int s = 0; for (int bb = 0; bb < 256; ++bb) s += cn[bb * 16 + tid]; tot[tid] = s; }
    __syncthreads();
    if (tid < 2) { int run = 0; int* tstg = (int*)(ws + WS_SLOT + SL_TST) + tid * 16;
        for (int e = 0; e < 8; ++e) { base[tid * 8 + e] = run * 256; if (blockIdx.x == 0) tstg[e] = run; run += (tot[tid * 8 + e] + 255) >> 8; }
        if (blockIdx.x == 0) tstg[8] = run; }
    __syncthreads();
    int* stok = (int*)(ws + WS_SLOT + SL_TOK); float* sgate = (float*)(ws + WS_SLOT + SL_GATE);
    if (blockIdx.x == 0) {
        for (int grp = 0; grp < 16; ++grp) { const int r = grp >> 3, lo = base[grp] + tot[grp], hi = base[grp] + (((tot[grp] + 255) >> 8) << 8);
            for (int s = lo + tid; s < hi; s += NTHR) { stok[r * MOE_SLOTS + s] = -1; sgate[r * MOE_SLOTS + s] = 0.f; } }
    }
    const int* te = (const int*)(ws + WS_SLOT + SL_TOKE); const float* tg = (const float*)(ws + WS_SLOT + SL_TOKG); int* toks = (int*)(ws + WS_SLOT + SL_TOKS);
    for (int rb = blockIdx.x; rb < MT / 64; rb += gridDim.x) {
        __syncthreads();
        if (tid < 16) { int s = 0; for (int bb = 0; bb < rb; ++bb) s += cn[bb * 16 + tid]; pre[tid] = s; }
        __syncthreads();
        if (wave == 0) { const int m = rb * 64 + lane;
#pragma unroll
            for (int r = 0; r < 2; ++r) { const int e = te[2 * m + r]; int slot = 0;
#pragma unroll
                for (int ee = 0; ee < 8; ++ee) { const unsigned long long mk = __ballot(e == ee); const int rk = __popcll(mk & ((1ull << lane) - 1ull)); if (e == ee) slot = base[r * 8 + ee] + pre[r * 8 + ee] + rk; }
                stok[r * MOE_SLOTS + slot] = m; sgate[r * MOE_SLOTS + slot] = tg[2 * m + r]; toks[2 * m + r] = slot; } }
        asm volatile("s_waitcnt vmcnt(0)" ::: "memory");
        __syncthreads();
        moe_gather(a, rb, 0);
    }
}
__device__ __forceinline__ void moe_convert_weights(const Args& a, LAS unsigned char* lds) {
    const int tid = opaque_tid(), lane = tid & 63, wave = __builtin_amdgcn_readfirstlane(tid >> 6);
    const int gw = blockIdx.x * NWAVES + wave, NGW = gridDim.x * NWAVES; LAS float* scr = (LAS float*)(lds + 1024 + wave * 16384);
    for (int e = 0; e < NEXP; ++e) {
        conv_matrix(INF(IN_MW1) + (size_t)e * DM * DFF, DM, DFF, (bf16*)(a.ws + WS_MW13) + (size_t)e * 5632 * DM, 1, gw, NGW, scr, lane);
        conv_matrix(INF(IN_MW3) + (size_t)e * DM * DFF, DM, DFF, (bf16*)(a.ws + WS_MW13) + (size_t)e * 5632 * DM, 2, gw, NGW, scr, lane);
        conv_matrix(INF(IN_MW2) + (size_t)e * DFF * DM, DFF, DM, (bf16*)(a.ws + WS_MW2) + (size_t)e * DM * DFF, 0, gw, NGW, scr, lane);
    }
}

constexpr int NPL = 15, NPHASES = 1 + 2 * NPL;
__host__ __device__ constexpr bool phase_empty(int k) { return k >= 1 && k < 1 + NPL && ((k - 1) >= 9 && (k - 1) <= 11); }

__global__ void __launch_bounds__(NTHR, 2) hybrid_fwd(Args a) {
    extern __shared__ __attribute__((aligned(16))) unsigned char lds_raw[];
    LAS unsigned char* lds = (LAS unsigned char*)lds_raw;
    volatile LAS unsigned* MISC = (volatile LAS unsigned*)(lds + MISC_OFF);
    const int tid = opaque_tid();
    unsigned char* ws = a.ws; unsigned* ctl = (unsigned*)(ws + WS_CTL);
    for (int u = tid; u < (LDS_BYTES - MISC_OFF) / 4; u += NTHR) MISC[u] = 0u;
    __syncthreads();
    if (tid < N_INPUTS) *(LAS unsigned long long*)(lds + PTAB_OFF + 8 * tid) = (unsigned long long)a.in[tid];
    __syncthreads();
    const int lo = a.ph_lo, hi = a.ph_hi;
    const bool multi = (hi - lo) > 1;
    XcdBarrier bar; bar.bar = ctl + CW_BAR; bar.x = 0; bar.st = nullptr;
    if (multi) bar = xcd_barrier_post(ctl + CW_BAR, MISC + 8);
#ifndef PHSEL
#define PHSEL -1
#endif
#define IN(k) (lo <= (k) && (k) < hi)
#define INL(j) ((PHSEL == -1 || PHSEL == (j)) && IN(pb + (j)))
#define SEAM(k) do { if ((k) + 1 < hi) xcd_barrier(bar); } while (0)
    const int G = gridDim.x, bx = blockIdx.x;

    if ((PHSEL == -1 || PHSEL == 100) && IN(0)) { phase_prologue(a, lds); SEAM(0); }

    for (int l = 0; l < 2; ++l) {
        const int pb = 1 + l * NPL;
        if (INL(0)) { pg8::StaticOrder S; S.init(ws + WS_HN, (bf16*)(ws + WS_WIN) + (size_t)l * ZLD * DM, MT, ZLD, DM, G, bx);
            pg8::EpiBf16Store E{(bf16*)(ws + WS_Z), ZLD}; pg8::gemm_phase(lds, DM, S, E); SEAM(pb + 0); }
        if (INL(1)) { phase_prep(a, l, lds); SEAM(pb + 1); }
        if (INL(2)) {
#ifndef NO_SCAN
            for (int it = bx; it < 16 * NSEG; it += G) rwkv_scan_seg(a, lds, it & 15, it >> 4);
#endif
            unsigned* qn = ctl + CW_Q + 64 * (l * 2);
#ifndef NO_NSA
            for (;;) { __syncthreads(); if (tid == 0) MISC[16] = __hip_atomic_fetch_add(qn, 1u, __ATOMIC_RELAXED, __HIP_MEMORY_SCOPE_AGENT); __syncthreads();
                const int it = (int)MISC[16]; if (it >= 512) break; nsa_item(a, lds, (it & 7) >> 1, it & 1, 63 - (it >> 3)); }
#endif
            SEAM(pb + 2); }
        if (INL(3)) {
            for (int bh = bx; bh < 16; bh += G) rwkv_chain(a, lds, bh);
            unsigned* qg = ctl + CW_Q + 64 * (l * 2 + 1);
#ifndef NO_GMLP
            for (;;) { __syncthreads(); if (tid == 0) MISC[16] = __hip_atomic_fetch_add(qg, 1u, __ATOMIC_RELAXED, __HIP_MEMORY_SCOPE_AGENT); __syncthreads();
                const int it = (int)MISC[16]; if (it >= 512) break; gmlp_item(a, l, lds, it >> 7, (it >> 2) & 31, it & 3); }
#endif
            SEAM(pb + 3); }
        if (INL(4)) { for (int it = bx; it < 16 * 64; it += G) rwkv_post_item(a, l, lds, it & 15, it >> 4); SEAM(pb + 4); }
        if (INL(5)) { pg8::StaticOrder S; S.init(ws + WS_YCAT, (bf16*)(ws + WS_WOUT) + (size_t)l * DM * DM, MT, DM, DM, G, bx);
            pg8::EpiResAdd E{a.out, DM}; pg8::gemm_phase(lds, DM, S, E); SEAM(pb + 5); }
        if (INL(6)) { if (l == 0) phase_norm<0>(a, lds, INF(IN_GFFN)); else { moe_convert_weights(a, lds); __syncthreads(); phase_norm<1>(a, lds, INF(IN_GFFN) + DM); } SEAM(pb + 6); }
        if (l == 0) {
            if (INL(7)) { pg8::StaticOrder S; S.init(ws + WS_HN, ws + WS_W13, MT, 2 * DFF, DM, G, bx); pg8::EpiSwiglu E{(bf16*)(ws + WS_ACT), DFF}; pg8::gemm_phase(lds, DM, S, E); SEAM(pb + 7); }
            if (INL(8)) { pg8::StaticOrder S; S.init(ws + WS_ACT, ws + WS_W2, MT, DM, DFF, G, bx); pg8::EpiResAdd E{a.out, DM}; pg8::gemm_phase(lds, DFF, S, E); if (pb + 12 < hi) xcd_barrier(bar); }
        } else {
            if (INL(7)) { phase_moe_assign(a, lds); SEAM(pb + 7); }
            if (INL(8)) { MoeOrder S; moe_order_init(S, a, 0, ws + WS_HNS, ws + WS_MW13, (size_t)5632 * DM * 2, DM, 22); pg8::EpiSwiglu E{(bf16*)(ws + WS_ACTM), DFF}; pg8::gemm_phase(lds, DM, S, E); SEAM(pb + 8); }
            if (INL(9)) { for (int rb = bx; rb < MT / 64; rb += G) moe_gather(a, rb, 1);
                MoeOrder S; moe_order_init(S, a, 0, ws + WS_ACTM, ws + WS_MW2, (size_t)DM * DFF * 2, DFF, 4);
                pg8::EpiMoe2 E{a.out, (const int*)(ws + WS_SLOT + SL_TOK), (const float*)(ws + WS_SLOT + SL_GATE), DM}; pg8::gemm_phase(lds, DFF, S, E); SEAM(pb + 9); }
            if (INL(10)) { MoeOrder S; moe_order_init(S, a, 1, ws + WS_HNS, ws + WS_MW13, (size_t)5632 * DM * 2, DM, 22); pg8::EpiSwiglu E{(bf16*)(ws + WS_ACTM), DFF}; pg8::gemm_phase(lds, DM, S, E); SEAM(pb + 10); }
            if (INL(11)) { MoeOrder S; moe_order_init(S, a, 1, ws + WS_ACTM, ws + WS_MW2, (size_t)DM * DFF * 2, DFF, 4);
                pg8::EpiMoe2 E{a.out, (const int*)(ws + WS_SLOT + SL_TOK) + MOE_SLOTS, (const float*)(ws + WS_SLOT + SL_GATE) + MOE_SLOTS, DM}; pg8::gemm_phase(lds, DFF, S, E); SEAM(pb + 11); }
        }
        if (INL(12)) { phase_norm<0>(a, lds, INF(IN_GPLE) + l * DM); SEAM(pb + 12); }
        if (INL(13)) {
            { pg8::StaticOrder S; S.init((bf16*)(ws + WS_PB) + (size_t)l * MT * 256, (bf16*)(ws + WS_WP) + (size_t)l * DM * 256, MT, DM, 256, G, bx); pg8::EpiBf16Store E{(bf16*)(ws + WS_PP), DM}; pg8::gemm_phase(lds, 256, S, E); }
            { pg8::StaticOrder S; S.init(ws + WS_HN, (bf16*)(ws + WS_WG) + (size_t)l * DM * DM, MT, DM, DM, G, bx); pg8::EpiPle E{a.out, (const bf16*)(ws + WS_PP), DM}; pg8::gemm_phase(lds, DM, S, E); }
            SEAM(pb + 13); }
        if (INL(14)) { if (l == 0) { phase_norm<0>(a, lds, INF(IN_GMIX) + DM); SEAM(pb + 14); } else phase_norm<2>(a, lds, INF(IN_GFINAL)); }
    }
#undef IN
#undef INL
#undef SEAM
}

extern "C" void kernel_launch(void* const* d_in, const int* in_sizes, int n_in, void* d_out, int out_size, void* d_ws, size_t ws_size, hipStream_t stream) {
    static int grid = 0;
    if (grid == 0) {
        if (n_in != N_INPUTS || out_size != MT * DM || ws_size < WS_END) { fprintf(stderr, "kernel_launch: unexpected shapes (n_in %d, out %d, ws %zu)\n", n_in, out_size, ws_size); grid = -1; return; }
        int dev = 0, cus = 0, per_cu = 0;
        if (hipGetDevice(&dev) != hipSuccess || hipDeviceGetAttribute(&cus, hipDeviceAttributeMultiprocessorCount, dev) != hipSuccess) { grid = -1; return; }
        if (hipFuncSetAttribute((const void*)hybrid_fwd, hipFuncAttributeMaxDynamicSharedMemorySize, LDS_BYTES) != hipSuccess) { fprintf(stderr, "kernel_launch: hipFuncSetAttribute failed\n"); grid = -1; return; }
        if (hipOccupancyMaxActiveBlocksPerMultiprocessor(&per_cu, (const void*)hybrid_fwd, NTHR, LDS_BYTES) != hipSuccess || per_cu < 1) fprintf(stderr, "kernel_launch: occupancy query reports %d\n", per_cu);
        (void)hipGetLastError();
        grid = cus;
    }
    if (grid < 0) return;
    (void)hipMemsetAsync((char*)d_ws + WS_CTL, 0, CTL_ZERO_BYTES, stream);
    Args a{};
    for (int i = 0; i < N_INPUTS; ++i) a.in[i] = d_in[i];
    a.out = (float*)d_out; a.ws = (unsigned char*)d_ws;
#if MK_ONE_LAUNCH
    a.ph_lo = 0; a.ph_hi = NPHASES;
    hipLaunchKernelGGL(hybrid_fwd, dim3(grid), dim3(NTHR), LDS_BYTES, stream, a);
#else
    for (int k = 0; k < NPHASES; ++k) { if (phase_empty(k)) continue; a.ph_lo = k; a.ph_hi = k + 1;
        hipLaunchKernelGGL(hybrid_fwd, dim3(grid), dim3(NTHR), LDS_BYTES, stream, a); }
#endif
}
```

```cpp
#include <hip/hip_runtime.h>
#include <cstdio>
#include <cstdint>

#ifndef MK_ONE_LAUNCH
#define MK_ONE_LAUNCH 1
#endif

#define LAS __attribute__((address_space(3)))
#define GAS __attribute__((address_space(1)))
typedef unsigned short bf16;
typedef short bf16x8 __attribute__((ext_vector_type(8)));
typedef float f32x4 __attribute__((ext_vector_type(4)));
typedef float f32x2 __attribute__((ext_vector_type(2)));
typedef unsigned u32x4 __attribute__((ext_vector_type(4)));
typedef unsigned u32x2 __attribute__((ext_vector_type(2)));

constexpr int NB = 4, SEQ = 4096, DM = 1024, MT = NB * SEQ;
constexpr int DIN = 2840, ZLD = 3072;
constexpr int DFF = 2816, NEXP = 8;
constexpr int ZC_U = 0, ZC_V = 256, ZC_B = 512, ZC_Q = 1536, ZC_KC = 2048, ZC_VC = 2176, ZC_KS = 2304, ZC_VS = 2432, ZC_KW = 2560, ZC_VW = 2688, ZC_GT = 2816;
constexpr int NCMP = 255;
constexpr int NWAVES = 8, NTHR = 512;

__device__ __forceinline__ unsigned f2bf(float f) { unsigned u = __builtin_bit_cast(unsigned, f); return (u + 0x7fffu + ((u >> 16) & 1u)) >> 16; }
__device__ __forceinline__ float bf2f(unsigned b) { return __builtin_bit_cast(float, b << 16); }
__device__ __forceinline__ unsigned pk2(float lo, float hi) { return f2bf(lo) | (f2bf(hi) << 16); }
__device__ __forceinline__ float bflo(unsigned w) { return __builtin_bit_cast(float, w << 16); }
__device__ __forceinline__ float bfhi(unsigned w) { return __builtin_bit_cast(float, w & 0xffff0000u); }
__device__ __forceinline__ float sigmoidf_(float x) { return 1.0f / (1.0f + __expf(-x)); }
__device__ __forceinline__ float gelu_tanh(float x) { const float u = 0.7978845608028654f * (x + 0.044715f * x * x * x); const float e = __expf(-2.0f * fabsf(u)); float t = (1.0f - e) / (1.0f + e); t = u < 0.f ? -t : t; return 0.5f * x * (1.0f + t); }
__device__ __forceinline__ float wave_sum(float v) {
#pragma unroll
    for (int o = 1; o < 64; o <<= 1) v += __shfl_xor(v, o);
    return v;
}
__device__ __forceinline__ int opaque_tid() { int t = threadIdx.x; asm volatile("" : "+v"(t)); return t; }
#define LDS_WAIT() asm volatile("s_waitcnt lgkmcnt(0)" ::: "memory")
#define VM_WAIT() asm volatile("s_waitcnt vmcnt(0)" ::: "memory")

namespace pg8 {
constexpr int BM = 256, BK = 64, HALF = 128, HTB = HALF * BK * 2  , STAGE_BYTES = 8 * HTB, NXCD = 8, WGM = 8;
__host__ __device__ __forceinline__ int lds_byte(int r, int c) { const int st = (r >> 4) * 2 + (c >> 5), rr = r & 15, cc = c & 31, ob = rr * 64 + cc * 2; return st * 1024 + (ob ^ (((ob >> 9) & 1) << 5)); }
__host__ __device__ __forceinline__ void stage_rc(int b, int& R, int& C) { const int st = b / 1024, sb = b % 1024, swz = sb ^ (((sb >> 9) & 1) << 5); R = (st >> 1) * 16 + swz / 64; C = (st & 1) * 32 + (swz % 64) / 2; }
__host__ __device__ __forceinline__ int perm32(int rho) { const int n = rho >> 4, i = rho & 15; return 8 * (i >> 2) + 4 * n + (i & 3); }

struct Unit { int pm, pn, aux; };

struct StaticOrder {
    const char* A; const char* Bt; int K; int nM, nN, nwg, G, c;
    __device__ void init(const void* A_, const void* Bt_, int M, int N, int K_, int G_, int c_) { A = (const char*)A_; Bt = (const char*)Bt_; K = K_; nM = M / BM; nN = N / BM; nwg = nM * nN; G = G_; c = c_; }
    __device__ bool next(int i, Unit& u) const {
        const long L = (long)i * G + c; if (L >= nwg) return false;
        int wgid = (int)L; { const int q = nwg / NXCD, r = nwg % NXCD, xcd = wgid % NXCD, off = wgid / NXCD; wgid = (xcd < r ? xcd * (q + 1) : r * (q + 1) + (xcd - r) * q) + off; }
        const int nig = WGM * nN, gid = wgid / nig, fm = gid * WGM, gsz = (nM - fm) < WGM ? (nM - fm) : WGM;
        u.pm = fm + ((wgid % nig) % gsz); u.pn = (wgid % nig) / gsz; u.aux = 0; return true;
    }
    __device__ __forceinline__ const char* abase(const Unit& u) const { return A + (size_t)u.pm * ((size_t)BM * K * 2); }
    __device__ __forceinline__ const char* bbase(const Unit& u) const { return Bt + (size_t)u.pn * ((size_t)BM * K * 2); }
};

__device__ __forceinline__ unsigned cvt_pk_bf16(float lo, float hi) { unsigned r; asm volatile("v_cvt_pk_bf16_f32 %0, %1, %2" : "=v"(r) : "v"(lo), "v"(hi)); return r; }

struct EpiBf16Store {
    static constexpr bool PERM = true;
    bf16* O; int ldc;
    __device__ __forceinline__ void operator()(const f32x4 (&acc)[2][2][4][2], const Unit& u, int wr, int wc, int fr, int fq) const {
        const int row0 = u.pm * BM + wr * 64 + fr, col0 = u.pn * BM + wc * 32 + 8 * fq;
#pragma unroll
        for (int ai = 0; ai < 2; ++ai)
#pragma unroll
            for (int m = 0; m < 4; ++m) { bf16* rowp = O + (size_t)(row0 + ai * HALF + m * 16) * ldc + col0;
#pragma unroll
                for (int bj = 0; bj < 2; ++bj) { const f32x4 v0 = acc[ai][bj][m][0], v1 = acc[ai][bj][m][1];
                    u32x4 w; w.x = cvt_pk_bf16(v0[0], v0[1]); w.y = cvt_pk_bf16(v0[2], v0[3]); w.z = cvt_pk_bf16(v1[0], v1[1]); w.w = cvt_pk_bf16(v1[2], v1[3]);
                    *(u32x4*)(rowp + bj * HALF) = w; } }
    }
};
struct EpiResAdd {
    static constexpr bool PERM = false;
    float* H; int ldc;
    __device__ __forceinline__ void operator()(const f32x4 (&acc)[2][2][4][2], const Unit& u, int wr, int wc, int fr, int fq) const {
        const int row0 = u.pm * BM + wr * 64 + fr, col0 = u.pn * BM + wc * 32 + 4 * fq;
#pragma unroll
        for (int ai = 0; ai < 2; ++ai)
#pragma unroll
            for (int m = 0; m < 4; ++m) { float* rowp = H + (size_t)(row0 + ai * HALF + m * 16) * ldc + col0;
#pragma unroll
                for (int bj = 0; bj < 2; ++bj)
#pragma unroll
                    for (int n = 0; n < 2; ++n) { f32x4* p = (f32x4*)(rowp + bj * HALF + n * 16); *p = *p + acc[ai][bj][m][n]; } }
    }
};
struct EpiSwiglu {
    static constexpr bool PERM = true;
    bf16* O; int ldc;
    __device__ __forceinline__ void operator()(const f32x4 (&acc)[2][2][4][2], const Unit& u, int wr, int wc, int fr, int fq) const {
        const int row0 = u.pm * BM + wr * 64 + fr, col0 = u.pn * HALF + wc * 32 + 8 * fq;
#pragma unroll
        for (int ai = 0; ai < 2; ++ai)
#pragma unroll
            for (int m = 0; m < 4; ++m) { bf16* rowp = O + (size_t)(row0 + ai * HALF + m * 16) * ldc + col0;
                float o[8];
#pragma unroll
                for (int n = 0; n < 2; ++n)
#pragma unroll
                    for (int i = 0; i < 4; ++i) { const float a = acc[ai][0][m][n][i], b = acc[ai][1][m][n][i]; o[n * 4 + i] = a * b / (1.0f + __expf(-a)); }
                u32x4 w; w.x = cvt_pk_bf16(o[0], o[1]); w.y = cvt_pk_bf16(o[2], o[3]); w.z = cvt_pk_bf16(o[4], o[5]); w.w = cvt_pk_bf16(o[6], o[7]);
                *(u32x4*)rowp = w; __builtin_amdgcn_sched_barrier(0); }
    }
};
struct EpiPle {
    static constexpr bool PERM = false;
    float* H; const bf16* PP; int ldc;
    __device__ __forceinline__ void operator()(const f32x4 (&acc)[2][2][4][2], const Unit& u, int wr, int wc, int fr, int fq) const {
        const int row0 = u.pm * BM + wr * 64 + fr, col0 = u.pn * BM + wc * 32 + 4 * fq;
#pragma unroll
        for (int ai = 0; ai < 2; ++ai)
#pragma unroll
            for (int m = 0; m < 4; ++m) { const size_t off = (size_t)(row0 + ai * HALF + m * 16) * ldc + col0;
#pragma unroll
                for (int bj = 0; bj < 2; ++bj)
#pragma unroll
                    for (int n = 0; n < 2; ++n) { const size_t o2 = off + bj * HALF + n * 16; const u32x2 pw = *(const u32x2*)(PP + o2); const f32x4 a = acc[ai][bj][m][n];
                        f32x4 g; g[0] = bflo(pw.x) * sigmoidf_(a[0]); g[1] = bfhi(pw.x) * sigmoidf_(a[1]); g[2] = bflo(pw.y) * sigmoidf_(a[2]); g[3] = bfhi(pw.y) * sigmoidf_(a[3]);
                        f32x4* p = (f32x4*)(H + o2); *p = *p + g; }
                __builtin_amdgcn_sched_barrier(0); }
    }
};
struct EpiMoe2 {
    static constexpr bool PERM = false;
    float* H; const int* slot_tok; const float* slot_gate; int ldc;
    __device__ __forceinline__ void operator()(const f32x4 (&acc)[2][2][4][2], const Unit& u, int wr, int wc, int fr, int fq) const {
        const int row0 = u.pm * BM + wr * 64 + fr, col0 = u.pn * BM + wc * 32 + 4 * fq;
#pragma unroll
        for (int ai = 0; ai < 2; ++ai)
#pragma unroll
            for (int m = 0; m < 4; ++m) { const int slot = row0 + ai * HALF + m * 16; const int tok = slot_tok[slot]; const float gt = slot_gate[slot];
                if (tok >= 0) { float* rowp = H + (size_t)tok * ldc + col0;
#pragma unroll
                    for (int bj = 0; bj < 2; ++bj)
#pragma unroll
                        for (int n = 0; n < 2; ++n) { f32x4* p = (f32x4*)(rowp + bj * HALF + n * 16); *p = *p + acc[ai][bj][m][n] * gt; } }
                __builtin_amdgcn_sched_barrier(0); }
    }
};

template <class Epi, class Sched, bool ALIGN_EPI = true, bool SP2 = true>
__device__ __forceinline__ void gemm_phase(LAS unsigned char* lds, const int K, const Sched& S, const Epi& E) {
    int tid = threadIdx.x; asm volatile("" : "+v"(tid));
    const int wid = __builtin_amdgcn_readfirstlane(tid >> 6), lane = tid & 63, wr = wid >> 2, wc = wid & 3, fr = lane & 15, fq = lane >> 4;
    const int nt = K / BK;
    unsigned voffA[2], voffB[2];
#pragma unroll
    for (int i = 0; i < 2; ++i) { int R, C; stage_rc(tid * 16 + i * 8192, R, C); const int Rb = Epi::PERM ? ((R & ~31) + perm32(R & 31)) : R;
        voffA[i] = (unsigned)(R * K + C) * 2u; voffB[i] = (unsigned)(Rb * K + C) * 2u; }
    const size_t kstep = (size_t)(BK * 2);
    const size_t hstep = (size_t)HALF * K * 2;
    const unsigned ldsw = (unsigned)wid * 1024u;
    const int aoff = lds_byte(wr * 64 + fr, fq * 8), boff = lds_byte(wc * 32 + fr, fq * 8);
#define PG8_SA(b, h) (((b) * 2 + (h)) * HTB)
#define PG8_SB(b, h) ((4 + (b) * 2 + (h)) * HTB)
#define PG8_STAGE(bufoff, gbase, voff) do { _Pragma("unroll") for (int _i = 0; _i < 2; ++_i) \
        __builtin_amdgcn_global_load_lds((const unsigned*)((const char*)(gbase) + (voff)[_i]), (LAS unsigned*)(lds + (bufoff) + ldsw + _i * 8192), 16, 0, 0); } while (0)
#define PG8_LDA(dst, b, h) do { _Pragma("unroll") for (int m = 0; m < 4; ++m) _Pragma("unroll") for (int k = 0; k < 2; ++k) dst[m][k] = *(const LAS bf16x8*)(lds + PG8_SA(b, h) + aoff + m * 2048 + k * 1024); } while (0)
#define PG8_LDB(dst, b, h) do { _Pragma("unroll") for (int n = 0; n < 2; ++n) _Pragma("unroll") for (int k = 0; k < 2; ++k) dst[n][k] = *(const LAS bf16x8*)(lds + PG8_SB(b, h) + boff + n * 2048 + k * 1024); } while (0)
#define PG8_MMA(ai, bj, At, Bt) do { __builtin_amdgcn_s_setprio(1); _Pragma("unroll") for (int m = 0; m < 4; ++m) _Pragma("unroll") for (int n = 0; n < 2; ++n) _Pragma("unroll") for (int k = 0; k < 2; ++k) \
        acc[ai][bj][m][n] = __builtin_amdgcn_mfma_f32_16x16x32_bf16(Bt[n][k], At[m][k], acc[ai][bj][m][n], 0, 0, 0); __builtin_amdgcn_s_setprio(0); } while (0)
#define PG8_WAIT_V(n) asm volatile("s_waitcnt vmcnt(" #n ")" ::: "memory")
#define PG8_WAIT_L(n) asm volatile("s_waitcnt lgkmcnt(" #n ")" ::: "memory")
#define PG8_BAR __builtin_amdgcn_s_barrier()
#define PG8_SCHED __builtin_amdgcn_sched_barrier(0)
    Unit cur, nxt; int ui = 0;
    if (!S.next(0, cur)) return;
    f32x4 acc[2][2][4][2];
#pragma unroll
    for (int a = 0; a < 2; ++a)
#pragma unroll
        for (int b = 0; b < 2; ++b)
#pragma unroll
            for (int m = 0; m < 4; ++m)
#pragma unroll
                for (int n = 0; n < 2; ++n) acc[a][b][m][n] = (f32x4){0.f, 0.f, 0.f, 0.f};
    bf16x8 At[4][2], B0[2][2], B1[2][2];
    const char* cA = S.abase(cur); const char* cB = S.bbase(cur);
    if constexpr (SP2) {
        PG8_STAGE(PG8_SB(0, 0), cB, voffB); PG8_STAGE(PG8_SB(0, 1), cB + hstep, voffB); PG8_STAGE(PG8_SA(0, 0), cA, voffA); PG8_STAGE(PG8_SA(0, 1), cA + hstep, voffA);
        if (wr == 1) PG8_BAR;
        PG8_WAIT_V(2); PG8_BAR;
        PG8_STAGE(PG8_SB(1, 0), cB + kstep, voffB); PG8_STAGE(PG8_SA(1, 0), cA + kstep, voffA); PG8_STAGE(PG8_SB(1, 1), cB + hstep + kstep, voffB);
        PG8_WAIT_V(6); PG8_BAR;
    } else {
        PG8_STAGE(PG8_SB(0, 0), cB, voffB); PG8_STAGE(PG8_SA(0, 0), cA, voffA); PG8_STAGE(PG8_SB(0, 1), cB + hstep, voffB); PG8_STAGE(PG8_SA(0, 1), cA + hstep, voffA);
        if (wr == 1) PG8_BAR;
        PG8_WAIT_V(4); PG8_BAR;
        PG8_STAGE(PG8_SB(1, 0), cB + kstep, voffB); PG8_STAGE(PG8_SA(1, 0), cA + kstep, voffA); PG8_STAGE(PG8_SB(1, 1), cB + hstep + kstep, voffB);
        PG8_WAIT_V(6); PG8_BAR;
    }
    for (;;) {
        const bool has_next = S.next(ui + 1, nxt);
        const char* nA = has_next ? S.abase(nxt) : cA; const char* nB = has_next ? S.bbase(nxt) : cB;
        for (int t = 0; t < nt; t += 2) {
            const bool last = (t == nt - 2);
            const char* a1 = cA + (size_t)(t + 1) * kstep;
            const char* a2 = last ? nA : cA + (size_t)(t + 2) * kstep; const char* b2 = last ? nB : cB + (size_t)(t + 2) * kstep;
            const char* a3 = a2 + kstep; const char* b3 = b2 + kstep;
            if constexpr (SP2) {
            PG8_LDB(B0, 0, 0); PG8_LDB(B1, 0, 1); PG8_SCHED; PG8_LDA(At, 0, 0); PG8_STAGE(PG8_SA(1, 1), a1 + hstep, voffA);
            PG8_WAIT_V(8); PG8_WAIT_L(0); PG8_BAR; PG8_MMA(0, 0, At, B0); PG8_MMA(0, 1, At, B1); PG8_BAR; PG8_SCHED;
            PG8_LDA(At, 0, 1); PG8_STAGE(PG8_SB(0, 0), b2, voffB); PG8_STAGE(PG8_SB(0, 1), b2 + hstep, voffB); PG8_STAGE(PG8_SA(0, 0), a2, voffA);
            PG8_WAIT_V(8); PG8_WAIT_L(0); PG8_BAR; PG8_MMA(1, 0, At, B0); PG8_MMA(1, 1, At, B1); PG8_BAR; PG8_SCHED;
            PG8_LDB(B0, 1, 0); PG8_LDB(B1, 1, 1); PG8_SCHED; PG8_LDA(At, 1, 0); PG8_STAGE(PG8_SA(0, 1), a2 + hstep, voffA);
            PG8_WAIT_V(8); PG8_WAIT_L(0); PG8_BAR; PG8_MMA(0, 0, At, B0); PG8_MMA(0, 1, At, B1); PG8_BAR; PG8_SCHED;
            PG8_LDA(At, 1, 1); PG8_STAGE(PG8_SB(1, 0), b3, voffB); PG8_STAGE(PG8_SB(1, 1), b3 + hstep, voffB); PG8_STAGE(PG8_SA(1, 0), a3, voffA);
            PG8_WAIT_V(8); PG8_WAIT_L(0); PG8_BAR; PG8_MMA(1, 0, At, B0); PG8_MMA(1, 1, At, B1); PG8_BAR; PG8_SCHED;
            } else {
            PG8_LDB(B0, 0, 0); PG8_SCHED; PG8_LDA(At, 0, 0); PG8_STAGE(PG8_SA(1, 1), a1 + hstep, voffA);
            PG8_WAIT_L(8); PG8_BAR; PG8_WAIT_L(0); PG8_MMA(0, 0, At, B0); PG8_BAR; PG8_SCHED;
            PG8_LDB(B1, 0, 1); PG8_STAGE(PG8_SB(0, 0), b2, voffB);
            PG8_BAR; PG8_WAIT_L(0); PG8_MMA(0, 1, At, B1); PG8_BAR;
            PG8_LDA(At, 0, 1); PG8_STAGE(PG8_SA(0, 0), a2, voffA);
            PG8_BAR; PG8_WAIT_L(0); PG8_MMA(1, 0, At, B0); PG8_BAR; PG8_SCHED;
            PG8_STAGE(PG8_SB(0, 1), b2 + hstep, voffB);
            PG8_WAIT_V(6); PG8_BAR; PG8_MMA(1, 1, At, B1); PG8_BAR;
            PG8_LDB(B0, 1, 0); PG8_SCHED; PG8_LDA(At, 1, 0); PG8_STAGE(PG8_SA(0, 1), a2 + hstep, voffA);
            PG8_WAIT_L(8); PG8_BAR; PG8_WAIT_L(0); PG8_MMA(0, 0, At, B0); PG8_BAR; PG8_SCHED;
            PG8_LDB(B1, 1, 1); PG8_STAGE(PG8_SB(1, 0), b3, voffB);
            PG8_BAR; PG8_WAIT_L(0); PG8_MMA(0, 1, At, B1); PG8_BAR;
            PG8_LDA(At, 1, 1); PG8_STAGE(PG8_SA(1, 0), a3, voffA);
            PG8_BAR; PG8_WAIT_L(0); PG8_MMA(1, 0, At, B0); PG8_BAR; PG8_SCHED;
            PG8_STAGE(PG8_SB(1, 1), b3 + hstep, voffB);
            PG8_WAIT_V(6); PG8_BAR; PG8_MMA(1, 1, At, B1); PG8_BAR;
            }
        }
        if constexpr (ALIGN_EPI) { if (wr == 0) PG8_BAR; }
        E(acc, cur, wr, wc, fr, fq);
        if (!has_next) break;
#pragma unroll
        for (int a = 0; a < 2; ++a)
#pragma unroll
            for (int b = 0; b < 2; ++b)
#pragma unroll
                for (int m = 0; m < 4; ++m)
#pragma unroll
                    for (int n = 0; n < 2; ++n) acc[a][b][m][n] = (f32x4){0.f, 0.f, 0.f, 0.f};
        cur = nxt; cA = nA; cB = nB; ++ui;
        if constexpr (ALIGN_EPI) { if (wr == 1) PG8_BAR; }
    }
    PG8_WAIT_V(0);
    if constexpr (!ALIGN_EPI) { if (wr == 0) PG8_BAR; }
    PG8_BAR;
#undef PG8_SA
#undef PG8_SB
#undef PG8_STAGE
#undef PG8_LDA
#undef PG8_LDB
#undef PG8_MMA
#undef PG8_WAIT_V
#undef PG8_WAIT_L
#undef PG8_BAR
#undef PG8_SCHED
}
}

constexpr size_t MiB = 1u << 20;
constexpr size_t WS_CTL = 0, CTL_ZERO_BYTES = 65536;
constexpr size_t WS_WIN = 1 * MiB;
constexpr size_t WS_WOUT = 13 * MiB;
constexpr size_t WS_W13 = 17 * MiB;
constexpr size_t WS_W2 = 28 * MiB;
constexpr size_t WS_WG = 34 * MiB;
constexpr size_t WS_WP = 38 * MiB;
constexpr size_t WS_CW1 = 39 * MiB;
constexpr size_t WS_LORA = 41 * MiB;
constexpr size_t WS_ROPE = 41 * MiB + 512 * 1024;
constexpr size_t WS_CBIAS = 42 * MiB + 512 * 1024;
constexpr size_t WS_PB = 43 * MiB;
constexpr size_t WS_HN = 60 * MiB;
constexpr size_t WS_Z = 92 * MiB;
constexpr size_t WS_YCAT = 188 * MiB;
constexpr size_t WS_QROT = 220 * MiB;
constexpr size_t WS_KSR = 236 * MiB, WS_KWR = 240 * MiB, WS_VST = 244 * MiB, WS_VWT = 248 * MiB;
constexpr size_t WS_KCMP = 252 * MiB, WS_VCMPT = 252 * MiB + 512 * 1024;
constexpr size_t WS_REC = 253 * MiB;
constexpr size_t WS_G = 349 * MiB;
constexpr size_t WS_YRAW = 365 * MiB;
constexpr size_t WS_BONUS = 381 * MiB;
constexpr size_t WS_ACT = 92 * MiB;
constexpr size_t WS_HNS = 92 * MiB;
constexpr size_t WS_ACTM = 128 * MiB;
constexpr size_t WS_MW13 = 227 * MiB;
constexpr size_t WS_MW2 = 315 * MiB;
constexpr size_t WS_SLOT = 359 * MiB;
constexpr size_t WS_PP = 92 * MiB;
constexpr size_t WS_YP = 382 * MiB;
constexpr size_t WS_SEGE = 398 * MiB;
constexpr size_t WS_SST = 406 * MiB;
constexpr size_t WS_END = 410 * MiB;
constexpr int NSEG = 16, SEGLEN = SEQ / NSEG;
constexpr int MOE_SLOTS = 18432;
constexpr size_t SL_TOK = 0;
constexpr size_t SL_GATE = SL_TOK + 2 * MOE_SLOTS * 4;
constexpr size_t SL_TOKE = SL_GATE + 2 * MOE_SLOTS * 4;
constexpr size_t SL_TOKG = SL_TOKE + (size_t)MT * 2 * 4;
constexpr size_t SL_TOKS = SL_TOKG + (size_t)MT * 2 * 4;
constexpr size_t SL_BCNT = SL_TOKS + (size_t)MT * 2 * 4;
constexpr size_t SL_TST = SL_BCNT + 256 * 16 * 4;
static_assert(SL_TST + 128 <= 1 * MiB, "slot tables");
constexpr int CW_BAR = 4096;
constexpr int CW_Q = 8192;

constexpr int RING_BYTES = 131072;
constexpr int MISC_OFF = RING_BYTES;
constexpr int LDS_BYTES = 147456;

#define XB_TMO      128
#define XB_XCNT(j)  (256  + 64 * (j))
#define XB_XSUB(j)  (1280 + 64 * (j))
#define XB_XGEN(j)  (2304 + 64 * (j))
#define XB_TOP      3328
#define XB_TOPGEN   3392
#define XCD_BAR_WORDS 3456
#define XB_SPIN_CAP (1u << 18)
__device__ __forceinline__ unsigned xb_ld(unsigned* p)              { return __hip_atomic_load(p, __ATOMIC_RELAXED, __HIP_MEMORY_SCOPE_AGENT); }
__device__ __forceinline__ unsigned xb_add(unsigned* p, unsigned v) { return __hip_atomic_fetch_add(p, v, __ATOMIC_RELAXED, __HIP_MEMORY_SCOPE_AGENT); }
__device__ __forceinline__ unsigned xb_xcc_id() { return (unsigned)__builtin_amdgcn_s_getreg((3 << 11) | 20) & 0xFu; }
#define XB_SPIN(cond, bar) do { unsigned _sp = 0; while (cond) { __builtin_amdgcn_s_sleep(1); \
    if ((++_sp & 255u) == 0u) { if (xb_ld(&(bar)[XB_TMO])) break; if (_sp > XB_SPIN_CAP) { atomicAdd(&(bar)[XB_TMO], 1u); break; } } } } while (0)
struct XcdBarrier { unsigned* bar; unsigned x; volatile LAS unsigned* st; };
__device__ __forceinline__ XcdBarrier xcd_barrier_post(unsigned* bar, volatile LAS unsigned* st) {
    XcdBarrier b; b.bar = bar; b.x = xb_xcc_id(); b.st = st;
    if (threadIdx.x == 0) (void)xb_add(&bar[XB_XCNT(b.x)], 1u);
    return b;
}
__device__ __forceinline__ void xcd_barrier_complete(unsigned* bar, unsigned x, unsigned& nloc, unsigned& nx) {
    const unsigned G = gridDim.x * gridDim.y * gridDim.z;
    unsigned sum, cnt, mine, sp = 0u;
    for (;;) {
        sum = 0u; cnt = 0u; mine = 0u;
#pragma unroll
        for (unsigned j = 0; j < 16; ++j) { const unsigned c = xb_ld(&bar[XB_XCNT(j)]); sum += c; cnt += (c > 0u) ? 1u : 0u; mine = (j == x) ? c : mine; }
        if (sum == G) break;
        __builtin_amdgcn_s_sleep(1);
        if ((++sp & 255u) == 0u) { if (xb_ld(&bar[XB_TMO])) break; if (sp > XB_SPIN_CAP) { atomicAdd(&bar[XB_TMO], 1u); break; } }
    }
    nloc = mine > 0u ? mine : 1u; nx = cnt > 0u ? cnt : 1u;
}
__device__ __forceinline__ void xcd_barrier(const XcdBarrier& b) {
    asm volatile("s_waitcnt vmcnt(0)" ::: "memory");
    __syncthreads();
    if (threadIdx.x == 0) {
        unsigned* bar = b.bar;
        __builtin_amdgcn_s_waitcnt(0);
        unsigned nloc = b.st[0], nx = b.st[1];
        if (nloc == 0u) { xcd_barrier_complete(bar, b.x, nloc, nx); b.st[0] = nloc; b.st[1] = nx; }
        const unsigned old = xb_add(&bar[XB_XSUB(b.x)], 1u);
        const unsigned gen = old / nloc;
        if (old + 1u == (gen + 1u) * nloc) {
            __builtin_amdgcn_fence(__ATOMIC_RELEASE, "agent");
            asm volatile("s_waitcnt vmcnt(0)" ::: "memory");
            const unsigned og = xb_add(&bar[XB_TOP], 1u);
            const unsigned tg = og / nx;
            if (og + 1u == (tg + 1u) * nx) xb_add(&bar[XB_TOPGEN], 1u);
            else XB_SPIN(xb_ld(&bar[XB_TOPGEN]) == tg, bar);
            __builtin_amdgcn_fence(__ATOMIC_ACQUIRE, "agent");
            xb_add(&bar[XB_XGEN(b.x)], 1u);
            asm volatile("s_waitcnt vmcnt(0)" ::: "memory");
        } else {
            XB_SPIN(xb_ld(&bar[XB_XGEN(b.x)]) == gen, bar);
            __builtin_amdgcn_fence(__ATOMIC_ACQUIRE, "agent");
            asm volatile("s_waitcnt vmcnt(0)" ::: "memory");
        }
    }
    __syncthreads();
}

enum { IN_X = 0, IN_P, IN_POS, IN_GMIX, IN_WIN, IN_WOUT, IN_GMLNG, IN_GMLNB, IN_GMWS, IN_GMBS, IN_RWMU, IN_RWW0, IN_RWWUP, IN_RWA0, IN_RWAUP, IN_RWGUP,
       IN_RWKK, IN_RWKA, IN_RWRK, IN_RWGNG, IN_RWGNB, IN_CMPPOS, IN_KCW1, IN_KCW2, IN_VCW1, IN_VCW2, IN_GFFN, IN_FW1, IN_FW3, IN_FW2, IN_RTW, IN_RTB,
       IN_MW1, IN_MW3, IN_MW2, IN_GPLE, IN_PLEG, IN_PLEP, IN_GFINAL, N_INPUTS };
struct Args { const void* in[N_INPUTS]; float* out; unsigned char* ws; int ph_lo, ph_hi; };
constexpr int PTAB_OFF = 131072 + 256;
__device__ __forceinline__ const void* ldptr(int k) {
    extern __shared__ __attribute__((aligned(16))) unsigned char lds_raw[];
    const LAS unsigned* t = (const LAS unsigned*)((LAS unsigned char*)lds_raw + PTAB_OFF) + 2 * k;
    const unsigned lo = __builtin_amdgcn_readfirstlane(t[0]), hi = __builtin_amdgcn_readfirstlane(t[1]);
    return (const void*)(((unsigned long long)hi << 32) | lo);
}
#define INF(k) ((const float*)ldptr(k))

__device__ __forceinline__ void conv_matrix(const float* W, int K, int N, bf16* dst, int mode, int gw, int NGW, LAS float* scr, int lane) {
    (void)scr;
    const int nblk = (N + 63) / 64, nit = (K / 64) * nblk;
    for (int it = gw; it < nit; it += NGW) {
        const int kb = it / nblk, nb = it % nblk, n = nb * 64 + lane, k0 = kb * 64; const bool ok = n < N;
        const int drow = mode == 0 ? n : ((n >> 7) * 256 + (n & 127) + (mode == 2 ? 128 : 0));
        const float* src = W + (size_t)k0 * N + (ok ? n : 0);
        float v[64];
#pragma unroll
        for (int k = 0; k < 64; ++k) v[k] = src[(size_t)k * N];
        if (ok) { u32x4* d = (u32x4*)(dst + (size_t)drow * K + k0);
#pragma unroll
            for (int c = 0; c < 8; ++c) { u32x4 o; o.x = pk2(v[8 * c], v[8 * c + 1]); o.y = pk2(v[8 * c + 2], v[8 * c + 3]); o.z = pk2(v[8 * c + 4], v[8 * c + 5]); o.w = pk2(v[8 * c + 6], v[8 * c + 7]); d[c] = o; } }
    }
}
__device__ __forceinline__ void rms_row_bf16(const float* xrow, const float* g, bf16* orow, float* cp, int lane) {
    const f32x4* xr = (const f32x4*)xrow + lane; f32x4 v[4]; float s = 0.f;
#pragma unroll
    for (int j = 0; j < 4; ++j) { v[j] = xr[64 * j]; s += (v[j].x * v[j].x + v[j].y * v[j].y) + (v[j].z * v[j].z + v[j].w * v[j].w); }
    const float rs = 1.0f / sqrtf(wave_sum(s) * (1.0f / 1024.0f) + 1e-6f);
    if (cp) {
#pragma unroll
        for (int j = 0; j < 4; ++j) ((f32x4*)cp + lane)[64 * j] = v[j]; }
    u32x2* o8 = (u32x2*)orow + lane;
#pragma unroll
    for (int j = 0; j < 4; ++j) { const f32x4 gg = ((const f32x4*)g + lane)[64 * j]; u32x2 w; w.x = pk2(v[j].x * rs * gg.x, v[j].y * rs * gg.y); w.y = pk2(v[j].z * rs * gg.z, v[j].w * rs * gg.w); o8[64 * j] = w; }
}

__device__ __forceinline__ void phase_prologue(const Args& a, LAS unsigned char* lds) {
    const int tid = opaque_tid(), lane = tid & 63, wave = __builtin_amdgcn_readfirstlane(tid >> 6);
    const int G = gridDim.x, gw = blockIdx.x * NWAVES + wave, NGW = G * NWAVES;
    const size_t gt = (size_t)blockIdx.x * NTHR + tid, NGT = (size_t)G * NTHR;
    unsigned char* ws = a.ws;
    LAS float* scr = (LAS float*)(lds + wave * 16384);
    for (int l = 0; l < 2; ++l) {
        conv_matrix(INF(IN_WIN) + (size_t)l * DM * DIN, DM, DIN, (bf16*)(ws + WS_WIN) + (size_t)l * ZLD * DM, 0, gw, NGW, scr, lane);
        conv_matrix(INF(IN_WOUT) + (size_t)l * DM * DM, DM, DM, (bf16*)(ws + WS_WOUT) + (size_t)l * DM * DM, 0, gw, NGW, scr, lane);
        conv_matrix(INF(IN_PLEG) + (size_t)l * DM * DM, DM, DM, (bf16*)(ws + WS_WG) + (size_t)l * DM * DM, 0, gw, NGW, scr, lane);
        conv_matrix(INF(IN_PLEP) + (size_t)l * 256 * DM, 256, DM, (bf16*)(ws + WS_WP) + (size_t)l * DM * 256, 0, gw, NGW, scr, lane);
        conv_matrix(INF(IN_KCW1) + (size_t)l * 2048 * 128, 2048, 128, (bf16*)(ws + WS_CW1) + (size_t)(l * 2 + 0) * 128 * 2048, 0, gw, NGW, scr, lane);
        conv_matrix(INF(IN_VCW1) + (size_t)l * 2048 * 128, 2048, 128, (bf16*)(ws + WS_CW1) + (size_t)(l * 2 + 1) * 128 * 2048, 0, gw, NGW, scr, lane);
        bf16* lora = (bf16*)(ws + WS_LORA) + (size_t)l * 65536;
        conv_matrix(INF(IN_RWWUP) + (size_t)l * 64 * 256, 64, 256, lora, 0, gw, NGW, scr, lane);
        conv_matrix(INF(IN_RWAUP) + (size_t)l * 64 * 256, 64, 256, lora + 16384, 0, gw, NGW, scr, lane);
        conv_matrix(INF(IN_RWGUP) + (size_t)l * 128 * 256, 128, 256, lora + 32768, 0, gw, NGW, scr, lane);
        { u32x4* zr = (u32x4*)((bf16*)(ws + WS_WIN) + ((size_t)l * ZLD + DIN) * DM); const size_t n16 = (size_t)(ZLD - DIN) * DM * 2 / 16;
          for (size_t i = gt; i < n16; i += NGT) zr[i] = (u32x4){0u, 0u, 0u, 0u}; }
    }
    conv_matrix(INF(IN_FW1), DM, DFF, (bf16*)(ws + WS_W13), 1, gw, NGW, scr, lane);
    conv_matrix(INF(IN_FW3), DM, DFF, (bf16*)(ws + WS_W13), 2, gw, NGW, scr, lane);
    conv_matrix(INF(IN_FW2), DFF, DM, (bf16*)(ws + WS_W2), 0, gw, NGW, scr, lane);
    { const f32x4* src = (const f32x4*)INF(IN_P); u32x2* dst = (u32x2*)(ws + WS_PB); const size_t n4 = (size_t)2 * MT * 256 / 4;
      for (size_t i = gt; i < n4; i += NGT) { const f32x4 v = src[i]; u32x2 w; w.x = pk2(v.x, v.y); w.y = pk2(v.z, v.w); dst[i] = w; } }
    { const int* pos = (const int*)ldptr(IN_POS); float* ct = (float*)(ws + WS_ROPE); float* st = ct + (size_t)MT * 8;
      const float inv[8] = {1.0f, 0.1939227432012558f, 0.03760603070259094f, 0.007292664609849453f, 0.0014142135623842478f, 0.00027424818836152554f, 5.3182957344688475e-05f, 1.0313385246263351e-05f};
      for (size_t i = gt; i < (size_t)MT * 8; i += NGT) { const int m = (int)(i >> 3), k = (int)(i & 7);
          float iv = inv[0];
#pragma unroll
          for (int q = 1; q < 8; ++q) iv = (k == q) ? inv[q] : iv;
          const float ang = (float)pos[m] * iv;
          const double ad = (double)ang; const double kq = __builtin_rint(ad * 0.15915494309189535); const float red = (float)(ad - kq * 6.283185307179586);
          ct[i] = __cosf(red); st[i] = __sinf(red); } }
    if (blockIdx.x < 64) {
        const int lk = blockIdx.x >> 4, ck = blockIdx.x & 15, l = lk >> 1, kv = lk & 1; const float* W1 = INF(kv ? IN_VCW1 : IN_KCW1) + (size_t)l * 2048 * 128; const float* pos = INF(IN_CMPPOS) + (size_t)l * 2048;
        LAS float* red = (LAS float*)(lds + 8448);
        const int hid = tid & 127, part = tid >> 7; const int kb = ck * 128 + part * 32; float s = 0.f;
#pragma unroll
        for (int k = 0; k < 32; ++k) s += pos[kb + k] * W1[(size_t)(kb + k) * 128 + hid];
        red[part * 128 + hid] = s; __syncthreads();
        if (tid < 128) ((float*)(ws + WS_CBIAS))[(lk * 16 + ck) * 128 + tid] = red[tid] + red[128 + tid] + red[256 + tid] + red[384 + tid];
    }
    for (int m = gw; m < MT; m += NGW) rms_row_bf16(INF(IN_X) + (size_t)m * DM, INF(IN_GMIX), (bf16*)(ws + WS_HN) + (size_t)m * DM, a.out + (size_t)m * DM, lane);
}

template <int MODE>
__device__ __forceinline__ void phase_norm(const Args& a, LAS unsigned char* lds, const float* g) {
    const int tid = opaque_tid(), lane = tid & 63, wave = __builtin_amdgcn_readfirstlane(tid >> 6);
    unsigned char* ws = a.ws;
    LAS int* lcnt = (LAS int*)lds;
    if (MODE == 1) { if (tid < 16) lcnt[tid] = 0; __syncthreads(); }
    for (int rb = blockIdx.x; rb < MT / 64; rb += gridDim.x) {
        for (int i = 0; i < 8; ++i) {
            const int m = rb * 64 + wave * 8 + i;
            float* hrow = a.out + (size_t)m * DM;
            const f32x4* xr = (const f32x4*)hrow + lane; f32x4 v[4]; float s = 0.f;
#pragma unroll
            for (int j = 0; j < 4; ++j) { v[j] = xr[64 * j]; s += (v[j].x * v[j].x + v[j].y * v[j].y) + (v[j].z * v[j].z + v[j].w * v[j].w); }
            const float rs = 1.0f / sqrtf(wave_sum(s) * (1.0f / 1024.0f) + 1e-6f);
#pragma unroll
            for (int j = 0; j < 4; ++j) { const f32x4 gg = ((const f32x4*)g + lane)[64 * j]; v[j].x *= rs * gg.x; v[j].y *= rs * gg.y; v[j].z *= rs * gg.z; v[j].w *= rs * gg.w; }
            if (MODE == 2) {
#pragma unroll
                for (int j = 0; j < 4; ++j) ((f32x4*)hrow + lane)[64 * j] = v[j];
            } else {
                u32x2* o8 = (u32x2*)((bf16*)(ws + WS_HN) + (size_t)m * DM) + lane;
#pragma unroll
                for (int j = 0; j < 4; ++j) { u32x2 w; w.x = pk2(v[j].x, v[j].y); w.y = pk2(v[j].z, v[j].w); o8[64 * j] = w; }
            }
            if (MODE == 1) {
                const float* rw = INF(IN_RTW); float lg[8];
#pragma unroll
                for (int e = 0; e < 8; ++e) lg[e] = 0.f;
#pragma unroll
                for (int j = 0; j < 4; ++j)
#pragma unroll
                    for (int c = 0; c < 4; ++c) { const int k = 4 * (lane + 64 * j) + c; const f32x4 w0 = *(const f32x4*)(rw + (size_t)k * 8), w1 = *(const f32x4*)(rw + (size_t)k * 8 + 4); const float x = v[j][c];
                        lg[0] += x * w0.x; lg[1] += x * w0.y; lg[2] += x * w0.z; lg[3] += x * w0.w; lg[4] += x * w1.x; lg[5] += x * w1.y; lg[6] += x * w1.z; lg[7] += x * w1.w; }
#pragma unroll
                for (int e = 0; e < 8; ++e) lg[e] = wave_sum(lg[e]) + INF(IN_RTB)[e];
                int e0 = 0; float v0 = lg[0];
#pragma unroll
                for (int e = 1; e < 8; ++e) if (lg[e] > v0) { v0 = lg[e]; e0 = e; }
                int e1 = -1; float v1 = -3.0e38f;
#pragma unroll
                for (int e = 0; e < 8; ++e) if (e != e0 && lg[e] > v1) { v1 = lg[e]; e1 = e; }
                const float p1 = 1.0f / (1.0f + __expf(v0 - v1)), p0 = 1.0f - p1;
                if (lane == 0) { int* te = (int*)(ws + WS_SLOT + SL_TOKE); float* tg = (float*)(ws + WS_SLOT + SL_TOKG); te[2 * m] = e0; te[2 * m + 1] = e1; tg[2 * m] = p0; tg[2 * m + 1] = p1;
                    atomicAdd((int*)&lcnt[e0], 1); atomicAdd((int*)&lcnt[8 + e1], 1); }
            }
        }
        if (MODE == 1) { __syncthreads(); if (tid < 16) { ((int*)(ws + WS_SLOT + SL_BCNT))[rb * 16 + tid] = lcnt[tid]; lcnt[tid] = 0; } __syncthreads(); }
    }
}

__device__ __forceinline__ bf16x8 ld_bf8(const bf16* p) { return *(const bf16x8*)p; }
__device__ __forceinline__ float tanhf_(float x) { const float e = __expf(2.0f * x); return 1.0f - 2.0f / (e + 1.0f); }

__device__ __forceinline__ void rw_shift8(const bf16* z, const float* mu, int m, int tpos, int c, float (&o)[8]) {
    const u32x4 cur = *(const u32x4*)(z + (size_t)m * ZLD + ZC_B + c);
    u32x4 prv = (u32x4){0u, 0u, 0u, 0u}; if (tpos > 0) prv = *(const u32x4*)(z + (size_t)(m - 1) * ZLD + ZC_B + c);
    const f32x4 m0 = *(const f32x4*)(mu + c), m1 = *(const f32x4*)(mu + c + 4);
    float cu[8] = {bflo(cur.x), bfhi(cur.x), bflo(cur.y), bfhi(cur.y), bflo(cur.z), bfhi(cur.z), bflo(cur.w), bfhi(cur.w)};
    float pv[8] = {bflo(prv.x), bfhi(prv.x), bflo(prv.y), bfhi(prv.y), bflo(prv.z), bfhi(prv.z), bflo(prv.w), bfhi(prv.w)};
    float mm[8] = {m0.x, m0.y, m0.z, m0.w, m1.x, m1.y, m1.z, m1.w};
#pragma unroll
    for (int j = 0; j < 8; ++j) o[j] = cu[j] + (pv[j] - cu[j]) * mm[j];
}
__device__ __forceinline__ void rw_shift4(const bf16* z, const float* mu, int m, int tpos, int c, float (&o)[4]) {
    const u32x2 cur = *(const u32x2*)(z + (size_t)m * ZLD + ZC_B + c);
    u32x2 prv = (u32x2){0u, 0u}; if (tpos > 0) prv = *(const u32x2*)(z + (size_t)(m - 1) * ZLD + ZC_B + c);
    const f32x4 m0 = *(const f32x4*)(mu + c);
    o[0] = bflo(cur.x) + (bflo(prv.x) - bflo(cur.x)) * m0.x; o[1] = bfhi(cur.x) + (bfhi(prv.x) - bfhi(cur.x)) * m0.y;
    o[2] = bflo(cur.y) + (bflo(prv.y) - bflo(cur.y)) * m0.z; o[3] = bfhi(cur.y) + (bfhi(prv.y) - bfhi(cur.y)) * m0.w;
}
__device__ __forceinline__ bf16x8 pack8(const float (&x)[8]) {
    u32x4 w; w.x = pk2(x[0], x[1]); w.y = pk2(x[2], x[3]); w.z = pk2(x[4], x[5]); w.w = pk2(x[6], x[7]);
    return __builtin_bit_cast(bf16x8, w);
}

__device__ __forceinline__ void rwkv_prep_tile(const Args& a, int layer, int m0, int lane) {
    unsigned char* ws = a.ws;
    const bf16* z = (const bf16*)(ws + WS_Z);
    const float* mu = INF(IN_RWMU) + (size_t)layer * 1024;
    const bf16* lora = (const bf16*)(ws + WS_LORA) + (size_t)layer * 65536;
    const bf16* wupT = lora; const bf16* aupT = lora + 16384; const bf16* gupT = lora + 32768;
    const int fq = lane >> 4, fr = lane & 15;
    const int m = m0 + fr, tpos = m & (SEQ - 1), bb = m >> 12;
    bf16x8 wdB[2], adB[2], gdB[4];
#pragma unroll
    for (int ks = 0; ks < 2; ++ks) { float x[8]; rw_shift8(z, mu, m, tpos, 768 + 32 * ks + 8 * fq, x);
#pragma unroll
        for (int j = 0; j < 8; ++j) x[j] = tanhf_(x[j]);
        wdB[ks] = pack8(x);
        rw_shift8(z, mu, m, tpos, 832 + 32 * ks + 8 * fq, x); adB[ks] = pack8(x); }
#pragma unroll
    for (int ks = 0; ks < 4; ++ks) { float x[8]; rw_shift8(z, mu, m, tpos, 896 + 32 * ks + 8 * fq, x);
#pragma unroll
        for (int j = 0; j < 8; ++j) x[j] = sigmoidf_(x[j]);
        gdB[ks] = pack8(x); }
    const float* w0p = INF(IN_RWW0) + layer * 256; const float* a0p = INF(IN_RWA0) + layer * 256; const float* kkp = INF(IN_RWKK) + layer * 256;
    const float* kap = INF(IN_RWKA) + layer * 256; const float* rkp = INF(IN_RWRK) + layer * 256;
    float* rec = (float*)(ws + WS_REC); float* gbuf = (float*)(ws + WS_G); float* bonus = (float*)(ws + WS_BONUS);
    float ss = 0.f, bs = 0.f, inv = 0.f;
#pragma unroll 1
    for (int hc = 0; hc < 16; ++hc) {
        const int h = hc >> 2, ct = hc & 3;
        if (ct == 0) {
            ss = 0.f; bs = 0.f;
#pragma unroll
            for (int c2 = 0; c2 < 4; ++c2) { const int c0 = h * 64 + 16 * c2 + 4 * fq; float k4[4]; rw_shift4(z, mu, m, tpos, 256 + c0, k4); const f32x4 k_k = *(const f32x4*)(kkp + c0);
#pragma unroll
                for (int i = 0; i < 4; ++i) { const float kx = k4[i] * k_k[i]; ss += kx * kx; } }
            ss += __shfl_xor(ss, 16); ss += __shfl_xor(ss, 32);
            inv = 1.0f / sqrtf(fmaxf(ss, 1e-24f));
        }
        f32x4 aw = (f32x4){0.f, 0.f, 0.f, 0.f}, aa = aw, ag = aw;
        const int chr = h * 64 + 16 * ct + fr;
#pragma unroll
        for (int ks = 0; ks < 2; ++ks) { const bf16x8 A1 = ld_bf8(wupT + chr * 64 + 32 * ks + 8 * fq), A2 = ld_bf8(aupT + chr * 64 + 32 * ks + 8 * fq);
            aw = __builtin_amdgcn_mfma_f32_16x16x32_bf16(A1, wdB[ks], aw, 0, 0, 0); aa = __builtin_amdgcn_mfma_f32_16x16x32_bf16(A2, adB[ks], aa, 0, 0, 0); }
#pragma unroll
        for (int ks = 0; ks < 4; ++ks) { const bf16x8 A3 = ld_bf8(gupT + chr * 128 + 32 * ks + 8 * fq); ag = __builtin_amdgcn_mfma_f32_16x16x32_bf16(A3, gdB[ks], ag, 0, 0, 0); }
        float* rp = rec + ((size_t)(bb * 4 + h) * SEQ + tpos) * 384;
        const int c0 = h * 64 + 16 * ct + 4 * fq, d0 = 16 * ct + 4 * fq;
        float r4[4], k4[4], v4[4]; rw_shift4(z, mu, m, tpos, c0, r4); rw_shift4(z, mu, m, tpos, 256 + c0, k4); rw_shift4(z, mu, m, tpos, 512 + c0, v4);
        const f32x4 w0 = *(const f32x4*)(w0p + c0), a0 = *(const f32x4*)(a0p + c0), k_k = *(const f32x4*)(kkp + c0), k_a = *(const f32x4*)(kap + c0), r_k = *(const f32x4*)(rkp + c0);
        f32x4 odw, okk, ob, okp;
#pragma unroll
        for (int i = 0; i < 4; ++i) {
            const float wl = w0[i] + aw[i]; const float nx = -wl; const float sp = fmaxf(nx, 0.f) + log1pf(__expf(-fabsf(nx)));
            const float wlog = -sp - 0.5f; odw[i] = __expf(-__expf(wlog));
            const float aval = sigmoidf_(a0[i] + aa[i]);
            const float kkn = k4[i] * k_k[i] * inv; okk[i] = kkn; ob[i] = kkn * aval;
            const float kpv = k4[i] * (1.0f + (aval - 1.0f) * k_a[i]); okp[i] = kpv;
            bs += r4[i] * kpv * r_k[i];
        }
        *(f32x4*)(rp + d0) = odw; *(f32x4*)(rp + 64 + d0) = okk; *(f32x4*)(rp + 128 + d0) = ob; *(f32x4*)(rp + 192 + d0) = okp;
        *(f32x4*)(rp + 256 + d0) = (f32x4){r4[0], r4[1], r4[2], r4[3]}; *(f32x4*)(rp + 320 + d0) = (f32x4){v4[0], v4[1], v4[2], v4[3]};
        *(f32x4*)(gbuf + (size_t)m * 256 + c0) = ag;
        if (ct == 3) { float b2 = bs; b2 += __shfl_xor(b2, 16); b2 += __shfl_xor(b2, 32); if (fq == 0) bonus[(size_t)m * 4 + h] = b2; }
    }
}

__device__ __forceinline__ void nsa_prep_item(const Args& a, LAS unsigned char* lds, int b, int tt) {
    unsigned char* ws = a.ws; const int tid = opaque_tid();
    const bf16* z = (const bf16*)(ws + WS_Z);
    const float* ct = (const float*)(ws + WS_ROPE); const float* st = ct + (size_t)MT * 8;
    const int mb = b * SEQ + tt * 64;
    for (int task = tid; task < 64 * 12; task += NTHR) {
        const int tok = task / 12, unit = task % 12, m = mb + tok;
        const bf16* src; bf16* dst;
        if (unit < 8) { src = z + (size_t)m * ZLD + ZC_Q + unit * 64; dst = (bf16*)(ws + WS_QROT) + (size_t)m * 512 + unit * 64; }
        else if (unit < 10) { src = z + (size_t)m * ZLD + ZC_KS + (unit - 8) * 64; dst = (bf16*)(ws + WS_KSR) + (size_t)m * 128 + (unit - 8) * 64; }
        else { src = z + (size_t)m * ZLD + ZC_KW + (unit - 10) * 64; dst = (bf16*)(ws + WS_KWR) + (size_t)m * 128 + (unit - 10) * 64; }
        u32x4 v[8];
#pragma unroll
        for (int i = 0; i < 8; ++i) v[i] = ((const u32x4*)src)[i];
        const f32x4 c0 = *(const f32x4*)(ct + (size_t)m * 8), c1 = *(const f32x4*)(ct + (size_t)m * 8 + 4), s0 = *(const f32x4*)(st + (size_t)m * 8), s1 = *(const f32x4*)(st + (size_t)m * 8 + 4);
        const float cc[8] = {c0.x, c0.y, c0.z, c0.w, c1.x, c1.y, c1.z, c1.w}, sn[8] = {s0.x, s0.y, s0.z, s0.w, s1.x, s1.y, s1.z, s1.w};
        const float x1[8] = {bflo(v[0].x), bfhi(v[0].x), bflo(v[0].y), bfhi(v[0].y), bflo(v[0].z), bfhi(v[0].z), bflo(v[0].w), bfhi(v[0].w)};
        const float x2[8] = {bflo(v[1].x), bfhi(v[1].x), bflo(v[1].y), bfhi(v[1].y), bflo(v[1].z), bfhi(v[1].z), bflo(v[1].w), bfhi(v[1].w)};
        float o1[8], o2[8];
#pragma unroll
        for (int i = 0; i < 8; ++i) { o1[i] = x1[i] * cc[i] - x2[i] * sn[i]; o2[i] = x1[i] * sn[i] + x2[i] * cc[i]; }
        v[0] = (u32x4){pk2(o1[0], o1[1]), pk2(o1[2], o1[3]), pk2(o1[4], o1[5]), pk2(o1[6], o1[7])};
        v[1] = (u32x4){pk2(o2[0], o2[1]), pk2(o2[2], o2[3]), pk2(o2[4], o2[5]), pk2(o2[6], o2[7])};
#pragma unroll
        for (int i = 0; i < 8; ++i) ((u32x4*)dst)[i] = v[i];
    }
    LAS bf16* tile = (LAS bf16*)lds;
    { const int tok = tid >> 3, ch = tid & 7;
#pragma unroll
      for (int mi = 0; mi < 4; ++mi) { const int col = (mi < 2 ? ZC_VS : ZC_VW) + (mi & 1) * 64;
          *(LAS u32x4*)(tile + mi * 4608 + tok * 72 + ch * 8) = *(const u32x4*)(z + (size_t)(mb + tok) * ZLD + col + ch * 8); } }
    __syncthreads();
    { const int d = tid >> 3, tc = tid & 7;
#pragma unroll
      for (int mi = 0; mi < 4; ++mi) { unsigned e[8];
#pragma unroll
          for (int j = 0; j < 8; ++j) e[j] = tile[mi * 4608 + (tc * 8 + j) * 72 + d];
          u32x4 w; w.x = e[0] | (e[1] << 16); w.y = e[2] | (e[3] << 16); w.z = e[4] | (e[5] << 16); w.w = e[6] | (e[7] << 16);
          bf16* dst = (bf16*)(ws + (mi < 2 ? WS_VST : WS_VWT)) + ((size_t)(b * 2 + (mi & 1)) * 64 + d) * SEQ + tt * 64 + tc * 8;
          *(u32x4*)dst = w; } }
    __syncthreads();
}

__device__ __forceinline__ void nsa_compress_item(const Args& a, int layer, LAS unsigned char* lds, int b, int g, int kv, int nt) {
    unsigned char* ws = a.ws; const int tid = opaque_tid(), lane = tid & 63, wave = __builtin_amdgcn_readfirstlane(tid >> 6), fq = lane >> 4, fr = lane & 15;
    const bf16* z = (const bf16*)(ws + WS_Z);
    const bf16* w1t = (const bf16*)(ws + WS_CW1) + (size_t)(layer * 2 + kv) * 128 * 2048;
    const int colb = (kv ? ZC_VC : ZC_KC) + g * 64;
    f32x4 acc[8];
#pragma unroll
    for (int ht = 0; ht < 8; ++ht) acc[ht] = (f32x4){0.f, 0.f, 0.f, 0.f};
    for (int li = 0; li < 4; ++li) { const int l = wave * 4 + li;
        int tok = 256 * nt + 16 * fr + l; tok = tok > SEQ - 1 ? SEQ - 1 : tok;
#pragma unroll
        for (int hf = 0; hf < 2; ++hf) {
            const bf16x8 B = ld_bf8(z + (size_t)(b * SEQ + tok) * ZLD + colb + 32 * hf + 8 * fq);
#pragma unroll
            for (int ht = 0; ht < 8; ++ht) { const bf16x8 A = ld_bf8(w1t + (size_t)(16 * ht + fr) * 2048 + 64 * l + 32 * hf + 8 * fq);
                acc[ht] = __builtin_amdgcn_mfma_f32_16x16x32_bf16(A, B, acc[ht], 0, 0, 0); } } }
    LAS float* part = (LAS float*)lds;
    LAS float* hid = (LAS float*)(lds + 65536);
#pragma unroll
    for (int ht = 0; ht < 8; ++ht)
#pragma unroll
        for (int r = 0; r < 4; ++r) part[(wave * 128 + 16 * ht + 4 * fq + r) * 16 + fr] = acc[ht][r];
    __syncthreads();
    { const int hh = tid >> 2, nq = tid & 3; f32x4 s = (f32x4){0.f, 0.f, 0.f, 0.f};
#pragma unroll
      for (int w = 0; w < 8; ++w) s = s + *(LAS f32x4*)(part + (w * 128 + hh) * 16 + 4 * nq);
      float cb = 0.f; { const float* cbp = (const float*)(ws + WS_CBIAS) + (size_t)(layer * 2 + kv) * 16 * 128 + hh;
#pragma unroll
        for (int c = 0; c < 16; ++c) cb += cbp[c * 128]; }
      f32x4 o; o.x = gelu_tanh(s.x + cb); o.y = gelu_tanh(s.y + cb); o.z = gelu_tanh(s.z + cb); o.w = gelu_tanh(s.w + cb);
      *(LAS f32x4*)(hid + hh * 16 + 4 * nq) = o; }
    __syncthreads();
    { const float* W2 = INF(kv ? IN_VCW2 : IN_KCW2) + (size_t)layer * 128 * 64; const int n = tid & 15, dg = tid >> 4; float o0 = 0.f, o1 = 0.f;
      for (int hh = 0; hh < 128; ++hh) { const float x = hid[hh * 16 + n]; o0 += x * W2[hh * 64 + dg]; o1 += x * W2[hh * 64 + dg + 32]; }
      const int ng = 16 * nt + n; if (ng >= NCMP) { o0 = 0.f; o1 = 0.f; }
      if (kv == 0) { bf16* kc = (bf16*)(ws + WS_KCMP) + ((size_t)(b * 2 + g) * 256 + ng) * 64; kc[dg] = (bf16)f2bf(o0); kc[dg + 32] = (bf16)f2bf(o1); }
      else { bf16* vc = (bf16*)(ws + WS_VCMPT) + (size_t)(b * 2 + g) * 64 * 256; vc[(size_t)dg * 256 + ng] = (bf16)f2bf(o0); vc[(size_t)(dg + 32) * 256 + ng] = (bf16)f2bf(o1); } }
    __syncthreads();
}

__device__ __forceinline__ void phase_prep(const Args& a, int layer, LAS unsigned char* lds) {
    const int tid = opaque_tid(), lane = tid & 63, wave = __builtin_amdgcn_readfirstlane(tid >> 6);
#ifndef NO_RWP
    if (wave < 4) for (int tile = blockIdx.x * 4 + wave; tile < MT / 16; tile += gridDim.x * 4) rwkv_prep_tile(a, layer, tile * 16, lane);
#endif
#ifndef NO_NSAP
    for (int it = blockIdx.x; it < NB * 64; it += gridDim.x) nsa_prep_item(a, lds, it >> 6, it & 63);
#endif
#ifndef NO_CMP
    for (int it = blockIdx.x; it < NB * 2 * 2 * 16; it += gridDim.x) nsa_compress_item(a, layer, lds, it >> 6, (it >> 5) & 1, (it >> 4) & 1, it & 15);
#endif
}

__device__ __forceinline__ float dpp_xor1(float x) { return __builtin_bit_cast(float, __builtin_amdgcn_update_dpp(0, __builtin_bit_cast(int, x), 0xB1, 0xf, 0xf, true)); }
__device__ __forceinline__ float dpp_xor2(float x) { return __builtin_bit_cast(float, __builtin_amdgcn_update_dpp(0, __builtin_bit_cast(int, x), 0x4E, 0xf, 0xf, true)); }
__device__ __forceinline__ float dpp_hmir(float x) { return __builtin_bit_cast(float, __builtin_amdgcn_update_dpp(0, __builtin_bit_cast(int, x), 0x141, 0xf, 0xf, true)); }
__device__ __forceinline__ float red8(float x) { x += dpp_xor1(x); x += dpp_xor2(x); x += dpp_hmir(x); return x; }

__device__ __forceinline__ void rwkv_scan_seg(const Args& a, LAS unsigned char* lds, int bh, int seg) {
    unsigned char* ws = a.ws; const int tid = opaque_tid(), lane = tid & 63, wave = __builtin_amdgcn_readfirstlane(tid >> 6);
    const int row = wave * 8 + (lane >> 3), kq = lane & 7;
    const f32x4* rec4 = (const f32x4*)(ws + WS_REC) + ((size_t)bh * SEQ + (size_t)seg * SEGLEN) * 96;
    const size_t yoff = ((size_t)(bh >> 2) * SEQ + (size_t)seg * SEGLEN) * 256 + (bh & 3) * 64 + row;
    float* yraw = (float*)(ws + WS_YRAW) + yoff; float* ypb = (float*)(ws + WS_YP) + yoff;
    LAS f32x4* buf = (LAS f32x4*)lds;
    float s[8], q[8];
#pragma unroll
    for (int j = 0; j < 8; ++j) { s[j] = 0.f; q[j] = (8 * kq + j == row) ? 1.f : 0.f; }
    __syncthreads();
    { f32x4 p0 = rec4[tid], p1 = rec4[tid + 512], p2 = rec4[tid + 1024]; buf[tid] = p0; buf[tid + 512] = p1; buf[tid + 1024] = p2; }
    __syncthreads();
    for (int c = 0; c < SEGLEN / 16; ++c) {
        const int p = c & 1;
        f32x4 n0, n1, n2; const bool more = (c + 1 < SEGLEN / 16);
        if (more) { const f32x4* src = rec4 + (size_t)(c + 1) * 1536; n0 = src[tid]; n1 = src[tid + 512]; n2 = src[tid + 1024]; }
        const LAS f32x4* bp = buf + p * 1536;
#pragma unroll 2
        for (int st = 0; st < 16; ++st) {
            const LAS f32x4* sp = bp + st * 96;
            const f32x4 w0 = sp[2 * kq], w1 = sp[2 * kq + 1], k0 = sp[16 + 2 * kq], k1 = sp[16 + 2 * kq + 1], b0 = sp[32 + 2 * kq], b1 = sp[32 + 2 * kq + 1];
            const f32x4 q0 = sp[48 + 2 * kq], q1 = sp[48 + 2 * kq + 1], r0 = sp[64 + 2 * kq], r1 = sp[64 + 2 * kq + 1];
            const float vv = ((const LAS float*)(sp + 80))[row];
            const float wv[8] = {w0.x, w0.y, w0.z, w0.w, w1.x, w1.y, w1.z, w1.w}, kk[8] = {k0.x, k0.y, k0.z, k0.w, k1.x, k1.y, k1.z, k1.w};
            const float bv[8] = {b0.x, b0.y, b0.z, b0.w, b1.x, b1.y, b1.z, b1.w}, kp[8] = {q0.x, q0.y, q0.z, q0.w, q1.x, q1.y, q1.z, q1.w};
            const float rr[8] = {r0.x, r0.y, r0.z, r0.w, r1.x, r1.y, r1.z, r1.w};
            float d1 = (s[0] * kk[0] + s[1] * kk[1]) + (s[2] * kk[2] + s[3] * kk[3]) + ((s[4] * kk[4] + s[5] * kk[5]) + (s[6] * kk[6] + s[7] * kk[7]));
            float e1 = (q[0] * kk[0] + q[1] * kk[1]) + (q[2] * kk[2] + q[3] * kk[3]) + ((q[4] * kk[4] + q[5] * kk[5]) + (q[6] * kk[6] + q[7] * kk[7]));
            d1 += dpp_xor1(d1); e1 += dpp_xor1(e1); d1 += dpp_xor2(d1); e1 += dpp_xor2(e1); d1 += dpp_hmir(d1); e1 += dpp_hmir(e1);
            const float sa = -d1, sq = -e1;
            float d2 = 0.f, e2 = 0.f;
#pragma unroll
            for (int j = 0; j < 8; ++j) { s[j] = s[j] * wv[j] + (sa * bv[j] + vv * kp[j]); d2 += s[j] * rr[j]; q[j] = q[j] * wv[j] + sq * bv[j]; e2 += q[j] * rr[j]; }
            d2 += dpp_xor1(d2); e2 += dpp_xor1(e2); d2 += dpp_xor2(d2); e2 += dpp_xor2(e2); d2 += dpp_hmir(d2); e2 += dpp_hmir(e2);
            if (kq == 0) { yraw[(size_t)(c * 16 + st) * 256] = d2; ypb[(size_t)(c * 16 + st) * 256] = e2; }
        }
        if (more) { LAS f32x4* dp = buf + (p ^ 1) * 1536; dp[tid] = n0; dp[tid + 512] = n1; dp[tid + 1024] = n2; }
        __syncthreads();
    }
    float* se = (float*)(ws + WS_SEGE) + ((size_t)(bh * NSEG + seg) * 2) * 4096 + row * 64 + 8 * kq;
    *(f32x4*)se = (f32x4){s[0], s[1], s[2], s[3]}; *(f32x4*)(se + 4) = (f32x4){s[4], s[5], s[6], s[7]};
    *(f32x4*)(se + 4096) = (f32x4){q[0], q[1], q[2], q[3]}; *(f32x4*)(se + 4096 + 4) = (f32x4){q[4], q[5], q[6], q[7]};
}

__device__ __forceinline__ void rwkv_chain(const Args& a, LAS unsigned char* lds, int bh) {
    unsigned char* ws = a.ws; const int tid = opaque_tid();
    LAS float* S = (LAS float*)lds;
    LAS float* P = S + 64 * 68;
    const int v = tid >> 3, kg = tid & 7;
    float* sst = (float*)(ws + WS_SST) + (size_t)bh * NSEG * 4096;
    const float* sege = (const float*)(ws + WS_SEGE) + (size_t)bh * NSEG * 2 * 4096;
    __syncthreads();
    for (int i = tid; i < 64 * 68; i += NTHR) S[i] = 0.f;
    for (int i = tid; i < 4096; i += NTHR) sst[i] = 0.f;
    __syncthreads();
    for (int sg = 1; sg < NSEG; ++sg) {
        const float* e0 = sege + (size_t)(sg - 1) * 2 * 4096;
        for (int i = tid; i < 1024; i += NTHR) *(LAS f32x4*)(P + 4 * i) = *(const f32x4*)(e0 + 4096 + 4 * i);
        f32x4 o0 = *(const f32x4*)(e0 + v * 64 + 8 * kg), o1 = *(const f32x4*)(e0 + v * 64 + 8 * kg + 4);
        __syncthreads();
#pragma unroll 4
        for (int i = 0; i < 64; ++i) { const float sv = S[v * 68 + i]; const f32x4 p0 = *(const LAS f32x4*)(P + i * 64 + 8 * kg), p1 = *(const LAS f32x4*)(P + i * 64 + 8 * kg + 4);
            o0 = o0 + p0 * sv; o1 = o1 + p1 * sv; }
        __syncthreads();
        *(LAS f32x4*)(S + v * 68 + 8 * kg) = o0; *(LAS f32x4*)(S + v * 68 + 8 * kg + 4) = o1;
        *(f32x4*)(sst + (size_t)sg * 4096 + v * 64 + 8 * kg) = o0; *(f32x4*)(sst + (size_t)sg * 4096 + v * 64 + 8 * kg + 4) = o1;
        __syncthreads();
    }
}

__device__ __forceinline__ void rwkv_post_item(const Args& a, int layer, LAS unsigned char* lds, int bh, int tile) {
    unsigned char* ws = a.ws; const int tid = opaque_tid();
    const int seg = tile / (SEGLEN / 64), bb = bh >> 2, h = bh & 3;
    LAS float* S = (LAS float*)lds;
    LAS float* YP = S + 64 * 68;
    const float* sst = (const float*)(ws + WS_SST) + (size_t)(bh * NSEG + seg) * 4096;
    const size_t m0 = (size_t)bb * SEQ + (size_t)tile * 64;
    __syncthreads();
    for (int i = tid; i < 1024; i += NTHR) { const int r = i >> 4, c4 = i & 15; *(LAS f32x4*)(S + r * 68 + 4 * c4) = *(const f32x4*)(sst + r * 64 + 4 * c4);
        *(LAS f32x4*)(YP + r * 68 + 4 * c4) = *(const f32x4*)((const float*)(ws + WS_YP) + (m0 + r) * 256 + h * 64 + 4 * c4); }
    __syncthreads();
    const int tok = tid >> 3, vg = tid & 7; const size_t m = m0 + tok; const int c0 = h * 64 + 8 * vg;
    const f32x4 ya = *(const f32x4*)((const float*)(ws + WS_YRAW) + m * 256 + c0), yb = *(const f32x4*)((const float*)(ws + WS_YRAW) + m * 256 + c0 + 4);
    float y[8] = {ya.x, ya.y, ya.z, ya.w, yb.x, yb.y, yb.z, yb.w};
    if (seg > 0) {
#pragma unroll 4
        for (int i = 0; i < 64; i += 4) { const f32x4 yp = *(const LAS f32x4*)(YP + tok * 68 + i);
#pragma unroll
            for (int j = 0; j < 8; ++j) { const f32x4 sr = *(const LAS f32x4*)(S + (8 * vg + j) * 68 + i); y[j] += (sr.x * yp.x + sr.y * yp.y) + (sr.z * yp.z + sr.w * yp.w); } }
    }
    float sm = 0.f;
#pragma unroll
    for (int j = 0; j < 8; ++j) sm += y[j];
    sm += __shfl_xor(sm, 1); sm += __shfl_xor(sm, 2); sm += __shfl_xor(sm, 4);
    const float mean = sm * (1.0f / 64.0f); float qq = 0.f;
#pragma unroll
    for (int j = 0; j < 8; ++j) { y[j] -= mean; qq += y[j] * y[j]; }
    qq += __shfl_xor(qq, 1); qq += __shfl_xor(qq, 2); qq += __shfl_xor(qq, 4);
    const float rstd = 1.0f / sqrtf(qq * (1.0f / 64.0f) + 64e-5f);
    const float* gng = INF(IN_RWGNG) + layer * 256 + c0; const float* gnb = INF(IN_RWGNB) + layer * 256 + c0;
    const float* gt = (const float*)(ws + WS_G) + m * 256 + c0;
    const float* vv = (const float*)(ws + WS_REC) + ((size_t)bh * SEQ + (size_t)tile * 64 + tok) * 384 + 320 + 8 * vg;
    const float bo = ((const float*)(ws + WS_BONUS))[m * 4 + h];
    float o[8];
#pragma unroll
    for (int j = 0; j < 8; ++j) o[j] = (y[j] * rstd * gng[j] + gnb[j] + vv[j] * bo) * gt[j];
    u32x4 w; w.x = pk2(o[0], o[1]); w.y = pk2(o[2], o[3]); w.z = pk2(o[4], o[5]); w.w = pk2(o[6], o[7]);
    *(u32x4*)((bf16*)(ws + WS_YCAT) + m * DM + 256 + c0) = w;
}

__device__ __forceinline__ void gmlp_item(const Args& a, int layer, LAS unsigned char* lds, int b, int n, int h) {
    unsigned char* ws = a.ws; const int tid = opaque_tid(), lane = tid & 63, wave = __builtin_amdgcn_readfirstlane(tid >> 6), fq = lane >> 4, fr = lane & 15;
    const bf16* z = (const bf16*)(ws + WS_Z); bf16* ycat = (bf16*)(ws + WS_YCAT);
    LAS bf16* vt = (LAS bf16*)lds;
    const int mb = b * SEQ + n * 128;
    { const int s = tid >> 2, part = tid & 3; const bf16* src = z + (size_t)(mb + s) * ZLD + ZC_V + h * 64 + part * 16;
      const u32x4 v0 = ((const u32x4*)src)[0], v1 = ((const u32x4*)src)[1];
      float x[16] = {bflo(v0.x), bfhi(v0.x), bflo(v0.y), bfhi(v0.y), bflo(v0.z), bfhi(v0.z), bflo(v0.w), bfhi(v0.w), bflo(v1.x), bfhi(v1.x), bflo(v1.y), bfhi(v1.y), bflo(v1.z), bfhi(v1.z), bflo(v1.w), bfhi(v1.w)};
      float sm = 0.f;
#pragma unroll
      for (int j = 0; j < 16; ++j) { x[j] = gelu_tanh(x[j]); sm += x[j]; }
      sm += __shfl_xor(sm, 1); sm += __shfl_xor(sm, 2);
      const float mean = sm * (1.0f / 64.0f); float q = 0.f;
#pragma unroll
      for (int j = 0; j < 16; ++j) { x[j] -= mean; q += x[j] * x[j]; }
      q += __shfl_xor(q, 1); q += __shfl_xor(q, 2);
      const float rstd = 1.0f / sqrtf(q * (1.0f / 64.0f) + 1e-5f);
      const float* lg = INF(IN_GMLNG) + (layer * 4 + h) * 64 + part * 16; const float* lb = INF(IN_GMLNB) + (layer * 4 + h) * 64 + part * 16;
#pragma unroll
      for (int j = 0; j < 16; ++j) vt[(part * 16 + j) * 136 + s] = (bf16)f2bf(x[j] * rstd * lg[j] + lb[j]); }
    __syncthreads();
    {
        const float* W = INF(IN_GMWS) + ((size_t)(layer * 4 + h) * 128 + 16 * wave + fr) * 128;
        f32x4 acc[4];
#pragma unroll
        for (int dt = 0; dt < 4; ++dt) acc[dt] = (f32x4){0.f, 0.f, 0.f, 0.f};
        const int trow = 16 * wave + fr; const int nks = (wave >> 1) + 1;
        for (int ks = 0; ks < nks; ++ks) {
            const int s0 = 32 * ks + 8 * fq; const f32x4 wa = *(const f32x4*)(W + s0), wb = *(const f32x4*)(W + s0 + 4);
            float wv[8] = {wa.x, wa.y, wa.z, wa.w, wb.x, wb.y, wb.z, wb.w};
#pragma unroll
            for (int j = 0; j < 8; ++j) wv[j] = (s0 + j <= trow) ? wv[j] : 0.f;
            const bf16x8 A = pack8(wv);
#pragma unroll
            for (int dt = 0; dt < 4; ++dt) { const bf16x8 B = *(const LAS bf16x8*)(vt + (16 * dt + fr) * 136 + s0); acc[dt] = __builtin_amdgcn_mfma_f32_16x16x32_bf16(A, B, acc[dt], 0, 0, 0); } }
        const float* bs = INF(IN_GMBS) + (layer * 4 + h) * 128;
#pragma unroll
        for (int r = 0; r < 4; ++r) { const int t = 16 * wave + 4 * fq + r; const float bias = bs[t];
#pragma unroll
            for (int dt = 0; dt < 4; ++dt) { const int d = 16 * dt + fr; const float u = gelu_tanh(bf2f(z[(size_t)(mb + t) * ZLD + ZC_U + h * 64 + d]));
                ycat[(size_t)(mb + t) * DM + h * 64 + d] = (bf16)f2bf(u * (acc[dt][r] + bias)); } }
    }
    __syncthreads();
}

constexpr int NSA_KB = 0, NSA_VB = 18432, NSA_IMP = 36864, NSA_SELM = 53248, NSA_UNI = 53760, NSA_OT = 54272;
struct NsaTileSrc { const bf16* kbase; int kld; const bf16* vbase; int vld; };

__device__ __forceinline__ void nsa_tile_load(const NsaTileSrc& S, int kb, int tid, u32x4& kr, u32x4& vr) {
    const int row = tid >> 3, ch = tid & 7;
    kr = *(const u32x4*)(S.kbase + (size_t)(kb * 64 + row) * S.kld + ch * 8);
    vr = *(const u32x4*)(S.vbase + (size_t)row * S.vld + kb * 64 + ch * 8);
}
__device__ __forceinline__ void nsa_tile_store(LAS unsigned char* lds, int p, int tid, const u32x4& kr, const u32x4& vr) {
    const int row = tid >> 3, ch = tid & 7;
    *(LAS u32x4*)(lds + NSA_KB + p * 9216 + (row * 72 + ch * 8) * 2) = kr;
    *(LAS u32x4*)(lds + NSA_VB + p * 9216 + (row * 72 + ch * 8) * 2) = vr;
}
__device__ __forceinline__ void nsa_scores(LAS unsigned char* lds, int p, const bf16x8 (&Q)[2][2], f32x4 (&sc)[4][2], int fq, int fr) {
#pragma unroll
    for (int kt = 0; kt < 4; ++kt) {
        const LAS unsigned char* kp = lds + NSA_KB + p * 9216 + ((16 * kt + fr) * 72 + 8 * fq) * 2;
        const bf16x8 K0 = *(const LAS bf16x8*)kp, K1 = *(const LAS bf16x8*)(kp + 64);
#pragma unroll
        for (int qg = 0; qg < 2; ++qg) { f32x4 c = (f32x4){0.f, 0.f, 0.f, 0.f};
            c = __builtin_amdgcn_mfma_f32_16x16x32_bf16(K0, Q[qg][0], c, 0, 0, 0); c = __builtin_amdgcn_mfma_f32_16x16x32_bf16(K1, Q[qg][1], c, 0, 0, 0); sc[kt][qg] = c; } }
}
template <int MODE>
__device__ __forceinline__ bool nsa_allowed(int kidx, int t, int kb, unsigned long long selm) {
    if (MODE == 0) return (16 * kidx + 31 <= t) && (kidx < NCMP);
    if (MODE == 1) return (kidx <= t) && ((selm >> kb) & 1ull);
    return (kidx <= t) && (kidx + 512 > t);
}
template <int MODE>
__device__ __forceinline__ void nsa_tile_compute(LAS unsigned char* lds, int p, int kb, const bf16x8 (&Q)[2][2], const int (&tq)[2], const unsigned long long (&selm)[2],
                                                 float (&m_run)[2], float (&l_run)[2], f32x4 (&O)[4][2], int fq, int fr) {
    f32x4 sc[4][2];
    nsa_scores(lds, p, Q, sc, fq, fr);
    const float SC = 0.125f * 1.4426950408889634f;
    bf16x8 P[2][2];
#pragma unroll
    for (int qg = 0; qg < 2; ++qg) {
        float mx = -1e30f;
#pragma unroll
        for (int kt = 0; kt < 4; ++kt)
#pragma unroll
            for (int r = 0; r < 4; ++r) { const int kidx = kb * 64 + 16 * kt + 4 * fq + r;
                const float v = nsa_allowed<MODE>(kidx, tq[qg], kb, selm[qg]) ? sc[kt][qg][r] * SC : -1e30f; sc[kt][qg][r] = v; mx = fmaxf(mx, v); }
        mx = fmaxf(mx, __shfl_xor(mx, 16)); mx = fmaxf(mx, __shfl_xor(mx, 32));
        const float mn = fmaxf(m_run[qg], mx); const float alpha = __builtin_amdgcn_exp2f(m_run[qg] - mn); m_run[qg] = mn;
        float ls = 0.f; float pv[4][4];
#pragma unroll
        for (int kt = 0; kt < 4; ++kt)
#pragma unroll
            for (int r = 0; r < 4; ++r) { const float sv = sc[kt][qg][r]; const float e = (sv > -1e29f) ? __builtin_amdgcn_exp2f(sv - mn) : 0.f; pv[kt][r] = e; ls += e; }
        l_run[qg] = l_run[qg] * alpha + ls;
#pragma unroll
        for (int dt = 0; dt < 4; ++dt) O[dt][qg] = O[dt][qg] * alpha;
#pragma unroll
        for (int s = 0; s < 2; ++s) { u32x4 w; w.x = pk2(pv[2 * s][0], pv[2 * s][1]); w.y = pk2(pv[2 * s][2], pv[2 * s][3]); w.z = pk2(pv[2 * s + 1][0], pv[2 * s + 1][1]); w.w = pk2(pv[2 * s + 1][2], pv[2 * s + 1][3]);
            P[qg][s] = __builtin_bit_cast(bf16x8, w); }
    }
#pragma unroll
    for (int dt = 0; dt < 4; ++dt)
#pragma unroll
        for (int s = 0; s < 2; ++s) {
            const LAS unsigned char* vp = lds + NSA_VB + p * 9216 + ((16 * dt + fr) * 72 + 32 * s + 4 * fq) * 2;
            const u32x2 a0 = *(const LAS u32x2*)vp, a1 = *(const LAS u32x2*)(vp + 32);
            const u32x4 aw = (u32x4){a0.x, a0.y, a1.x, a1.y}; const bf16x8 A = __builtin_bit_cast(bf16x8, aw);
#pragma unroll
            for (int qg = 0; qg < 2; ++qg) O[dt][qg] = __builtin_amdgcn_mfma_f32_16x16x32_bf16(A, P[qg][s], O[dt][qg], 0, 0, 0);
        }
}

template <int MODE>
__device__ __forceinline__ void nsa_branch(LAS unsigned char* lds, const NsaTileSrc& S, int kb_lo, int kb_hi, unsigned long long tilemask, const bf16x8 (&Q)[2][2], const int (&tq)[2],
                                           const unsigned long long (&selm)[2], const float (&gate)[2], const bool first, float (&m_out)[2], float (&l_out)[2], int tid, int fq, int fr) {
    float m_run[2] = {-1e30f, -1e30f}, l_run[2] = {0.f, 0.f}; f32x4 O[4][2];
#pragma unroll
    for (int dt = 0; dt < 4; ++dt)
#pragma unroll
        for (int qg = 0; qg < 2; ++qg) O[dt][qg] = (f32x4){0.f, 0.f, 0.f, 0.f};
    int cur = kb_lo; while (cur <= kb_hi && !((tilemask >> cur) & 1ull)) ++cur;
    if (cur <= kb_hi) {
        u32x4 kr, vr; nsa_tile_load(S, cur, tid, kr, vr); nsa_tile_store(lds, 0, tid, kr, vr);
        __syncthreads();
        int p = 0;
        while (cur <= kb_hi) {
            int nxt = cur + 1; while (nxt <= kb_hi && !((tilemask >> nxt) & 1ull)) ++nxt;
            if (nxt <= kb_hi) nsa_tile_load(S, nxt, tid, kr, vr);
            nsa_tile_compute<MODE>(lds, p, cur, Q, tq, selm, m_run, l_run, O, fq, fr);
            if (nxt <= kb_hi) nsa_tile_store(lds, p ^ 1, tid, kr, vr);
            __syncthreads();
            p ^= 1; cur = nxt;
        }
    }
#pragma unroll
    for (int qg = 0; qg < 2; ++qg) { float l = l_run[qg]; l += __shfl_xor(l, 16); l += __shfl_xor(l, 32); l_out[qg] = l; m_out[qg] = m_run[qg];
        const float sc = l > 0.f ? gate[qg] / l : 0.f;
        LAS float* ot = (LAS float*)(lds + NSA_OT) + tid;
#pragma unroll
        for (int dt = 0; dt < 4; ++dt)
#pragma unroll
            for (int r = 0; r < 4; ++r) { LAS float* pp = ot + ((dt * 2 + qg) * 4 + r) * 512; const float v = O[dt][qg][r] * sc; *pp = first ? v : (*pp + v); } }
}

__device__ __forceinline__ void nsa_item(const Args& a, LAS unsigned char* lds, int b, int g, int T) {
    unsigned char* ws = a.ws; const int tid = opaque_tid(), lane = tid & 63, wave = __builtin_amdgcn_readfirstlane(tid >> 6), fq = lane >> 4, fr = lane & 15;
    const bf16* z = (const bf16*)(ws + WS_Z);
    const int head = g * 4 + (fr & 3);
    int tq[2], mq[2]; bf16x8 Qraw[2][2]; float gt[2][3];
#pragma unroll
    for (int qg = 0; qg < 2; ++qg) { const int tl = 8 * wave + 4 * qg + (fr >> 2); tq[qg] = T * 64 + tl; mq[qg] = b * SEQ + tq[qg];
#pragma unroll
        for (int ks = 0; ks < 2; ++ks) Qraw[qg][ks] = ld_bf8(z + (size_t)mq[qg] * ZLD + ZC_Q + head * 64 + 32 * ks + 8 * fq);
#pragma unroll
        for (int br = 0; br < 3; ++br) gt[qg][br] = sigmoidf_(bf2f(z[(size_t)mq[qg] * ZLD + ZC_GT + head * 3 + br])); }
    if (tid < 64) { ((LAS unsigned long long*)(lds + NSA_SELM))[tid] = 0ull; if (tid < 2) ((LAS unsigned*)(lds + NSA_UNI))[tid] = 0u; }
    const unsigned long long nosel[2] = {0ull, 0ull};
    NsaTileSrc SC_; SC_.kbase = (const bf16*)(ws + WS_KCMP) + (size_t)(b * 2 + g) * 256 * 64; SC_.kld = 64; SC_.vbase = (const bf16*)(ws + WS_VCMPT) + (size_t)(b * 2 + g) * 64 * 256; SC_.vld = 256;
    float mc[2], lc[2];
    { float gc[2] = {gt[0][0], gt[1][0]};
      nsa_branch<0>(lds, SC_, 0, 3, ~0ull, Qraw, tq, nosel, gc, true, mc, lc, tid, fq, fr); }
    {
        LAS float* imp = (LAS float*)(lds + NSA_IMP);
        float carry[2] = {0.f, 0.f}; const float SCL = 0.125f * 1.4426950408889634f;
        float invl[2] = {lc[0] > 0.f ? 1.0f / lc[0] : 0.f, lc[1] > 0.f ? 1.0f / lc[1] : 0.f};
        for (int kb = 0; kb < 4; ++kb) {
            { const int row = tid >> 3, ch = tid & 7; *(LAS u32x4*)(lds + NSA_KB + (row * 72 + ch * 8) * 2) = *(const u32x4*)(SC_.kbase + (size_t)(kb * 64 + row) * 64 + ch * 8); }
            __syncthreads();
            f32x4 sc[4][2]; nsa_scores(lds, 0, Qraw, sc, fq, fr);
#pragma unroll
            for (int kt = 0; kt < 4; ++kt)
#pragma unroll
                for (int qg = 0; qg < 2; ++qg) { float pn[4];
#pragma unroll
                    for (int r = 0; r < 4; ++r) { const int kidx = kb * 64 + 16 * kt + 4 * fq + r; const bool al = nsa_allowed<0>(kidx, tq[qg], kb, 0ull);
                        pn[r] = al ? __builtin_amdgcn_exp2f(sc[kt][qg][r] * SCL - mc[qg]) * invl[qg] : 0.f; }
                    const float y = __shfl(pn[3], (lane + 48) & 63);
                    float v = (pn[0] + pn[1]) + (pn[2] + pn[3]) + (fq == 0 ? carry[qg] : y); carry[qg] = y;
                    v += __shfl_xor(v, 1); v += __shfl_xor(v, 2);
                    if ((fr & 3) == 0) imp[(8 * wave + 4 * qg + (fr >> 2)) * 64 + 16 * kb + 4 * kt + fq] = v; }
            __syncthreads();
        }
    }
    {
        const LAS float* imp = (const LAS float*)(lds + NSA_IMP);
        const int tl = tid >> 3, part = tid & 7; float vm[8]; int cnt[8];
        { const f32x4 x0 = *(const LAS f32x4*)(imp + tl * 64 + part * 8), x1 = *(const LAS f32x4*)(imp + tl * 64 + part * 8 + 4);
          const float xx[8] = {x0.x, x0.y, x0.z, x0.w, x1.x, x1.y, x1.z, x1.w};
#pragma unroll
          for (int j = 0; j < 8; ++j) { const int mi = part * 8 + j; const bool valid = mi <= T; const bool forced = (mi == 0) || (mi == T) || (mi == T - 1);
              vm[j] = valid ? xx[j] + (forced ? 1e4f : 0.f) : -1e4f; cnt[j] = 0; } }
        for (int q4 = 0; q4 < 16; ++q4) { const f32x4 x = *(const LAS f32x4*)(imp + tl * 64 + 4 * q4); const float xq[4] = {x.x, x.y, x.z, x.w};
#pragma unroll
            for (int i = 0; i < 4; ++i) { const int q = 4 * q4 + i; const bool valid = q <= T; const bool forced = (q == 0) || (q == T) || (q == T - 1);
                const float vq = valid ? xq[i] + (forced ? 1e4f : 0.f) : -1e4f;
#pragma unroll
                for (int j = 0; j < 8; ++j) { const int mi = part * 8 + j; cnt[j] += (vq > vm[j] || (vq == vm[j] && q < mi)) ? 1 : 0; } } }
        unsigned bits = 0u;
#pragma unroll
        for (int j = 0; j < 8; ++j) if (cnt[j] < 16 && vm[j] > -5000.f) bits |= 1u << j;
        atomicOr((unsigned*)(lds + NSA_SELM) + tl * 2 + (part >> 2), bits << (8 * (part & 3)));
        atomicOr((unsigned*)(lds + NSA_UNI) + (part >> 2), bits << (8 * (part & 3)));
    }
    __syncthreads();
    bf16x8 Qrot[2][2];
#pragma unroll
    for (int qg = 0; qg < 2; ++qg)
#pragma unroll
        for (int ks = 0; ks < 2; ++ks) Qrot[qg][ks] = ld_bf8((const bf16*)(ws + WS_QROT) + (size_t)mq[qg] * 512 + head * 64 + 32 * ks + 8 * fq);
    unsigned long long selm[2], uni;
    { const LAS unsigned long long* sm = (const LAS unsigned long long*)(lds + NSA_SELM); selm[0] = sm[8 * wave + (fr >> 2)]; selm[1] = sm[8 * wave + 4 + (fr >> 2)]; const LAS unsigned* up = (const LAS unsigned*)(lds + NSA_UNI); uni = ((unsigned long long)(unsigned)__builtin_amdgcn_readfirstlane(up[1]) << 32) | (unsigned)__builtin_amdgcn_readfirstlane(up[0]); }
    { NsaTileSrc SS; SS.kbase = (const bf16*)(ws + WS_KSR) + (size_t)b * SEQ * 128 + g * 64; SS.kld = 128; SS.vbase = (const bf16*)(ws + WS_VST) + (size_t)(b * 2 + g) * 64 * SEQ; SS.vld = SEQ;
      float gs[2] = {gt[0][1], gt[1][1]}, mo[2], lo[2];
      nsa_branch<1>(lds, SS, 0, T, uni, Qrot, tq, selm, gs, false, mo, lo, tid, fq, fr); }
    { NsaTileSrc SW; SW.kbase = (const bf16*)(ws + WS_KWR) + (size_t)b * SEQ * 128 + g * 64; SW.kld = 128; SW.vbase = (const bf16*)(ws + WS_VWT) + (size_t)(b * 2 + g) * 64 * SEQ; SW.vld = SEQ;
      float gw_[2] = {gt[0][2], gt[1][2]}, mo[2], lo[2]; const int lo_kb = T >= 8 ? T - 8 : 0;
      nsa_branch<2>(lds, SW, lo_kb, T, ~0ull, Qrot, tq, nosel, gw_, false, mo, lo, tid, fq, fr); }
    bf16* ycat = (bf16*)(ws + WS_YCAT);
#pragma unroll
    for (int qg = 0; qg < 2; ++qg)
#pragma unroll
        for (int dt = 0; dt < 4; ++dt) { const LAS float* ot = (const LAS float*)(lds + NSA_OT) + tid + ((dt * 2 + qg) * 4) * 512;
            u32x2 w; w.x = pk2(ot[0], ot[512]); w.y = pk2(ot[1024], ot[1536]);
            *(u32x2*)(ycat + (size_t)mq[qg] * DM + 512 + head * 64 + 16 * dt + 4 * fq) = w; }
}

struct MoeOrder {
    const char* A; const char* W; size_t estride; int K, nct, G, c; int tst[9];
    __device__ bool next(int i, pg8::Unit& u) const {
        const long L = (long)i * G + c; if (L >= (long)tst[8] * nct) return false;
        const int rt = (int)(L / nct), ct = (int)(L % nct); int e = 0;
#pragma unroll
        for (int j = 1; j < 8; ++j) e += (rt >= tst[j]) ? 1 : 0;
        u.pm = rt; u.pn = ct; u.aux = e; return true;
    }
    __device__ __forceinline__ const char* abase(const pg8::Unit& u) const { return A + (size_t)u.pm * ((size_t)256 * K * 2); }
    __device__ __forceinline__ const char* bbase(const pg8::Unit& u) const { return W + (size_t)u.aux * estride + (size_t)u.pn * ((size_t)256 * K * 2); }
};
__device__ __forceinline__ void moe_order_init(MoeOrder& S, const Args& a, int rank, const void* A, const void* W, size_t estride, int K, int nct) {
    S.A = (const char*)A; S.W = (const char*)W; S.estride = estride; S.K = K; S.nct = nct; S.G = gridDim.x; S.c = blockIdx.x;
    const int* t = (const int*)(a.ws + WS_SLOT + SL_TST) + rank * 16;
#pragma unroll
    for (int j = 0; j < 9; ++j) S.tst[j] = __builtin_amdgcn_readfirstlane(t[j]);
}
__device__ __forceinline__ void moe_gather(const Args& a, int rb, int r) {
    unsigned char* ws = a.ws; const int tid = opaque_tid();
    const int* toks = (const int*)(ws + WS_SLOT + SL_TOKS);
    const u32x4* hn = (const u32x4*)(ws + WS_HN); u32x4* hns = (u32x4*)(ws + WS_HNS);
    for (int i = tid; i < 64 * 128; i += NTHR) { const int tl = i >> 7, ch = i & 127, m = rb * 64 + tl; const int slot = toks[2 * m + r];
        hns[(size_t)slot * 128 + ch] = hn[(size_t)m * 128 + ch]; }
}
__device__ __forceinline__ void phase_moe_assign(const Args& a, LAS unsigned char* lds) {
    unsigned char* ws = a.ws; const int tid = opaque_tid(), lane = tid & 63, wave = __builtin_amdgcn_readfirstlane(tid >> 6);
    LAS int* cn = (LAS int*)lds;
    LAS int* tot = cn + 4096; LAS int* base = tot + 16; LAS int* pre = base + 16;
    const int* bcnt = (const int*)(ws + WS_SLOT + SL_BCNT);
    for (int i = tid; i < 4096; i += NTHR) cn[i] = bcnt[i];
    __syncthreads();
    if (tid < 16) { int s = 0; for (int bb = 0; bb < 256; ++bb) s += cn[bb * 16 + tid]; tot[tid] = s; }
    __syncthreads();
    if (tid < 2) { int run = 0; int* tstg = (int*)(ws + WS_SLOT + SL_TST) + tid * 16;
        for (int e = 0; e < 8; ++e) { base[tid * 8 + e] = run * 256; if (blockIdx.x == 0) tstg[e] = run; run += (tot[tid * 8 + e] + 255) >> 8; }
        if (blockIdx.x == 0) tstg[8] = run; }
    __syncthreads();
    int* stok = (int*)(ws + WS_SLOT + SL_TOK); float* sgate = (float*)(ws + WS_SLOT + SL_GATE);
    if (blockIdx.x == 0) {
        for (int grp = 0; grp < 16; ++grp) { const int r = grp >> 3, lo = base[grp] + tot[grp], hi = base[grp] + (((tot[grp] + 255) >> 8) << 8);
            for (int s = lo + tid; s < hi; s += NTHR) { stok[r * MOE_SLOTS + s] = -1; sgate[r * MOE_SLOTS + s] = 0.f; } }
    }
    const int* te = (const int*)(ws + WS_SLOT + SL_TOKE); const float* tg = (const float*)(ws + WS_SLOT + SL_TOKG); int* toks = (int*)(ws + WS_SLOT + SL_TOKS);
    for (int rb = blockIdx.x; rb < MT / 64; rb += gridDim.x) {
        __syncthreads();
        if (tid < 16) { int s = 0; for (int bb = 0; bb < rb; ++bb) s += cn[bb * 16 + tid]; pre[tid] = s; }
        __syncthreads();
        if (wave == 0) { const int m = rb * 64 + lane;
#pragma unroll
            for (int r = 0; r < 2; ++r) { const int e = te[2 * m + r]; int slot = 0;
#pragma unroll
                for (int ee = 0; ee < 8; ++ee) { const unsigned long long mk = __ballot(e == ee); const int rk = __popcll(mk & ((1ull << lane) - 1ull)); if (e == ee) slot = base[r * 8 + ee] + pre[r * 8 + ee] + rk; }
                stok[r * MOE_SLOTS + slot] = m; sgate[r * MOE_SLOTS + slot] = tg[2 * m + r]; toks[2 * m + r] = slot; } }
        asm volatile("s_waitcnt vmcnt(0)" ::: "memory");
        __syncthreads();
        moe_gather(a, rb, 0);
    }
}
__device__ __forceinline__ void moe_convert_weights(const Args& a, LAS unsigned char* lds) {
    const int tid = opaque_tid(), lane = tid & 63, wave = __builtin_amdgcn_readfirstlane(tid >> 6);
    const int gw = blockIdx.x * NWAVES + wave, NGW = gridDim.x * NWAVES; LAS float* scr = (LAS float*)(lds + 1024 + wave * 16384);
    for (int e = 0; e < NEXP; ++e) {
        conv_matrix(INF(IN_MW1) + (size_t)e * DM * DFF, DM, DFF, (bf16*)(a.ws + WS_MW13) + (size_t)e * 5632 * DM, 1, gw, NGW, scr, lane);
        conv_matrix(INF(IN_MW3) + (size_t)e * DM * DFF, DM, DFF, (bf16*)(a.ws + WS_MW13) + (size_t)e * 5632 * DM, 2, gw, NGW, scr, lane);
        conv_matrix(INF(IN_MW2) + (size_t)e * DFF * DM, DFF, DM, (bf16*)(a.ws + WS_MW2) + (size_t)e * DM * DFF, 0, gw, NGW, scr, lane);
    }
}

constexpr int NPL = 15, NPHASES = 1 + 2 * NPL;
__host__ __device__ constexpr bool phase_empty(int k) { return k >= 1 && k < 1 + NPL && ((k - 1) >= 9 && (k - 1) <= 11); }

__global__ void __launch_bounds__(NTHR, 2) hybrid_fwd(Args a) {
    extern __shared__ __attribute__((aligned(16))) unsigned char lds_raw[];
    LAS unsigned char* lds = (LAS unsigned char*)lds_raw;
    volatile LAS unsigned* MISC = (volatile LAS unsigned*)(lds + MISC_OFF);
    const int tid = opaque_tid();
    unsigned char* ws = a.ws; unsigned* ctl = (unsigned*)(ws + WS_CTL);
    for (int u = tid; u < (LDS_BYTES - MISC_OFF) / 4; u += NTHR) MISC[u] = 0u;
    __syncthreads();
    if (tid < N_INPUTS) *(LAS unsigned long long*)(lds + PTAB_OFF + 8 * tid) = (unsigned long long)a.in[tid];
    __syncthreads();
    const int lo = a.ph_lo, hi = a.ph_hi;
    const bool multi = (hi - lo) > 1;
    XcdBarrier bar; bar.bar = ctl + CW_BAR; bar.x = 0; bar.st = nullptr;
    if (multi) bar = xcd_barrier_post(ctl + CW_BAR, MISC + 8);
#ifndef PHSEL
#define PHSEL -1
#endif
#ifndef REP_GIN
#define REP_GIN 1
#endif
#ifndef REP_PREP
#define REP_PREP 1
#endif
#ifndef REP_NSA
#define REP_NSA 1
#endif
#ifndef REP_SCAN
#define REP_SCAN 1
#endif
#ifndef REP_GMLP
#define REP_GMLP 1
#endif
#ifndef REP_F1
#define REP_F1 1
#endif
#ifndef REP_PRO
#define REP_PRO 1
#endif
#define IN(k) (lo <= (k) && (k) < hi)
#define INL(j) ((PHSEL == -1 || PHSEL == (j)) && IN(pb + (j)))
#define SEAM(k) do { if ((k) + 1 < hi) xcd_barrier(bar); } while (0)
    const int G = gridDim.x, bx = blockIdx.x;

    if ((PHSEL == -1 || PHSEL == 100) && IN(0)) { for (int rep = 0; rep < REP_PRO; ++rep) { phase_prologue(a, lds); __syncthreads(); } SEAM(0); }

    for (int l = 0; l < 2; ++l) {
        const int pb = 1 + l * NPL;
        if (INL(0)) for (int rep = 0; rep < REP_GIN; ++rep) { pg8::StaticOrder S; S.init(ws + WS_HN, (bf16*)(ws + WS_WIN) + (size_t)l * ZLD * DM, MT, ZLD, DM, G, bx);
            pg8::EpiBf16Store E{(bf16*)(ws + WS_Z), ZLD}; pg8::gemm_phase(lds, DM, S, E); if (rep == REP_GIN - 1) SEAM(pb + 0); }
        if (INL(1)) { for (int rep = 0; rep < REP_PREP; ++rep) phase_prep(a, l, lds); SEAM(pb + 1); }
        if (INL(2)) {
#ifndef NO_SCAN
            for (int rep = 0; rep < REP_SCAN; ++rep) for (int it = bx; it < 16 * NSEG; it += G) rwkv_scan_seg(a, lds, it & 15, it >> 4);
#endif
            unsigned* qn = ctl + CW_Q + 64 * (l * 2);
#ifndef NO_NSA
            for (;;) { __syncthreads(); if (tid == 0) MISC[16] = __hip_atomic_fetch_add(qn, 1u, __ATOMIC_RELAXED, __HIP_MEMORY_SCOPE_AGENT); __syncthreads();
                int it = (int)MISC[16]; if (it >= 512 * REP_NSA) break; it &= 511; nsa_item(a, lds, (it & 7) >> 1, it & 1, 63 - (it >> 3)); }
#endif
            SEAM(pb + 2); }
        if (INL(3)) {
            for (int bh = bx; bh < 16; bh += G) rwkv_chain(a, lds, bh);
            unsigned* qg = ctl + CW_Q + 64 * (l * 2 + 1);
#ifndef NO_GMLP
            for (;;) { __syncthreads(); if (tid == 0) MISC[16] = __hip_atomic_fetch_add(qg, 1u, __ATOMIC_RELAXED, __HIP_MEMORY_SCOPE_AGENT); __syncthreads();
                int it = (int)MISC[16]; if (it >= 512 * REP_GMLP) break; it &= 511; gmlp_item(a, l, lds, it >> 7, (it >> 2) & 31, it & 3); }
#endif
            SEAM(pb + 3); }
        if (INL(4)) { for (int it = bx; it < 16 * 64; it += G) rwkv_post_item(a, l, lds, it & 15, it >> 4); SEAM(pb + 4); }
        if (INL(5)) { pg8::StaticOrder S; S.init(ws + WS_YCAT, (bf16*)(ws + WS_WOUT) + (size_t)l * DM * DM, MT, DM, DM, G, bx);
            pg8::EpiResAdd E{a.out, DM}; pg8::gemm_phase(lds, DM, S, E); SEAM(pb + 5); }
        if (INL(6)) { if (l == 0) phase_norm<0>(a, lds, INF(IN_GFFN)); else { for (int rep = 0; rep < REP_PRO; ++rep) { moe_convert_weights(a, lds); __syncthreads(); } phase_norm<1>(a, lds, INF(IN_GFFN) + DM); } SEAM(pb + 6); }
        if (l == 0) {
            if (INL(7)) { for (int rep = 0; rep < REP_F1; ++rep) { pg8::StaticOrder S; S.init(ws + WS_HN, ws + WS_W13, MT, 2 * DFF, DM, G, bx); pg8::EpiSwiglu E{(bf16*)(ws + WS_ACT), DFF}; pg8::gemm_phase(lds, DM, S, E); } SEAM(pb + 7); }
            if (INL(8)) { pg8::StaticOrder S; S.init(ws + WS_ACT, ws + WS_W2, MT, DM, DFF, G, bx); pg8::EpiResAdd E{a.out, DM}; pg8::gemm_phase(lds, DFF, S, E); if (pb + 12 < hi) xcd_barrier(bar); }
        } else {
            if (INL(7)) { phase_moe_assign(a, lds); SEAM(pb + 7); }
            if (INL(8)) { for (int rep = 0; rep < REP_F1; ++rep) { MoeOrder S; moe_order_init(S, a, 0, ws + WS_HNS, ws + WS_MW13, (size_t)5632 * DM * 2, DM, 22); pg8::EpiSwiglu E{(bf16*)(ws + WS_ACTM), DFF}; pg8::gemm_phase(lds, DM, S, E); } SEAM(pb + 8); }
            if (INL(9)) { for (int rb = bx; rb < MT / 64; rb += G) moe_gather(a, rb, 1);
                MoeOrder S; moe_order_init(S, a, 0, ws + WS_ACTM, ws + WS_MW2, (size_t)DM * DFF * 2, DFF, 4);
                pg8::EpiMoe2 E{a.out, (const int*)(ws + WS_SLOT + SL_TOK), (const float*)(ws + WS_SLOT + SL_GATE), DM}; pg8::gemm_phase(lds, DFF, S, E); SEAM(pb + 9); }
            if (INL(10)) { MoeOrder S; moe_order_init(S, a, 1, ws + WS_HNS, ws + WS_MW13, (size_t)5632 * DM * 2, DM, 22); pg8::EpiSwiglu E{(bf16*)(ws + WS_ACTM), DFF}; pg8::gemm_phase(lds, DM, S, E); SEAM(pb + 10); }
            if (INL(11)) { MoeOrder S; moe_order_init(S, a, 1, ws + WS_ACTM, ws + WS_MW2, (size_t)DM * DFF * 2, DFF, 4);
                pg8::EpiMoe2 E{a.out, (const int*)(ws + WS_SLOT + SL_TOK) + MOE_SLOTS, (const float*)(ws + WS_SLOT + SL_GATE) + MOE_SLOTS, DM}; pg8::gemm_phase(lds, DFF, S, E); SEAM(pb + 11); }
        }
        if (INL(12)) { phase_norm<0>(a, lds, INF(IN_GPLE) + l * DM); SEAM(pb + 12); }
        if (INL(13)) {
            { pg8::StaticOrder S; S.init((bf16*)(ws + WS_PB) + (size_t)l * MT * 256, (bf16*)(ws + WS_WP) + (size_t)l * DM * 256, MT, DM, 256, G, bx); pg8::EpiBf16Store E{(bf16*)(ws + WS_PP), DM}; pg8::gemm_phase(lds, 256, S, E); }
            { pg8::StaticOrder S; S.init(ws + WS_HN, (bf16*)(ws + WS_WG) + (size_t)l * DM * DM, MT, DM, DM, G, bx); pg8::EpiPle E{a.out, (const bf16*)(ws + WS_PP), DM}; pg8::gemm_phase(lds, DM, S, E); }
            SEAM(pb + 13); }
        if (INL(14)) { if (l == 0) { phase_norm<0>(a, lds, INF(IN_GMIX) + DM); SEAM(pb + 14); } else phase_norm<2>(a, lds, INF(IN_GFINAL)); }
    }
#undef IN
#undef INL
#undef SEAM
}

extern "C" void kernel_launch(void* const* d_in, const int* in_sizes, int n_in, void* d_out, int out_size, void* d_ws, size_t ws_size, hipStream_t stream) {
    static int grid = 0;
    if (grid == 0) {
        if (n_in != N_INPUTS || out_size != MT * DM || ws_size < WS_END) { fprintf(stderr, "kernel_launch: unexpected shapes (n_in %d, out %d, ws %zu)\n", n_in, out_size, ws_size); grid = -1; return; }
        int dev = 0, cus = 0, per_cu = 0;
        if (hipGetDevice(&dev) != hipSuccess || hipDeviceGetAttribute(&cus, hipDeviceAttributeMultiprocessorCount, dev) != hipSuccess) { grid = -1; return; }
        if (hipFuncSetAttribute((const void*)hybrid_fwd, hipFuncAttributeMaxDynamicSharedMemorySize, LDS_BYTES) != hipSuccess) { fprintf(stderr, "kernel_launch: hipFuncSetAttribute failed\n"); grid = -1; return; }
        if (hipOccupancyMaxActiveBlocksPerMultiprocessor(&per_cu, (const void*)hybrid_fwd, NTHR, LDS_BYTES) != hipSuccess || per_cu < 1) fprintf(stderr, "kernel_launch: occupancy query reports %d\n", per_cu);
        (void)hipGetLastError();
        grid = cus;
    }
    if (grid < 0) return;
    (void)hipMemsetAsync((char*)d_ws + WS_CTL, 0, CTL_ZERO_BYTES, stream);
    Args a{};
    for (int i = 0; i < N_INPUTS; ++i) a.in[i] = d_in[i];
    a.out = (float*)d_out; a.ws = (unsigned char*)d_ws;
#if MK_ONE_LAUNCH
    a.ph_lo = 0; a.ph_hi = NPHASES;
    hipLaunchKernelGGL(hybrid_fwd, dim3(grid), dim3(NTHR), LDS_BYTES, stream, a);
#else
    for (int k = 0; k < NPHASES; ++k) { if (phase_empty(k)) continue; a.ph_lo = k; a.ph_hi = k + 1;
        hipLaunchKernelGGL(hybrid_fwd, dim3(grid), dim3(NTHR), LDS_BYTES, stream, a); }
#endif
}
```

```cpp
#include <hip/hip_runtime.h>
#include <cstdio>
#include <cstdint>

#ifndef MK_ONE_LAUNCH
#define MK_ONE_LAUNCH 1
#endif

#define LAS __attribute__((address_space(3)))
#define GAS __attribute__((address_space(1)))
typedef unsigned short bf16;
typedef short bf16x8 __attribute__((ext_vector_type(8)));
typedef float f32x4 __attribute__((ext_vector_type(4)));
typedef float f32x2 __attribute__((ext_vector_type(2)));
typedef unsigned u32x4 __attribute__((ext_vector_type(4)));
typedef unsigned u32x2 __attribute__((ext_vector_type(2)));

constexpr int NB = 4, SEQ = 4096, DM = 1024, MT = NB * SEQ;
constexpr int DIN = 2840, ZLD = 3072;
constexpr int DFF = 2816, NEXP = 8;
constexpr int ZC_U = 0, ZC_V = 256, ZC_B = 512, ZC_Q = 1536, ZC_KC = 2048, ZC_VC = 2176, ZC_KS = 2304, ZC_VS = 2432, ZC_KW = 2560, ZC_VW = 2688, ZC_GT = 2816;
constexpr int NCMP = 255;
constexpr int NWAVES = 8, NTHR = 512;

__device__ __forceinline__ unsigned f2bf(float f) { unsigned u = __builtin_bit_cast(unsigned, f); return (u + 0x7fffu + ((u >> 16) & 1u)) >> 16; }
__device__ __forceinline__ float bf2f(unsigned b) { return __builtin_bit_cast(float, b << 16); }
__device__ __forceinline__ unsigned pk2(float lo, float hi) { return f2bf(lo) | (f2bf(hi) << 16); }
__device__ __forceinline__ float bflo(unsigned w) { return __builtin_bit_cast(float, w << 16); }
__device__ __forceinline__ float bfhi(unsigned w) { return __builtin_bit_cast(float, w & 0xffff0000u); }
__device__ __forceinline__ float sigmoidf_(float x) { return 1.0f / (1.0f + __expf(-x)); }
__device__ __forceinline__ float gelu_tanh(float x) { const float u = 0.7978845608028654f * (x + 0.044715f * x * x * x); const float e = __expf(-2.0f * fabsf(u)); float t = (1.0f - e) / (1.0f + e); t = u < 0.f ? -t : t; return 0.5f * x * (1.0f + t); }
__device__ __forceinline__ float wave_sum(float v) {
#pragma unroll
    for (int o = 1; o < 64; o <<= 1) v += __shfl_xor(v, o);
    return v;
}
__device__ __forceinline__ int opaque_tid() { int t = threadIdx.x; asm volatile("" : "+v"(t)); return t; }
#define LDS_WAIT() asm volatile("s_waitcnt lgkmcnt(0)" ::: "memory")
#define VM_WAIT() asm volatile("s_waitcnt vmcnt(0)" ::: "memory")

namespace pg8 {
constexpr int BM = 256, BK = 64, HALF = 128, HTB = HALF * BK * 2  , STAGE_BYTES = 8 * HTB, NXCD = 8, WGM = 8;
__host__ __device__ __forceinline__ int lds_byte(int r, int c) { const int st = (r >> 4) * 2 + (c >> 5), rr = r & 15, cc = c & 31, ob = rr * 64 + cc * 2; return st * 1024 + (ob ^ (((ob >> 9) & 1) << 5)); }
__host__ __device__ __forceinline__ void stage_rc(int b, int& R, int& C) { const int st = b / 1024, sb = b % 1024, swz = sb ^ (((sb >> 9) & 1) << 5); R = (st >> 1) * 16 + swz / 64; C = (st & 1) * 32 + (swz % 64) / 2; }
__host__ __device__ __forceinline__ int perm32(int rho) { const int n = rho >> 4, i = rho & 15; return 8 * (i >> 2) + 4 * n + (i & 3); }

struct Unit { int pm, pn, aux; };

struct StaticOrder {
    const char* A; const char* Bt; int K; int nM, nN, nwg, G, c;
    __device__ void init(const void* A_, const void* Bt_, int M, int N, int K_, int G_, int c_) { A = (const char*)A_; Bt = (const char*)Bt_; K = K_; nM = M / BM; nN = N / BM; nwg = nM * nN; G = G_; c = c_; }
    __device__ bool next(int i, Unit& u) const {
        const long L = (long)i * G + c; if (L >= nwg) return false;
        int wgid = (int)L; { const int q = nwg / NXCD, r = nwg % NXCD, xcd = wgid % NXCD, off = wgid / NXCD; wgid = (xcd < r ? xcd * (q + 1) : r * (q + 1) + (xcd - r) * q) + off; }
        const int nig = WGM * nN, gid = wgid / nig, fm = gid * WGM, gsz = (nM - fm) < WGM ? (nM - fm) : WGM;
        u.pm = fm + ((wgid % nig) % gsz); u.pn = (wgid % nig) / gsz; u.aux = 0; return true;
    }
    __device__ __forceinline__ const char* abase(const Unit& u) const { return A + (size_t)u.pm * ((size_t)BM * K * 2); }
    __device__ __forceinline__ const char* bbase(const Unit& u) const { return Bt + (size_t)u.pn * ((size_t)BM * K * 2); }
};

__device__ __forceinline__ unsigned cvt_pk_bf16(float lo, float hi) { unsigned r; asm volatile("v_cvt_pk_bf16_f32 %0, %1, %2" : "=v"(r) : "v"(lo), "v"(hi)); return r; }

struct EpiBf16Store {
    static constexpr bool PERM = true;
    bf16* O; int ldc;
    __device__ __forceinline__ void operator()(const f32x4 (&acc)[2][2][4][2], const Unit& u, int wr, int wc, int fr, int fq) const {
        const int row0 = u.pm * BM + wr * 64 + fr, col0 = u.pn * BM + wc * 32 + 8 * fq;
#pragma unroll
        for (int ai = 0; ai < 2; ++ai)
#pragma unroll
            for (int m = 0; m < 4; ++m) { bf16* rowp = O + (size_t)(row0 + ai * HALF + m * 16) * ldc + col0;
#pragma unroll
                for (int bj = 0; bj < 2; ++bj) { const f32x4 v0 = acc[ai][bj][m][0], v1 = acc[ai][bj][m][1];
                    u32x4 w; w.x = cvt_pk_bf16(v0[0], v0[1]); w.y = cvt_pk_bf16(v0[2], v0[3]); w.z = cvt_pk_bf16(v1[0], v1[1]); w.w = cvt_pk_bf16(v1[2], v1[3]);
                    *(u32x4*)(rowp + bj * HALF) = w; } }
    }
};
struct EpiResAdd {
    static constexpr bool PERM = false;
    float* H; int ldc;
    __device__ __forceinline__ void operator()(const f32x4 (&acc)[2][2][4][2], const Unit& u, int wr, int wc, int fr, int fq) const {
        const int row0 = u.pm * BM + wr * 64 + fr, col0 = u.pn * BM + wc * 32 + 4 * fq;
#pragma unroll
        for (int ai = 0; ai < 2; ++ai)
#pragma unroll
            for (int m = 0; m < 4; ++m) { float* rowp = H + (size_t)(row0 + ai * HALF + m * 16) * ldc + col0;
#pragma unroll
                for (int bj = 0; bj < 2; ++bj)
#pragma unroll
                    for (int n = 0; n < 2; ++n) { f32x4* p = (f32x4*)(rowp + bj * HALF + n * 16); *p = *p + acc[ai][bj][m][n]; } }
    }
};
struct EpiSwiglu {
    static constexpr bool PERM = true;
    bf16* O; int ldc;
    __device__ __forceinline__ void operator()(const f32x4 (&acc)[2][2][4][2], const Unit& u, int wr, int wc, int fr, int fq) const {
        const int row0 = u.pm * BM + wr * 64 + fr, col0 = u.pn * HALF + wc * 32 + 8 * fq;
#pragma unroll
        for (int ai = 0; ai < 2; ++ai)
#pragma unroll
            for (int m = 0; m < 4; ++m) { bf16* rowp = O + (size_t)(row0 + ai * HALF + m * 16) * ldc + col0;
                float o[8];
#pragma unroll
                for (int n = 0; n < 2; ++n)
#pragma unroll
                    for (int i = 0; i < 4; ++i) { const float a = acc[ai][0][m][n][i], b = acc[ai][1][m][n][i]; o[n * 4 + i] = a * b / (1.0f + __expf(-a)); }
                u32x4 w; w.x = cvt_pk_bf16(o[0], o[1]); w.y = cvt_pk_bf16(o[2], o[3]); w.z = cvt_pk_bf16(o[4], o[5]); w.w = cvt_pk_bf16(o[6], o[7]);
                *(u32x4*)rowp = w; __builtin_amdgcn_sched_barrier(0); }
    }
};
struct EpiPle {
    static constexpr bool PERM = false;
    float* H; const bf16* PP; int ldc;
    __device__ __forceinline__ void operator()(const f32x4 (&acc)[2][2][4][2], const Unit& u, int wr, int wc, int fr, int fq) const {
        const int row0 = u.pm * BM + wr * 64 + fr, col0 = u.pn * BM + wc * 32 + 4 * fq;
#pragma unroll
        for (int ai = 0; ai < 2; ++ai)
#pragma unroll
            for (int m = 0; m < 4; ++m) { const size_t off = (size_t)(row0 + ai * HALF + m * 16) * ldc + col0;
#pragma unroll
                for (int bj = 0; bj < 2; ++bj)
#pragma unroll
                    for (int n = 0; n < 2; ++n) { const size_t o2 = off + bj * HALF + n * 16; const u32x2 pw = *(const u32x2*)(PP + o2); const f32x4 a = acc[ai][bj][m][n];
                        f32x4 g; g[0] = bflo(pw.x) * sigmoidf_(a[0]); g[1] = bfhi(pw.x) * sigmoidf_(a[1]); g[2] = bflo(pw.y) * sigmoidf_(a[2]); g[3] = bfhi(pw.y) * sigmoidf_(a[3]);
                        f32x4* p = (f32x4*)(H + o2); *p = *p + g; }
                __builtin_amdgcn_sched_barrier(0); }
    }
};
struct EpiMoe2 {
    static constexpr bool PERM = false;
    float* H; const int* slot_tok; const float* slot_gate; int ldc;
    __device__ __forceinline__ void operator()(const f32x4 (&acc)[2][2][4][2], const Unit& u, int wr, int wc, int fr, int fq) const {
        const int row0 = u.pm * BM + wr * 64 + fr, col0 = u.pn * BM + wc * 32 + 4 * fq;
#pragma unroll
        for (int ai = 0; ai < 2; ++ai)
#pragma unroll
            for (int m = 0; m < 4; ++m) { const int slot = row0 + ai * HALF + m * 16; const int tok = slot_tok[slot]; const float gt = slot_gate[slot];
                if (tok >= 0) { float* rowp = H + (size_t)tok * ldc + col0;
#pragma unroll
                    for (int bj = 0; bj < 2; ++bj)
#pragma unroll
                        for (int n = 0; n < 2; ++n) { f32x4* p = (f32x4*)(rowp + bj * HALF + n * 16); *p = *p + acc[ai][bj][m][n] * gt; } }
                __builtin_amdgcn_sched_barrier(0); }
    }
};

template <class Epi, class Sched, bool ALIGN_EPI = true, bool SP2 = true>
__device__ __forceinline__ void gemm_phase(LAS unsigned char* lds, const int K, const Sched& S, const Epi& E) {
    int tid = threadIdx.x; asm volatile("" : "+v"(tid));
    const int wid = __builtin_amdgcn_readfirstlane(tid >> 6), lane = tid & 63, wr = wid >> 2, wc = wid & 3, fr = lane & 15, fq = lane >> 4;
    const int nt = K / BK;
    unsigned voffA[2], voffB[2];
#pragma unroll
    for (int i = 0; i < 2; ++i) { int R, C; stage_rc(tid * 16 + i * 8192, R, C); const int Rb = Epi::PERM ? ((R & ~31) + perm32(R & 31)) : R;
        voffA[i] = (unsigned)(R * K + C) * 2u; voffB[i] = (unsigned)(Rb * K + C) * 2u; }
    const size_t kstep = (size_t)(BK * 2);
    const size_t hstep = (size_t)HALF * K * 2;
    const unsigned ldsw = (unsigned)wid * 1024u;
    const int aoff = lds_byte(wr * 64 + fr, fq * 8), boff = lds_byte(wc * 32 + fr, fq * 8);
#define PG8_SA(b, h) (((b) * 2 + (h)) * HTB)
#define PG8_SB(b, h) ((4 + (b) * 2 + (h)) * HTB)
#define PG8_STAGE(bufoff, gbase, voff) do { _Pragma("unroll") for (int _i = 0; _i < 2; ++_i) \
        __builtin_amdgcn_global_load_lds((const unsigned*)((const char*)(gbase) + (voff)[_i]), (LAS unsigned*)(lds + (bufoff) + ldsw + _i * 8192), 16, 0, 0); } while (0)
#define PG8_LDA(dst, b, h) do { _Pragma("unroll") for (int m = 0; m < 4; ++m) _Pragma("unroll") for (int k = 0; k < 2; ++k) dst[m][k] = *(const LAS bf16x8*)(lds + PG8_SA(b, h) + aoff + m * 2048 + k * 1024); } while (0)
#define PG8_LDB(dst, b, h) do { _Pragma("unroll") for (int n = 0; n < 2; ++n) _Pragma("unroll") for (int k = 0; k < 2; ++k) dst[n][k] = *(const LAS bf16x8*)(lds + PG8_SB(b, h) + boff + n * 2048 + k * 1024); } while (0)
#define PG8_MMA(ai, bj, At, Bt) do { __builtin_amdgcn_s_setprio(1); _Pragma("unroll") for (int m = 0; m < 4; ++m) _Pragma("unroll") for (int n = 0; n < 2; ++n) _Pragma("unroll") for (int k = 0; k < 2; ++k) \
        acc[ai][bj][m][n] = __builtin_amdgcn_mfma_f32_16x16x32_bf16(Bt[n][k], At[m][k], acc[ai][bj][m][n], 0, 0, 0); __builtin_amdgcn_s_setprio(0); } while (0)
#define PG8_WAIT_V(n) asm volatile("s_waitcnt vmcnt(" #n ")" ::: "memory")
#define PG8_WAIT_L(n) asm volatile("s_waitcnt lgkmcnt(" #n ")" ::: "memory")
#define PG8_BAR __builtin_amdgcn_s_barrier()
#define PG8_SCHED __builtin_amdgcn_sched_barrier(0)
    Unit cur, nxt; int ui = 0;
    if (!S.next(0, cur)) return;
    f32x4 acc[2][2][4][2];
#pragma unroll
    for (int a = 0; a < 2; ++a)
#pragma unroll
        for (int b = 0; b < 2; ++b)
#pragma unroll
            for (int m = 0; m < 4; ++m)
#pragma unroll
                for (int n = 0; n < 2; ++n) acc[a][b][m][n] = (f32x4){0.f, 0.f, 0.f, 0.f};
    bf16x8 At[4][2], B0[2][2], B1[2][2];
    const char* cA = S.abase(cur); const char* cB = S.bbase(cur);
    if constexpr (SP2) {
        PG8_STAGE(PG8_SB(0, 0), cB, voffB); PG8_STAGE(PG8_SB(0, 1), cB + hstep, voffB); PG8_STAGE(PG8_SA(0, 0), cA, voffA); PG8_STAGE(PG8_SA(0, 1), cA + hstep, voffA);
        if (wr == 1) PG8_BAR;
        PG8_WAIT_V(2); PG8_BAR;
        PG8_STAGE(PG8_SB(1, 0), cB + kstep, voffB); PG8_STAGE(PG8_SA(1, 0), cA + kstep, voffA); PG8_STAGE(PG8_SB(1, 1), cB + hstep + kstep, voffB);
        PG8_WAIT_V(6); PG8_BAR;
    } else {
        PG8_STAGE(PG8_SB(0, 0), cB, voffB); PG8_STAGE(PG8_SA(0, 0), cA, voffA); PG8_STAGE(PG8_SB(0, 1), cB + hstep, voffB); PG8_STAGE(PG8_SA(0, 1), cA + hstep, voffA);
        if (wr == 1) PG8_BAR;
        PG8_WAIT_V(4); PG8_BAR;
        PG8_STAGE(PG8_SB(1, 0), cB + kstep, voffB); PG8_STAGE(PG8_SA(1, 0), cA + kstep, voffA); PG8_STAGE(PG8_SB(1, 1), cB + hstep + kstep, voffB);
        PG8_WAIT_V(6); PG8_BAR;
    }
    for (;;) {
        const bool has_next = S.next(ui + 1, nxt);
        const char* nA = has_next ? S.abase(nxt) : cA; const char* nB = has_next ? S.bbase(nxt) : cB;
        for (int t = 0; t < nt; t += 2) {
            const bool last = (t == nt - 2);
            const char* a1 = cA + (size_t)(t + 1) * kstep;
            const char* a2 = last ? nA : cA + (size_t)(t + 2) * kstep; const char* b2 = last ? nB : cB + (size_t)(t + 2) * kstep;
            const char* a3 = a2 + kstep; const char* b3 = b2 + kstep;
            if constexpr (SP2) {
            PG8_LDB(B0, 0, 0); PG8_LDB(B1, 0, 1); PG8_SCHED; PG8_LDA(At, 0, 0); PG8_STAGE(PG8_SA(1, 1), a1 + hstep, voffA);
            PG8_WAIT_V(8); PG8_WAIT_L(0); PG8_BAR; PG8_MMA(0, 0, At, B0); PG8_MMA(0, 1, At, B1); PG8_BAR; PG8_SCHED;
            PG8_LDA(At, 0, 1); PG8_STAGE(PG8_SB(0, 0), b2, voffB); PG8_STAGE(PG8_SB(0, 1), b2 + hstep, voffB); PG8_STAGE(PG8_SA(0, 0), a2, voffA);
            PG8_WAIT_V(8); PG8_WAIT_L(0); PG8_BAR; PG8_MMA(1, 0, At, B0); PG8_MMA(1, 1, At, B1); PG8_BAR; PG8_SCHED;
            PG8_LDB(B0, 1, 0); PG8_LDB(B1, 1, 1); PG8_SCHED; PG8_LDA(At, 1, 0); PG8_STAGE(PG8_SA(0, 1), a2 + hstep, voffA);
            PG8_WAIT_V(8); PG8_WAIT_L(0); PG8_BAR; PG8_MMA(0, 0, At, B0); PG8_MMA(0, 1, At, B1); PG8_BAR; PG8_SCHED;
            PG8_LDA(At, 1, 1); PG8_STAGE(PG8_SB(1, 0), b3, voffB); PG8_STAGE(PG8_SB(1, 1), b3 + hstep, voffB); PG8_STAGE(PG8_SA(1, 0), a3, voffA);
            PG8_WAIT_V(8); PG8_WAIT_L(0); PG8_BAR; PG8_MMA(1, 0, At, B0); PG8_MMA(1, 1, At, B1); PG8_BAR; PG8_SCHED;
            } else {
            PG8_LDB(B0, 0, 0); PG8_SCHED; PG8_LDA(At, 0, 0); PG8_STAGE(PG8_SA(1, 1), a1 + hstep, voffA);
            PG8_WAIT_L(8); PG8_BAR; PG8_WAIT_L(0); PG8_MMA(0, 0, At, B0); PG8_BAR; PG8_SCHED;
            PG8_LDB(B1, 0, 1); PG8_STAGE(PG8_SB(0, 0), b2, voffB);
            PG8_BAR; PG8_WAIT_L(0); PG8_MMA(0, 1, At, B1); PG8_BAR;
            PG8_LDA(At, 0, 1); PG8_STAGE(PG8_SA(0, 0), a2, voffA);
            PG8_BAR; PG8_WAIT_L(0); PG8_MMA(1, 0, At, B0); PG8_BAR; PG8_SCHED;
            PG8_STAGE(PG8_SB(0, 1), b2 + hstep, voffB);
            PG8_WAIT_V(6); PG8_BAR; PG8_MMA(1, 1, At, B1); PG8_BAR;
            PG8_LDB(B0, 1, 0); PG8_SCHED; PG8_LDA(At, 1, 0); PG8_STAGE(PG8_SA(0, 1), a2 + hstep, voffA);
            PG8_WAIT_L(8); PG8_BAR; PG8_WAIT_L(0); PG8_MMA(0, 0, At, B0); PG8_BAR; PG8_SCHED;
            PG8_LDB(B1, 1, 1); PG8_STAGE(PG8_SB(1, 0), b3, voffB);
            PG8_BAR; PG8_WAIT_L(0); PG8_MMA(0, 1, At, B1); PG8_BAR;
            PG8_LDA(At, 1, 1); PG8_STAGE(PG8_SA(1, 0), a3, voffA);
            PG8_BAR; PG8_WAIT_L(0); PG8_MMA(1, 0, At, B0); PG8_BAR; PG8_SCHED;
            PG8_STAGE(PG8_SB(1, 1), b3 + hstep, voffB);
            PG8_WAIT_V(6); PG8_BAR; PG8_MMA(1, 1, At, B1); PG8_BAR;
            }
        }
        if constexpr (ALIGN_EPI) { if (wr == 0) PG8_BAR; }
        E(acc, cur, wr, wc, fr, fq);
        if (!has_next) break;
#pragma unroll
        for (int a = 0; a < 2; ++a)
#pragma unroll
            for (int b = 0; b < 2; ++b)
#pragma unroll
                for (int m = 0; m < 4; ++m)
#pragma unroll
                    for (int n = 0; n < 2; ++n) acc[a][b][m][n] = (f32x4){0.f, 0.f, 0.f, 0.f};
        cur = nxt; cA = nA; cB = nB; ++ui;
        if constexpr (ALIGN_EPI) { if (wr == 1) PG8_BAR; }
    }
    PG8_WAIT_V(0);
    if constexpr (!ALIGN_EPI) { if (wr == 0) PG8_BAR; }
    PG8_BAR;
#undef PG8_SA
#undef PG8_SB
#undef PG8_STAGE
#undef PG8_LDA
#undef PG8_LDB
#undef PG8_MMA
#undef PG8_WAIT_V
#undef PG8_WAIT_L
#undef PG8_BAR
#undef PG8_SCHED
}
}

constexpr size_t MiB = 1u << 20;
constexpr size_t WS_CTL = 0, CTL_ZERO_BYTES = 65536;
constexpr size_t WS_WIN = 1 * MiB;
constexpr size_t WS_WOUT = 13 * MiB;
constexpr size_t WS_W13 = 17 * MiB;
constexpr size_t WS_W2 = 28 * MiB;
constexpr size_t WS_WG = 34 * MiB;
constexpr size_t WS_WP = 38 * MiB;
constexpr size_t WS_CW1 = 39 * MiB;
constexpr size_t WS_LORA = 41 * MiB;
constexpr size_t WS_ROPE = 41 * MiB + 512 * 1024;
constexpr size_t WS_CBIAS = 42 * MiB + 512 * 1024;
constexpr size_t WS_PB = 43 * MiB;
constexpr size_t WS_HN = 60 * MiB;
constexpr size_t WS_Z = 92 * MiB;
constexpr size_t WS_YCAT = 188 * MiB;
constexpr size_t WS_QROT = 220 * MiB;
constexpr size_t WS_KSR = 236 * MiB, WS_KWR = 240 * MiB, WS_VST = 244 * MiB, WS_VWT = 248 * MiB;
constexpr size_t WS_KCMP = 252 * MiB, WS_VCMPT = 252 * MiB + 512 * 1024;
constexpr size_t WS_REC = 253 * MiB;
constexpr size_t WS_G = 349 * MiB;
constexpr size_t WS_YRAW = 365 * MiB;
constexpr size_t WS_BONUS = 381 * MiB;
constexpr size_t WS_ACT = 92 * MiB;
constexpr size_t WS_HNS = 92 * MiB;
constexpr size_t WS_ACTM = 128 * MiB;
constexpr size_t WS_MW13 = 227 * MiB;
constexpr size_t WS_MW2 = 315 * MiB;
constexpr size_t WS_SLOT = 359 * MiB;
constexpr size_t WS_PP = 92 * MiB;
constexpr size_t WS_YP = 382 * MiB;
constexpr size_t WS_SEGE = 398 * MiB;
constexpr size_t WS_SST = 406 * MiB;
constexpr size_t WS_END = 410 * MiB;
constexpr int NSEG = 16, SEGLEN = SEQ / NSEG;
constexpr int MOE_SLOTS = 18432;
constexpr size_t SL_TOK = 0;
constexpr size_t SL_GATE = SL_TOK + 2 * MOE_SLOTS * 4;
constexpr size_t SL_TOKE = SL_GATE + 2 * MOE_SLOTS * 4;
constexpr size_t SL_TOKG = SL_TOKE + (size_t)MT * 2 * 4;
constexpr size_t SL_TOKS = SL_TOKG + (size_t)MT * 2 * 4;
constexpr size_t SL_BCNT = SL_TOKS + (size_t)MT * 2 * 4;
constexpr size_t SL_TST = SL_BCNT + 256 * 16 * 4;
static_assert(SL_TST + 128 <= 1 * MiB, "slot tables");
constexpr int CW_BAR = 4096;
constexpr int CW_Q = 8192;

constexpr int RING_BYTES = 131072;
constexpr int MISC_OFF = RING_BYTES;
constexpr int LDS_BYTES = 147456;

#define XB_TMO      128
#define XB_XCNT(j)  (256  + 64 * (j))
#define XB_XSUB(j)  (1280 + 64 * (j))
#define XB_XGEN(j)  (2304 + 64 * (j))
#define XB_TOP      3328
#define XB_TOPGEN   3392
#define XCD_BAR_WORDS 3456
#define XB_SPIN_CAP (1u << 18)
__device__ __forceinline__ unsigned xb_ld(unsigned* p)              { return __hip_atomic_load(p, __ATOMIC_RELAXED, __HIP_MEMORY_SCOPE_AGENT); }
__device__ __forceinline__ unsigned xb_add(unsigned* p, unsigned v) { return __hip_atomic_fetch_add(p, v, __ATOMIC_RELAXED, __HIP_MEMORY_SCOPE_AGENT); }
__device__ __forceinline__ unsigned xb_xcc_id() { return (unsigned)__builtin_amdgcn_s_getreg((3 << 11) | 20) & 0xFu; }
#define XB_SPIN(cond, bar) do { unsigned _sp = 0; while (cond) { __builtin_amdgcn_s_sleep(1); \
    if ((++_sp & 255u) == 0u) { if (xb_ld(&(bar)[XB_TMO])) break; if (_sp > XB_SPIN_CAP) { atomicAdd(&(bar)[XB_TMO], 1u); break; } } } } while (0)
struct XcdBarrier { unsigned* bar; unsigned x; volatile LAS unsigned* st; };
__device__ __forceinline__ XcdBarrier xcd_barrier_post(unsigned* bar, volatile LAS unsigned* st) {
    XcdBarrier b; b.bar = bar; b.x = xb_xcc_id(); b.st = st;
    if (threadIdx.x == 0) (void)xb_add(&bar[XB_XCNT(b.x)], 1u);
    return b;
}
__device__ __forceinline__ void xcd_barrier_complete(unsigned* bar, unsigned x, unsigned& nloc, unsigned& nx) {
    const unsigned G = gridDim.x * gridDim.y * gridDim.z;
    unsigned sum, cnt, mine, sp = 0u;
    for (;;) {
        sum = 0u; cnt = 0u; mine = 0u;
#pragma unroll
        for (unsigned j = 0; j < 16; ++j) { const unsigned c = xb_ld(&bar[XB_XCNT(j)]); sum += c; cnt += (c > 0u) ? 1u : 0u; mine = (j == x) ? c : mine; }
        if (sum == G) break;
        __builtin_amdgcn_s_sleep(1);
        if ((++sp & 255u) == 0u) { if (xb_ld(&bar[XB_TMO])) break; if (sp > XB_SPIN_CAP) { atomicAdd(&bar[XB_TMO], 1u); break; } }
    }
    nloc = mine > 0u ? mine : 1u; nx = cnt > 0u ? cnt : 1u;
}
__device__ __forceinline__ void xcd_barrier(const XcdBarrier& b) {
    asm volatile("s_waitcnt vmcnt(0)" ::: "memory");
    __syncthreads();
    if (threadIdx.x == 0) {
        unsigned* bar = b.bar;
        __builtin_amdgcn_s_waitcnt(0);
        unsigned nloc = b.st[0], nx = b.st[1];
        if (nloc == 0u) { xcd_barrier_complete(bar, b.x, nloc, nx); b.st[0] = nloc; b.st[1] = nx; }
        const unsigned old = xb_add(&bar[XB_XSUB(b.x)], 1u);
        const unsigned gen = old / nloc;
        if (old + 1u == (gen + 1u) * nloc) {
            __builtin_amdgcn_fence(__ATOMIC_RELEASE, "agent");
            asm volatile("s_waitcnt vmcnt(0)" ::: "memory");
            const unsigned og = xb_add(&bar[XB_TOP], 1u);
            const unsigned tg = og / nx;
            if (og + 1u == (tg + 1u) * nx) xb_add(&bar[XB_TOPGEN], 1u);
            else XB_SPIN(xb_ld(&bar[XB_TOPGEN]) == tg, bar);
            __builtin_amdgcn_fence(__ATOMIC_ACQUIRE, "agent");
            xb_add(&bar[XB_XGEN(b.x)], 1u);
            asm volatile("s_waitcnt vmcnt(0)" ::: "memory");
        } else {
            XB_SPIN(xb_ld(&bar[XB_XGEN(b.x)]) == gen, bar);
            __builtin_amdgcn_fence(__ATOMIC_ACQUIRE, "agent");
            asm volatile("s_waitcnt vmcnt(0)" ::: "memory");
        }
    }
    __syncthreads();
}

enum { IN_X = 0, IN_P, IN_POS, IN_GMIX, IN_WIN, IN_WOUT, IN_GMLNG, IN_GMLNB, IN_GMWS, IN_GMBS, IN_RWMU, IN_RWW0, IN_RWWUP, IN_RWA0, IN_RWAUP, IN_RWGUP,
       IN_RWKK, IN_RWKA, IN_RWRK, IN_RWGNG, IN_RWGNB, IN_CMPPOS, IN_KCW1, IN_KCW2, IN_VCW1, IN_VCW2, IN_GFFN, IN_FW1, IN_FW3, IN_FW2, IN_RTW, IN_RTB,
       IN_MW1, IN_MW3, IN_MW2, IN_GPLE, IN_PLEG, IN_PLEP, IN_GFINAL, N_INPUTS };
struct Args { const void* in[N_INPUTS]; float* out; unsigned char* ws; int ph_lo, ph_hi; };
constexpr int PTAB_OFF = 131072 + 256;
__device__ __forceinline__ const void* ldptr(int k) {
    extern __shared__ __attribute__((aligned(16))) unsigned char lds_raw[];
    const LAS unsigned* t = (const LAS unsigned*)((LAS unsigned char*)lds_raw + PTAB_OFF) + 2 * k;
    const unsigned lo = __builtin_amdgcn_readfirstlane(t[0]), hi = __builtin_amdgcn_readfirstlane(t[1]);
    return (const void*)(((unsigned long long)hi << 32) | lo);
}
#define INF(k) ((const float*)ldptr(k))

__device__ __forceinline__ void conv_matrix(const float* W, int K, int N, bf16* dst, int mode, int gw, int NGW, LAS float* scr, int lane) {
    (void)scr;
    const int nblk = (N + 63) / 64, nit = (K / 64) * nblk;
    for (int it = gw; it < nit; it += NGW) {
        const int kb = it / nblk, nb = it % nblk, n = nb * 64 + lane, k0 = kb * 64; const bool ok = n < N;
        const int drow = mode == 0 ? n : ((n >> 7) * 256 + (n & 127) + (mode == 2 ? 128 : 0));
        const float* src = W + (size_t)k0 * N + (ok ? n : 0);
        float v[64];
#pragma unroll
        for (int k = 0; k < 64; ++k) v[k] = src[(size_t)k * N];
        if (ok) { u32x4* d = (u32x4*)(dst + (size_t)drow * K + k0);
#pragma unroll
            for (int c = 0; c < 8; ++c) { u32x4 o; o.x = pk2(v[8 * c], v[8 * c + 1]); o.y = pk2(v[8 * c + 2], v[8 * c + 3]); o.z = pk2(v[8 * c + 4], v[8 * c + 5]); o.w = pk2(v[8 * c + 6], v[8 * c + 7]); d[c] = o; } }
    }
}
__device__ __forceinline__ void rms_row_bf16(const float* xrow, const float* g, bf16* orow, float* cp, int lane) {
    const f32x4* xr = (const f32x4*)xrow + lane; f32x4 v[4]; float s = 0.f;
#pragma unroll
    for (int j = 0; j < 4; ++j) { v[j] = xr[64 * j]; s += (v[j].x * v[j].x + v[j].y * v[j].y) + (v[j].z * v[j].z + v[j].w * v[j].w); }
    const float rs = 1.0f / sqrtf(wave_sum(s) * (1.0f / 1024.0f) + 1e-6f);
    if (cp) {
#pragma unroll
        for (int j = 0; j < 4; ++j) ((f32x4*)cp + lane)[64 * j] = v[j]; }
    u32x2* o8 = (u32x2*)orow + lane;
#pragma unroll
    for (int j = 0; j < 4; ++j) { const f32x4 gg = ((const f32x4*)g + lane)[64 * j]; u32x2 w; w.x = pk2(v[j].x * rs * gg.x, v[j].y * rs * gg.y); w.y = pk2(v[j].z * rs * gg.z, v[j].w * rs * gg.w); o8[64 * j] = w; }
}

__device__ __forceinline__ void phase_prologue(const Args& a, LAS unsigned char* lds) {
    const int tid = opaque_tid(), lane = tid & 63, wave = __builtin_amdgcn_readfirstlane(tid >> 6);
    const int G = gridDim.x, gw = blockIdx.x * NWAVES + wave, NGW = G * NWAVES;
    const size_t gt = (size_t)blockIdx.x * NTHR + tid, NGT = (size_t)G * NTHR;
    unsigned char* ws = a.ws;
    LAS float* scr = (LAS float*)(lds + wave * 16384);
    for (int l = 0; l < 2; ++l) {
        conv_matrix(INF(IN_WIN) + (size_t)l * DM * DIN, DM, DIN, (bf16*)(ws + WS_WIN) + (size_t)l * ZLD * DM, 0, gw, NGW, scr, lane);
        conv_matrix(INF(IN_WOUT) + (size_t)l * DM * DM, DM, DM, (bf16*)(ws + WS_WOUT) + (size_t)l * DM * DM, 0, gw, NGW, scr, lane);
        conv_matrix(INF(IN_PLEG) + (size_t)l * DM * DM, DM, DM, (bf16*)(ws + WS_WG) + (size_t)l * DM * DM, 0, gw, NGW, scr, lane);
        conv_matrix(INF(IN_PLEP) + (size_t)l * 256 * DM, 256, DM, (bf16*)(ws + WS_WP) + (size_t)l * DM * 256, 0, gw, NGW, scr, lane);
        conv_matrix(INF(IN_KCW1) + (size_t)l * 2048 * 128, 2048, 128, (bf16*)(ws + WS_CW1) + (size_t)(l * 2 + 0) * 128 * 2048, 0, gw, NGW, scr, lane);
        conv_matrix(INF(IN_VCW1) + (size_t)l * 2048 * 128, 2048, 128, (bf16*)(ws + WS_CW1) + (size_t)(l * 2 + 1) * 128 * 2048, 0, gw, NGW, scr, lane);
        bf16* lora = (bf16*)(ws + WS_LORA) + (size_t)l * 65536;
        conv_matrix(INF(IN_RWWUP) + (size_t)l * 64 * 256, 64, 256, lora, 0, gw, NGW, scr, lane);
        conv_matrix(INF(IN_RWAUP) + (size_t)l * 64 * 256, 64, 256, lora + 16384, 0, gw, NGW, scr, lane);
        conv_matrix(INF(IN_RWGUP) + (size_t)l * 128 * 256, 128, 256, lora + 32768, 0, gw, NGW, scr, lane);
        { u32x4* zr = (u32x4*)((bf16*)(ws + WS_WIN) + ((size_t)l * ZLD + DIN) * DM); const size_t n16 = (size_t)(ZLD - DIN) * DM * 2 / 16;
          for (size_t i = gt; i < n16; i += NGT) zr[i] = (u32x4){0u, 0u, 0u, 0u}; }
    }
    conv_matrix(INF(IN_FW1), DM, DFF, (bf16*)(ws + WS_W13), 1, gw, NGW, scr, lane);
    conv_matrix(INF(IN_FW3), DM, DFF, (bf16*)(ws + WS_W13), 2, gw, NGW, scr, lane);
    conv_matrix(INF(IN_FW2), DFF, DM, (bf16*)(ws + WS_W2), 0, gw, NGW, scr, lane);
    { const f32x4* src = (const f32x4*)INF(IN_P); u32x2* dst = (u32x2*)(ws + WS_PB); const size_t n4 = (size_t)2 * MT * 256 / 4;
      for (size_t i = gt; i < n4; i += NGT) { const f32x4 v = src[i]; u32x2 w; w.x = pk2(v.x, v.y); w.y = pk2(v.z, v.w); dst[i] = w; } }
    { const int* pos = (const int*)ldptr(IN_POS); float* ct = (float*)(ws + WS_ROPE); float* st = ct + (size_t)MT * 8;
      const float inv[8] = {1.0f, 0.1939227432012558f, 0.03760603070259094f, 0.007292664609849453f, 0.0014142135623842478f, 0.00027424818836152554f, 5.3182957344688475e-05f, 1.0313385246263351e-05f};
      for (size_t i = gt; i < (size_t)MT * 8; i += NGT) { const int m = (int)(i >> 3), k = (int)(i & 7);
          float iv = inv[0];
#pragma unroll
          for (int q = 1; q < 8; ++q) iv = (k == q) ? inv[q] : iv;
          const float ang = (float)pos[m] * iv;
          const double ad = (double)ang; const double kq = __builtin_rint(ad * 0.15915494309189535); const float red = (float)(ad - kq * 6.283185307179586);
          ct[i] = __cosf(red); st[i] = __sinf(red); } }
    if (blockIdx.x < 64) {
        const int lk = blockIdx.x >> 4, ck = blockIdx.x & 15, l = lk >> 1, kv = lk & 1; const float* W1 = INF(kv ? IN_VCW1 : IN_KCW1) + (size_t)l * 2048 * 128; const float* pos = INF(IN_CMPPOS) + (size_t)l * 2048;
        LAS float* red = (LAS float*)(lds + 8448);
        const int hid = tid & 127, part = tid >> 7; const int kb = ck * 128 + part * 32; float s = 0.f;
#pragma unroll
        for (int k = 0; k < 32; ++k) s += pos[kb + k] * W1[(size_t)(kb + k) * 128 + hid];
        red[part * 128 + hid] = s; __syncthreads();
        if (tid < 128) ((float*)(ws + WS_CBIAS))[(lk * 16 + ck) * 128 + tid] = red[tid] + red[128 + tid] + red[256 + tid] + red[384 + tid];
    }
    for (int m = gw; m < MT; m += NGW) rms_row_bf16(INF(IN_X) + (size_t)m * DM, INF(IN_GMIX), (bf16*)(ws + WS_HN) + (size_t)m * DM, a.out + (size_t)m * DM, lane);
}

template <int MODE>
__device__ __forceinline__ void phase_norm(const Args& a, LAS unsigned char* lds, const float* g) {
    const int tid = opaque_tid(), lane = tid & 63, wave = __builtin_amdgcn_readfirstlane(tid >> 6);
    unsigned char* ws = a.ws;
    LAS int* lcnt = (LAS int*)lds;
    if (MODE == 1) { if (tid < 16) lcnt[tid] = 0; __syncthreads(); }
    for (int rb = blockIdx.x; rb < MT / 64; rb += gridDim.x) {
        for (int i = 0; i < 8; ++i) {
            const int m = rb * 64 + wave * 8 + i;
            float* hrow = a.out + (size_t)m * DM;
            const f32x4* xr = (const f32x4*)hrow + lane; f32x4 v[4]; float s = 0.f;
#pragma unroll
            for (int j = 0; j < 4; ++j) { v[j] = xr[64 * j]; s += (v[j].x * v[j].x + v[j].y * v[j].y) + (v[j].z * v[j].z + v[j].w * v[j].w); }
            const float rs = 1.0f / sqrtf(wave_sum(s) * (1.0f / 1024.0f) + 1e-6f);
#pragma unroll
            for (int j = 0; j < 4; ++j) { const f32x4 gg = ((const f32x4*)g + lane)[64 * j]; v[j].x *= rs * gg.x; v[j].y *= rs * gg.y; v[j].z *= rs * gg.z; v[j].w *= rs * gg.w; }
            if (MODE == 2) {
#pragma unroll
                for (int j = 0; j < 4; ++j) ((f32x4*)hrow + lane)[64 * j] = v[j];
            } else {
                u32x2* o8 = (u32x2*)((bf16*)(ws + WS_HN) + (size_t)m * DM) + lane;
#pragma unroll
                for (int j = 0; j < 4; ++j) { u32x2 w; w.x = pk2(v[j].x, v[j].y); w.y = pk2(v[j].z, v[j].w); o8[64 * j] = w; }
            }
            if (MODE == 1) {
                const float* rw = INF(IN_RTW); float lg[8];
#pragma unroll
                for (int e = 0; e < 8; ++e) lg[e] = 0.f;
#pragma unroll
                for (int j = 0; j < 4; ++j)
#pragma unroll
                    for (int c = 0; c < 4; ++c) { const int k = 4 * (lane + 64 * j) + c; const f32x4 w0 = *(const f32x4*)(rw + (size_t)k * 8), w1 = *(const f32x4*)(rw + (size_t)k * 8 + 4); const float x = v[j][c];
                        lg[0] += x * w0.x; lg[1] += x * w0.y; lg[2] += x * w0.z; lg[3] += x * w0.w; lg[4] += x * w1.x; lg[5] += x * w1.y; lg[6] += x * w1.z; lg[7] += x * w1.w; }
#pragma unroll
                for (int e = 0; e < 8; ++e) lg[e] = wave_sum(lg[e]) + INF(IN_RTB)[e];
                int e0 = 0; float v0 = lg[0];
#pragma unroll
                for (int e = 1; e < 8; ++e) if (lg[e] > v0) { v0 = lg[e]; e0 = e; }
                int e1 = -1; float v1 = -3.0e38f;
#pragma unroll
                for (int e = 0; e < 8; ++e) if (e != e0 && lg[e] > v1) { v1 = lg[e]; e1 = e; }
                const float p1 = 1.0f / (1.0f + __expf(v0 - v1)), p0 = 1.0f - p1;
                if (lane == 0) { int* te = (int*)(ws + WS_SLOT + SL_TOKE); float* tg = (float*)(ws + WS_SLOT + SL_TOKG); te[2 * m] = e0; te[2 * m + 1] = e1; tg[2 * m] = p0; tg[2 * m + 1] = p1;
                    atomicAdd((int*)&lcnt[e0], 1); atomicAdd((int*)&lcnt[8 + e1], 1); }
            }
        }
        if (MODE == 1) { __syncthreads(); if (tid < 16) { ((int*)(ws + WS_SLOT + SL_BCNT))[rb * 16 + tid] = lcnt[tid]; lcnt[tid] = 0; } __syncthreads(); }
    }
}

__device__ __forceinline__ bf16x8 ld_bf8(const bf16* p) { return *(const bf16x8*)p; }
__device__ __forceinline__ float tanhf_(float x) { const float e = __expf(2.0f * x); return 1.0f - 2.0f / (e + 1.0f); }

__device__ __forceinline__ void rw_shift8(const bf16* z, const float* mu, int m, int tpos, int c, float (&o)[8]) {
    const u32x4 cur = *(const u32x4*)(z + (size_t)m * ZLD + ZC_B + c);
    u32x4 prv = (u32x4){0u, 0u, 0u, 0u}; if (tpos > 0) prv = *(const u32x4*)(z + (size_t)(m - 1) * ZLD + ZC_B + c);
    const f32x4 m0 = *(const f32x4*)(mu + c), m1 = *(const f32x4*)(mu + c + 4);
    float cu[8] = {bflo(cur.x), bfhi(cur.x), bflo(cur.y), bfhi(cur.y), bflo(cur.z), bfhi(cur.z), bflo(cur.w), bfhi(cur.w)};
    float pv[8] = {bflo(prv.x), bfhi(prv.x), bflo(prv.y), bfhi(prv.y), bflo(prv.z), bfhi(prv.z), bflo(prv.w), bfhi(prv.w)};
    float mm[8] = {m0.x, m0.y, m0.z, m0.w, m1.x, m1.y, m1.z, m1.w};
#pragma unroll
    for (int j = 0; j < 8; ++j) o[j] = cu[j] + (pv[j] - cu[j]) * mm[j];
}
__device__ __forceinline__ void rw_shift4(const bf16* z, const float* mu, int m, int tpos, int c, float (&o)[4]) {
    const u32x2 cur = *(const u32x2*)(z + (size_t)m * ZLD + ZC_B + c);
    u32x2 prv = (u32x2){0u, 0u}; if (tpos > 0) prv = *(const u32x2*)(z + (size_t)(m - 1) * ZLD + ZC_B + c);
    const f32x4 m0 = *(const f32x4*)(mu + c);
    o[0] = bflo(cur.x) + (bflo(prv.x) - bflo(cur.x)) * m0.x; o[1] = bfhi(cur.x) + (bfhi(prv.x) - bfhi(cur.x)) * m0.y;
    o[2] = bflo(cur.y) + (bflo(prv.y) - bflo(cur.y)) * m0.z; o[3] = bfhi(cur.y) + (bfhi(prv.y) - bfhi(cur.y)) * m0.w;
}
__device__ __forceinline__ bf16x8 pack8(const float (&x)[8]) {
    u32x4 w; w.x = pk2(x[0], x[1]); w.y = pk2(x[2], x[3]); w.z = pk2(x[4], x[5]); w.w = pk2(x[6], x[7]);
    return __builtin_bit_cast(bf16x8, w);
}

__device__ __forceinline__ void rwkv_prep_tile(const Args& a, int layer, int m0, int lane, int hc_lo, int hc_hi) {
    unsigned char* ws = a.ws;
    const bf16* z = (const bf16*)(ws + WS_Z);
    const float* mu = INF(IN_RWMU) + (size_t)layer * 1024;
    const bf16* lora = (const bf16*)(ws + WS_LORA) + (size_t)layer * 65536;
    const bf16* wupT = lora; const bf16* aupT = lora + 16384; const bf16* gupT = lora + 32768;
    const int fq = lane >> 4, fr = lane & 15;
    const int m = m0 + fr, tpos = m & (SEQ - 1), bb = m >> 12;
    bf16x8 wdB[2], adB[2], gdB[4];
#pragma unroll
    for (int ks = 0; ks < 2; ++ks) { float x[8]; rw_shift8(z, mu, m, tpos, 768 + 32 * ks + 8 * fq, x);
#pragma unroll
        for (int j = 0; j < 8; ++j) x[j] = tanhf_(x[j]);
        wdB[ks] = pack8(x);
        rw_shift8(z, mu, m, tpos, 832 + 32 * ks + 8 * fq, x); adB[ks] = pack8(x); }
#pragma unroll
    for (int ks = 0; ks < 4; ++ks) { float x[8]; rw_shift8(z, mu, m, tpos, 896 + 32 * ks + 8 * fq, x);
#pragma unroll
        for (int j = 0; j < 8; ++j) x[j] = sigmoidf_(x[j]);
        gdB[ks] = pack8(x); }
    const float* w0p = INF(IN_RWW0) + layer * 256; const float* a0p = INF(IN_RWA0) + layer * 256; const float* kkp = INF(IN_RWKK) + layer * 256;
    const float* kap = INF(IN_RWKA) + layer * 256; const float* rkp = INF(IN_RWRK) + layer * 256;
    float* rec = (float*)(ws + WS_REC); float* gbuf = (float*)(ws + WS_G); float* bonus = (float*)(ws + WS_BONUS);
    float ss = 0.f, bs = 0.f, inv = 0.f;
#pragma unroll 1
    for (int hc = hc_lo; hc < hc_hi; ++hc) {
        const int h = hc >> 2, ct = hc & 3;
        if (ct == 0) {
            ss = 0.f; bs = 0.f;
#pragma unroll
            for (int c2 = 0; c2 < 4; ++c2) { const int c0 = h * 64 + 16 * c2 + 4 * fq; float k4[4]; rw_shift4(z, mu, m, tpos, 256 + c0, k4); const f32x4 k_k = *(const f32x4*)(kkp + c0);
#pragma unroll
                for (int i = 0; i < 4; ++i) { const float kx = k4[i] * k_k[i]; ss += kx * kx; } }
            ss += __shfl_xor(ss, 16); ss += __shfl_xor(ss, 32);
            inv = 1.0f / sqrtf(fmaxf(ss, 1e-24f));
        }
        f32x4 aw = (f32x4){0.f, 0.f, 0.f, 0.f}, aa = aw, ag = aw;
        const int chr = h * 64 + 16 * ct + fr;
#pragma unroll
        for (int ks = 0; ks < 2; ++ks) { const bf16x8 A1 = ld_bf8(wupT + chr * 64 + 32 * ks + 8 * fq), A2 = ld_bf8(aupT + chr * 64 + 32 * ks + 8 * fq);
            aw = __builtin_amdgcn_mfma_f32_16x16x32_bf16(A1, wdB[ks], aw, 0, 0, 0); aa = __builtin_amdgcn_mfma_f32_16x16x32_bf16(A2, adB[ks], aa, 0, 0, 0); }
#pragma unroll
        for (int ks = 0; ks < 4; ++ks) { const bf16x8 A3 = ld_bf8(gupT + chr * 128 + 32 * ks + 8 * fq); ag = __builtin_amdgcn_mfma_f32_16x16x32_bf16(A3, gdB[ks], ag, 0, 0, 0); }
        float* rp = rec + ((size_t)(bb * 4 + h) * SEQ + tpos) * 384;
        const int c0 = h * 64 + 16 * ct + 4 * fq, d0 = 16 * ct + 4 * fq;
        float r4[4], k4[4], v4[4]; rw_shift4(z, mu, m, tpos, c0, r4); rw_shift4(z, mu, m, tpos, 256 + c0, k4); rw_shift4(z, mu, m, tpos, 512 + c0, v4);
        const f32x4 w0 = *(const f32x4*)(w0p + c0), a0 = *(const f32x4*)(a0p + c0), k_k = *(const f32x4*)(kkp + c0), k_a = *(const f32x4*)(kap + c0), r_k = *(const f32x4*)(rkp + c0);
        f32x4 odw, okk, ob, okp;
#pragma unroll
        for (int i = 0; i < 4; ++i) {
            const float wl = w0[i] + aw[i]; const float nx = -wl; const float sp = fmaxf(nx, 0.f) + log1pf(__expf(-fabsf(nx)));
            const float wlog = -sp - 0.5f; odw[i] = __expf(-__expf(wlog));
            const float aval = sigmoidf_(a0[i] + aa[i]);
            const float kkn = k4[i] * k_k[i] * inv; okk[i] = kkn; ob[i] = kkn * aval;
            const float kpv = k4[i] * (1.0f + (aval - 1.0f) * k_a[i]); okp[i] = kpv;
            bs += r4[i] * kpv * r_k[i];
        }
        *(f32x4*)(rp + d0) = odw; *(f32x4*)(rp + 64 + d0) = okk; *(f32x4*)(rp + 128 + d0) = ob; *(f32x4*)(rp + 192 + d0) = okp;
        *(f32x4*)(rp + 256 + d0) = (f32x4){r4[0], r4[1], r4[2], r4[3]}; *(f32x4*)(rp + 320 + d0) = (f32x4){v4[0], v4[1], v4[2], v4[3]};
        *(f32x4*)(gbuf + (size_t)m * 256 + c0) = ag;
        if (ct == 3) { float b2 = bs; b2 += __shfl_xor(b2, 16); b2 += __shfl_xor(b2, 32); if (fq == 0) bonus[(size_t)m * 4 + h] = b2; }
    }
}

__device__ __forceinline__ void nsa_prep_item(const Args& a, LAS unsigned char* lds, int b, int tt) {
    unsigned char* ws = a.ws; const int tid = opaque_tid();
    const bf16* z = (const bf16*)(ws + WS_Z);
    const float* ct = (const float*)(ws + WS_ROPE); const float* st = ct + (size_t)MT * 8;
    const int mb = b * SEQ + tt * 64;
    for (int task = tid; task < 64 * 12; task += NTHR) {
        const int tok = task / 12, unit = task % 12, m = mb + tok;
        const bf16* src; bf16* dst;
        if (unit < 8) { src = z + (size_t)m * ZLD + ZC_Q + unit * 64; dst = (bf16*)(ws + WS_QROT) + (size_t)m * 512 + unit * 64; }
        else if (unit < 10) { src = z + (size_t)m * ZLD + ZC_KS + (unit - 8) * 64; dst = (bf16*)(ws + WS_KSR) + (size_t)m * 128 + (unit - 8) * 64; }
        else { src = z + (size_t)m * ZLD + ZC_KW + (unit - 10) * 64; dst = (bf16*)(ws + WS_KWR) + (size_t)m * 128 + (unit - 10) * 64; }
        u32x4 v[8];
#pragma unroll
        for (int i = 0; i < 8; ++i) v[i] = ((const u32x4*)src)[i];
        const f32x4 c0 = *(const f32x4*)(ct + (size_t)m * 8), c1 = *(const f32x4*)(ct + (size_t)m * 8 + 4), s0 = *(const f32x4*)(st + (size_t)m * 8), s1 = *(const f32x4*)(st + (size_t)m * 8 + 4);
        const float cc[8] = {c0.x, c0.y, c0.z, c0.w, c1.x, c1.y, c1.z, c1.w}, sn[8] = {s0.x, s0.y, s0.z, s0.w, s1.x, s1.y, s1.z, s1.w};
        const float x1[8] = {bflo(v[0].x), bfhi(v[0].x), bflo(v[0].y), bfhi(v[0].y), bflo(v[0].z), bfhi(v[0].z), bflo(v[0].w), bfhi(v[0].w)};
        const float x2[8] = {bflo(v[1].x), bfhi(v[1].x), bflo(v[1].y), bfhi(v[1].y), bflo(v[1].z), bfhi(v[1].z), bflo(v[1].w), bfhi(v[1].w)};
        float o1[8], o2[8];
#pragma unroll
        for (int i = 0; i < 8; ++i) { o1[i] = x1[i] * cc[i] - x2[i] * sn[i]; o2[i] = x1[i] * sn[i] + x2[i] * cc[i]; }
        v[0] = (u32x4){pk2(o1[0], o1[1]), pk2(o1[2], o1[3]), pk2(o1[4], o1[5]), pk2(o1[6], o1[7])};
        v[1] = (u32x4){pk2(o2[0], o2[1]), pk2(o2[2], o2[3]), pk2(o2[4], o2[5]), pk2(o2[6], o2[7])};
#pragma unroll
        for (int i = 0; i < 8; ++i) ((u32x4*)dst)[i] = v[i];
    }
    LAS bf16* tile = (LAS bf16*)lds;
    { const int tok = tid >> 3, ch = tid & 7;
#pragma unroll
      for (int mi = 0; mi < 4; ++mi) { const int col = (mi < 2 ? ZC_VS : ZC_VW) + (mi & 1) * 64;
          *(LAS u32x4*)(tile + mi * 4608 + tok * 72 + ch * 8) = *(const u32x4*)(z + (size_t)(mb + tok) * ZLD + col + ch * 8); } }
    __syncthreads();
    { const int d = tid >> 3, tc = tid & 7;
#pragma unroll
      for (int mi = 0; mi < 4; ++mi) { unsigned e[8];
#pragma unroll
          for (int j = 0; j < 8; ++j) e[j] = tile[mi * 4608 + (tc * 8 + j) * 72 + d];
          u32x4 w; w.x = e[0] | (e[1] << 16); w.y = e[2] | (e[3] << 16); w.z = e[4] | (e[5] << 16); w.w = e[6] | (e[7] << 16);
          bf16* dst = (bf16*)(ws + (mi < 2 ? WS_VST : WS_VWT)) + ((size_t)(b * 2 + (mi & 1)) * 64 + d) * SEQ + tt * 64 + tc * 8;
          *(u32x4*)dst = w; } }
    __syncthreads();
}

__device__ __forceinline__ void nsa_compress_item(const Args& a, int layer, LAS unsigned char* lds, int b, int g, int kv, int nt) {
    unsigned char* ws = a.ws; const int tid = opaque_tid(), lane = tid & 63, wave = __builtin_amdgcn_readfirstlane(tid >> 6), fq = lane >> 4, fr = lane & 15;
    const bf16* z = (const bf16*)(ws + WS_Z);
    const bf16* w1t = (const bf16*)(ws + WS_CW1) + (size_t)(layer * 2 + kv) * 128 * 2048;
    const int colb = (kv ? ZC_VC : ZC_KC) + g * 64;
    f32x4 acc[8];
#pragma unroll
    for (int ht = 0; ht < 8; ++ht) acc[ht] = (f32x4){0.f, 0.f, 0.f, 0.f};
    for (int li = 0; li < 4; ++li) { const int l = wave * 4 + li;
        int tok = 256 * nt + 16 * fr + l; tok = tok > SEQ - 1 ? SEQ - 1 : tok;
#pragma unroll
        for (int hf = 0; hf < 2; ++hf) {
            const bf16x8 B = ld_bf8(z + (size_t)(b * SEQ + tok) * ZLD + colb + 32 * hf + 8 * fq);
#pragma unroll
            for (int ht = 0; ht < 8; ++ht) { const bf16x8 A = ld_bf8(w1t + (size_t)(16 * ht + fr) * 2048 + 64 * l + 32 * hf + 8 * fq);
                acc[ht] = __builtin_amdgcn_mfma_f32_16x16x32_bf16(A, B, acc[ht], 0, 0, 0); } } }
    LAS float* part = (LAS float*)lds;
    LAS float* hid = (LAS float*)(lds + 65536);
#pragma unroll
    for (int ht = 0; ht < 8; ++ht)
#pragma unroll
        for (int r = 0; r < 4; ++r) part[(wave * 128 + 16 * ht + 4 * fq + r) * 16 + fr] = acc[ht][r];
    __syncthreads();
    { const int hh = tid >> 2, nq = tid & 3; f32x4 s = (f32x4){0.f, 0.f, 0.f, 0.f};
#pragma unroll
      for (int w = 0; w < 8; ++w) s = s + *(LAS f32x4*)(part + (w * 128 + hh) * 16 + 4 * nq);
      float cb = 0.f; { const float* cbp = (const float*)(ws + WS_CBIAS) + (size_t)(layer * 2 + kv) * 16 * 128 + hh;
#pragma unroll
        for (int c = 0; c < 16; ++c) cb += cbp[c * 128]; }
      f32x4 o; o.x = gelu_tanh(s.x + cb); o.y = gelu_tanh(s.y + cb); o.z = gelu_tanh(s.z + cb); o.w = gelu_tanh(s.w + cb);
      *(LAS f32x4*)(hid + hh * 16 + 4 * nq) = o; }
    __syncthreads();
    { const float* W2 = INF(kv ? IN_VCW2 : IN_KCW2) + (size_t)layer * 128 * 64; const int n = tid & 15, dg = tid >> 4; float o0 = 0.f, o1 = 0.f;
      for (int hh = 0; hh < 128; ++hh) { const float x = hid[hh * 16 + n]; o0 += x * W2[hh * 64 + dg]; o1 += x * W2[hh * 64 + dg + 32]; }
      const int ng = 16 * nt + n; if (ng >= NCMP) { o0 = 0.f; o1 = 0.f; }
      if (kv == 0) { bf16* kc = (bf16*)(ws + WS_KCMP) + ((size_t)(b * 2 + g) * 256 + ng) * 64; kc[dg] = (bf16)f2bf(o0); kc[dg + 32] = (bf16)f2bf(o1); }
      else { bf16* vc = (bf16*)(ws + WS_VCMPT) + (size_t)(b * 2 + g) * 64 * 256; vc[(size_t)dg * 256 + ng] = (bf16)f2bf(o0); vc[(size_t)(dg + 32) * 256 + ng] = (bf16)f2bf(o1); } }
    __syncthreads();
}

__device__ __forceinline__ void phase_prep(const Args& a, int layer, LAS unsigned char* lds) {
    const int tid = opaque_tid(), lane = tid & 63, wave = __builtin_amdgcn_readfirstlane(tid >> 6);
#ifndef NO_RWP
    for (int tile = blockIdx.x * 4 + (wave & 3); tile < MT / 16; tile += gridDim.x * 4) rwkv_prep_tile(a, layer, tile * 16, lane, 8 * (wave >> 2), 8 * (wave >> 2) + 8);
#endif
#ifndef NO_NSAP
    for (int it = blockIdx.x; it < NB * 64; it += gridDim.x) nsa_prep_item(a, lds, it >> 6, it & 63);
#endif
#ifndef NO_CMP
    for (int it = blockIdx.x; it < NB * 2 * 2 * 16; it += gridDim.x) nsa_compress_item(a, layer, lds, it >> 6, (it >> 5) & 1, (it >> 4) & 1, it & 15);
#endif
}

__device__ __forceinline__ float dpp_xor1(float x) { return __builtin_bit_cast(float, __builtin_amdgcn_update_dpp(0, __builtin_bit_cast(int, x), 0xB1, 0xf, 0xf, true)); }
__device__ __forceinline__ float dpp_xor2(float x) { return __builtin_bit_cast(float, __builtin_amdgcn_update_dpp(0, __builtin_bit_cast(int, x), 0x4E, 0xf, 0xf, true)); }
__device__ __forceinline__ float dpp_hmir(float x) { return __builtin_bit_cast(float, __builtin_amdgcn_update_dpp(0, __builtin_bit_cast(int, x), 0x141, 0xf, 0xf, true)); }
__device__ __forceinline__ float red8(float x) { x += dpp_xor1(x); x += dpp_xor2(x); x += dpp_hmir(x); return x; }

__device__ __forceinline__ void rwkv_scan_seg(const Args& a, LAS unsigned char* lds, int bh, int seg) {
    unsigned char* ws = a.ws; const int tid = opaque_tid(), lane = tid & 63, wave = __builtin_amdgcn_readfirstlane(tid >> 6);
    const int row = wave * 8 + (lane >> 3), kq = lane & 7;
    const f32x4* rec4 = (const f32x4*)(ws + WS_REC) + ((size_t)bh * SEQ + (size_t)seg * SEGLEN) * 96;
    const size_t yoff = ((size_t)(bh >> 2) * SEQ + (size_t)seg * SEGLEN) * 256 + (bh & 3) * 64 + row;
    float* yraw = (float*)(ws + WS_YRAW) + yoff; float* ypb = (float*)(ws + WS_YP) + yoff;
    LAS f32x4* buf = (LAS f32x4*)lds;
    float s[8], q[8];
#pragma unroll
    for (int j = 0; j < 8; ++j) { s[j] = 0.f; q[j] = (8 * kq + j == row) ? 1.f : 0.f; }
    __syncthreads();
    { f32x4 p0 = rec4[tid], p1 = rec4[tid + 512], p2 = rec4[tid + 1024]; buf[tid] = p0; buf[tid + 512] = p1; buf[tid + 1024] = p2; }
    __syncthreads();
    for (int c = 0; c < SEGLEN / 16; ++c) {
        const int p = c & 1;
        f32x4 n0, n1, n2; const bool more = (c + 1 < SEGLEN / 16);
        if (more) { const f32x4* src = rec4 + (size_t)(c + 1) * 1536; n0 = src[tid]; n1 = src[tid + 512]; n2 = src[tid + 1024]; }
        const LAS f32x4* bp = buf + p * 1536;
#pragma unroll 2
        for (int st = 0; st < 16; ++st) {
            const LAS f32x4* sp = bp + st * 96;
            const f32x4 w0 = sp[2 * kq], w1 = sp[2 * kq + 1], k0 = sp[16 + 2 * kq], k1 = sp[16 + 2 * kq + 1], b0 = sp[32 + 2 * kq], b1 = sp[32 + 2 * kq + 1];
            const f32x4 q0 = sp[48 + 2 * kq], q1 = sp[48 + 2 * kq + 1], r0 = sp[64 + 2 * kq], r1 = sp[64 + 2 * kq + 1];
            const float vv = ((const LAS float*)(sp + 80))[row];
            const float wv[8] = {w0.x, w0.y, w0.z, w0.w, w1.x, w1.y, w1.z, w1.w}, kk[8] = {k0.x, k0.y, k0.z, k0.w, k1.x, k1.y, k1.z, k1.w};
            const float bv[8] = {b0.x, b0.y, b0.z, b0.w, b1.x, b1.y, b1.z, b1.w}, kp[8] = {q0.x, q0.y, q0.z, q0.w, q1.x, q1.y, q1.z, q1.w};
            const float rr[8] = {r0.x, r0.y, r0.z, r0.w, r1.x, r1.y, r1.z, r1.w};
            float d1 = (s[0] * kk[0] + s[1] * kk[1]) + (s[2] * kk[2] + s[3] * kk[3]) + ((s[4] * kk[4] + s[5] * kk[5]) + (s[6] * kk[6] + s[7] * kk[7]));
            float e1 = (q[0] * kk[0] + q[1] * kk[1]) + (q[2] * kk[2] + q[3] * kk[3]) + ((q[4] * kk[4] + q[5] * kk[5]) + (q[6] * kk[6] + q[7] * kk[7]));
            d1 += dpp_xor1(d1); e1 += dpp_xor1(e1); d1 += dpp_xor2(d1); e1 += dpp_xor2(e1); d1 += dpp_hmir(d1); e1 += dpp_hmir(e1);
            const float sa = -d1, sq = -e1;
            float d2 = 0.f, e2 = 0.f;
#pragma unroll
            for (int j = 0; j < 8; ++j) { s[j] = s[j] * wv[j] + (sa * bv[j] + vv * kp[j]); d2 += s[j] * rr[j]; q[j] = q[j] * wv[j] + sq * bv[j]; e2 += q[j] * rr[j]; }
            d2 += dpp_xor1(d2); e2 += dpp_xor1(e2); d2 += dpp_xor2(d2); e2 += dpp_xor2(e2); d2 += dpp_hmir(d2); e2 += dpp_hmir(e2);
            if (kq == 0) { yraw[(size_t)(c * 16 + st) * 256] = d2; ypb[(size_t)(c * 16 + st) * 256] = e2; }
        }
        if (more) { LAS f32x4* dp = buf + (p ^ 1) * 1536; dp[tid] = n0; dp[tid + 512] = n1; dp[tid + 1024] = n2; }
        __syncthreads();
    }
    float* se = (float*)(ws + WS_SEGE) + ((size_t)(bh * NSEG + seg) * 2) * 4096 + row * 64 + 8 * kq;
    *(f32x4*)se = (f32x4){s[0], s[1], s[2], s[3]}; *(f32x4*)(se + 4) = (f32x4){s[4], s[5], s[6], s[7]};
    *(f32x4*)(se + 4096) = (f32x4){q[0], q[1], q[2], q[3]}; *(f32x4*)(se + 4096 + 4) = (f32x4){q[4], q[5], q[6], q[7]};
}

__device__ __forceinline__ void rwkv_chain(const Args& a, LAS unsigned char* lds, int bh) {
    unsigned char* ws = a.ws; const int tid = opaque_tid();
    LAS float* S = (LAS float*)lds;
    LAS float* P = S + 64 * 68;
    const int v = tid >> 3, kg = tid & 7;
    float* sst = (float*)(ws + WS_SST) + (size_t)bh * NSEG * 4096;
    const float* sege = (const float*)(ws + WS_SEGE) + (size_t)bh * NSEG * 2 * 4096;
    __syncthreads();
    for (int i = tid; i < 64 * 68; i += NTHR) S[i] = 0.f;
    for (int i = tid; i < 4096; i += NTHR) sst[i] = 0.f;
    __syncthreads();
    for (int sg = 1; sg < NSEG; ++sg) {
        const float* e0 = sege + (size_t)(sg - 1) * 2 * 4096;
        for (int i = tid; i < 1024; i += NTHR) *(LAS f32x4*)(P + 4 * i) = *(const f32x4*)(e0 + 4096 + 4 * i);
        f32x4 o0 = *(const f32x4*)(e0 + v * 64 + 8 * kg), o1 = *(const f32x4*)(e0 + v * 64 + 8 * kg + 4);
        __syncthreads();
#pragma unroll 4
        for (int i = 0; i < 64; ++i) { const float sv = S[v * 68 + i]; const f32x4 p0 = *(const LAS f32x4*)(P + i * 64 + 8 * kg), p1 = *(const LAS f32x4*)(P + i * 64 + 8 * kg + 4);
            o0 = o0 + p0 * sv; o1 = o1 + p1 * sv; }
        __syncthreads();
        *(LAS f32x4*)(S + v * 68 + 8 * kg) = o0; *(LAS f32x4*)(S + v * 68 + 8 * kg + 4) = o1;
        *(f32x4*)(sst + (size_t)sg * 4096 + v * 64 + 8 * kg) = o0; *(f32x4*)(sst + (size_t)sg * 4096 + v * 64 + 8 * kg + 4) = o1;
        __syncthreads();
    }
}

__device__ __forceinline__ void rwkv_post_item(const Args& a, int layer, LAS unsigned char* lds, int bh, int tile) {
    unsigned char* ws = a.ws; const int tid = opaque_tid();
    const int seg = tile / (SEGLEN / 64), bb = bh >> 2, h = bh & 3;
    LAS float* S = (LAS float*)lds;
    LAS float* YP = S + 64 * 68;
    const float* sst = (const float*)(ws + WS_SST) + (size_t)(bh * NSEG + seg) * 4096;
    const size_t m0 = (size_t)bb * SEQ + (size_t)tile * 64;
    __syncthreads();
    for (int i = tid; i < 1024; i += NTHR) { const int r = i >> 4, c4 = i & 15; *(LAS f32x4*)(S + r * 68 + 4 * c4) = *(const f32x4*)(sst + r * 64 + 4 * c4);
        *(LAS f32x4*)(YP + r * 68 + 4 * c4) = *(const f32x4*)((const float*)(ws + WS_YP) + (m0 + r) * 256 + h * 64 + 4 * c4); }
    __syncthreads();
    const int tok = tid >> 3, vg = tid & 7; const size_t m = m0 + tok; const int c0 = h * 64 + 8 * vg;
    const f32x4 ya = *(const f32x4*)((const float*)(ws + WS_YRAW) + m * 256 + c0), yb = *(const f32x4*)((const float*)(ws + WS_YRAW) + m * 256 + c0 + 4);
    float y[8] = {ya.x, ya.y, ya.z, ya.w, yb.x, yb.y, yb.z, yb.w};
    if (seg > 0) {
#pragma unroll 4
        for (int i = 0; i < 64; i += 4) { const f32x4 yp = *(const LAS f32x4*)(YP + tok * 68 + i);
#pragma unroll
            for (int j = 0; j < 8; ++j) { const f32x4 sr = *(const LAS f32x4*)(S + (8 * vg + j) * 68 + i); y[j] += (sr.x * yp.x + sr.y * yp.y) + (sr.z * yp.z + sr.w * yp.w); } }
    }
    float sm = 0.f;
#pragma unroll
    for (int j = 0; j < 8; ++j) sm += y[j];
    sm += __shfl_xor(sm, 1); sm += __shfl_xor(sm, 2); sm += __shfl_xor(sm, 4);
    const float mean = sm * (1.0f / 64.0f); float qq = 0.f;
#pragma unroll
    for (int j = 0; j < 8; ++j) { y[j] -= mean; qq += y[j] * y[j]; }
    qq += __shfl_xor(qq, 1); qq += __shfl_xor(qq, 2); qq += __shfl_xor(qq, 4);
    const float rstd = 1.0f / sqrtf(qq * (1.0f / 64.0f) + 64e-5f);
    const float* gng = INF(IN_RWGNG) + layer * 256 + c0; const float* gnb = INF(IN_RWGNB) + layer * 256 + c0;
    const float* gt = (const float*)(ws + WS_G) + m * 256 + c0;
    const float* vv = (const float*)(ws + WS_REC) + ((size_t)bh * SEQ + (size_t)tile * 64 + tok) * 384 + 320 + 8 * vg;
    const float bo = ((const float*)(ws + WS_BONUS))[m * 4 + h];
    float o[8];
#pragma unroll
    for (int j = 0; j < 8; ++j) o[j] = (y[j] * rstd * gng[j] + gnb[j] + vv[j] * bo) * gt[j];
    u32x4 w; w.x = pk2(o[0], o[1]); w.y = pk2(o[2], o[3]); w.z = pk2(o[4], o[5]); w.w = pk2(o[6], o[7]);
    *(u32x4*)((bf16*)(ws + WS_YCAT) + m * DM + 256 + c0) = w;
}

__device__ __forceinline__ void gmlp_item(const Args& a, int layer, LAS unsigned char* lds, int b, int n, int h) {
    unsigned char* ws = a.ws; const int tid = opaque_tid(), lane = tid & 63, wave = __builtin_amdgcn_readfirstlane(tid >> 6), fq = lane >> 4, fr = lane & 15;
    const bf16* z = (const bf16*)(ws + WS_Z); bf16* ycat = (bf16*)(ws + WS_YCAT);
    LAS bf16* vt = (LAS bf16*)lds;
    const int mb = b * SEQ + n * 128;
    { const int s = tid >> 2, part = tid & 3; const bf16* src = z + (size_t)(mb + s) * ZLD + ZC_V + h * 64 + part * 16;
      const u32x4 v0 = ((const u32x4*)src)[0], v1 = ((const u32x4*)src)[1];
      float x[16] = {bflo(v0.x), bfhi(v0.x), bflo(v0.y), bfhi(v0.y), bflo(v0.z), bfhi(v0.z), bflo(v0.w), bfhi(v0.w), bflo(v1.x), bfhi(v1.x), bflo(v1.y), bfhi(v1.y), bflo(v1.z), bfhi(v1.z), bflo(v1.w), bfhi(v1.w)};
      float sm = 0.f;
#pragma unroll
      for (int j = 0; j < 16; ++j) { x[j] = gelu_tanh(x[j]); sm += x[j]; }
      sm += __shfl_xor(sm, 1); sm += __shfl_xor(sm, 2);
      const float mean = sm * (1.0f / 64.0f); float q = 0.f;
#pragma unroll
      for (int j = 0; j < 16; ++j) { x[j] -= mean; q += x[j] * x[j]; }
      q += __shfl_xor(q, 1); q += __shfl_xor(q, 2);
      const float rstd = 1.0f / sqrtf(q * (1.0f / 64.0f) + 1e-5f);
      const float* lg = INF(IN_GMLNG) + (layer * 4 + h) * 64 + part * 16; const float* lb = INF(IN_GMLNB) + (layer * 4 + h) * 64 + part * 16;
#pragma unroll
      for (int j = 0; j < 16; ++j) vt[(part * 16 + j) * 136 + s] = (bf16)f2bf(x[j] * rstd * lg[j] + lb[j]); }
    __syncthreads();
    {
        const float* W = INF(IN_GMWS) + ((size_t)(layer * 4 + h) * 128 + 16 * wave + fr) * 128;
        f32x4 acc[4];
#pragma unroll
        for (int dt = 0; dt < 4; ++dt) acc[dt] = (f32x4){0.f, 0.f, 0.f, 0.f};
        const int trow = 16 * wave + fr; const int nks = (wave >> 1) + 1;
        for (int ks = 0; ks < nks; ++ks) {
            const int s0 = 32 * ks + 8 * fq; const f32x4 wa = *(const f32x4*)(W + s0), wb = *(const f32x4*)(W + s0 + 4);
            float wv[8] = {wa.x, wa.y, wa.z, wa.w, wb.x, wb.y, wb.z, wb.w};
#pragma unroll
            for (int j = 0; j < 8; ++j) wv[j] = (s0 + j <= trow) ? wv[j] : 0.f;
            const bf16x8 A = pack8(wv);
#pragma unroll
            for (int dt = 0; dt < 4; ++dt) { const bf16x8 B = *(const LAS bf16x8*)(vt + (16 * dt + fr) * 136 + s0); acc[dt] = __builtin_amdgcn_mfma_f32_16x16x32_bf16(A, B, acc[dt], 0, 0, 0); } }
        const float* bs = INF(IN_GMBS) + (layer * 4 + h) * 128;
#pragma unroll
        for (int r = 0; r < 4; ++r) { const int t = 16 * wave + 4 * fq + r; const float bias = bs[t];
#pragma unroll
            for (int dt = 0; dt < 4; ++dt) { const int d = 16 * dt + fr; const float u = gelu_tanh(bf2f(z[(size_t)(mb + t) * ZLD + ZC_U + h * 64 + d]));
                ycat[(size_t)(mb + t) * DM + h * 64 + d] = (bf16)f2bf(u * (acc[dt][r] + bias)); } }
    }
    __syncthreads();
}

constexpr int NSA_KB = 0, NSA_VB = 18432, NSA_IMP = 36864, NSA_SELM = 53248, NSA_UNI = 53760, NSA_OT = 54272;
struct NsaTileSrc { const bf16* kbase; int kld; const bf16* vbase; int vld; };

__device__ __forceinline__ void nsa_tile_load(const NsaTileSrc& S, int kb, int tid, u32x4& kr, u32x4& vr) {
    const int row = tid >> 3, ch = tid & 7;
    kr = *(const u32x4*)(S.kbase + (size_t)(kb * 64 + row) * S.kld + ch * 8);
    vr = *(const u32x4*)(S.vbase + (size_t)row * S.vld + kb * 64 + ch * 8);
}
__device__ __forceinline__ void nsa_tile_store(LAS unsigned char* lds, int p, int tid, const u32x4& kr, const u32x4& vr) {
    const int row = tid >> 3, ch = tid & 7;
    *(LAS u32x4*)(lds + NSA_KB + p * 9216 + (row * 72 + ch * 8) * 2) = kr;
    *(LAS u32x4*)(lds + NSA_VB + p * 9216 + (row * 72 + ch * 8) * 2) = vr;
}
__device__ __forceinline__ void nsa_scores(LAS unsigned char* lds, int p, const bf16x8 (&Q)[2][2], f32x4 (&sc)[4][2], int fq, int fr) {
#pragma unroll
    for (int kt = 0; kt < 4; ++kt) {
        const LAS unsigned char* kp = lds + NSA_KB + p * 9216 + ((16 * kt + fr) * 72 + 8 * fq) * 2;
        const bf16x8 K0 = *(const LAS bf16x8*)kp, K1 = *(const LAS bf16x8*)(kp + 64);
#pragma unroll
        for (int qg = 0; qg < 2; ++qg) { f32x4 c = (f32x4){0.f, 0.f, 0.f, 0.f};
            c = __builtin_amdgcn_mfma_f32_16x16x32_bf16(K0, Q[qg][0], c, 0, 0, 0); c = __builtin_amdgcn_mfma_f32_16x16x32_bf16(K1, Q[qg][1], c, 0, 0, 0); sc[kt][qg] = c; } }
}
template <int MODE>
__device__ __forceinline__ bool nsa_allowed(int kidx, int t, int kb, unsigned long long selm) {
    if (MODE == 0) return (16 * kidx + 31 <= t) && (kidx < NCMP);
    if (MODE == 1) return (kidx <= t) && ((selm >> kb) & 1ull);
    return (kidx <= t) && (kidx + 512 > t);
}
template <int MODE, int MM>
__device__ __forceinline__ void nsa_tile_compute(LAS unsigned char* lds, int p, int kb, const bf16x8 (&Q)[2][2], const int (&tq)[2], const unsigned long long (&selm)[2],
                                                 float (&m_run)[2], float (&l_run)[2], f32x4 (&O)[4][2], int fq, int fr) {
    f32x4 sc[4][2];
    nsa_scores(lds, p, Q, sc, fq, fr);
    const float SC = 0.125f * 1.4426950408889634f;
    bf16x8 P[2][2]; float alpha[2];
#pragma unroll
    for (int qg = 0; qg < 2; ++qg) {
        float mx = -1e30f; float tokf = 1.0f;
        if (MM == 2) {
#pragma unroll
            for (int kt = 0; kt < 4; ++kt)
#pragma unroll
                for (int r = 0; r < 4; ++r) { const int kidx = kb * 64 + 16 * kt + 4 * fq + r;
                    const float v = nsa_allowed<MODE>(kidx, tq[qg], kb, selm[qg]) ? sc[kt][qg][r] * SC : -1e30f; sc[kt][qg][r] = v; mx = fmaxf(mx, v); }
        } else {
#pragma unroll
            for (int kt = 0; kt < 4; ++kt) mx = fmaxf(fmaxf(mx, fmaxf(sc[kt][qg][0], sc[kt][qg][1])), fmaxf(sc[kt][qg][2], sc[kt][qg][3]));
            mx *= SC;
            if (MM == 1) { const bool ok = (selm[qg] >> kb) & 1ull; tokf = ok ? 1.0f : 0.0f; mx = ok ? mx : -1e30f; }
        }
        mx = fmaxf(mx, __shfl_xor(mx, 16)); mx = fmaxf(mx, __shfl_xor(mx, 32));
        const float mn = fmaxf(m_run[qg], mx); alpha[qg] = __builtin_amdgcn_exp2f(m_run[qg] - mn); m_run[qg] = mn;
        float ls = 0.f; float pv[4][4];
#pragma unroll
        for (int kt = 0; kt < 4; ++kt)
#pragma unroll
            for (int r = 0; r < 4; ++r) { float e;
                if (MM == 2) { const float sv = sc[kt][qg][r]; e = (sv > -1e29f) ? __builtin_amdgcn_exp2f(sv - mn) : 0.f; }
                else { e = __builtin_amdgcn_exp2f(__builtin_fmaf(sc[kt][qg][r], SC, -mn)); if (MM == 1) e *= tokf; }
                pv[kt][r] = e; ls += e; }
        l_run[qg] = l_run[qg] * alpha[qg] + ls;
#pragma unroll
        for (int s = 0; s < 2; ++s) { u32x4 w; w.x = pg8::cvt_pk_bf16(pv[2 * s][0], pv[2 * s][1]); w.y = pg8::cvt_pk_bf16(pv[2 * s][2], pv[2 * s][3]); w.z = pg8::cvt_pk_bf16(pv[2 * s + 1][0], pv[2 * s + 1][1]); w.w = pg8::cvt_pk_bf16(pv[2 * s + 1][2], pv[2 * s + 1][3]);
            P[qg][s] = __builtin_bit_cast(bf16x8, w); }
    }
    if (!__all(alpha[0] == 1.0f && alpha[1] == 1.0f)) {
#pragma unroll
        for (int qg = 0; qg < 2; ++qg)
#pragma unroll
            for (int dt = 0; dt < 4; ++dt) O[dt][qg] = O[dt][qg] * alpha[qg];
    }
#pragma unroll
    for (int dt = 0; dt < 4; ++dt)
#pragma unroll
        for (int s = 0; s < 2; ++s) {
            const LAS unsigned char* vp = lds + NSA_VB + p * 9216 + ((16 * dt + fr) * 72 + 32 * s + 4 * fq) * 2;
            const u32x2 a0 = *(const LAS u32x2*)vp, a1 = *(const LAS u32x2*)(vp + 32);
            const u32x4 aw = (u32x4){a0.x, a0.y, a1.x, a1.y}; const bf16x8 A = __builtin_bit_cast(bf16x8, aw);
#pragma unroll
            for (int qg = 0; qg < 2; ++qg) O[dt][qg] = __builtin_amdgcn_mfma_f32_16x16x32_bf16(A, P[qg][s], O[dt][qg], 0, 0, 0);
        }
}

template <int MODE>
__device__ __forceinline__ void nsa_branch(LAS unsigned char* lds, const NsaTileSrc& S, int kb_lo, int kb_hi, int full_lo, int full_hi, unsigned long long tilemask, const bf16x8 (&Q)[2][2], const int (&tq)[2],
                                           const unsigned long long (&selm)[2], const float (&gate)[2], const bool first, float (&m_out)[2], float (&l_out)[2], int tid, int fq, int fr) {
    float m_run[2] = {-1e30f, -1e30f}, l_run[2] = {0.f, 0.f}; f32x4 O[4][2];
#pragma unroll
    for (int dt = 0; dt < 4; ++dt)
#pragma unroll
        for (int qg = 0; qg < 2; ++qg) O[dt][qg] = (f32x4){0.f, 0.f, 0.f, 0.f};
    int cur = kb_lo; while (cur <= kb_hi && !((tilemask >> cur) & 1ull)) ++cur;
    if (cur <= kb_hi) {
        u32x4 kr, vr; nsa_tile_load(S, cur, tid, kr, vr); nsa_tile_store(lds, 0, tid, kr, vr);
        __syncthreads();
        int p = 0;
        while (cur <= kb_hi) {
            int nxt = cur + 1; while (nxt <= kb_hi && !((tilemask >> nxt) & 1ull)) ++nxt;
            if (nxt <= kb_hi) nsa_tile_load(S, nxt, tid, kr, vr);
            if (MODE != 0 && cur >= full_lo && cur <= full_hi) nsa_tile_compute<MODE, (MODE == 1 ? 1 : 0)>(lds, p, cur, Q, tq, selm, m_run, l_run, O, fq, fr);
            else nsa_tile_compute<MODE, 2>(lds, p, cur, Q, tq, selm, m_run, l_run, O, fq, fr);
            if (nxt <= kb_hi) nsa_tile_store(lds, p ^ 1, tid, kr, vr);
            __syncthreads();
            p ^= 1; cur = nxt;
        }
    }
#pragma unroll
    for (int qg = 0; qg < 2; ++qg) { float l = l_run[qg]; l += __shfl_xor(l, 16); l += __shfl_xor(l, 32); l_out[qg] = l; m_out[qg] = m_run[qg];
        const float sc = l > 0.f ? gate[qg] / l : 0.f;
        LAS float* ot = (LAS float*)(lds + NSA_OT) + tid;
#pragma unroll
        for (int dt = 0; dt < 4; ++dt)
#pragma unroll
            for (int r = 0; r < 4; ++r) { LAS float* pp = ot + ((dt * 2 + qg) * 4 + r) * 512; const float v = O[dt][qg][r] * sc; *pp = first ? v : (*pp + v); } }
}

__device__ __forceinline__ void nsa_item(const Args& a, LAS unsigned char* lds, int b, int g, int T) {
    unsigned char* ws = a.ws; const int tid = opaque_tid(), lane = tid & 63, wave = __builtin_amdgcn_readfirstlane(tid >> 6), fq = lane >> 4, fr = lane & 15;
    const bf16* z = (const bf16*)(ws + WS_Z);
    const int head = g * 4 + (fr & 3);
    int tq[2], mq[2]; bf16x8 Qraw[2][2]; float gt[2][3];
#pragma unroll
    for (int qg = 0; qg < 2; ++qg) { const int tl = 8 * wave + 4 * qg + (fr >> 2); tq[qg] = T * 64 + tl; mq[qg] = b * SEQ + tq[qg];
#pragma unroll
        for (int ks = 0; ks < 2; ++ks) Qraw[qg][ks] = ld_bf8(z + (size_t)mq[qg] * ZLD + ZC_Q + head * 64 + 32 * ks + 8 * fq);
#pragma unroll
        for (int br = 0; br < 3; ++br) gt[qg][br] = sigmoidf_(bf2f(z[(size_t)mq[qg] * ZLD + ZC_GT + head * 3 + br])); }
    if (tid < 64) { ((LAS unsigned long long*)(lds + NSA_SELM))[tid] = 0ull; if (tid < 2) ((LAS unsigned*)(lds + NSA_UNI))[tid] = 0u; }
    const unsigned long long nosel[2] = {0ull, 0ull};
    NsaTileSrc SC_; SC_.kbase = (const bf16*)(ws + WS_KCMP) + (size_t)(b * 2 + g) * 256 * 64; SC_.kld = 64; SC_.vbase = (const bf16*)(ws + WS_VCMPT) + (size_t)(b * 2 + g) * 64 * 256; SC_.vld = 256;
    float mc[2], lc[2];
    { float gc[2] = {gt[0][0], gt[1][0]};
      nsa_branch<0>(lds, SC_, 0, 3, 1, 0, ~0ull, Qraw, tq, nosel, gc, true, mc, lc, tid, fq, fr); }
    {
        LAS float* imp = (LAS float*)(lds + NSA_IMP);
        float carry[2] = {0.f, 0.f}; const float SCL = 0.125f * 1.4426950408889634f;
        float invl[2] = {lc[0] > 0.f ? 1.0f / lc[0] : 0.f, lc[1] > 0.f ? 1.0f / lc[1] : 0.f};
        for (int kb = 0; kb < 4; ++kb) {
            { const int row = tid >> 3, ch = tid & 7; *(LAS u32x4*)(lds + NSA_KB + (row * 72 + ch * 8) * 2) = *(const u32x4*)(SC_.kbase + (size_t)(kb * 64 + row) * 64 + ch * 8); }
            __syncthreads();
            f32x4 sc[4][2]; nsa_scores(lds, 0, Qraw, sc, fq, fr);
#pragma unroll
            for (int kt = 0; kt < 4; ++kt)
#pragma unroll
                for (int qg = 0; qg < 2; ++qg) { float pn[4];
#pragma unroll
                    for (int r = 0; r < 4; ++r) { const int kidx = kb * 64 + 16 * kt + 4 * fq + r; const bool al = nsa_allowed<0>(kidx, tq[qg], kb, 0ull);
                        pn[r] = al ? __builtin_amdgcn_exp2f(sc[kt][qg][r] * SCL - mc[qg]) * invl[qg] : 0.f; }
                    const float y = __shfl(pn[3], (lane + 48) & 63);
                    float v = (pn[0] + pn[1]) + (pn[2] + pn[3]) + (fq == 0 ? carry[qg] : y); carry[qg] = y;
                    v += __shfl_xor(v, 1); v += __shfl_xor(v, 2);
                    if ((fr & 3) == 0) imp[(8 * wave + 4 * qg + (fr >> 2)) * 64 + 16 * kb + 4 * kt + fq] = v; }
            __syncthreads();
        }
    }
    {
        const LAS float* imp = (const LAS float*)(lds + NSA_IMP);
        const int tl = tid >> 3, part = tid & 7; float vm[8]; int cnt[8];
        { const f32x4 x0 = *(const LAS f32x4*)(imp + tl * 64 + part * 8), x1 = *(const LAS f32x4*)(imp + tl * 64 + part * 8 + 4);
          const float xx[8] = {x0.x, x0.y, x0.z, x0.w, x1.x, x1.y, x1.z, x1.w};
#pragma unroll
          for (int j = 0; j < 8; ++j) { const int mi = part * 8 + j; const bool valid = mi <= T; const bool forced = (mi == 0) || (mi == T) || (mi == T - 1);
              vm[j] = valid ? xx[j] + (forced ? 1e4f : 0.f) : -1e4f; cnt[j] = 0; } }
        for (int q4 = 0; q4 < 16; ++q4) { const f32x4 x = *(const LAS f32x4*)(imp + tl * 64 + 4 * q4); const float xq[4] = {x.x, x.y, x.z, x.w};
#pragma unroll
            for (int i = 0; i < 4; ++i) { const int q = 4 * q4 + i; const bool valid = q <= T; const bool forced = (q == 0) || (q == T) || (q == T - 1);
                const float vq = valid ? xq[i] + (forced ? 1e4f : 0.f) : -1e4f;
#pragma unroll
                for (int j = 0; j < 8; ++j) { const int mi = part * 8 + j; cnt[j] += (vq > vm[j] || (vq == vm[j] && q < mi)) ? 1 : 0; } } }
        unsigned bits = 0u;
#pragma unroll
        for (int j = 0; j < 8; ++j) if (cnt[j] < 16 && vm[j] > -5000.f) bits |= 1u << j;
        atomicOr((unsigned*)(lds + NSA_SELM) + tl * 2 + (part >> 2), bits << (8 * (part & 3)));
        atomicOr((unsigned*)(lds + NSA_UNI) + (part >> 2), bits << (8 * (part & 3)));
    }
    __syncthreads();
    bf16x8 Qrot[2][2];
#pragma unroll
    for (int qg = 0; qg < 2; ++qg)
#pragma unroll
        for (int ks = 0; ks < 2; ++ks) Qrot[qg][ks] = ld_bf8((const bf16*)(ws + WS_QROT) + (size_t)mq[qg] * 512 + head * 64 + 32 * ks + 8 * fq);
    unsigned long long selm[2], uni;
    { const LAS unsigned long long* sm = (const LAS unsigned long long*)(lds + NSA_SELM); selm[0] = sm[8 * wave + (fr >> 2)]; selm[1] = sm[8 * wave + 4 + (fr >> 2)]; const LAS unsigned* up = (const LAS unsigned*)(lds + NSA_UNI); uni = ((unsigned long long)(unsigned)__builtin_amdgcn_readfirstlane(up[1]) << 32) | (unsigned)__builtin_amdgcn_readfirstlane(up[0]); }
    { NsaTileSrc SS; SS.kbase = (const bf16*)(ws + WS_KSR) + (size_t)b * SEQ * 128 + g * 64; SS.kld = 128; SS.vbase = (const bf16*)(ws + WS_VST) + (size_t)(b * 2 + g) * 64 * SEQ; SS.vld = SEQ;
      float gs[2] = {gt[0][1], gt[1][1]}, mo[2], lo[2];
      nsa_branch<1>(lds, SS, 0, T, 0, T - 1, uni, Qrot, tq, selm, gs, false, mo, lo, tid, fq, fr); }
    { NsaTileSrc SW; SW.kbase = (const bf16*)(ws + WS_KWR) + (size_t)b * SEQ * 128 + g * 64; SW.kld = 128; SW.vbase = (const bf16*)(ws + WS_VWT) + (size_t)(b * 2 + g) * 64 * SEQ; SW.vld = SEQ;
      float gw_[2] = {gt[0][2], gt[1][2]}, mo[2], lo[2]; const int lo_kb = T >= 8 ? T - 8 : 0;
      nsa_branch<2>(lds, SW, lo_kb, T, T - 7, T - 1, ~0ull, Qrot, tq, nosel, gw_, false, mo, lo, tid, fq, fr); }
    bf16* ycat = (bf16*)(ws + WS_YCAT);
#pragma unroll
    for (int qg = 0; qg < 2; ++qg)
#pragma unroll
        for (int dt = 0; dt < 4; ++dt) { const LAS float* ot = (const LAS float*)(lds + NSA_OT) + tid + ((dt * 2 + qg) * 4) * 512;
            u32x2 w; w.x = pk2(ot[0], ot[512]); w.y = pk2(ot[1024], ot[1536]);
            *(u32x2*)(ycat + (size_t)mq[qg] * DM + 512 + head * 64 + 16 * dt + 4 * fq) = w; }
}

struct MoeOrder {
    const char* A; const char* W; size_t estride; int K, nct, G, c; int tst[9];
    __device__ bool next(int i, pg8::Unit& u) const {
        const long L = (long)i * G + c; if (L >= (long)tst[8] * nct) return false;
        const int rt = (int)(L / nct), ct = (int)(L % nct); int e = 0;
#pragma unroll
        for (int j = 1; j < 8; ++j) e += (rt >= tst[j]) ? 1 : 0;
        u.pm = rt; u.pn = ct; u.aux = e; return true;
    }
    __device__ __forceinline__ const char* abase(const pg8::Unit& u) const { return A + (size_t)u.pm * ((size_t)256 * K * 2); }
    __device__ __forceinline__ const char* bbase(const pg8::Unit& u) const { return W + (size_t)u.aux * estride + (size_t)u.pn * ((size_t)256 * K * 2); }
};
__device__ __forceinline__ void moe_order_init(MoeOrder& S, const Args& a, int rank, const void* A, const void* W, size_t estride, int K, int nct) {
    S.A = (const char*)A; S.W = (const char*)W; S.estride = estride; S.K = K; S.nct = nct; S.G = gridDim.x; S.c = blockIdx.x;
    const int* t = (const int*)(a.ws + WS_SLOT + SL_TST) + rank * 16;
#pragma unroll
    for (int j = 0; j < 9; ++j) S.tst[j] = __builtin_amdgcn_readfirstlane(t[j]);
}
__device__ __forceinline__ void moe_gather(const Args& a, int rb, int r) {
    unsigned char* ws = a.ws; const int tid = opaque_tid();
    const int* toks = (const int*)(ws + WS_SLOT + SL_TOKS);
    const u32x4* hn = (const u32x4*)(ws + WS_HN); u32x4* hns = (u32x4*)(ws + WS_HNS);
    for (int i = tid; i < 64 * 128; i += NTHR) { const int tl = i >> 7, ch = i & 127, m = rb * 64 + tl; const int slot = toks[2 * m + r];
        hns[(size_t)slot * 128 + ch] = hn[(size_t)m * 128 + ch]; }
}
__device__ __forceinline__ void phase_moe_assign(const Args& a, LAS unsigned char* lds) {
    unsigned char* ws = a.ws; const int tid = opaque_tid(), lane = tid & 63, wave = __builtin_amdgcn_readfirstlane(tid >> 6);
    LAS int* cn = (LAS int*)lds;
    LAS int* tot = cn + 4096; LAS int* base = tot + 16; LAS int* pre = base + 16;
    const int* bcnt = (const int*)(ws + WS_SLOT + SL_BCNT);
    for (int i = tid; i < 4096; i += NTHR) cn[i] = bcnt[i];
    __syncthreads();
    if (tid < 16) { int s = 0; for (int bb = 0; bb < 256; ++bb) s += cn[bb * 16 + tid]; tot[tid] = s; }
    __syncthreads();
    if (tid < 2) { int run = 0; int* tstg = (int*)(ws + WS_SLOT + SL_TST) + tid * 16;
        for (int e = 0; e < 8; ++e) { base[tid * 8 + e] = run * 256; if (blockIdx.x == 0) tstg[e] = run; run += (tot[tid * 8 + e] + 255) >> 8; }
        if (blockIdx.x == 0) tstg[8] = run; }
    __syncthreads();
    int* stok = (int*)(ws + WS_SLOT + SL_TOK); float* sgate = (float*)(ws + WS_SLOT + SL_GATE);
    if (blockIdx.x == 0) {
        for (int grp = 0; grp < 16; ++grp) { const int r = grp >> 3, lo = base[grp] + tot[grp], hi = base[grp] + (((tot[grp] + 255) >> 8) << 8);
            for (int s = lo + tid; s < hi; s += NTHR) { stok[r * MOE_SLOTS + s] = -1; sgate[r * MOE_SLOTS + s] = 0.f; } }
    }
    const int* te = (const int*)(ws + WS_SLOT + SL_TOKE); const float* tg = (const float*)(ws + WS_SLOT + SL_TOKG); int* toks = (int*)(ws + WS_SLOT + SL_TOKS);
    for (int rb = blockIdx.x; rb < MT / 64; rb += gridDim.x) {
        __syncthreads();
        if (tid < 16) { int s = 0; for (int bb = 0; bb < rb; ++bb) s += cn[bb * 16 + tid]; pre[tid] = s; }
        __syncthreads();
        if (wave == 0) { const int m = rb * 64 + lane;
#pragma unroll
            for (int r = 0; r < 2; ++r) { const int e = te[2 * m + r]; int slot = 0;
#pragma unroll
                for (int ee = 0; ee < 8; ++ee) { const unsigned long long mk = __ballot(e == ee); const int rk = __popcll(mk & ((1ull << lane) - 1ull)); if (e == ee) slot = base[r * 8 + ee] + pre[r * 8 + ee] + rk; }
                stok[r * MOE_SLOTS + slot] = m; sgate[r * MOE_SLOTS + slot] = tg[2 * m + r]; toks[2 * m + r] = slot; } }
        asm volatile("s_waitcnt vmcnt(0)" ::: "memory");
        __syncthreads();
        moe_gather(a, rb, 0);
    }
}
__device__ __forceinline__ void moe_convert_weights(const Args& a, LAS unsigned char* lds) {
    const int tid = opaque_tid(), lane = tid & 63, wave = __builtin_amdgcn_readfirstlane(tid >> 6);
    const int gw = blockIdx.x * NWAVES + wave, NGW = gridDim.x * NWAVES; LAS float* scr = (LAS float*)(lds + 1024 + wave * 16384);
    for (int e = 0; e < NEXP; ++e) {
        conv_matrix(INF(IN_MW1) + (size_t)e * DM * DFF, DM, DFF, (bf16*)(a.ws + WS_MW13) + (size_t)e * 5632 * DM, 1, gw, NGW, scr, lane);
        conv_matrix(INF(IN_MW3) + (size_t)e * DM * DFF, DM, DFF, (bf16*)(a.ws + WS_MW13) + (size_t)e * 5632 * DM, 2, gw, NGW, scr, lane);
        conv_matrix(INF(IN_MW2) + (size_t)e * DFF * DM, DFF, DM, (bf16*)(a.ws + WS_MW2) + (size_t)e * DM * DFF, 0, gw, NGW, scr, lane);
    }
}

constexpr int NPL = 15, NPHASES = 1 + 2 * NPL;
__host__ __device__ constexpr bool phase_empty(int k) { return k >= 1 && k < 1 + NPL && ((k - 1) >= 9 && (k - 1) <= 11); }

__global__ void __launch_bounds__(NTHR, 2) hybrid_fwd(Args a) {
    extern __shared__ __attribute__((aligned(16))) unsigned char lds_raw[];
    LAS unsigned char* lds = (LAS unsigned char*)lds_raw;
    volatile LAS unsigned* MISC = (volatile LAS unsigned*)(lds + MISC_OFF);
    const int tid = opaque_tid();
    unsigned char* ws = a.ws; unsigned* ctl = (unsigned*)(ws + WS_CTL);
    for (int u = tid; u < (LDS_BYTES - MISC_OFF) / 4; u += NTHR) MISC[u] = 0u;
    __syncthreads();
    if (tid < N_INPUTS) *(LAS unsigned long long*)(lds + PTAB_OFF + 8 * tid) = (unsigned long long)a.in[tid];
    __syncthreads();
    const int lo = a.ph_lo, hi = a.ph_hi;
    const bool multi = (hi - lo) > 1;
    XcdBarrier bar; bar.bar = ctl + CW_BAR; bar.x = 0; bar.st = nullptr;
    if (multi) bar = xcd_barrier_post(ctl + CW_BAR, MISC + 8);
#ifndef PHSEL
#define PHSEL -1
#endif
#ifndef REP_GIN
#define REP_GIN 1
#endif
#ifndef REP_PREP
#define REP_PREP 1
#endif
#ifndef REP_NSA
#define REP_NSA 1
#endif
#ifndef REP_SCAN
#define REP_SCAN 1
#endif
#ifndef REP_GMLP
#define REP_GMLP 1
#endif
#ifndef REP_F1
#define REP_F1 1
#endif
#ifndef REP_PRO
#define REP_PRO 1
#endif
#define IN(k) (lo <= (k) && (k) < hi)
#define INL(j) ((PHSEL == -1 || PHSEL == (j)) && IN(pb + (j)))
#define SEAM(k) do { if ((k) + 1 < hi) xcd_barrier(bar); } while (0)
    const int G = gridDim.x, bx = blockIdx.x;

    if ((PHSEL == -1 || PHSEL == 100) && IN(0)) { for (int rep = 0; rep < REP_PRO; ++rep) { phase_prologue(a, lds); __syncthreads(); } SEAM(0); }

    for (int l = 0; l < 2; ++l) {
        const int pb = 1 + l * NPL;
        if (INL(0)) for (int rep = 0; rep < REP_GIN; ++rep) { pg8::StaticOrder S; S.init(ws + WS_HN, (bf16*)(ws + WS_WIN) + (size_t)l * ZLD * DM, MT, ZLD, DM, G, bx);
            pg8::EpiBf16Store E{(bf16*)(ws + WS_Z), ZLD}; pg8::gemm_phase(lds, DM, S, E); if (rep == REP_GIN - 1) SEAM(pb + 0); }
        if (INL(1)) { for (int rep = 0; rep < REP_PREP; ++rep) phase_prep(a, l, lds); SEAM(pb + 1); }
        if (INL(2)) {
#ifndef NO_SCAN
            for (int rep = 0; rep < REP_SCAN; ++rep) for (int it = bx; it < 16 * NSEG; it += G) rwkv_scan_seg(a, lds, it & 15, it >> 4);
#endif
#ifndef NO_NSA
            {
                const unsigned xcc = xb_xcc_id() & 7u;
                for (unsigned k = 0; k < 8; ++k) { const unsigned qi = (xcc + k) & 7u; unsigned* qn = ctl + CW_Q + 64 * (4 + l * 8 + qi);
                    for (;;) { __syncthreads(); if (tid == 0) MISC[16] = __hip_atomic_fetch_add(qn, 1u, __ATOMIC_RELAXED, __HIP_MEMORY_SCOPE_AGENT); __syncthreads();
                        const int it = (int)MISC[16]; if (it >= 64 * REP_NSA) break; nsa_item(a, lds, (int)(qi >> 1), (int)(qi & 1), 63 - (it & 63)); } }
            }
#endif
            SEAM(pb + 2); }
        if (INL(3)) {
            for (int bh = bx; bh < 16; bh += G) rwkv_chain(a, lds, bh);
            unsigned* qg = ctl + CW_Q + 64 * (l * 2 + 1);
#ifndef NO_GMLP
            for (;;) { __syncthreads(); if (tid == 0) MISC[16] = __hip_atomic_fetch_add(qg, 1u, __ATOMIC_RELAXED, __HIP_MEMORY_SCOPE_AGENT); __syncthreads();
                int it = (int)MISC[16]; if (it >= 512 * REP_GMLP) break; it &= 511; gmlp_item(a, l, lds, it >> 7, (it >> 2) & 31, it & 3); }
#endif
            SEAM(pb + 3); }
        if (INL(4)) { for (int it = bx; it < 16 * 64; it += G) rwkv_post_item(a, l, lds, it & 15, it >> 4); SEAM(pb + 4); }
        if (INL(5)) { pg8::StaticOrder S; S.init(ws + WS_YCAT, (bf16*)(ws + WS_WOUT) + (size_t)l * DM * DM, MT, DM, DM, G, bx);
            pg8::EpiResAdd E{a.out, DM}; pg8::gemm_phase(lds, DM, S, E); SEAM(pb + 5); }
        if (INL(6)) { if (l == 0) phase_norm<0>(a, lds, INF(IN_GFFN)); else { for (int rep = 0; rep < REP_PRO; ++rep) { moe_convert_weights(a, lds); __syncthreads(); } phase_norm<1>(a, lds, INF(IN_GFFN) + DM); } SEAM(pb + 6); }
        if (l == 0) {
            if (INL(7)) { for (int rep = 0; rep < REP_F1; ++rep) { pg8::StaticOrder S; S.init(ws + WS_HN, ws + WS_W13, MT, 2 * DFF, DM, G, bx); pg8::EpiSwiglu E{(bf16*)(ws + WS_ACT), DFF}; pg8::gemm_phase(lds, DM, S, E); } SEAM(pb + 7); }
            if (INL(8)) { pg8::StaticOrder S; S.init(ws + WS_ACT, ws + WS_W2, MT, DM, DFF, G, bx); pg8::EpiResAdd E{a.out, DM}; pg8::gemm_phase(lds, DFF, S, E); if (pb + 12 < hi) xcd_barrier(bar); }
        } else {
            if (INL(7)) { phase_moe_assign(a, lds); SEAM(pb + 7); }
            if (INL(8)) { for (int rep = 0; rep < REP_F1; ++rep) { MoeOrder S; moe_order_init(S, a, 0, ws + WS_HNS, ws + WS_MW13, (size_t)5632 * DM * 2, DM, 22); pg8::EpiSwiglu E{(bf16*)(ws + WS_ACTM), DFF}; pg8::gemm_phase(lds, DM, S, E); } SEAM(pb + 8); }
            if (INL(9)) { for (int rb = bx; rb < MT / 64; rb += G) moe_gather(a, rb, 1);
                MoeOrder S; moe_order_init(S, a, 0, ws + WS_ACTM, ws + WS_MW2, (size_t)DM * DFF * 2, DFF, 4);
                pg8::EpiMoe2 E{a.out, (const int*)(ws + WS_SLOT + SL_TOK), (const float*)(ws + WS_SLOT + SL_GATE), DM}; pg8::gemm_phase(lds, DFF, S, E); SEAM(pb + 9); }
            if (INL(10)) { MoeOrder S; moe_order_init(S, a, 1, ws + WS_HNS, ws + WS_MW13, (size_t)5632 * DM * 2, DM, 22); pg8::EpiSwiglu E{(bf16*)(ws + WS_ACTM), DFF}; pg8::gemm_phase(lds, DM, S, E); SEAM(pb + 10); }
            if (INL(11)) { MoeOrder S; moe_order_init(S, a, 1, ws + WS_ACTM, ws + WS_MW2, (size_t)DM * DFF * 2, DFF, 4);
                pg8::EpiMoe2 E{a.out, (const int*)(ws + WS_SLOT + SL_TOK) + MOE_SLOTS, (const float*)(ws + WS_SLOT + SL_GATE) + MOE_SLOTS, DM}; pg8::gemm_phase(lds, DFF, S, E); SEAM(pb + 11); }
        }
        if (INL(12)) { phase_norm<0>(a, lds, INF(IN_GPLE) + l * DM); SEAM(pb + 12); }
        if (INL(13)) {
            { pg8::StaticOrder S; S.init((bf16*)(ws + WS_PB) + (size_t)l * MT * 256, (bf16*)(ws + WS_WP) + (size_t)l * DM * 256, MT, DM, 256, G, bx); pg8::EpiBf16Store E{(bf16*)(ws + WS_PP), DM}; pg8::gemm_phase(lds, 256, S, E); }
            { pg8::StaticOrder S; S.init(ws + WS_HN, (bf16*)(ws + WS_WG) + (size_t)l * DM * DM, MT, DM, DM, G, bx); pg8::EpiPle E{a.out, (const bf16*)(ws + WS_PP), DM}; pg8::gemm_phase(lds, DM, S, E); }
            SEAM(pb + 13); }
        if (INL(14)) { if (l == 0) { phase_norm<0>(a, lds, INF(IN_GMIX) + DM); SEAM(pb + 14); } else phase_norm<2>(a, lds, INF(IN_GFINAL)); }
    }
#undef IN
#undef INL
#undef SEAM
}

extern "C" void kernel_launch(void* const* d_in, const int* in_sizes, int n_in, void* d_out, int out_size, void* d_ws, size_t ws_size, hipStream_t stream) {
    static int grid = 0;
    if (grid == 0) {
        if (n_in != N_INPUTS || out_size != MT * DM || ws_size < WS_END) { fprintf(stderr, "kernel_launch: unexpected shapes (n_in %d, out %d, ws %zu)\n", n_in, out_size, ws_size); grid = -1; return; }
        int dev = 0, cus = 0, per_cu = 0;
        if (hipGetDevice(&dev) != hipSuccess || hipDeviceGetAttribute(&cus, hipDeviceAttributeMultiprocessorCount, dev) != hipSuccess) { grid = -1; return; }
        if (hipFuncSetAttribute((const void*)hybrid_fwd, hipFuncAttributeMaxDynamicSharedMemorySize, LDS_BYTES) != hipSuccess) { fprintf(stderr, "kernel_launch: hipFuncSetAttribute failed\n"); grid = -1; return; }
        if (hipOccupancyMaxActiveBlocksPerMultiprocessor(&per_cu, (const void*)hybrid_fwd, NTHR, LDS_BYTES) != hipSuccess || per_cu < 1) fprintf(stderr, "kernel_launch: occupancy query reports %d\n", per_cu);
        (void)hipGetLastError();
        grid = cus;
    }
    if (grid < 0) return;
    (void)hipMemsetAsync((char*)d_ws + WS_CTL, 0, CTL_ZERO_BYTES, stream);
    Args a{};
    for (int i = 0; i < N_INPUTS; ++i) a.in[i] = d_in[i];
    a.out = (float*)d_out; a.ws = (unsigned char*)d_ws;
#if MK_ONE_LAUNCH
    a.ph_lo = 0; a.ph_hi = NPHASES;
    hipLaunchKernelGGL(hybrid_fwd, dim3(grid), dim3(NTHR), LDS_BYTES, stream, a);
#else
    for (int k = 0; k < NPHASES; ++k) { if (phase_empty(k)) continue; a.ph_lo = k; a.ph_hi = k + 1;
        hipLaunchKernelGGL(hybrid_fwd, dim3(grid), dim3(NTHR), LDS_BYTES, stream, a); }
#endif
}
```

```cpp
#include <hip/hip_runtime.h>
#include <cstdio>
#include <cstdint>

#ifndef MK_ONE_LAUNCH
#define MK_ONE_LAUNCH 1
#endif

#define LAS __attribute__((address_space(3)))
#define GAS __attribute__((address_space(1)))
typedef unsigned short bf16;
typedef short bf16x8 __attribute__((ext_vector_type(8)));
typedef float f32x4 __attribute__((ext_vector_type(4)));
typedef float f32x2 __attribute__((ext_vector_type(2)));
typedef unsigned u32x4 __attribute__((ext_vector_type(4)));
typedef unsigned u32x2 __attribute__((ext_vector_type(2)));

constexpr int NB = 4, SEQ = 4096, DM = 1024, MT = NB * SEQ;
constexpr int DIN = 2840, ZLD = 3072;
constexpr int DFF = 2816, NEXP = 8;
constexpr int ZC_U = 0, ZC_V = 256, ZC_B = 512, ZC_Q = 1536, ZC_KC = 2048, ZC_VC = 2176, ZC_KS = 2304, ZC_VS = 2432, ZC_KW = 2560, ZC_VW = 2688, ZC_GT = 2816;
constexpr int NCMP = 255;
constexpr int NWAVES = 8, NTHR = 512;

__device__ __forceinline__ unsigned f2bf(float f) { unsigned u = __builtin_bit_cast(unsigned, f); return (u + 0x7fffu + ((u >> 16) & 1u)) >> 16; }
__device__ __forceinline__ float bf2f(unsigned b) { return __builtin_bit_cast(float, b << 16); }
__device__ __forceinline__ unsigned pk2(float lo, float hi) { return f2bf(lo) | (f2bf(hi) << 16); }
__device__ __forceinline__ float bflo(unsigned w) { return __builtin_bit_cast(float, w << 16); }
__device__ __forceinline__ float bfhi(unsigned w) { return __builtin_bit_cast(float, w & 0xffff0000u); }
__device__ __forceinline__ float sigmoidf_(float x) { return 1.0f / (1.0f + __expf(-x)); }
__device__ __forceinline__ float gelu_tanh(float x) { const float u = 0.7978845608028654f * (x + 0.044715f * x * x * x); const float e = __expf(-2.0f * fabsf(u)); float t = (1.0f - e) / (1.0f + e); t = u < 0.f ? -t : t; return 0.5f * x * (1.0f + t); }
__device__ __forceinline__ float wave_sum(float v) {
#pragma unroll
    for (int o = 1; o < 64; o <<= 1) v += __shfl_xor(v, o);
    return v;
}
__device__ __forceinline__ int opaque_tid() { int t = threadIdx.x; asm volatile("" : "+v"(t)); return t; }
#define LDS_WAIT() asm volatile("s_waitcnt lgkmcnt(0)" ::: "memory")
#define VM_WAIT() asm volatile("s_waitcnt vmcnt(0)" ::: "memory")

namespace pg8 {
constexpr int BM = 256, BK = 64, HALF = 128, HTB = HALF * BK * 2  , STAGE_BYTES = 8 * HTB, NXCD = 8, WGM = 8;
__host__ __device__ __forceinline__ int lds_byte(int r, int c) { const int st = (r >> 4) * 2 + (c >> 5), rr = r & 15, cc = c & 31, ob = rr * 64 + cc * 2; return st * 1024 + (ob ^ (((ob >> 9) & 1) << 5)); }
__host__ __device__ __forceinline__ void stage_rc(int b, int& R, int& C) { const int st = b / 1024, sb = b % 1024, swz = sb ^ (((sb >> 9) & 1) << 5); R = (st >> 1) * 16 + swz / 64; C = (st & 1) * 32 + (swz % 64) / 2; }
__host__ __device__ __forceinline__ int perm32(int rho) { const int n = rho >> 4, i = rho & 15; return 8 * (i >> 2) + 4 * n + (i & 3); }

struct Unit { int pm, pn, aux; };

struct StaticOrder {
    const char* A; const char* Bt; int K; int nM, nN, nwg, G, c;
    __device__ void init(const void* A_, const void* Bt_, int M, int N, int K_, int G_, int c_) { A = (const char*)A_; Bt = (const char*)Bt_; K = K_; nM = M / BM; nN = N / BM; nwg = nM * nN; G = G_; c = c_; }
    __device__ bool next(int i, Unit& u) const {
        const long L = (long)i * G + c; if (L >= nwg) return false;
        int wgid = (int)L; { const int q = nwg / NXCD, r = nwg % NXCD, xcd = wgid % NXCD, off = wgid / NXCD; wgid = (xcd < r ? xcd * (q + 1) : r * (q + 1) + (xcd - r) * q) + off; }
        const int nig = WGM * nN, gid = wgid / nig, fm = gid * WGM, gsz = (nM - fm) < WGM ? (nM - fm) : WGM;
        u.pm = fm + ((wgid % nig) % gsz); u.pn = (wgid % nig) / gsz; u.aux = 0; return true;
    }
    __device__ __forceinline__ const char* abase(const Unit& u) const { return A + (size_t)u.pm * ((size_t)BM * K * 2); }
    __device__ __forceinline__ const char* bbase(const Unit& u) const { return Bt + (size_t)u.pn * ((size_t)BM * K * 2); }
};

__device__ __forceinline__ unsigned cvt_pk_bf16(float lo, float hi) { unsigned r; asm volatile("v_cvt_pk_bf16_f32 %0, %1, %2" : "=v"(r) : "v"(lo), "v"(hi)); return r; }

__device__ __forceinline__ float row_rs(const float* rss, int row, int fq) {
    const f32x4 p = *(const f32x4*)(rss + (size_t)row * 16 + 4 * fq); float s = (p[0] + p[1]) + (p[2] + p[3]);
    s += __shfl_xor(s, 16); s += __shfl_xor(s, 32); return 1.0f / sqrtf(s * (1.0f / 1024.0f) + 1e-6f);
}
__device__ __forceinline__ void put_hb_rss(const f32x4 (&v)[2][2], bf16* hb_row  , float* rss_row  , int fq) {
    float q = 0.f;
#pragma unroll
    for (int bj = 0; bj < 2; ++bj) { const f32x4 x = v[bj][0], y = v[bj][1];
        q += ((x[0] * x[0] + x[1] * x[1]) + (x[2] * x[2] + x[3] * x[3])) + ((y[0] * y[0] + y[1] * y[1]) + (y[2] * y[2] + y[3] * y[3]));
        u32x4 w; w.x = cvt_pk_bf16(x[0], x[1]); w.y = cvt_pk_bf16(x[2], x[3]); w.z = cvt_pk_bf16(y[0], y[1]); w.w = cvt_pk_bf16(y[2], y[3]); *(u32x4*)(hb_row + bj * HALF) = w; }
    q += __shfl_xor(q, 16); q += __shfl_xor(q, 32);
    if (fq == 0) *rss_row = q;
}
__device__ __forceinline__ void put_hb_rss4(const f32x4 (&v)[2][2], bf16* hb_row  , float* rss_row  , int fq) {
    float q = 0.f;
#pragma unroll
    for (int bj = 0; bj < 2; ++bj)
#pragma unroll
        for (int n = 0; n < 2; ++n) { const f32x4 x = v[bj][n]; q += (x[0] * x[0] + x[1] * x[1]) + (x[2] * x[2] + x[3] * x[3]);
            u32x2 w; w.x = cvt_pk_bf16(x[0], x[1]); w.y = cvt_pk_bf16(x[2], x[3]); *(u32x2*)(hb_row + bj * HALF + n * 16) = w; }
    q += __shfl_xor(q, 16); q += __shfl_xor(q, 32);
    if (fq == 0) *rss_row = q;
}
struct EpiBf16Store {
    static constexpr bool PERM = true;
    bf16* O; int ldc; const LAS float* rstab;
    __device__ __forceinline__ void operator()(const f32x4 (&acc)[2][2][4][2], const Unit& u, int ui, int wr, int wc, int fr, int fq) const {
        const int row0 = u.pm * BM + wr * 64 + fr, col0 = u.pn * BM + wc * 32 + 8 * fq;
        float rsv[2][4];
#pragma unroll
        for (int ai = 0; ai < 2; ++ai)
#pragma unroll
            for (int m = 0; m < 4; ++m) rsv[ai][m] = rstab ? rstab[ui * 256 + ai * HALF + wr * 64 + m * 16 + fr] : 1.0f;
#pragma unroll
        for (int ai = 0; ai < 2; ++ai)
#pragma unroll
            for (int m = 0; m < 4; ++m) { const int row = row0 + ai * HALF + m * 16; bf16* rowp = O + (size_t)row * ldc + col0; const float rs = rsv[ai][m];
#pragma unroll
                for (int bj = 0; bj < 2; ++bj) { const f32x4 v0 = acc[ai][bj][m][0] * rs, v1 = acc[ai][bj][m][1] * rs;
                    u32x4 w; w.x = cvt_pk_bf16(v0[0], v0[1]); w.y = cvt_pk_bf16(v0[2], v0[3]); w.z = cvt_pk_bf16(v1[0], v1[1]); w.w = cvt_pk_bf16(v1[2], v1[3]);
                    *(u32x4*)(rowp + bj * HALF) = w; } }
    }
};
struct EpiResAdd {
    static constexpr bool PERM = true;
    float* H; int ldc; bf16* hb; float* rss_out;
    __device__ __forceinline__ void operator()(const f32x4 (&acc)[2][2][4][2], const Unit& u, int ui, int wr, int wc, int fr, int fq) const {
        const int row0 = u.pm * BM + wr * 64 + fr, col0 = u.pn * BM + wc * 32 + 8 * fq;
#pragma unroll
        for (int ai = 0; ai < 2; ++ai)
#pragma unroll
            for (int m = 0; m < 4; ++m) { const int row = row0 + ai * HALF + m * 16; float* rowp = H + (size_t)row * ldc + col0; f32x4 v[2][2];
#pragma unroll
                for (int bj = 0; bj < 2; ++bj)
#pragma unroll
                    for (int n = 0; n < 2; ++n) { f32x4* p = (f32x4*)(rowp + bj * HALF + n * 4); v[bj][n] = *p + acc[ai][bj][m][n]; *p = v[bj][n]; }
                put_hb_rss(v, hb + (size_t)row * ldc + col0, rss_out + (size_t)row * 16 + u.pn * 4 + wc, fq); }
    }
};
struct EpiSwiglu {
    static constexpr bool PERM = true;
    bf16* O; int ldc; const LAS float* rstab;
    __device__ __forceinline__ void operator()(const f32x4 (&acc)[2][2][4][2], const Unit& u, int ui, int wr, int wc, int fr, int fq) const {
        const int row0 = u.pm * BM + wr * 64 + fr, col0 = u.pn * HALF + wc * 32 + 8 * fq;
#pragma unroll
        for (int ai = 0; ai < 2; ++ai)
#pragma unroll
            for (int m = 0; m < 4; ++m) { const int row = row0 + ai * HALF + m * 16; bf16* rowp = O + (size_t)row * ldc + col0;
                const float rs = rstab[ui * 256 + ai * HALF + wr * 64 + m * 16 + fr];
                float o[8];
#pragma unroll
                for (int n = 0; n < 2; ++n)
#pragma unroll
                    for (int i = 0; i < 4; ++i) { const float a = acc[ai][0][m][n][i] * rs, b = acc[ai][1][m][n][i] * rs; o[n * 4 + i] = a * b / (1.0f + __expf(-a)); }
                u32x4 w; w.x = cvt_pk_bf16(o[0], o[1]); w.y = cvt_pk_bf16(o[2], o[3]); w.z = cvt_pk_bf16(o[4], o[5]); w.w = cvt_pk_bf16(o[6], o[7]);
                *(u32x4*)rowp = w; __builtin_amdgcn_sched_barrier(0); }
    }
};
struct EpiPle {
    static constexpr bool PERM = false;
    float* H; unsigned char* ws; const LAS float* rstab; size_t off_pp, off_hb, off_rss;
    __device__ __forceinline__ void operator()(const f32x4 (&acc)[2][2][4][2], const Unit& u, int ui, int wr, int wc, int fr, int fq) const {
        const int row0 = u.pm * BM + wr * 64 + fr, col0 = u.pn * BM + wc * 32 + 4 * fq;
        const bf16* PP = (const bf16*)(ws + off_pp); bf16* hb = (bf16*)(ws + off_hb); float* rss_out = (float*)(ws + off_rss);
#pragma unroll
        for (int ai = 0; ai < 2; ++ai)
#pragma unroll
            for (int m = 0; m < 4; ++m) { const int row = row0 + ai * HALF + m * 16; const size_t off = (size_t)row * 1024 + col0; const float rs = rstab[ui * 256 + ai * HALF + wr * 64 + m * 16 + fr]; f32x4 v[2][2];
#pragma unroll
                for (int bj = 0; bj < 2; ++bj)
#pragma unroll
                    for (int n = 0; n < 2; ++n) { const size_t o2 = off + bj * HALF + n * 16; const u32x2 pw = *(const u32x2*)(PP + o2); const f32x4 a = acc[ai][bj][m][n] * rs;
                        f32x4 g; g[0] = bflo(pw.x) * sigmoidf_(a[0]); g[1] = bfhi(pw.x) * sigmoidf_(a[1]); g[2] = bflo(pw.y) * sigmoidf_(a[2]); g[3] = bfhi(pw.y) * sigmoidf_(a[3]);
                        f32x4* p = (f32x4*)(H + o2); v[bj][n] = *p + g; *p = v[bj][n]; }
                put_hb_rss4(v, hb + off, rss_out + (size_t)row * 16 + u.pn * 4 + wc, fq);
                if (m & 1) __builtin_amdgcn_sched_barrier(0); }
    }
};
template <bool FINAL> struct EpiMoe2 {
    static constexpr bool PERM = true;
    float* H; const int* slot_tok; const float* slot_gate; int ldc; bf16* hb; float* rss_out;
    __device__ __forceinline__ void operator()(const f32x4 (&acc)[2][2][4][2], const Unit& u, int ui, int wr, int wc, int fr, int fq) const {
        const int row0 = u.pm * BM + wr * 64 + fr, col0 = u.pn * BM + wc * 32 + 8 * fq;
        int tokv[2][4]; float gtv[2][4];
#pragma unroll
        for (int ai = 0; ai < 2; ++ai)
#pragma unroll
            for (int m = 0; m < 4; ++m) { const int slot = row0 + ai * HALF + m * 16; tokv[ai][m] = slot_tok[slot]; gtv[ai][m] = slot_gate[slot]; }
#pragma unroll
        for (int ai = 0; ai < 2; ++ai)
#pragma unroll
            for (int m = 0; m < 4; ++m) { const int tok = tokv[ai][m]; const float gt = gtv[ai][m];
                const int tk = tok < 0 ? 0 : tok; float* rowp = H + (size_t)tk * ldc + col0; f32x4 v[2][2];
#pragma unroll
                for (int bj = 0; bj < 2; ++bj)
#pragma unroll
                    for (int n = 0; n < 2; ++n) { f32x4* p = (f32x4*)(rowp + bj * HALF + n * 4); v[bj][n] = *p + acc[ai][bj][m][n] * gt; if (tok >= 0) *p = v[bj][n]; }
                if (FINAL) { float q = 0.f;
#pragma unroll
                    for (int bj = 0; bj < 2; ++bj) { const f32x4 x = v[bj][0], y = v[bj][1];
                        q += ((x[0] * x[0] + x[1] * x[1]) + (x[2] * x[2] + x[3] * x[3])) + ((y[0] * y[0] + y[1] * y[1]) + (y[2] * y[2] + y[3] * y[3]));
                        u32x4 w; w.x = cvt_pk_bf16(x[0], x[1]); w.y = cvt_pk_bf16(x[2], x[3]); w.z = cvt_pk_bf16(y[0], y[1]); w.w = cvt_pk_bf16(y[2], y[3]);
                        if (tok >= 0) *(u32x4*)(hb + (size_t)tk * ldc + col0 + bj * HALF) = w; }
                    q += __shfl_xor(q, 16); q += __shfl_xor(q, 32);
                    if (fq == 0 && tok >= 0) rss_out[(size_t)tk * 16 + u.pn * 4 + wc] = q; }
                if (m & 1) __builtin_amdgcn_sched_barrier(0); }
    }
};

template <class Epi, class Sched, bool ALIGN_EPI = true, bool SP2 = true>
__device__ __forceinline__ void gemm_phase(LAS unsigned char* lds, const int K, const Sched& S, const Epi& E) {
    int tid = threadIdx.x; asm volatile("" : "+v"(tid));
    const int wid = __builtin_amdgcn_readfirstlane(tid >> 6), lane = tid & 63, wr = wid >> 2, wc = wid & 3, fr = lane & 15, fq = lane >> 4;
    const int nt = K / BK;
    unsigned voffA[2], voffB[2];
#pragma unroll
    for (int i = 0; i < 2; ++i) { int R, C; stage_rc(tid * 16 + i * 8192, R, C); const int Rb = Epi::PERM ? ((R & ~31) + perm32(R & 31)) : R;
        voffA[i] = (unsigned)(R * K + C) * 2u; voffB[i] = (unsigned)(Rb * K + C) * 2u; }
    const size_t kstep = (size_t)(BK * 2);
    const size_t hstep = (size_t)HALF * K * 2;
    const unsigned ldsw = (unsigned)wid * 1024u;
    const int aoff = lds_byte(wr * 64 + fr, fq * 8), boff = lds_byte(wc * 32 + fr, fq * 8);
#define PG8_SA(b, h) (((b) * 2 + (h)) * HTB)
#define PG8_SB(b, h) ((4 + (b) * 2 + (h)) * HTB)
#define PG8_STAGE(bufoff, gbase, voff) do { _Pragma("unroll") for (int _i = 0; _i < 2; ++_i) \
        __builtin_amdgcn_global_load_lds((const unsigned*)((const char*)(gbase) + (voff)[_i]), (LAS unsigned*)(lds + (bufoff) + ldsw + _i * 8192), 16, 0, 0); } while (0)
#define PG8_LDA(dst, b, h) do { _Pragma("unroll") for (int m = 0; m < 4; ++m) _Pragma("unroll") for (int k = 0; k < 2; ++k) dst[m][k] = *(const LAS bf16x8*)(lds + PG8_SA(b, h) + aoff + m * 2048 + k * 1024); } while (0)
#define PG8_LDB(dst, b, h) do { _Pragma("unroll") for (int n = 0; n < 2; ++n) _Pragma("unroll") for (int k = 0; k < 2; ++k) dst[n][k] = *(const LAS bf16x8*)(lds + PG8_SB(b, h) + boff + n * 2048 + k * 1024); } while (0)
#define PG8_MMA(ai, bj, At, Bt) do { __builtin_amdgcn_s_setprio(1); _Pragma("unroll") for (int m = 0; m < 4; ++m) _Pragma("unroll") for (int n = 0; n < 2; ++n) _Pragma("unroll") for (int k = 0; k < 2; ++k) \
        acc[ai][bj][m][n] = __builtin_amdgcn_mfma_f32_16x16x32_bf16(Bt[n][k], At[m][k], acc[ai][bj][m][n], 0, 0, 0); __builtin_amdgcn_s_setprio(0); } while (0)
#define PG8_WAIT_V(n) asm volatile("s_waitcnt vmcnt(" #n ")" ::: "memory")
#define PG8_WAIT_L(n) asm volatile("s_waitcnt lgkmcnt(" #n ")" ::: "memory")
#define PG8_BAR __builtin_amdgcn_s_barrier()
#define PG8_SCHED __builtin_amdgcn_sched_barrier(0)
    Unit cur, nxt; int ui = 0;
    if (!S.next(0, cur)) return;
    f32x4 acc[2][2][4][2];
#pragma unroll
    for (int a = 0; a < 2; ++a)
#pragma unroll
        for (int b = 0; b < 2; ++b)
#pragma unroll
            for (int m = 0; m < 4; ++m)
#pragma unroll
                for (int n = 0; n < 2; ++n) acc[a][b][m][n] = (f32x4){0.f, 0.f, 0.f, 0.f};
    bf16x8 At[4][2], B0[2][2], B1[2][2];
    const char* cA = S.abase(cur); const char* cB = S.bbase(cur);
    if constexpr (SP2) {
        PG8_STAGE(PG8_SB(0, 0), cB, voffB); PG8_STAGE(PG8_SB(0, 1), cB + hstep, voffB); PG8_STAGE(PG8_SA(0, 0), cA, voffA); PG8_STAGE(PG8_SA(0, 1), cA + hstep, voffA);
        if (wr == 1) PG8_BAR;
        PG8_WAIT_V(2); PG8_BAR;
        PG8_STAGE(PG8_SB(1, 0), cB + kstep, voffB); PG8_STAGE(PG8_SA(1, 0), cA + kstep, voffA); PG8_STAGE(PG8_SB(1, 1), cB + hstep + kstep, voffB);
        PG8_WAIT_V(6); PG8_BAR;
    } else {
        PG8_STAGE(PG8_SB(0, 0), cB, voffB); PG8_STAGE(PG8_SA(0, 0), cA, voffA); PG8_STAGE(PG8_SB(0, 1), cB + hstep, voffB); PG8_STAGE(PG8_SA(0, 1), cA + hstep, voffA);
        if (wr == 1) PG8_BAR;
        PG8_WAIT_V(4); PG8_BAR;
        PG8_STAGE(PG8_SB(1, 0), cB + kstep, voffB); PG8_STAGE(PG8_SA(1, 0), cA + kstep, voffA); PG8_STAGE(PG8_SB(1, 1), cB + hstep + kstep, voffB);
        PG8_WAIT_V(6); PG8_BAR;
    }
    for (;;) {
        const bool has_next = S.next(ui + 1, nxt);
        const char* nA = has_next ? S.abase(nxt) : cA; const char* nB = has_next ? S.bbase(nxt) : cB;
        for (int t = 0; t < nt; t += 2) {
            const bool last = (t == nt - 2);
            const char* a1 = cA + (size_t)(t + 1) * kstep;
            const char* a2 = last ? nA : cA + (size_t)(t + 2) * kstep; const char* b2 = last ? nB : cB + (size_t)(t + 2) * kstep;
            const char* a3 = a2 + kstep; const char* b3 = b2 + kstep;
            if constexpr (SP2) {
            PG8_LDB(B0, 0, 0); PG8_LDB(B1, 0, 1); PG8_SCHED; PG8_LDA(At, 0, 0); PG8_STAGE(PG8_SA(1, 1), a1 + hstep, voffA);
            PG8_WAIT_V(8); PG8_WAIT_L(0); PG8_BAR; PG8_MMA(0, 0, At, B0); PG8_MMA(0, 1, At, B1); PG8_BAR; PG8_SCHED;
            PG8_LDA(At, 0, 1); PG8_STAGE(PG8_SB(0, 0), b2, voffB); PG8_STAGE(PG8_SB(0, 1), b2 + hstep, voffB); PG8_STAGE(PG8_SA(0, 0), a2, voffA);
            PG8_WAIT_V(8); PG8_WAIT_L(0); PG8_BAR; PG8_MMA(1, 0, At, B0); PG8_MMA(1, 1, At, B1); PG8_BAR; PG8_SCHED;
            PG8_LDB(B0, 1, 0); PG8_LDB(B1, 1, 1); PG8_SCHED; PG8_LDA(At, 1, 0); PG8_STAGE(PG8_SA(0, 1), a2 + hstep, voffA);
            PG8_WAIT_V(8); PG8_WAIT_L(0); PG8_BAR; PG8_MMA(0, 0, At, B0); PG8_MMA(0, 1, At, B1); PG8_BAR; PG8_SCHED;
            PG8_LDA(At, 1, 1); PG8_STAGE(PG8_SB(1, 0), b3, voffB); PG8_STAGE(PG8_SB(1, 1), b3 + hstep, voffB); PG8_STAGE(PG8_SA(1, 0), a3, voffA);
            PG8_WAIT_V(8); PG8_WAIT_L(0); PG8_BAR; PG8_MMA(1, 0, At, B0); PG8_MMA(1, 1, At, B1); PG8_BAR; PG8_SCHED;
            } else {
            PG8_LDB(B0, 0, 0); PG8_SCHED; PG8_LDA(At, 0, 0); PG8_STAGE(PG8_SA(1, 1), a1 + hstep, voffA);
            PG8_WAIT_L(8); PG8_BAR; PG8_WAIT_L(0); PG8_MMA(0, 0, At, B0); PG8_BAR; PG8_SCHED;
            PG8_LDB(B1, 0, 1); PG8_STAGE(PG8_SB(0, 0), b2, voffB);
            PG8_BAR; PG8_WAIT_L(0); PG8_MMA(0, 1, At, B1); PG8_BAR;
            PG8_LDA(At, 0, 1); PG8_STAGE(PG8_SA(0, 0), a2, voffA);
            PG8_BAR; PG8_WAIT_L(0); PG8_MMA(1, 0, At, B0); PG8_BAR; PG8_SCHED;
            PG8_STAGE(PG8_SB(0, 1), b2 + hstep, voffB);
            PG8_WAIT_V(6); PG8_BAR; PG8_MMA(1, 1, At, B1); PG8_BAR;
            PG8_LDB(B0, 1, 0); PG8_SCHED; PG8_LDA(At, 1, 0); PG8_STAGE(PG8_SA(0, 1), a2 + hstep, voffA);
            PG8_WAIT_L(8); PG8_BAR; PG8_WAIT_L(0); PG8_MMA(0, 0, At, B0); PG8_BAR; PG8_SCHED;
            PG8_LDB(B1, 1, 1); PG8_STAGE(PG8_SB(1, 0), b3, voffB);
            PG8_BAR; PG8_WAIT_L(0); PG8_MMA(0, 1, At, B1); PG8_BAR;
            PG8_LDA(At, 1, 1); PG8_STAGE(PG8_SA(1, 0), a3, voffA);
            PG8_BAR; PG8_WAIT_L(0); PG8_MMA(1, 0, At, B0); PG8_BAR; PG8_SCHED;
            PG8_STAGE(PG8_SB(1, 1), b3 + hstep, voffB);
            PG8_WAIT_V(6); PG8_BAR; PG8_MMA(1, 1, At, B1); PG8_BAR;
            }
        }
        if constexpr (ALIGN_EPI) { if (wr == 0) PG8_BAR; }
        E(acc, cur, ui, wr, wc, fr, fq);
        if (!has_next) break;
#pragma unroll
        for (int a = 0; a < 2; ++a)
#pragma unroll
            for (int b = 0; b < 2; ++b)
#pragma unroll
                for (int m = 0; m < 4; ++m)
#pragma unroll
                    for (int n = 0; n < 2; ++n) acc[a][b][m][n] = (f32x4){0.f, 0.f, 0.f, 0.f};
        cur = nxt; cA = nA; cB = nB; ++ui;
        if constexpr (ALIGN_EPI) { if (wr == 1) PG8_BAR; }
    }
    PG8_WAIT_V(0);
    if constexpr (!ALIGN_EPI) { if (wr == 0) PG8_BAR; }
    PG8_BAR;
#undef PG8_SA
#undef PG8_SB
#undef PG8_STAGE
#undef PG8_LDA
#undef PG8_LDB
#undef PG8_MMA
#undef PG8_WAIT_V
#undef PG8_WAIT_L
#undef PG8_BAR
#undef PG8_SCHED
}
}

constexpr size_t MiB = 1u << 20;
constexpr size_t WS_CTL = 0, CTL_ZERO_BYTES = 65536;
constexpr size_t WS_WIN = 1 * MiB;
constexpr size_t WS_WOUT = 13 * MiB;
constexpr size_t WS_W13 = 17 * MiB;
constexpr size_t WS_W2 = 28 * MiB;
constexpr size_t WS_WG = 34 * MiB;
constexpr size_t WS_WP = 38 * MiB;
constexpr size_t WS_CW1 = 39 * MiB;
constexpr size_t WS_LORA = 41 * MiB;
constexpr size_t WS_ROPE = 41 * MiB + 512 * 1024;
constexpr size_t WS_CBIAS = 42 * MiB + 512 * 1024;
constexpr size_t WS_PB = 43 * MiB;
constexpr size_t WS_HN = 60 * MiB;
constexpr size_t WS_Z = 92 * MiB;
constexpr size_t WS_YCAT = 188 * MiB;
constexpr size_t WS_QROT = 220 * MiB;
constexpr size_t WS_KSR = 236 * MiB, WS_KWR = 240 * MiB, WS_VST = 244 * MiB, WS_VWT = 248 * MiB;
constexpr size_t WS_KCMP = 252 * MiB, WS_VCMPT = 252 * MiB + 512 * 1024;
constexpr size_t WS_REC = 253 * MiB;
constexpr size_t WS_G = 349 * MiB;
constexpr size_t WS_YRAW = 365 * MiB;
constexpr size_t WS_BONUS = 381 * MiB;
constexpr size_t WS_ACT = 92 * MiB;
constexpr size_t WS_HNS = 92 * MiB;
constexpr size_t WS_ACTM = 128 * MiB;
constexpr size_t WS_MW13 = 227 * MiB;
constexpr size_t WS_MW2 = 315 * MiB;
constexpr size_t WS_SLOT = 359 * MiB;
constexpr size_t WS_PP = 92 * MiB;
constexpr size_t WS_YP = 382 * MiB;
constexpr size_t WS_SEGE = 398 * MiB;
constexpr size_t WS_SST = 406 * MiB;
constexpr size_t WS_END = 412 * MiB;
constexpr size_t WS_HB2 = 188 * MiB;
constexpr size_t WS_RSS = 410 * MiB;
constexpr int NSEG = 16, SEGLEN = SEQ / NSEG;
constexpr int MOE_SLOTS = 18432;
constexpr size_t SL_TOK = 0;
constexpr size_t SL_GATE = SL_TOK + 2 * MOE_SLOTS * 4;
constexpr size_t SL_TOKE = SL_GATE + 2 * MOE_SLOTS * 4;
constexpr size_t SL_TOKG = SL_TOKE + (size_t)MT * 2 * 4;
constexpr size_t SL_TOKS = SL_TOKG + (size_t)MT * 2 * 4;
constexpr size_t SL_BCNT = SL_TOKS + (size_t)MT * 2 * 4;
constexpr size_t SL_TST = SL_BCNT + 256 * 16 * 4;
static_assert(SL_TST + 128 <= 1 * MiB, "slot tables");
constexpr int CW_BAR = 4096;
constexpr int CW_Q = 8192;

constexpr int RING_BYTES = 131072;
constexpr int MISC_OFF = RING_BYTES;
constexpr int RSTAB_OFF = RING_BYTES + 2048;
constexpr int RSTAB_MAX_UNITS = 30;
constexpr int LDS_BYTES = 163840;

#define XB_TMO      128
#define XB_XCNT(j)  (256  + 64 * (j))
#define XB_XSUB(j)  (1280 + 64 * (j))
#define XB_XGEN(j)  (2304 + 64 * (j))
#define XB_TOP      3328
#define XB_TOPGEN   3392
#define XCD_BAR_WORDS 3456
#define XB_SPIN_CAP (1u << 18)
__device__ __forceinline__ unsigned xb_ld(unsigned* p)              { return __hip_atomic_load(p, __ATOMIC_RELAXED, __HIP_MEMORY_SCOPE_AGENT); }
__device__ __forceinline__ unsigned xb_add(unsigned* p, unsigned v) { return __hip_atomic_fetch_add(p, v, __ATOMIC_RELAXED, __HIP_MEMORY_SCOPE_AGENT); }
__device__ __forceinline__ unsigned xb_xcc_id() { return (unsigned)__builtin_amdgcn_s_getreg((3 << 11) | 20) & 0xFu; }
#define XB_SPIN(cond, bar) do { unsigned _sp = 0; while (cond) { __builtin_amdgcn_s_sleep(1); \
    if ((++_sp & 255u) == 0u) { if (xb_ld(&(bar)[XB_TMO])) break; if (_sp > XB_SPIN_CAP) { atomicAdd(&(bar)[XB_TMO], 1u); break; } } } } while (0)
struct XcdBarrier { unsigned* bar; unsigned x; volatile LAS unsigned* st; };
__device__ __forceinline__ XcdBarrier xcd_barrier_post(unsigned* bar, volatile LAS unsigned* st) {
    XcdBarrier b; b.bar = bar; b.x = xb_xcc_id(); b.st = st;
    if (threadIdx.x == 0) (void)xb_add(&bar[XB_XCNT(b.x)], 1u);
    return b;
}
__device__ __noinline__ unsigned long long xcd_barrier_complete(unsigned* bar, unsigned x) {
    const unsigned G = gridDim.x * gridDim.y * gridDim.z;
    unsigned sum, cnt, mine, sp = 0u;
    for (;;) {
        sum = 0u; cnt = 0u; mine = 0u;
        for (unsigned j = 0; j < 16; ++j) { const unsigned c = xb_ld(&bar[XB_XCNT(j)]); sum += c; cnt += (c > 0u) ? 1u : 0u; mine = (j == x) ? c : mine; }
        if (sum == G) break;
        __builtin_amdgcn_s_sleep(1);
        if ((++sp & 255u) == 0u) { if (xb_ld(&bar[XB_TMO])) break; if (sp > XB_SPIN_CAP) { atomicAdd(&bar[XB_TMO], 1u); break; } }
    }
    const unsigned nloc = mine > 0u ? mine : 1u, nx = cnt > 0u ? cnt : 1u;
    return (unsigned long long)nloc | ((unsigned long long)nx << 32);
}
__device__ __forceinline__ void xcd_barrier(const XcdBarrier& b) {
    asm volatile("s_waitcnt vmcnt(0)" ::: "memory");
    __syncthreads();
    if (threadIdx.x == 0) {
        unsigned* bar = b.bar;
        __builtin_amdgcn_s_waitcnt(0);
        unsigned nloc = b.st[0], nx = b.st[1];
        if (nloc == 0u) { const unsigned long long r = xcd_barrier_complete(bar, b.x); nloc = (unsigned)r; nx = (unsigned)(r >> 32); b.st[0] = nloc; b.st[1] = nx; }
        const unsigned old = xb_add(&bar[XB_XSUB(b.x)], 1u);
        const unsigned gen = old / nloc;
        if (old + 1u == (gen + 1u) * nloc) {
            __builtin_amdgcn_fence(__ATOMIC_RELEASE, "agent");
            asm volatile("s_waitcnt vmcnt(0)" ::: "memory");
            const unsigned og = xb_add(&bar[XB_TOP], 1u);
            const unsigned tg = og / nx;
            if (og + 1u == (tg + 1u) * nx) xb_add(&bar[XB_TOPGEN], 1u);
            else XB_SPIN(xb_ld(&bar[XB_TOPGEN]) == tg, bar);
            __builtin_amdgcn_fence(__ATOMIC_ACQUIRE, "agent");
            xb_add(&bar[XB_XGEN(b.x)], 1u);
            asm volatile("s_waitcnt vmcnt(0)" ::: "memory");
        } else {
            XB_SPIN(xb_ld(&bar[XB_XGEN(b.x)]) == gen, bar);
            __builtin_amdgcn_fence(__ATOMIC_ACQUIRE, "agent");
            asm volatile("s_waitcnt vmcnt(0)" ::: "memory");
        }
    }
    __syncthreads();
}

enum { IN_X = 0, IN_P, IN_POS, IN_GMIX, IN_WIN, IN_WOUT, IN_GMLNG, IN_GMLNB, IN_GMWS, IN_GMBS, IN_RWMU, IN_RWW0, IN_RWWUP, IN_RWA0, IN_RWAUP, IN_RWGUP,
       IN_RWKK, IN_RWKA, IN_RWRK, IN_RWGNG, IN_RWGNB, IN_CMPPOS, IN_KCW1, IN_KCW2, IN_VCW1, IN_VCW2, IN_GFFN, IN_FW1, IN_FW3, IN_FW2, IN_RTW, IN_RTB,
       IN_MW1, IN_MW3, IN_MW2, IN_GPLE, IN_PLEG, IN_PLEP, IN_GFINAL, N_INPUTS };
struct Args { const void* in[N_INPUTS]; float* out; unsigned char* ws; int ph_lo, ph_hi; };
constexpr int PTAB_OFF = 131072 + 256;
__device__ __forceinline__ const void* ldptr(int k) {
    extern __shared__ __attribute__((aligned(16))) unsigned char lds_raw[];
    const LAS unsigned* t = (const LAS unsigned*)((LAS unsigned char*)lds_raw + PTAB_OFF) + 2 * k;
    const unsigned lo = __builtin_amdgcn_readfirstlane(t[0]), hi = __builtin_amdgcn_readfirstlane(t[1]);
    return (const void*)(((unsigned long long)hi << 32) | lo);
}
#define INF(k) ((const float*)ldptr(k))
__device__ __forceinline__ unsigned char* ws_of(const Args& a) { unsigned char* w = a.ws; asm volatile("" : "+s"(w)); return w; }

__device__ __forceinline__ void conv_matrix(const float* W, int K, int N, bf16* dst, int mode, int gw, int NGW, LAS float* scr, int lane, const float* gk = nullptr) {
    (void)scr;
    const int nblk = (N + 63) / 64, nit = (K / 64) * nblk;
    for (int it = gw; it < nit; it += NGW) {
        const int kb = it / nblk, nb = it % nblk, n = nb * 64 + lane, k0 = kb * 64; const bool ok = n < N;
        const int drow = mode == 0 ? n : ((n >> 7) * 256 + (n & 127) + (mode == 2 ? 128 : 0));
        const float* src = W + (size_t)k0 * N + (ok ? n : 0);
        float v[64];
#pragma unroll
        for (int k = 0; k < 64; ++k) v[k] = src[(size_t)k * N];
        if (gk) {
#pragma unroll
            for (int k = 0; k < 64; ++k) v[k] *= gk[k0 + k]; }
        if (ok) { u32x4* d = (u32x4*)(dst + (size_t)drow * K + k0);
#pragma unroll
            for (int c = 0; c < 8; ++c) { u32x4 o; o.x = pk2(v[8 * c], v[8 * c + 1]); o.y = pk2(v[8 * c + 2], v[8 * c + 3]); o.z = pk2(v[8 * c + 4], v[8 * c + 5]); o.w = pk2(v[8 * c + 6], v[8 * c + 7]); d[c] = o; } }
    }
}
__device__ __forceinline__ void init_row(const float* xrow, bf16* orow, float* cp, float* rss_row, int lane) {
    const f32x4* xr = (const f32x4*)xrow + lane; f32x4 v[4]; float s = 0.f;
#pragma unroll
    for (int j = 0; j < 4; ++j) { v[j] = xr[64 * j]; s += (v[j].x * v[j].x + v[j].y * v[j].y) + (v[j].z * v[j].z + v[j].w * v[j].w); }
    s = wave_sum(s);
#pragma unroll
    for (int j = 0; j < 4; ++j) ((f32x4*)cp + lane)[64 * j] = v[j];
    u32x2* o8 = (u32x2*)orow + lane;
#pragma unroll
    for (int j = 0; j < 4; ++j) { u32x2 w; w.x = pk2(v[j].x, v[j].y); w.y = pk2(v[j].z, v[j].w); o8[64 * j] = w; }
    if (lane < 16) rss_row[lane] = lane == 0 ? s : 0.f;
}

__device__ __forceinline__ void phase_prologue(const Args& a, LAS unsigned char* lds) {
    const int tid = opaque_tid(), lane = tid & 63, wave = __builtin_amdgcn_readfirstlane(tid >> 6);
    const int G = gridDim.x, gw = blockIdx.x * NWAVES + wave, NGW = G * NWAVES;
    const size_t gt = (size_t)blockIdx.x * NTHR + tid, NGT = (size_t)G * NTHR;
    unsigned char* ws = ws_of(a);
    LAS float* scr = (LAS float*)(lds + wave * 16384);
    for (int l = 0; l < 2; ++l) {
        conv_matrix(INF(IN_WIN) + (size_t)l * DM * DIN, DM, DIN, (bf16*)(ws + WS_WIN) + (size_t)l * ZLD * DM, 0, gw, NGW, scr, lane, INF(IN_GMIX) + l * DM);
        conv_matrix(INF(IN_WOUT) + (size_t)l * DM * DM, DM, DM, (bf16*)(ws + WS_WOUT) + (size_t)l * DM * DM, 0, gw, NGW, scr, lane);
        conv_matrix(INF(IN_PLEG) + (size_t)l * DM * DM, DM, DM, (bf16*)(ws + WS_WG) + (size_t)l * DM * DM, 0, gw, NGW, scr, lane, INF(IN_GPLE) + l * DM);
        conv_matrix(INF(IN_PLEP) + (size_t)l * 256 * DM, 256, DM, (bf16*)(ws + WS_WP) + (size_t)l * DM * 256, 0, gw, NGW, scr, lane);
        conv_matrix(INF(IN_KCW1) + (size_t)l * 2048 * 128, 2048, 128, (bf16*)(ws + WS_CW1) + (size_t)(l * 2 + 0) * 128 * 2048, 0, gw, NGW, scr, lane);
        conv_matrix(INF(IN_VCW1) + (size_t)l * 2048 * 128, 2048, 128, (bf16*)(ws + WS_CW1) + (size_t)(l * 2 + 1) * 128 * 2048, 0, gw, NGW, scr, lane);
        bf16* lora = (bf16*)(ws + WS_LORA) + (size_t)l * 65536;
        conv_matrix(INF(IN_RWWUP) + (size_t)l * 64 * 256, 64, 256, lora, 0, gw, NGW, scr, lane);
        conv_matrix(INF(IN_RWAUP) + (size_t)l * 64 * 256, 64, 256, lora + 16384, 0, gw, NGW, scr, lane);
        conv_matrix(INF(IN_RWGUP) + (size_t)l * 128 * 256, 128, 256, lora + 32768, 0, gw, NGW, scr, lane);
        { u32x4* zr = (u32x4*)((bf16*)(ws + WS_WIN) + ((size_t)l * ZLD + DIN) * DM); const size_t n16 = (size_t)(ZLD - DIN) * DM * 2 / 16;
          for (size_t i = gt; i < n16; i += NGT) zr[i] = (u32x4){0u, 0u, 0u, 0u}; }
    }
    conv_matrix(INF(IN_FW1), DM, DFF, (bf16*)(ws + WS_W13), 1, gw, NGW, scr, lane, INF(IN_GFFN));
    conv_matrix(INF(IN_FW3), DM, DFF, (bf16*)(ws + WS_W13), 2, gw, NGW, scr, lane, INF(IN_GFFN));
    conv_matrix(INF(IN_FW2), DFF, DM, (bf16*)(ws + WS_W2), 0, gw, NGW, scr, lane);
    { const f32x4* src = (const f32x4*)INF(IN_P); u32x2* dst = (u32x2*)(ws + WS_PB); const size_t n4 = (size_t)2 * MT * 256 / 4;
      for (size_t i = gt; i < n4; i += NGT) { const f32x4 v = src[i]; u32x2 w; w.x = pk2(v.x, v.y); w.y = pk2(v.z, v.w); dst[i] = w; } }
    { const int* pos = (const int*)ldptr(IN_POS); float* ct = (float*)(ws + WS_ROPE); float* st = ct + (size_t)MT * 8;
      const float inv[8] = {1.0f, 0.1939227432012558f, 0.03760603070259094f, 0.007292664609849453f, 0.0014142135623842478f, 0.00027424818836152554f, 5.3182957344688475e-05f, 1.0313385246263351e-05f};
      for (size_t i = gt; i < (size_t)MT * 8; i += NGT) { const int m = (int)(i >> 3), k = (int)(i & 7);
          float iv = inv[0];
#pragma unroll
          for (int q = 1; q < 8; ++q) iv = (k == q) ? inv[q] : iv;
          const float ang = (float)pos[m] * iv;
          const double ad = (double)ang; const double kq = __builtin_rint(ad * 0.15915494309189535); const float red = (float)(ad - kq * 6.283185307179586);
          ct[i] = __cosf(red); st[i] = __sinf(red); } }
    if (blockIdx.x < 64) {
        const int lk = blockIdx.x >> 4, ck = blockIdx.x & 15, l = lk >> 1, kv = lk & 1; const float* W1 = INF(kv ? IN_VCW1 : IN_KCW1) + (size_t)l * 2048 * 128; const float* pos = INF(IN_CMPPOS) + (size_t)l * 2048;
        LAS float* red = (LAS float*)(lds + 8448);
        const int hid = tid & 127, part = tid >> 7; const int kb = ck * 128 + part * 32; float s = 0.f;
#pragma unroll
        for (int k = 0; k < 32; ++k) s += pos[kb + k] * W1[(size_t)(kb + k) * 128 + hid];
        red[part * 128 + hid] = s; __syncthreads();
        if (tid < 128) ((float*)(ws + WS_CBIAS))[(lk * 16 + ck) * 128 + tid] = red[tid] + red[128 + tid] + red[256 + tid] + red[384 + tid];
    }
    for (int m = gw; m < MT; m += NGW) init_row(INF(IN_X) + (size_t)m * DM, (bf16*)(ws + WS_HN) + (size_t)m * DM, a.out + (size_t)m * DM, (float*)(ws + WS_RSS) + (size_t)m * 16, lane);
}

template <int MODE>
__device__ __forceinline__ void phase_norm(const Args& a, LAS unsigned char* lds, const float* g) {
    const int tid = opaque_tid(), lane = tid & 63, wave = __builtin_amdgcn_readfirstlane(tid >> 6);
    unsigned char* ws = ws_of(a);
    LAS int* lcnt = (LAS int*)lds;
    if (MODE == 1) { if (tid < 16) lcnt[tid] = 0; __syncthreads(); }
    for (int rb = blockIdx.x; rb < MT / 64; rb += gridDim.x) {
        for (int i = 0; i < 8; ++i) {
            const int m = rb * 64 + wave * 8 + i;
            float* hrow = a.out + (size_t)m * DM;
            const f32x4* xr = (const f32x4*)hrow + lane; f32x4 v[4]; float s = 0.f;
#pragma unroll
            for (int j = 0; j < 4; ++j) { v[j] = xr[64 * j]; s += (v[j].x * v[j].x + v[j].y * v[j].y) + (v[j].z * v[j].z + v[j].w * v[j].w); }
            const float rs = 1.0f / sqrtf(wave_sum(s) * (1.0f / 1024.0f) + 1e-6f);
#pragma unroll
            for (int j = 0; j < 4; ++j) { const f32x4 gg = ((const f32x4*)g + lane)[64 * j]; v[j].x *= rs * gg.x; v[j].y *= rs * gg.y; v[j].z *= rs * gg.z; v[j].w *= rs * gg.w; }
            if (MODE == 2) {
#pragma unroll
                for (int j = 0; j < 4; ++j) ((f32x4*)hrow + lane)[64 * j] = v[j];
            } else if (MODE == 0) {
                u32x2* o8 = (u32x2*)((bf16*)(ws + WS_HN) + (size_t)m * DM) + lane;
#pragma unroll
                for (int j = 0; j < 4; ++j) { u32x2 w; w.x = pk2(v[j].x, v[j].y); w.y = pk2(v[j].z, v[j].w); o8[64 * j] = w; }
            }
            if (MODE == 1) {
                const float* rw = INF(IN_RTW); float lg[8];
#pragma unroll
                for (int e = 0; e < 8; ++e) lg[e] = 0.f;
#pragma unroll
                for (int j = 0; j < 4; ++j)
#pragma unroll
                    for (int c = 0; c < 4; ++c) { const int k = 4 * (lane + 64 * j) + c; const f32x4 w0 = *(const f32x4*)(rw + (size_t)k * 8), w1 = *(const f32x4*)(rw + (size_t)k * 8 + 4); const float x = v[j][c];
                        lg[0] += x * w0.x; lg[1] += x * w0.y; lg[2] += x * w0.z; lg[3] += x * w0.w; lg[4] += x * w1.x; lg[5] += x * w1.y; lg[6] += x * w1.z; lg[7] += x * w1.w; }
#pragma unroll
                for (int e = 0; e < 8; ++e) lg[e] = wave_sum(lg[e]) + INF(IN_RTB)[e];
                int e0 = 0; float v0 = lg[0];
#pragma unroll
                for (int e = 1; e < 8; ++e) if (lg[e] > v0) { v0 = lg[e]; e0 = e; }
                int e1 = -1; float v1 = -3.0e38f;
#pragma unroll
                for (int e = 0; e < 8; ++e) if (e != e0 && lg[e] > v1) { v1 = lg[e]; e1 = e; }
                const float p1 = 1.0f / (1.0f + __expf(v0 - v1)), p0 = 1.0f - p1;
                if (lane == 0) { int* te = (int*)(ws + WS_SLOT + SL_TOKE); float* tg = (float*)(ws + WS_SLOT + SL_TOKG); te[2 * m] = e0; te[2 * m + 1] = e1; tg[2 * m] = p0; tg[2 * m + 1] = p1;
                    atomicAdd((int*)&lcnt[e0], 1); atomicAdd((int*)&lcnt[8 + e1], 1); }
            }
        }
        if (MODE == 1) { __syncthreads(); if (tid < 16) { ((int*)(ws + WS_SLOT + SL_BCNT))[rb * 16 + tid] = lcnt[tid]; lcnt[tid] = 0; } __syncthreads(); }
    }
}

__device__ __forceinline__ bf16x8 ld_bf8(const bf16* p) { return *(const bf16x8*)p; }
__device__ __forceinline__ float tanhf_(float x) { const float e = __expf(2.0f * x); return 1.0f - 2.0f / (e + 1.0f); }

__device__ __forceinline__ void rw_shift8(const bf16* z, const float* mu, int m, int tpos, int c, float (&o)[8]) {
    const u32x4 cur = *(const u32x4*)(z + (size_t)m * ZLD + ZC_B + c);
    u32x4 prv = (u32x4){0u, 0u, 0u, 0u}; if (tpos > 0) prv = *(const u32x4*)(z + (size_t)(m - 1) * ZLD + ZC_B + c);
    const f32x4 m0 = *(const f32x4*)(mu + c), m1 = *(const f32x4*)(mu + c + 4);
    float cu[8] = {bflo(cur.x), bfhi(cur.x), bflo(cur.y), bfhi(cur.y), bflo(cur.z), bfhi(cur.z), bflo(cur.w), bfhi(cur.w)};
    float pv[8] = {bflo(prv.x), bfhi(prv.x), bflo(prv.y), bfhi(prv.y), bflo(prv.z), bfhi(prv.z), bflo(prv.w), bfhi(prv.w)};
    float mm[8] = {m0.x, m0.y, m0.z, m0.w, m1.x, m1.y, m1.z, m1.w};
#pragma unroll
    for (int j = 0; j < 8; ++j) o[j] = cu[j] + (pv[j] - cu[j]) * mm[j];
}
__device__ __forceinline__ void rw_shift4(const bf16* z, const float* mu, int m, int tpos, int c, float (&o)[4]) {
    const u32x2 cur = *(const u32x2*)(z + (size_t)m * ZLD + ZC_B + c);
    u32x2 prv = (u32x2){0u, 0u}; if (tpos > 0) prv = *(const u32x2*)(z + (size_t)(m - 1) * ZLD + ZC_B + c);
    const f32x4 m0 = *(const f32x4*)(mu + c);
    o[0] = bflo(cur.x) + (bflo(prv.x) - bflo(cur.x)) * m0.x; o[1] = bfhi(cur.x) + (bfhi(prv.x) - bfhi(cur.x)) * m0.y;
    o[2] = bflo(cur.y) + (bflo(prv.y) - bflo(cur.y)) * m0.z; o[3] = bfhi(cur.y) + (bfhi(prv.y) - bfhi(cur.y)) * m0.w;
}
__device__ __forceinline__ bf16x8 pack8(const float (&x)[8]) {
    u32x4 w; w.x = pk2(x[0], x[1]); w.y = pk2(x[2], x[3]); w.z = pk2(x[4], x[5]); w.w = pk2(x[6], x[7]);
    return __builtin_bit_cast(bf16x8, w);
}

__device__ __forceinline__ void rwkv_prep_tile(const Args& a, int layer, int m0, int lane, int hc_lo, int hc_hi) {
    unsigned char* ws = ws_of(a);
    const bf16* z = (const bf16*)(ws + WS_Z);
    const float* mu = INF(IN_RWMU) + (size_t)layer * 1024;
    const bf16* lora = (const bf16*)(ws + WS_LORA) + (size_t)layer * 65536;
    const bf16* wupT = lora; const bf16* aupT = lora + 16384; const bf16* gupT = lora + 32768;
    const int fq = lane >> 4, fr = lane & 15;
    const int m = m0 + fr, tpos = m & (SEQ - 1), bb = m >> 12;
    bf16x8 wdB[2], adB[2], gdB[4];
#pragma unroll
    for (int ks = 0; ks < 2; ++ks) { float x[8]; rw_shift8(z, mu, m, tpos, 768 + 32 * ks + 8 * fq, x);
#pragma unroll
        for (int j = 0; j < 8; ++j) x[j] = tanhf_(x[j]);
        wdB[ks] = pack8(x);
        rw_shift8(z, mu, m, tpos, 832 + 32 * ks + 8 * fq, x); adB[ks] = pack8(x); }
#pragma unroll
    for (int ks = 0; ks < 4; ++ks) { float x[8]; rw_shift8(z, mu, m, tpos, 896 + 32 * ks + 8 * fq, x);
#pragma unroll
        for (int j = 0; j < 8; ++j) x[j] = sigmoidf_(x[j]);
        gdB[ks] = pack8(x); }
    const float* w0p = INF(IN_RWW0) + layer * 256; const float* a0p = INF(IN_RWA0) + layer * 256; const float* kkp = INF(IN_RWKK) + layer * 256;
    const float* kap = INF(IN_RWKA) + layer * 256; const float* rkp = INF(IN_RWRK) + layer * 256;
    float* rec = (float*)(ws + WS_REC); float* gbuf = (float*)(ws + WS_G); float* bonus = (float*)(ws + WS_BONUS);
    float ss = 0.f, bs = 0.f, inv = 0.f;
#pragma unroll 1
    for (int hc = hc_lo; hc < hc_hi; ++hc) {
        const int h = hc >> 2, ct = hc & 3;
        if (ct == 0) {
            ss = 0.f; bs = 0.f;
#pragma unroll
            for (int c2 = 0; c2 < 4; ++c2) { const int c0 = h * 64 + 16 * c2 + 4 * fq; float k4[4]; rw_shift4(z, mu, m, tpos, 256 + c0, k4); const f32x4 k_k = *(const f32x4*)(kkp + c0);
#pragma unroll
                for (int i = 0; i < 4; ++i) { const float kx = k4[i] * k_k[i]; ss += kx * kx; } }
            ss += __shfl_xor(ss, 16); ss += __shfl_xor(ss, 32);
            inv = 1.0f / sqrtf(fmaxf(ss, 1e-24f));
        }
        f32x4 aw = (f32x4){0.f, 0.f, 0.f, 0.f}, aa = aw, ag = aw;
        const int chr = h * 64 + 16 * ct + fr;
#pragma unroll
        for (int ks = 0; ks < 2; ++ks) { const bf16x8 A1 = ld_bf8(wupT + chr * 64 + 32 * ks + 8 * fq), A2 = ld_bf8(aupT + chr * 64 + 32 * ks + 8 * fq);
            aw = __builtin_amdgcn_mfma_f32_16x16x32_bf16(A1, wdB[ks], aw, 0, 0, 0); aa = __builtin_amdgcn_mfma_f32_16x16x32_bf16(A2, adB[ks], aa, 0, 0, 0); }
#pragma unroll
        for (int ks = 0; ks < 4; ++ks) { const bf16x8 A3 = ld_bf8(gupT + chr * 128 + 32 * ks + 8 * fq); ag = __builtin_amdgcn_mfma_f32_16x16x32_bf16(A3, gdB[ks], ag, 0, 0, 0); }
        float* rp = rec + ((size_t)(bb * 4 + h) * SEQ + tpos) * 384;
        const int c0 = h * 64 + 16 * ct + 4 * fq, d0 = 16 * ct + 4 * fq;
        float r4[4], k4[4], v4[4]; rw_shift4(z, mu, m, tpos, c0, r4); rw_shift4(z, mu, m, tpos, 256 + c0, k4); rw_shift4(z, mu, m, tpos, 512 + c0, v4);
        const f32x4 w0 = *(const f32x4*)(w0p + c0), a0 = *(const f32x4*)(a0p + c0), k_k = *(const f32x4*)(kkp + c0), k_a = *(const f32x4*)(kap + c0), r_k = *(const f32x4*)(rkp + c0);
        f32x4 odw, okk, ob, okp;
#pragma unroll
        for (int i = 0; i < 4; ++i) {
            const float wl = w0[i] + aw[i]; const float nx = -wl; const float sp = fmaxf(nx, 0.f) + log1pf(__expf(-fabsf(nx)));
            const float wlog = -sp - 0.5f; odw[i] = __expf(-__expf(wlog));
            const float aval = sigmoidf_(a0[i] + aa[i]);
            const float kkn = k4[i] * k_k[i] * inv; okk[i] = kkn; ob[i] = kkn * aval;
            const float kpv = k4[i] * (1.0f + (aval - 1.0f) * k_a[i]); okp[i] = kpv;
            bs += r4[i] * kpv * r_k[i];
        }
        *(f32x4*)(rp + d0) = odw; *(f32x4*)(rp + 64 + d0) = okk; *(f32x4*)(rp + 128 + d0) = ob; *(f32x4*)(rp + 192 + d0) = okp;
        *(f32x4*)(rp + 256 + d0) = (f32x4){r4[0], r4[1], r4[2], r4[3]}; *(f32x4*)(rp + 320 + d0) = (f32x4){v4[0], v4[1], v4[2], v4[3]};
        *(f32x4*)(gbuf + (size_t)m * 256 + c0) = ag;
        if (ct == 3) { float b2 = bs; b2 += __shfl_xor(b2, 16); b2 += __shfl_xor(b2, 32); if (fq == 0) bonus[(size_t)m * 4 + h] = b2; }
    }
}

__device__ __forceinline__ void nsa_prep_item(const Args& a, LAS unsigned char* lds, int b, int tt) {
    unsigned char* ws = ws_of(a); const int tid = opaque_tid();
    const bf16* z = (const bf16*)(ws + WS_Z);
    const float* ct = (const float*)(ws + WS_ROPE); const float* st = ct + (size_t)MT * 8;
    const int mb = b * SEQ + tt * 64;
    for (int task = tid; task < 64 * 12; task += NTHR) {
        const int tok = task / 12, unit = task % 12, m = mb + tok;
        const bf16* src; bf16* dst;
        if (unit < 8) { src = z + (size_t)m * ZLD + ZC_Q + unit * 64; dst = (bf16*)(ws + WS_QROT) + (size_t)m * 512 + unit * 64; }
        else if (unit < 10) { src = z + (size_t)m * ZLD + ZC_KS + (unit - 8) * 64; dst = (bf16*)(ws + WS_KSR) + (size_t)m * 128 + (unit - 8) * 64; }
        else { src = z + (size_t)m * ZLD + ZC_KW + (unit - 10) * 64; dst = (bf16*)(ws + WS_KWR) + (size_t)m * 128 + (unit - 10) * 64; }
        u32x4 v[8];
#pragma unroll
        for (int i = 0; i < 8; ++i) v[i] = ((const u32x4*)src)[i];
        const f32x4 c0 = *(const f32x4*)(ct + (size_t)m * 8), c1 = *(const f32x4*)(ct + (size_t)m * 8 + 4), s0 = *(const f32x4*)(st + (size_t)m * 8), s1 = *(const f32x4*)(st + (size_t)m * 8 + 4);
        const float cc[8] = {c0.x, c0.y, c0.z, c0.w, c1.x, c1.y, c1.z, c1.w}, sn[8] = {s0.x, s0.y, s0.z, s0.w, s1.x, s1.y, s1.z, s1.w};
        const float x1[8] = {bflo(v[0].x), bfhi(v[0].x), bflo(v[0].y), bfhi(v[0].y), bflo(v[0].z), bfhi(v[0].z), bflo(v[0].w), bfhi(v[0].w)};
        const float x2[8] = {bflo(v[1].x), bfhi(v[1].x), bflo(v[1].y), bfhi(v[1].y), bflo(v[1].z), bfhi(v[1].z), bflo(v[1].w), bfhi(v[1].w)};
        float o1[8], o2[8];
#pragma unroll
        for (int i = 0; i < 8; ++i) { o1[i] = x1[i] * cc[i] - x2[i] * sn[i]; o2[i] = x1[i] * sn[i] + x2[i] * cc[i]; }
        v[0] = (u32x4){pk2(o1[0], o1[1]), pk2(o1[2], o1[3]), pk2(o1[4], o1[5]), pk2(o1[6], o1[7])};
        v[1] = (u32x4){pk2(o2[0], o2[1]), pk2(o2[2], o2[3]), pk2(o2[4], o2[5]), pk2(o2[6], o2[7])};
#pragma unroll
        for (int i = 0; i < 8; ++i) ((u32x4*)dst)[i] = v[i];
    }
    LAS bf16* tile = (LAS bf16*)lds;
    { const int tok = tid >> 3, ch = tid & 7;
#pragma unroll
      for (int mi = 0; mi < 4; ++mi) { const int col = (mi < 2 ? ZC_VS : ZC_VW) + (mi & 1) * 64;
          *(LAS u32x4*)(tile + mi * 4608 + tok * 72 + ch * 8) = *(const u32x4*)(z + (size_t)(mb + tok) * ZLD + col + ch * 8); } }
    __syncthreads();
    { const int d = tid >> 3, tc = tid & 7;
#pragma unroll
      for (int mi = 0; mi < 4; ++mi) { unsigned e[8];
#pragma unroll
          for (int j = 0; j < 8; ++j) e[j] = tile[mi * 4608 + (tc * 8 + j) * 72 + d];
          u32x4 w; w.x = e[0] | (e[1] << 16); w.y = e[2] | (e[3] << 16); w.z = e[4] | (e[5] << 16); w.w = e[6] | (e[7] << 16);
          bf16* dst = (bf16*)(ws + (mi < 2 ? WS_VST : WS_VWT)) + ((size_t)(b * 2 + (mi & 1)) * 64 + d) * SEQ + tt * 64 + tc * 8;
          *(u32x4*)dst = w; } }
    __syncthreads();
}

__device__ __forceinline__ void nsa_compress_item(const Args& a, int layer, LAS unsigned char* lds, int b, int g, int kv, int nt) {
    unsigned char* ws = ws_of(a); const int tid = opaque_tid(), lane = tid & 63, wave = __builtin_amdgcn_readfirstlane(tid >> 6), fq = lane >> 4, fr = lane & 15;
    const bf16* z = (const bf16*)(ws + WS_Z);
    const bf16* w1t = (const bf16*)(ws + WS_CW1) + (size_t)(layer * 2 + kv) * 128 * 2048;
    const int colb = (kv ? ZC_VC : ZC_KC) + g * 64;
    f32x4 acc[8];
#pragma unroll
    for (int ht = 0; ht < 8; ++ht) acc[ht] = (f32x4){0.f, 0.f, 0.f, 0.f};
    for (int li = 0; li < 4; ++li) { const int l = wave * 4 + li;
        int tok = 256 * nt + 16 * fr + l; tok = tok > SEQ - 1 ? SEQ - 1 : tok;
#pragma unroll
        for (int hf = 0; hf < 2; ++hf) {
            const bf16x8 B = ld_bf8(z + (size_t)(b * SEQ + tok) * ZLD + colb + 32 * hf + 8 * fq);
#pragma unroll
            for (int ht = 0; ht < 8; ++ht) { const bf16x8 A = ld_bf8(w1t + (size_t)(16 * ht + fr) * 2048 + 64 * l + 32 * hf + 8 * fq);
                acc[ht] = __builtin_amdgcn_mfma_f32_16x16x32_bf16(A, B, acc[ht], 0, 0, 0); } } }
    LAS float* part = (LAS float*)lds;
    LAS float* hid = (LAS float*)(lds + 65536);
#pragma unroll
    for (int ht = 0; ht < 8; ++ht)
#pragma unroll
        for (int r = 0; r < 4; ++r) part[(wave * 128 + 16 * ht + 4 * fq + r) * 16 + fr] = acc[ht][r];
    __syncthreads();
    { const int hh = tid >> 2, nq = tid & 3; f32x4 s = (f32x4){0.f, 0.f, 0.f, 0.f};
#pragma unroll
      for (int w = 0; w < 8; ++w) s = s + *(LAS f32x4*)(part + (w * 128 + hh) * 16 + 4 * nq);
      float cb = 0.f; { const float* cbp = (const float*)(ws + WS_CBIAS) + (size_t)(layer * 2 + kv) * 16 * 128 + hh;
#pragma unroll
        for (int c = 0; c < 16; ++c) cb += cbp[c * 128]; }
      f32x4 o; o.x = gelu_tanh(s.x + cb); o.y = gelu_tanh(s.y + cb); o.z = gelu_tanh(s.z + cb); o.w = gelu_tanh(s.w + cb);
      *(LAS f32x4*)(hid + hh * 16 + 4 * nq) = o; }
    __syncthreads();
    { const float* W2 = INF(kv ? IN_VCW2 : IN_KCW2) + (size_t)layer * 128 * 64; const int n = tid & 15, dg = tid >> 4; float o0 = 0.f, o1 = 0.f;
      for (int hh = 0; hh < 128; ++hh) { const float x = hid[hh * 16 + n]; o0 += x * W2[hh * 64 + dg]; o1 += x * W2[hh * 64 + dg + 32]; }
      const int ng = 16 * nt + n; if (ng >= NCMP) { o0 = 0.f; o1 = 0.f; }
      if (kv == 0) { bf16* kc = (bf16*)(ws + WS_KCMP) + ((size_t)(b * 2 + g) * 256 + ng) * 64; kc[dg] = (bf16)f2bf(o0); kc[dg + 32] = (bf16)f2bf(o1); }
      else { bf16* vc = (bf16*)(ws + WS_VCMPT) + (size_t)(b * 2 + g) * 64 * 256; vc[(size_t)dg * 256 + ng] = (bf16)f2bf(o0); vc[(size_t)(dg + 32) * 256 + ng] = (bf16)f2bf(o1); } }
    __syncthreads();
}

__device__ __forceinline__ void phase_prep(const Args& a, int layer, LAS unsigned char* lds) {
    const int tid = opaque_tid(), lane = tid & 63, wave = __builtin_amdgcn_readfirstlane(tid >> 6);
#ifndef NO_RWP
    for (int tile = blockIdx.x * 4 + (wave & 3); tile < MT / 16; tile += gridDim.x * 4) rwkv_prep_tile(a, layer, tile * 16, lane, 8 * (wave >> 2), 8 * (wave >> 2) + 8);
#endif
#ifndef NO_NSAP
    for (int it = blockIdx.x; it < NB * 64; it += gridDim.x) nsa_prep_item(a, lds, it >> 6, it & 63);
#endif
#ifndef NO_CMP
    for (int it = blockIdx.x; it < NB * 2 * 2 * 16; it += gridDim.x) nsa_compress_item(a, layer, lds, it >> 6, (it >> 5) & 1, (it >> 4) & 1, it & 15);
#endif
}

__device__ __forceinline__ float dpp_xor1(float x) { return __builtin_bit_cast(float, __builtin_amdgcn_update_dpp(0, __builtin_bit_cast(int, x), 0xB1, 0xf, 0xf, true)); }
__device__ __forceinline__ float dpp_xor2(float x) { return __builtin_bit_cast(float, __builtin_amdgcn_update_dpp(0, __builtin_bit_cast(int, x), 0x4E, 0xf, 0xf, true)); }
__device__ __forceinline__ float dpp_hmir(float x) { return __builtin_bit_cast(float, __builtin_amdgcn_update_dpp(0, __builtin_bit_cast(int, x), 0x141, 0xf, 0xf, true)); }
__device__ __forceinline__ float red8(float x) { x += dpp_xor1(x); x += dpp_xor2(x); x += dpp_hmir(x); return x; }

__device__ __forceinline__ void rwkv_scan_seg(const Args& a, LAS unsigned char* lds, int bh, int seg) {
    unsigned char* ws = ws_of(a); const int tid = opaque_tid(), lane = tid & 63, wave = __builtin_amdgcn_readfirstlane(tid >> 6);
    const int row = wave * 8 + (lane >> 3), kq = lane & 7;
    const f32x4* rec4 = (const f32x4*)(ws + WS_REC) + ((size_t)bh * SEQ + (size_t)seg * SEGLEN) * 96;
    const size_t yoff = ((size_t)(bh >> 2) * SEQ + (size_t)seg * SEGLEN) * 256 + (bh & 3) * 64 + row;
    float* yraw = (float*)(ws + WS_YRAW) + yoff; float* ypb = (float*)(ws + WS_YP) + yoff;
    LAS f32x4* buf = (LAS f32x4*)lds;
    float s[8], q[8];
#pragma unroll
    for (int j = 0; j < 8; ++j) { s[j] = 0.f; q[j] = (8 * kq + j == row) ? 1.f : 0.f; }
    __syncthreads();
    { f32x4 p0 = rec4[tid], p1 = rec4[tid + 512], p2 = rec4[tid + 1024]; buf[tid] = p0; buf[tid + 512] = p1; buf[tid + 1024] = p2; }
    __syncthreads();
    for (int c = 0; c < SEGLEN / 16; ++c) {
        const int p = c & 1;
        f32x4 n0, n1, n2; const bool more = (c + 1 < SEGLEN / 16);
        if (more) { const f32x4* src = rec4 + (size_t)(c + 1) * 1536; n0 = src[tid]; n1 = src[tid + 512]; n2 = src[tid + 1024]; }
        const LAS f32x4* bp = buf + p * 1536;
#pragma unroll 2
        for (int st = 0; st < 16; ++st) {
            const LAS f32x4* sp = bp + st * 96;
            const f32x4 w0 = sp[2 * kq], w1 = sp[2 * kq + 1], k0 = sp[16 + 2 * kq], k1 = sp[16 + 2 * kq + 1], b0 = sp[32 + 2 * kq], b1 = sp[32 + 2 * kq + 1];
            const f32x4 q0 = sp[48 + 2 * kq], q1 = sp[48 + 2 * kq + 1], r0 = sp[64 + 2 * kq], r1 = sp[64 + 2 * kq + 1];
            const float vv = ((const LAS float*)(sp + 80))[row];
            const float wv[8] = {w0.x, w0.y, w0.z, w0.w, w1.x, w1.y, w1.z, w1.w}, kk[8] = {k0.x, k0.y, k0.z, k0.w, k1.x, k1.y, k1.z, k1.w};
            const float bv[8] = {b0.x, b0.y, b0.z, b0.w, b1.x, b1.y, b1.z, b1.w}, kp[8] = {q0.x, q0.y, q0.z, q0.w, q1.x, q1.y, q1.z, q1.w};
            const float rr[8] = {r0.x, r0.y, r0.z, r0.w, r1.x, r1.y, r1.z, r1.w};
            float d1 = (s[0] * kk[0] + s[1] * kk[1]) + (s[2] * kk[2] + s[3] * kk[3]) + ((s[4] * kk[4] + s[5] * kk[5]) + (s[6] * kk[6] + s[7] * kk[7]));
            float e1 = (q[0] * kk[0] + q[1] * kk[1]) + (q[2] * kk[2] + q[3] * kk[3]) + ((q[4] * kk[4] + q[5] * kk[5]) + (q[6] * kk[6] + q[7] * kk[7]));
            d1 += dpp_xor1(d1); e1 += dpp_xor1(e1); d1 += dpp_xor2(d1); e1 += dpp_xor2(e1); d1 += dpp_hmir(d1); e1 += dpp_hmir(e1);
            const float sa = -d1, sq = -e1;
            float d2 = 0.f, e2 = 0.f;
#pragma unroll
            for (int j = 0; j < 8; ++j) { s[j] = s[j] * wv[j] + (sa * bv[j] + vv * kp[j]); d2 += s[j] * rr[j]; q[j] = q[j] * wv[j] + sq * bv[j]; e2 += q[j] * rr[j]; }
            d2 += dpp_xor1(d2); e2 += dpp_xor1(e2); d2 += dpp_xor2(d2); e2 += dpp_xor2(e2); d2 += dpp_hmir(d2); e2 += dpp_hmir(e2);
            if (kq == 0) { yraw[(size_t)(c * 16 + st) * 256] = d2; ypb[(size_t)(c * 16 + st) * 256] = e2; }
        }
        if (more) { LAS f32x4* dp = buf + (p ^ 1) * 1536; dp[tid] = n0; dp[tid + 512] = n1; dp[tid + 1024] = n2; }
        __syncthreads();
    }
    float* se = (float*)(ws + WS_SEGE) + ((size_t)(bh * NSEG + seg) * 2) * 4096 + row * 64 + 8 * kq;
    *(f32x4*)se = (f32x4){s[0], s[1], s[2], s[3]}; *(f32x4*)(se + 4) = (f32x4){s[4], s[5], s[6], s[7]};
    *(f32x4*)(se + 4096) = (f32x4){q[0], q[1], q[2], q[3]}; *(f32x4*)(se + 4096 + 4) = (f32x4){q[4], q[5], q[6], q[7]};
}

__device__ __forceinline__ void rwkv_chain(const Args& a, LAS unsigned char* lds, int bh) {
    unsigned char* ws = ws_of(a); const int tid = opaque_tid();
    LAS float* S = (LAS float*)lds;
    LAS float* P = S + 64 * 68;
    const int v = tid >> 3, kg = tid & 7;
    float* sst = (float*)(ws + WS_SST) + (size_t)bh * NSEG * 4096;
    const float* sege = (const float*)(ws + WS_SEGE) + (size_t)bh * NSEG * 2 * 4096;
    __syncthreads();
    for (int i = tid; i < 64 * 68; i += NTHR) S[i] = 0.f;
    for (int i = tid; i < 4096; i += NTHR) sst[i] = 0.f;
    __syncthreads();
    for (int sg = 1; sg < NSEG; ++sg) {
        const float* e0 = sege + (size_t)(sg - 1) * 2 * 4096;
        for (int i = tid; i < 1024; i += NTHR) *(LAS f32x4*)(P + 4 * i) = *(const f32x4*)(e0 + 4096 + 4 * i);
        f32x4 o0 = *(const f32x4*)(e0 + v * 64 + 8 * kg), o1 = *(const f32x4*)(e0 + v * 64 + 8 * kg + 4);
        __syncthreads();
#pragma unroll 4
        for (int i = 0; i < 64; ++i) { const float sv = S[v * 68 + i]; const f32x4 p0 = *(const LAS f32x4*)(P + i * 64 + 8 * kg), p1 = *(const LAS f32x4*)(P + i * 64 + 8 * kg + 4);
            o0 = o0 + p0 * sv; o1 = o1 + p1 * sv; }
        __syncthreads();
        *(LAS f32x4*)(S + v * 68 + 8 * kg) = o0; *(LAS f32x4*)(S + v * 68 + 8 * kg + 4) = o1;
        *(f32x4*)(sst + (size_t)sg * 4096 + v * 64 + 8 * kg) = o0; *(f32x4*)(sst + (size_t)sg * 4096 + v * 64 + 8 * kg + 4) = o1;
        __syncthreads();
    }
}

__device__ __forceinline__ void rwkv_post_item(const Args& a, int layer, LAS unsigned char* lds, int bh, int tile) {
    unsigned char* ws = ws_of(a); const int tid = opaque_tid();
    const int seg = tile / (SEGLEN / 64), bb = bh >> 2, h = bh & 3;
    LAS float* S = (LAS float*)lds;
    LAS float* YP = S + 64 * 68;
    const float* sst = (const float*)(ws + WS_SST) + (size_t)(bh * NSEG + seg) * 4096;
    const size_t m0 = (size_t)bb * SEQ + (size_t)tile * 64;
    __syncthreads();
    for (int i = tid; i < 1024; i += NTHR) { const int r = i >> 4, c4 = i & 15; *(LAS f32x4*)(S + r * 68 + 4 * c4) = *(const f32x4*)(sst + r * 64 + 4 * c4);
        *(LAS f32x4*)(YP + r * 68 + 4 * c4) = *(const f32x4*)((const float*)(ws + WS_YP) + (m0 + r) * 256 + h * 64 + 4 * c4); }
    __syncthreads();
    const int tok = tid >> 3, vg = tid & 7; const size_t m = m0 + tok; const int c0 = h * 64 + 8 * vg;
    const f32x4 ya = *(const f32x4*)((const float*)(ws + WS_YRAW) + m * 256 + c0), yb = *(const f32x4*)((const float*)(ws + WS_YRAW) + m * 256 + c0 + 4);
    float y[8] = {ya.x, ya.y, ya.z, ya.w, yb.x, yb.y, yb.z, yb.w};
    if (seg > 0) {
#pragma unroll 4
        for (int i = 0; i < 64; i += 4) { const f32x4 yp = *(const LAS f32x4*)(YP + tok * 68 + i);
#pragma unroll
            for (int j = 0; j < 8; ++j) { const f32x4 sr = *(const LAS f32x4*)(S + (8 * vg + j) * 68 + i); y[j] += (sr.x * yp.x + sr.y * yp.y) + (sr.z * yp.z + sr.w * yp.w); } }
    }
    float sm = 0.f;
#pragma unroll
    for (int j = 0; j < 8; ++j) sm += y[j];
    sm += __shfl_xor(sm, 1); sm += __shfl_xor(sm, 2); sm += __shfl_xor(sm, 4);
    const float mean = sm * (1.0f / 64.0f); float qq = 0.f;
#pragma unroll
    for (int j = 0; j < 8; ++j) { y[j] -= mean; qq += y[j] * y[j]; }
    qq += __shfl_xor(qq, 1); qq += __shfl_xor(qq, 2); qq += __shfl_xor(qq, 4);
    const float rstd = 1.0f / sqrtf(qq * (1.0f / 64.0f) + 64e-5f);
    const float* gng = INF(IN_RWGNG) + layer * 256 + c0; const float* gnb = INF(IN_RWGNB) + layer * 256 + c0;
    const float* gt = (const float*)(ws + WS_G) + m * 256 + c0;
    const float* vv = (const float*)(ws + WS_REC) + ((size_t)bh * SEQ + (size_t)tile * 64 + tok) * 384 + 320 + 8 * vg;
    const float bo = ((const float*)(ws + WS_BONUS))[m * 4 + h];
    float o[8];
#pragma unroll
    for (int j = 0; j < 8; ++j) o[j] = (y[j] * rstd * gng[j] + gnb[j] + vv[j] * bo) * gt[j];
    u32x4 w; w.x = pk2(o[0], o[1]); w.y = pk2(o[2], o[3]); w.z = pk2(o[4], o[5]); w.w = pk2(o[6], o[7]);
    *(u32x4*)((bf16*)(ws + WS_YCAT) + m * DM + 256 + c0) = w;
}

__device__ __forceinline__ void gmlp_item(const Args& a, int layer, LAS unsigned char* lds, int b, int n, int h) {
    unsigned char* ws = ws_of(a); const int tid = opaque_tid(), lane = tid & 63, wave = __builtin_amdgcn_readfirstlane(tid >> 6), fq = lane >> 4, fr = lane & 15;
    const bf16* z = (const bf16*)(ws + WS_Z); bf16* ycat = (bf16*)(ws + WS_YCAT);
    LAS bf16* vt = (LAS bf16*)lds;
    const int mb = b * SEQ + n * 128;
    { const int s = tid >> 2, part = tid & 3; const bf16* src = z + (size_t)(mb + s) * ZLD + ZC_V + h * 64 + part * 16;
      const u32x4 v0 = ((const u32x4*)src)[0], v1 = ((const u32x4*)src)[1];
      float x[16] = {bflo(v0.x), bfhi(v0.x), bflo(v0.y), bfhi(v0.y), bflo(v0.z), bfhi(v0.z), bflo(v0.w), bfhi(v0.w), bflo(v1.x), bfhi(v1.x), bflo(v1.y), bfhi(v1.y), bflo(v1.z), bfhi(v1.z), bflo(v1.w), bfhi(v1.w)};
      float sm = 0.f;
#pragma unroll
      for (int j = 0; j < 16; ++j) { x[j] = gelu_tanh(x[j]); sm += x[j]; }
      sm += __shfl_xor(sm, 1); sm += __shfl_xor(sm, 2);
      const float mean = sm * (1.0f / 64.0f); float q = 0.f;
#pragma unroll
      for (int j = 0; j < 16; ++j) { x[j] -= mean; q += x[j] * x[j]; }
      q += __shfl_xor(q, 1); q += __shfl_xor(q, 2);
      const float rstd = 1.0f / sqrtf(q * (1.0f / 64.0f) + 1e-5f);
      const float* lg = INF(IN_GMLNG) + (layer * 4 + h) * 64 + part * 16; const float* lb = INF(IN_GMLNB) + (layer * 4 + h) * 64 + part * 16;
#pragma unroll
      for (int j = 0; j < 16; ++j) vt[(part * 16 + j) * 136 + s] = (bf16)f2bf(x[j] * rstd * lg[j] + lb[j]); }
    __syncthreads();
    {
        const float* W = INF(IN_GMWS) + ((size_t)(layer * 4 + h) * 128 + 16 * wave + fr) * 128;
        f32x4 acc[4];
#pragma unroll
        for (int dt = 0; dt < 4; ++dt) acc[dt] = (f32x4){0.f, 0.f, 0.f, 0.f};
        const int trow = 16 * wave + fr; const int nks = (wave >> 1) + 1;
        for (int ks = 0; ks < nks; ++ks) {
            const int s0 = 32 * ks + 8 * fq; const f32x4 wa = *(const f32x4*)(W + s0), wb = *(const f32x4*)(W + s0 + 4);
            float wv[8] = {wa.x, wa.y, wa.z, wa.w, wb.x, wb.y, wb.z, wb.w};
#pragma unroll
            for (int j = 0; j < 8; ++j) wv[j] = (s0 + j <= trow) ? wv[j] : 0.f;
            const bf16x8 A = pack8(wv);
#pragma unroll
            for (int dt = 0; dt < 4; ++dt) { const bf16x8 B = *(const LAS bf16x8*)(vt + (16 * dt + fr) * 136 + s0); acc[dt] = __builtin_amdgcn_mfma_f32_16x16x32_bf16(A, B, acc[dt], 0, 0, 0); } }
        const float* bs = INF(IN_GMBS) + (layer * 4 + h) * 128;
#pragma unroll
        for (int r = 0; r < 4; ++r) { const int t = 16 * wave + 4 * fq + r; const float bias = bs[t];
#pragma unroll
            for (int dt = 0; dt < 4; ++dt) { const int d = 16 * dt + fr; const float u = gelu_tanh(bf2f(z[(size_t)(mb + t) * ZLD + ZC_U + h * 64 + d]));
                ycat[(size_t)(mb + t) * DM + h * 64 + d] = (bf16)f2bf(u * (acc[dt][r] + bias)); } }
    }
    __syncthreads();
}

constexpr int NSA_KB = 0, NSA_VB = 18432, NSA_IMP = 36864, NSA_SELM = 53248, NSA_UNI = 53760, NSA_OT = 54272;
struct NsaTileSrc { const bf16* kbase; int kld; const bf16* vbase; int vld; };

__device__ __forceinline__ void nsa_tile_load(const NsaTileSrc& S, int kb, int tid, u32x4& kr, u32x4& vr) {
    const int row = tid >> 3, ch = tid & 7;
    kr = *(const u32x4*)(S.kbase + (size_t)(kb * 64 + row) * S.kld + ch * 8);
    vr = *(const u32x4*)(S.vbase + (size_t)row * S.vld + kb * 64 + ch * 8);
}
__device__ __forceinline__ void nsa_tile_store(LAS unsigned char* lds, int p, int tid, const u32x4& kr, const u32x4& vr) {
    const int row = tid >> 3, ch = tid & 7;
    *(LAS u32x4*)(lds + NSA_KB + p * 9216 + (row * 72 + ch * 8) * 2) = kr;
    *(LAS u32x4*)(lds + NSA_VB + p * 9216 + (row * 72 + ch * 8) * 2) = vr;
}
__device__ __forceinline__ void nsa_scores(LAS unsigned char* lds, int p, const bf16x8 (&Q)[2][2], f32x4 (&sc)[4][2], int fq, int fr) {
#pragma unroll
    for (int kt = 0; kt < 4; ++kt) {
        const LAS unsigned char* kp = lds + NSA_KB + p * 9216 + ((16 * kt + fr) * 72 + 8 * fq) * 2;
        const bf16x8 K0 = *(const LAS bf16x8*)kp, K1 = *(const LAS bf16x8*)(kp + 64);
#pragma unroll
        for (int qg = 0; qg < 2; ++qg) { f32x4 c = (f32x4){0.f, 0.f, 0.f, 0.f};
            c = __builtin_amdgcn_mfma_f32_16x16x32_bf16(K0, Q[qg][0], c, 0, 0, 0); c = __builtin_amdgcn_mfma_f32_16x16x32_bf16(K1, Q[qg][1], c, 0, 0, 0); sc[kt][qg] = c; } }
}
template <int MODE>
__device__ __forceinline__ bool nsa_allowed(int kidx, int t, int kb, unsigned long long selm) {
    if (MODE == 0) return (16 * kidx + 31 <= t) && (kidx < NCMP);
    if (MODE == 1) return (kidx <= t) && ((selm >> kb) & 1ull);
    return (kidx <= t) && (kidx + 512 > t);
}
template <int MODE, int MM>
__device__ __forceinline__ void nsa_tile_compute(LAS unsigned char* lds, int p, int kb, const bf16x8 (&Q)[2][2], const int (&tq)[2], const unsigned long long (&selm)[2],
                                                 float (&m_run)[2], float (&l_run)[2], f32x4 (&O)[4][2], int fq, int fr) {
    f32x4 sc[4][2];
    nsa_scores(lds, p, Q, sc, fq, fr);
    const float SC = 0.125f * 1.4426950408889634f;
    bf16x8 P[2][2]; float alpha[2];
#pragma unroll
    for (int qg = 0; qg < 2; ++qg) {
        float mx = -1e30f; float tokf = 1.0f;
        if (MM == 2) {
#pragma unroll
            for (int kt = 0; kt < 4; ++kt)
#pragma unroll
                for (int r = 0; r < 4; ++r) { const int kidx = kb * 64 + 16 * kt + 4 * fq + r;
                    const float v = nsa_allowed<MODE>(kidx, tq[qg], kb, selm[qg]) ? sc[kt][qg][r] * SC : -1e30f; sc[kt][qg][r] = v; mx = fmaxf(mx, v); }
        } else {
#pragma unroll
            for (int kt = 0; kt < 4; ++kt) mx = fmaxf(fmaxf(mx, fmaxf(sc[kt][qg][0], sc[kt][qg][1])), fmaxf(sc[kt][qg][2], sc[kt][qg][3]));
            mx *= SC;
            if (MM == 1) { const bool ok = (selm[qg] >> kb) & 1ull; tokf = ok ? 1.0f : 0.0f; mx = ok ? mx : -1e30f; }
        }
        mx = fmaxf(mx, __shfl_xor(mx, 16)); mx = fmaxf(mx, __shfl_xor(mx, 32));
        const float mn = fmaxf(m_run[qg], mx); alpha[qg] = __builtin_amdgcn_exp2f(m_run[qg] - mn); m_run[qg] = mn;
        float ls = 0.f; float pv[4][4];
#pragma unroll
        for (int kt = 0; kt < 4; ++kt)
#pragma unroll
            for (int r = 0; r < 4; ++r) { float e;
                if (MM == 2) { const float sv = sc[kt][qg][r]; e = (sv > -1e29f) ? __builtin_amdgcn_exp2f(sv - mn) : 0.f; }
                else { e = __builtin_amdgcn_exp2f(__builtin_fmaf(sc[kt][qg][r], SC, -mn)); if (MM == 1) e *= tokf; }
                pv[kt][r] = e; ls += e; }
        l_run[qg] = l_run[qg] * alpha[qg] + ls;
#pragma unroll
        for (int s = 0; s < 2; ++s) { u32x4 w; w.x = pg8::cvt_pk_bf16(pv[2 * s][0], pv[2 * s][1]); w.y = pg8::cvt_pk_bf16(pv[2 * s][2], pv[2 * s][3]); w.z = pg8::cvt_pk_bf16(pv[2 * s + 1][0], pv[2 * s + 1][1]); w.w = pg8::cvt_pk_bf16(pv[2 * s + 1][2], pv[2 * s + 1][3]);
            P[qg][s] = __builtin_bit_cast(bf16x8, w); }
    }
    if (!__all(alpha[0] == 1.0f && alpha[1] == 1.0f)) {
#pragma unroll
        for (int qg = 0; qg < 2; ++qg)
#pragma unroll
            for (int dt = 0; dt < 4; ++dt) O[dt][qg] = O[dt][qg] * alpha[qg];
    }
#pragma unroll
    for (int dt = 0; dt < 4; ++dt)
#pragma unroll
        for (int s = 0; s < 2; ++s) {
            const LAS unsigned char* vp = lds + NSA_VB + p * 9216 + ((16 * dt + fr) * 72 + 32 * s + 4 * fq) * 2;
            const u32x2 a0 = *(const LAS u32x2*)vp, a1 = *(const LAS u32x2*)(vp + 32);
            const u32x4 aw = (u32x4){a0.x, a0.y, a1.x, a1.y}; const bf16x8 A = __builtin_bit_cast(bf16x8, aw);
#pragma unroll
            for (int qg = 0; qg < 2; ++qg) O[dt][qg] = __builtin_amdgcn_mfma_f32_16x16x32_bf16(A, P[qg][s], O[dt][qg], 0, 0, 0);
        }
}

template <int MODE>
__device__ __forceinline__ void nsa_branch(LAS unsigned char* lds, const NsaTileSrc& S, int kb_lo, int kb_hi, int full_lo, int full_hi, unsigned long long tilemask, const bf16x8 (&Q)[2][2], const int (&tq)[2],
                                           const unsigned long long (&selm)[2], const float (&gate)[2], const bool first, float (&m_out)[2], float (&l_out)[2], int tid, int fq, int fr) {
    float m_run[2] = {-1e30f, -1e30f}, l_run[2] = {0.f, 0.f}; f32x4 O[4][2];
#pragma unroll
    for (int dt = 0; dt < 4; ++dt)
#pragma unroll
        for (int qg = 0; qg < 2; ++qg) O[dt][qg] = (f32x4){0.f, 0.f, 0.f, 0.f};
    int cur = kb_lo; while (cur <= kb_hi && !((tilemask >> cur) & 1ull)) ++cur;
    if (cur <= kb_hi) {
        u32x4 kr, vr; nsa_tile_load(S, cur, tid, kr, vr); nsa_tile_store(lds, 0, tid, kr, vr);
        __syncthreads();
        int p = 0;
        while (cur <= kb_hi) {
            int nxt = cur + 1; while (nxt <= kb_hi && !((tilemask >> nxt) & 1ull)) ++nxt;
            if (nxt <= kb_hi) nsa_tile_load(S, nxt, tid, kr, vr);
            if (MODE != 0 && cur >= full_lo && cur <= full_hi) nsa_tile_compute<MODE, (MODE == 1 ? 1 : 0)>(lds, p, cur, Q, tq, selm, m_run, l_run, O, fq, fr);
            else nsa_tile_compute<MODE, 2>(lds, p, cur, Q, tq, selm, m_run, l_run, O, fq, fr);
            if (nxt <= kb_hi) nsa_tile_store(lds, p ^ 1, tid, kr, vr);
            __syncthreads();
            p ^= 1; cur = nxt;
        }
    }
#pragma unroll
    for (int qg = 0; qg < 2; ++qg) { float l = l_run[qg]; l += __shfl_xor(l, 16); l += __shfl_xor(l, 32); l_out[qg] = l; m_out[qg] = m_run[qg];
        const float sc = l > 0.f ? gate[qg] / l : 0.f;
        LAS float* ot = (LAS float*)(lds + NSA_OT) + tid;
#pragma unroll
        for (int dt = 0; dt < 4; ++dt)
#pragma unroll
            for (int r = 0; r < 4; ++r) { LAS float* pp = ot + ((dt * 2 + qg) * 4 + r) * 512; const float v = O[dt][qg][r] * sc; *pp = first ? v : (*pp + v); } }
}

__device__ __forceinline__ void nsa_item(const Args& a, LAS unsigned char* lds, int b, int g, int T) {
    unsigned char* ws = ws_of(a); const int tid = opaque_tid(), lane = tid & 63, wave = __builtin_amdgcn_readfirstlane(tid >> 6), fq = lane >> 4, fr = lane & 15;
    const bf16* z = (const bf16*)(ws + WS_Z);
    const int head = g * 4 + (fr & 3);
    int tq[2], mq[2]; bf16x8 Qraw[2][2]; float gt[2][3];
#pragma unroll
    for (int qg = 0; qg < 2; ++qg) { const int tl = 8 * wave + 4 * qg + (fr >> 2); tq[qg] = T * 64 + tl; mq[qg] = b * SEQ + tq[qg];
#pragma unroll
        for (int ks = 0; ks < 2; ++ks) Qraw[qg][ks] = ld_bf8(z + (size_t)mq[qg] * ZLD + ZC_Q + head * 64 + 32 * ks + 8 * fq);
#pragma unroll
        for (int br = 0; br < 3; ++br) gt[qg][br] = sigmoidf_(bf2f(z[(size_t)mq[qg] * ZLD + ZC_GT + head * 3 + br])); }
    if (tid < 64) { ((LAS unsigned long long*)(lds + NSA_SELM))[tid] = 0ull; if (tid < 2) ((LAS unsigned*)(lds + NSA_UNI))[tid] = 0u; }
    const unsigned long long nosel[2] = {0ull, 0ull};
    NsaTileSrc SC_; SC_.kbase = (const bf16*)(ws + WS_KCMP) + (size_t)(b * 2 + g) * 256 * 64; SC_.kld = 64; SC_.vbase = (const bf16*)(ws + WS_VCMPT) + (size_t)(b * 2 + g) * 64 * 256; SC_.vld = 256;
    float mc[2], lc[2];
    { float gc[2] = {gt[0][0], gt[1][0]};
      nsa_branch<0>(lds, SC_, 0, 3, 1, 0, ~0ull, Qraw, tq, nosel, gc, true, mc, lc, tid, fq, fr); }
    {
        LAS float* imp = (LAS float*)(lds + NSA_IMP);
        float carry[2] = {0.f, 0.f}; const float SCL = 0.125f * 1.4426950408889634f;
        float invl[2] = {lc[0] > 0.f ? 1.0f / lc[0] : 0.f, lc[1] > 0.f ? 1.0f / lc[1] : 0.f};
        for (int kb = 0; kb < 4; ++kb) {
            { const int row = tid >> 3, ch = tid & 7; *(LAS u32x4*)(lds + NSA_KB + (row * 72 + ch * 8) * 2) = *(const u32x4*)(SC_.kbase + (size_t)(kb * 64 + row) * 64 + ch * 8); }
            __syncthreads();
            f32x4 sc[4][2]; nsa_scores(lds, 0, Qraw, sc, fq, fr);
#pragma unroll
            for (int kt = 0; kt < 4; ++kt)
#pragma unroll
                for (int qg = 0; qg < 2; ++qg) { float pn[4];
#pragma unroll
                    for (int r = 0; r < 4; ++r) { const int kidx = kb * 64 + 16 * kt + 4 * fq + r; const bool al = nsa_allowed<0>(kidx, tq[qg], kb, 0ull);
                        pn[r] = al ? __builtin_amdgcn_exp2f(sc[kt][qg][r] * SCL - mc[qg]) * invl[qg] : 0.f; }
                    const float y = __shfl(pn[3], (lane + 48) & 63);
                    float v = (pn[0] + pn[1]) + (pn[2] + pn[3]) + (fq == 0 ? carry[qg] : y); carry[qg] = y;
                    v += __shfl_xor(v, 1); v += __shfl_xor(v, 2);
                    if ((fr & 3) == 0) imp[(8 * wave + 4 * qg + (fr >> 2)) * 64 + 16 * kb + 4 * kt + fq] = v; }
            __syncthreads();
        }
    }
    {
        const LAS float* imp = (const LAS float*)(lds + NSA_IMP);
        const int tl = tid >> 3, part = tid & 7; float vm[8]; int cnt[8];
        { const f32x4 x0 = *(const LAS f32x4*)(imp + tl * 64 + part * 8), x1 = *(const LAS f32x4*)(imp + tl * 64 + part * 8 + 4);
          const float xx[8] = {x0.x, x0.y, x0.z, x0.w, x1.x, x1.y, x1.z, x1.w};
#pragma unroll
          for (int j = 0; j < 8; ++j) { const int mi = part * 8 + j; const bool valid = mi <= T; const bool forced = (mi == 0) || (mi == T) || (mi == T - 1);
              vm[j] = valid ? xx[j] + (forced ? 1e4f : 0.f) : -1e4f; cnt[j] = 0; } }
        for (int q4 = 0; q4 < 16; ++q4) { const f32x4 x = *(const LAS f32x4*)(imp + tl * 64 + 4 * q4); const float xq[4] = {x.x, x.y, x.z, x.w};
#pragma unroll
            for (int i = 0; i < 4; ++i) { const int q = 4 * q4 + i; const bool valid = q <= T; const bool forced = (q == 0) || (q == T) || (q == T - 1);
                const float vq = valid ? xq[i] + (forced ? 1e4f : 0.f) : -1e4f;
#pragma unroll
                for (int j = 0; j < 8; ++j) { const int mi = part * 8 + j; cnt[j] += (vq > vm[j] || (vq == vm[j] && q < mi)) ? 1 : 0; } } }
        unsigned bits = 0u;
#pragma unroll
        for (int j = 0; j < 8; ++j) if (cnt[j] < 16 && vm[j] > -5000.f) bits |= 1u << j;
        atomicOr((unsigned*)(lds + NSA_SELM) + tl * 2 + (part >> 2), bits << (8 * (part & 3)));
        atomicOr((unsigned*)(lds + NSA_UNI) + (part >> 2), bits << (8 * (part & 3)));
    }
    __syncthreads();
    bf16x8 Qrot[2][2];
#pragma unroll
    for (int qg = 0; qg < 2; ++qg)
#pragma unroll
        for (int ks = 0; ks < 2; ++ks) Qrot[qg][ks] = ld_bf8((const bf16*)(ws + WS_QROT) + (size_t)mq[qg] * 512 + head * 64 + 32 * ks + 8 * fq);
    unsigned long long selm[2], uni;
    { const LAS unsigned long long* sm = (const LAS unsigned long long*)(lds + NSA_SELM); selm[0] = sm[8 * wave + (fr >> 2)]; selm[1] = sm[8 * wave + 4 + (fr >> 2)]; const LAS unsigned* up = (const LAS unsigned*)(lds + NSA_UNI); uni = ((unsigned long long)(unsigned)__builtin_amdgcn_readfirstlane(up[1]) << 32) | (unsigned)__builtin_amdgcn_readfirstlane(up[0]); }
    { NsaTileSrc SS; SS.kbase = (const bf16*)(ws + WS_KSR) + (size_t)b * SEQ * 128 + g * 64; SS.kld = 128; SS.vbase = (const bf16*)(ws + WS_VST) + (size_t)(b * 2 + g) * 64 * SEQ; SS.vld = SEQ;
      float gs[2] = {gt[0][1], gt[1][1]}, mo[2], lo[2];
      nsa_branch<1>(lds, SS, 0, T, 0, T - 1, uni, Qrot, tq, selm, gs, false, mo, lo, tid, fq, fr); }
    { NsaTileSrc SW; SW.kbase = (const bf16*)(ws + WS_KWR) + (size_t)b * SEQ * 128 + g * 64; SW.kld = 128; SW.vbase = (const bf16*)(ws + WS_VWT) + (size_t)(b * 2 + g) * 64 * SEQ; SW.vld = SEQ;
      float gw_[2] = {gt[0][2], gt[1][2]}, mo[2], lo[2]; const int lo_kb = T >= 8 ? T - 8 : 0;
      nsa_branch<2>(lds, SW, lo_kb, T, T - 7, T - 1, ~0ull, Qrot, tq, nosel, gw_, false, mo, lo, tid, fq, fr); }
    bf16* ycat = (bf16*)(ws + WS_YCAT);
#pragma unroll
    for (int qg = 0; qg < 2; ++qg)
#pragma unroll
        for (int dt = 0; dt < 4; ++dt) { const LAS float* ot = (const LAS float*)(lds + NSA_OT) + tid + ((dt * 2 + qg) * 4) * 512;
            u32x2 w; w.x = pk2(ot[0], ot[512]); w.y = pk2(ot[1024], ot[1536]);
            *(u32x2*)(ycat + (size_t)mq[qg] * DM + 512 + head * 64 + 16 * dt + 4 * fq) = w; }
}

struct MoeOrder {
    const char* A; const char* W; size_t estride; int K, nct, G, c; int tst[9];
    __device__ bool next(int i, pg8::Unit& u) const {
        const long L = (long)i * G + c; if (L >= (long)tst[8] * nct) return false;
        const int rt = (int)(L / nct), ct = (int)(L % nct); int e = 0;
#pragma unroll
        for (int j = 1; j < 8; ++j) e += (rt >= tst[j]) ? 1 : 0;
        u.pm = rt; u.pn = ct; u.aux = e; return true;
    }
    __device__ __forceinline__ const char* abase(const pg8::Unit& u) const { return A + (size_t)u.pm * ((size_t)256 * K * 2); }
    __device__ __forceinline__ const char* bbase(const pg8::Unit& u) const { return W + (size_t)u.aux * estride + (size_t)u.pn * ((size_t)256 * K * 2); }
};
__device__ __forceinline__ void moe_order_init(MoeOrder& S, const Args& a, int rank, const void* A, const void* W, size_t estride, int K, int nct) {
    S.A = (const char*)A; S.W = (const char*)W; S.estride = estride; S.K = K; S.nct = nct; S.G = gridDim.x; S.c = blockIdx.x;
    const int* t = (const int*)(ws_of(a) + WS_SLOT + SL_TST) + rank * 16;
#pragma unroll
    for (int j = 0; j < 9; ++j) S.tst[j] = __builtin_amdgcn_readfirstlane(t[j]);
}
__device__ __forceinline__ void moe_gather(const Args& a, int rb, int r) {
    unsigned char* ws = ws_of(a); const int tid = opaque_tid();
    const int* toks = (const int*)(ws + WS_SLOT + SL_TOKS);
    const u32x4* hn = (const u32x4*)(ws + WS_HN); u32x4* hns = (u32x4*)(ws + WS_HNS);
    for (int i = tid; i < 64 * 128; i += NTHR) { const int tl = i >> 7, ch = i & 127, m = rb * 64 + tl; const int slot = toks[2 * m + r];
        hns[(size_t)slot * 128 + ch] = hn[(size_t)m * 128 + ch]; }
}
__device__ __forceinline__ void phase_moe_assign(const Args& a, LAS unsigned char* lds) {
    unsigned char* ws = ws_of(a); const int tid = opaque_tid(), lane = tid & 63, wave = __builtin_amdgcn_readfirstlane(tid >> 6);
    LAS int* cn = (LAS int*)lds;
    LAS int* tot = cn + 4096; LAS int* base = tot + 16; LAS int* pre = base + 16;
    const int* bcnt = (const int*)(ws + WS_SLOT + SL_BCNT);
    for (int i = tid; i < 4096; i += NTHR) cn[i] = bcnt[i];
    __syncthreads();
    if (tid < 16) { int s = 0; for (int bb = 0; bb < 256; ++bb) s += cn[bb * 16 + tid]; tot[tid] = s; }
    __syncthreads();
    if (tid < 2) { int run = 0; int* tstg = (int*)(ws + WS_SLOT + SL_TST) + tid * 16;
        for (int e = 0; e < 8; ++e) { base[tid * 8 + e] = run * 256; if (blockIdx.x == 0) tstg[e] = run; run += (tot[tid * 8 + e] + 255) >> 8; }
        if (blockIdx.x == 0) tstg[8] = run; }
    __syncthreads();
    int* stok = (int*)(ws + WS_SLOT + SL_TOK); float* sgate = (float*)(ws + WS_SLOT + SL_GATE);
    if (blockIdx.x == 0) {
        for (int grp = 0; grp < 16; ++grp) { const int r = grp >> 3, lo = base[grp] + tot[grp], hi = base[grp] + (((tot[grp] + 255) >> 8) << 8);
            for (int s = lo + tid; s < hi; s += NTHR) { stok[r * MOE_SLOTS + s] = -1; sgate[r * MOE_SLOTS + s] = 0.f; } }
    }
    const int* te = (const int*)(ws + WS_SLOT + SL_TOKE); const float* tg = (const float*)(ws + WS_SLOT + SL_TOKG); int* toks = (int*)(ws + WS_SLOT + SL_TOKS);
    for (int rb = blockIdx.x; rb < MT / 64; rb += gridDim.x) {
        __syncthreads();
        if (tid < 16) { int s = 0; for (int bb = 0; bb < rb; ++bb) s += cn[bb * 16 + tid]; pre[tid] = s; }
        __syncthreads();
        if (wave == 0) { const int m = rb * 64 + lane;
#pragma unroll
            for (int r = 0; r < 2; ++r) { const int e = te[2 * m + r]; int slot = 0;
#pragma unroll
                for (int ee = 0; ee < 8; ++ee) { const unsigned long long mk = __ballot(e == ee); const int rk = __popcll(mk & ((1ull << lane) - 1ull)); if (e == ee) slot = base[r * 8 + ee] + pre[r * 8 + ee] + rk; }
                stok[r * MOE_SLOTS + slot] = m; sgate[r * MOE_SLOTS + slot] = tg[2 * m + r]; toks[2 * m + r] = slot; } }
        asm volatile("s_waitcnt vmcnt(0)" ::: "memory");
        __syncthreads();
        moe_gather(a, rb, 0);
    }
}
__device__ __forceinline__ void moe_convert_weights(const Args& a, LAS unsigned char* lds) {
    const int tid = opaque_tid(), lane = tid & 63, wave = __builtin_amdgcn_readfirstlane(tid >> 6);
    const int gw = blockIdx.x * NWAVES + wave, NGW = gridDim.x * NWAVES; LAS float* scr = (LAS float*)(lds + 1024 + wave * 16384);
    for (int e = 0; e < NEXP; ++e) {
        conv_matrix(INF(IN_MW1) + (size_t)e * DM * DFF, DM, DFF, (bf16*)(ws_of(a) + WS_MW13) + (size_t)e * 5632 * DM, 1, gw, NGW, scr, lane, INF(IN_GFFN) + DM);
        conv_matrix(INF(IN_MW3) + (size_t)e * DM * DFF, DM, DFF, (bf16*)(ws_of(a) + WS_MW13) + (size_t)e * 5632 * DM, 2, gw, NGW, scr, lane, INF(IN_GFFN) + DM);
        conv_matrix(INF(IN_MW2) + (size_t)e * DFF * DM, DFF, DM, (bf16*)(ws_of(a) + WS_MW2) + (size_t)e * DM * DFF, 0, gw, NGW, scr, lane);
    }
}

template <class Sched>
__device__ __forceinline__ void fill_rs_table(LAS unsigned char* lds, const Sched& S, const float* rss, const int* slot_tok) {
    const int tid = opaque_tid(); LAS float* tab = (LAS float*)(lds + RSTAB_OFF);
    const int rl = tid & 255;
    for (int i = tid >> 8; i < RSTAB_MAX_UNITS; i += 2) { pg8::Unit u; if (!S.next(i, u)) break;
        int row = u.pm * 256 + rl; if (slot_tok) { row = slot_tok[row]; row = row < 0 ? 0 : row; }
        const f32x4* p = (const f32x4*)(rss + (size_t)row * 16); const f32x4 a = p[0], b = p[1], c = p[2], d = p[3];
        const float sm = ((a[0] + a[1]) + (a[2] + a[3])) + ((b[0] + b[1]) + (b[2] + b[3])) + (((c[0] + c[1]) + (c[2] + c[3])) + ((d[0] + d[1]) + (d[2] + d[3])));
        tab[i * 256 + rl] = 1.0f / sqrtf(sm * (1.0f / 1024.0f) + 1e-6f); }
    __syncthreads();
}

constexpr int NPL = 15, NPHASES = 1 + 2 * NPL;
__host__ __device__ constexpr bool phase_empty(int k) { if (k < 1) return false; const int l = (k - 1) / NPL, j = (k - 1) % NPL; if (j == 12) return true; if (l == 0) return j == 6 || (j >= 9 && j <= 11) || j == 14; return false; }

#ifndef PHSEL
#define PHSEL -1
#endif
#ifndef REP_GIN
#define REP_GIN 1
#endif
#ifndef REP_PREP
#define REP_PREP 1
#endif
#ifndef REP_NSA
#define REP_NSA 1
#endif
#ifndef REP_SCAN
#define REP_SCAN 1
#endif
#ifndef REP_GMLP
#define REP_GMLP 1
#endif
#ifndef REP_F1
#define REP_F1 1
#endif
#ifndef REP_PRO
#define REP_PRO 1
#endif
#define IN(k) (lo <= (k) && (k) < hi)
#define INL(j) ((PHSEL == -1 || PHSEL == (j)) && IN(pb + (j)))
#define SEAM(k) do { if ((k) + 1 < hi) xcd_barrier(bar); } while (0)
#define WSP ({ unsigned char* _w = wsbase_; asm volatile("" : "+s"(_w)); _w; })

template <int L>
__device__ __forceinline__ void run_layer(const Args& a, LAS unsigned char* lds, volatile LAS unsigned* MISC, const XcdBarrier& bar, const int lo, const int hi) {
    constexpr int l = L;
    unsigned char* const wsbase_ = a.ws;
    const int G = gridDim.x, bx = blockIdx.x, tid = opaque_tid();
        const int pb = 1 + l * NPL;
#define ws WSP
#define ctl ((unsigned*)WSP)
#define hbA ((bf16*)(WSP + WS_HN))
#define hbB ((bf16*)(WSP + WS_HB2))
#define rssA ((float*)(WSP + WS_RSS))
#define rssB ((float*)(WSP + WS_RSS) + (size_t)MT * 16)
#define hb_in (l == 0 ? hbA : hbB)
#define rss_in (l == 0 ? rssA : rssB)
        if (INL(0)) for (int rep = 0; rep < REP_GIN; ++rep) { pg8::StaticOrder S; S.init(hb_in, (bf16*)(ws + WS_WIN) + (size_t)l * ZLD * DM, MT, ZLD, DM, G, bx);
            fill_rs_table(lds, S, rss_in, nullptr); pg8::EpiBf16Store E{(bf16*)(ws + WS_Z), ZLD, (const LAS float*)(lds + RSTAB_OFF)}; pg8::gemm_phase(lds, DM, S, E); if (rep == REP_GIN - 1) SEAM(pb + 0); }
        if (INL(1)) { for (int rep = 0; rep < REP_PREP; ++rep) phase_prep(a, l, lds); SEAM(pb + 1); }
        if (INL(2)) {
#ifndef NO_SCAN
            for (int rep = 0; rep < REP_SCAN; ++rep) for (int it = bx; it < 16 * NSEG; it += G) rwkv_scan_seg(a, lds, it & 15, it >> 4);
#endif
#ifndef NO_NSA
            {
                const unsigned xcc = xb_xcc_id() & 7u;
                for (unsigned k = 0; k < 8; ++k) { const unsigned qi = (xcc + k) & 7u; unsigned* qn = ctl + CW_Q + 64 * (4 + l * 8 + qi);
                    for (;;) { __syncthreads(); if (tid == 0) MISC[16] = __hip_atomic_fetch_add(qn, 1u, __ATOMIC_RELAXED, __HIP_MEMORY_SCOPE_AGENT); __syncthreads();
                        const int it = (int)MISC[16]; if (it >= 64 * REP_NSA) break; nsa_item(a, lds, (int)(qi >> 1), (int)(qi & 1), 63 - (it & 63)); } }
            }
#endif
            SEAM(pb + 2); }
        if (INL(3)) {
            for (int bh = bx; bh < 16; bh += G) rwkv_chain(a, lds, bh);
            unsigned* qg = ctl + CW_Q + 64 * (l * 2 + 1);
#ifndef NO_GMLP
            for (;;) { __syncthreads(); if (tid == 0) MISC[16] = __hip_atomic_fetch_add(qg, 1u, __ATOMIC_RELAXED, __HIP_MEMORY_SCOPE_AGENT); __syncthreads();
                int it = (int)MISC[16]; if (it >= 512 * REP_GMLP) break; it &= 511; gmlp_item(a, l, lds, it >> 7, (it >> 2) & 31, it & 3); }
#endif
            SEAM(pb + 3); }
        if (INL(4)) { for (int it = bx; it < 16 * 64; it += G) rwkv_post_item(a, l, lds, it & 15, it >> 4); SEAM(pb + 4); }
        if (INL(5)) { pg8::StaticOrder S; S.init(ws + WS_YCAT, (bf16*)(ws + WS_WOUT) + (size_t)l * DM * DM, MT, DM, DM, G, bx);
            pg8::EpiResAdd E{a.out, DM, hbA, rssA}; pg8::gemm_phase(lds, DM, S, E); SEAM(pb + 5); }
        if (l == 0) {
            if (INL(7)) { pg8::StaticOrder S; S.init(hbA, ws + WS_W13, MT, 2 * DFF, DM, G, bx); fill_rs_table(lds, S, rssA, nullptr); pg8::EpiSwiglu E{(bf16*)(ws + WS_ACT), DFF, (const LAS float*)(lds + RSTAB_OFF)}; pg8::gemm_phase(lds, DM, S, E); SEAM(pb + 7); }
            if (INL(8)) { pg8::StaticOrder S; S.init(ws + WS_ACT, ws + WS_W2, MT, DM, DFF, G, bx); pg8::EpiResAdd E{a.out, DM, hbA, rssA}; pg8::gemm_phase(lds, DFF, S, E); if (pb + 13 < hi) xcd_barrier(bar); }
        } else {
            if (INL(6)) { for (int rep = 0; rep < REP_PRO; ++rep) { moe_convert_weights(a, lds); __syncthreads(); } phase_norm<1>(a, lds, INF(IN_GFFN) + DM); SEAM(pb + 6); }
            if (INL(7)) { phase_moe_assign(a, lds); SEAM(pb + 7); }
            if (INL(8)) { MoeOrder S; moe_order_init(S, a, 0, ws + WS_HNS, ws + WS_MW13, (size_t)5632 * DM * 2, DM, 22);
                fill_rs_table(lds, S, rssA, (const int*)(ws + WS_SLOT + SL_TOK)); pg8::EpiSwiglu E{(bf16*)(ws + WS_ACTM), DFF, (const LAS float*)(lds + RSTAB_OFF)}; pg8::gemm_phase(lds, DM, S, E); SEAM(pb + 8); }
            if (INL(9)) { for (int rb = bx; rb < MT / 64; rb += G) moe_gather(a, rb, 1);
                MoeOrder S; moe_order_init(S, a, 0, ws + WS_ACTM, ws + WS_MW2, (size_t)DM * DFF * 2, DFF, 4);
                pg8::EpiMoe2<false> E{a.out, (const int*)(ws + WS_SLOT + SL_TOK), (const float*)(ws + WS_SLOT + SL_GATE), DM, hbA, rssA}; pg8::gemm_phase(lds, DFF, S, E); SEAM(pb + 9); }
            if (INL(10)) { MoeOrder S; moe_order_init(S, a, 1, ws + WS_HNS, ws + WS_MW13, (size_t)5632 * DM * 2, DM, 22);
                fill_rs_table(lds, S, rssA, (const int*)(ws + WS_SLOT + SL_TOK) + MOE_SLOTS); pg8::EpiSwiglu E{(bf16*)(ws + WS_ACTM), DFF, (const LAS float*)(lds + RSTAB_OFF)}; pg8::gemm_phase(lds, DM, S, E); SEAM(pb + 10); }
            if (INL(11)) { MoeOrder S; moe_order_init(S, a, 1, ws + WS_ACTM, ws + WS_MW2, (size_t)DM * DFF * 2, DFF, 4);
                pg8::EpiMoe2<true> E{a.out, (const int*)(ws + WS_SLOT + SL_TOK) + MOE_SLOTS, (const float*)(ws + WS_SLOT + SL_GATE) + MOE_SLOTS, DM, hbA, rssA}; pg8::gemm_phase(lds, DFF, S, E);
                if (pb + 13 < hi) xcd_barrier(bar); }
        }
        if (INL(13)) {
            { pg8::StaticOrder S; S.init((bf16*)(ws + WS_PB) + (size_t)l * MT * 256, (bf16*)(ws + WS_WP) + (size_t)l * DM * 256, MT, DM, 256, G, bx); pg8::EpiBf16Store E{(bf16*)(ws + WS_PP), DM, nullptr}; pg8::gemm_phase(lds, 256, S, E); }
            { pg8::StaticOrder S; S.init(hbA, (bf16*)(ws + WS_WG) + (size_t)l * DM * DM, MT, DM, DM, G, bx); fill_rs_table(lds, S, rssA, nullptr); pg8::EpiPle E{a.out, ws, (const LAS float*)(lds + RSTAB_OFF), WS_PP, WS_HB2, WS_RSS + (size_t)MT * 16 * 4}; pg8::gemm_phase(lds, DM, S, E); }
            SEAM(pb + 13); }
        if (INL(14)) { if (l == 1) phase_norm<2>(a, lds, INF(IN_GFINAL)); }

}

#undef ws
#undef ctl
#undef hbA
#undef hbB
#undef rssA
#undef rssB
#undef hb_in
#undef rss_in

__global__ void __launch_bounds__(NTHR, 2) hybrid_fwd(Args a) {
    extern __shared__ __attribute__((aligned(16))) unsigned char lds_raw[];
    LAS unsigned char* lds = (LAS unsigned char*)lds_raw;
    volatile LAS unsigned* MISC = (volatile LAS unsigned*)(lds + MISC_OFF);
    const int tid = opaque_tid();
    unsigned char* ws = ws_of(a); unsigned* ctl = (unsigned*)(ws + WS_CTL);
    for (int u = tid; u < (LDS_BYTES - MISC_OFF) / 4; u += NTHR) MISC[u] = 0u;
    __syncthreads();
    if (tid < N_INPUTS) *(LAS unsigned long long*)(lds + PTAB_OFF + 8 * tid) = (unsigned long long)a.in[tid];
    __syncthreads();
    const int lo = a.ph_lo, hi = a.ph_hi;
    const bool multi = (hi - lo) > 1;
    XcdBarrier bar; bar.bar = ctl + CW_BAR; bar.x = 0; bar.st = nullptr;
    if (multi) bar = xcd_barrier_post(ctl + CW_BAR, MISC + 8);
    const int G = gridDim.x, bx = blockIdx.x;

    if ((PHSEL == -1 || PHSEL == 100) && IN(0)) { for (int rep = 0; rep < REP_PRO; ++rep) { phase_prologue(a, lds); __syncthreads(); } SEAM(0); }

    run_layer<0>(a, lds, MISC, bar, lo, hi);
    run_layer<1>(a, lds, MISC, bar, lo, hi);
}

extern "C" void kernel_launch(void* const* d_in, const int* in_sizes, int n_in, void* d_out, int out_size, void* d_ws, size_t ws_size, hipStream_t stream) {
    static int grid = 0;
    if (grid == 0) {
        if (n_in != N_INPUTS || out_size != MT * DM || ws_size < WS_END) { fprintf(stderr, "kernel_launch: unexpected shapes (n_in %d, out %d, ws %zu)\n", n_in, out_size, ws_size); grid = -1; return; }
        int dev = 0, cus = 0, per_cu = 0;
        if (hipGetDevice(&dev) != hipSuccess || hipDeviceGetAttribute(&cus, hipDeviceAttributeMultiprocessorCount, dev) != hipSuccess) { grid = -1; return; }
        if (hipFuncSetAttribute((const void*)hybrid_fwd, hipFuncAttributeMaxDynamicSharedMemorySize, LDS_BYTES) != hipSuccess) { fprintf(stderr, "kernel_launch: hipFuncSetAttribute failed\n"); grid = -1; return; }
        if (hipOccupancyMaxActiveBlocksPerMultiprocessor(&per_cu, (const void*)hybrid_fwd, NTHR, LDS_BYTES) != hipSuccess || per_cu < 1) fprintf(stderr, "kernel_launch: occupancy query reports %d\n", per_cu);
        (void)hipGetLastError();
        grid = cus;
    }
    if (grid < 0) return;
    (void)hipMemsetAsync((char*)d_ws + WS_CTL, 0, CTL_ZERO_BYTES, stream);
    Args a{};
    for (int i = 0; i < N_INPUTS; ++i) a.in[i] = d_in[i];
    a.out = (float*)d_out; a.ws = (unsigned char*)d_ws;
#if MK_ONE_LAUNCH
    a.ph_lo = 0; a.ph_hi = NPHASES;
    hipLaunchKernelGGL(hybrid_fwd, dim3(grid), dim3(NTHR), LDS_BYTES, stream, a);
#else
    for (int k = 0; k < NPHASES; ++k) { if (phase_empty(k)) continue; a.ph_lo = k; a.ph_hi = k + 1;
        hipLaunchKernelGGL(hybrid_fwd, dim3(grid), dim3(NTHR), LDS_BYTES, stream, a); }
#endif
}
```

```cpp
#include <hip/hip_runtime.h>
#include <cstdio>
#include <cstdint>

#ifndef MK_ONE_LAUNCH
#define MK_ONE_LAUNCH 1
#endif

#define LAS __attribute__((address_space(3)))
#define GAS __attribute__((address_space(1)))
typedef unsigned short bf16;
typedef short bf16x8 __attribute__((ext_vector_type(8)));
typedef float f32x4 __attribute__((ext_vector_type(4)));
typedef float f32x2 __attribute__((ext_vector_type(2)));
typedef unsigned u32x4 __attribute__((ext_vector_type(4)));
typedef unsigned u32x2 __attribute__((ext_vector_type(2)));

constexpr int NB = 4, SEQ = 4096, DM = 1024, MT = NB * SEQ;
constexpr int DIN = 2840, ZLD = 3072;
constexpr int DFF = 2816, NEXP = 8;
constexpr int ZC_U = 0, ZC_V = 256, ZC_B = 512, ZC_Q = 1536, ZC_KC = 2048, ZC_VC = 2176, ZC_KS = 2304, ZC_VS = 2432, ZC_KW = 2560, ZC_VW = 2688, ZC_GT = 2816;
constexpr int NCMP = 255;
constexpr int NWAVES = 8, NTHR = 512;

__device__ __forceinline__ unsigned f2bf(float f) { unsigned u = __builtin_bit_cast(unsigned, f); return (u + 0x7fffu + ((u >> 16) & 1u)) >> 16; }
__device__ __forceinline__ float bf2f(unsigned b) { return __builtin_bit_cast(float, b << 16); }
__device__ __forceinline__ unsigned pk2(float lo, float hi) { return f2bf(lo) | (f2bf(hi) << 16); }
__device__ __forceinline__ float bflo(unsigned w) { return __builtin_bit_cast(float, w << 16); }
__device__ __forceinline__ float bfhi(unsigned w) { return __builtin_bit_cast(float, w & 0xffff0000u); }
__device__ __forceinline__ float sigmoidf_(float x) { return 1.0f / (1.0f + __expf(-x)); }
__device__ __forceinline__ float gelu_tanh(float x) { const float u = 0.7978845608028654f * (x + 0.044715f * x * x * x); const float e = __expf(-2.0f * fabsf(u)); float t = (1.0f - e) / (1.0f + e); t = u < 0.f ? -t : t; return 0.5f * x * (1.0f + t); }
__device__ __forceinline__ float wave_sum(float v) {
#pragma unroll
    for (int o = 1; o < 64; o <<= 1) v += __shfl_xor(v, o);
    return v;
}
__device__ __forceinline__ int opaque_tid() { int t = threadIdx.x; asm volatile("" : "+v"(t)); return t; }
#define LDS_WAIT() asm volatile("s_waitcnt lgkmcnt(0)" ::: "memory")
#define VM_WAIT() asm volatile("s_waitcnt vmcnt(0)" ::: "memory")

namespace pg8 {
constexpr int BM = 256, BK = 64, HALF = 128, HTB = HALF * BK * 2  , STAGE_BYTES = 8 * HTB, NXCD = 8, WGM = 8;
__host__ __device__ __forceinline__ int lds_byte(int r, int c) { const int st = (r >> 4) * 2 + (c >> 5), rr = r & 15, cc = c & 31, ob = rr * 64 + cc * 2; return st * 1024 + (ob ^ (((ob >> 9) & 1) << 5)); }
__host__ __device__ __forceinline__ void stage_rc(int b, int& R, int& C) { const int st = b / 1024, sb = b % 1024, swz = sb ^ (((sb >> 9) & 1) << 5); R = (st >> 1) * 16 + swz / 64; C = (st & 1) * 32 + (swz % 64) / 2; }
__host__ __device__ __forceinline__ int perm32(int rho) { const int n = rho >> 4, i = rho & 15; return 8 * (i >> 2) + 4 * n + (i & 3); }

struct Unit { int pm, pn, aux; };

struct StaticOrder {
    const char* A; const char* Bt; int K; int nM, nN, nwg, G, c;
    __device__ void init(const void* A_, const void* Bt_, int M, int N, int K_, int G_, int c_) { A = (const char*)A_; Bt = (const char*)Bt_; K = K_; nM = M / BM; nN = N / BM; nwg = nM * nN; G = G_; c = c_; }
    __device__ bool next(int i, Unit& u) const {
        const long L = (long)i * G + c; if (L >= nwg) return false;
        int wgid = (int)L; { const int q = nwg / NXCD, r = nwg % NXCD, xcd = wgid % NXCD, off = wgid / NXCD; wgid = (xcd < r ? xcd * (q + 1) : r * (q + 1) + (xcd - r) * q) + off; }
        const int nig = WGM * nN, gid = wgid / nig, fm = gid * WGM, gsz = (nM - fm) < WGM ? (nM - fm) : WGM;
        u.pm = fm + ((wgid % nig) % gsz); u.pn = (wgid % nig) / gsz; u.aux = 0; return true;
    }
    __device__ __forceinline__ const char* abase(const Unit& u) const { return A + (size_t)u.pm * ((size_t)BM * K * 2); }
    __device__ __forceinline__ const char* bbase(const Unit& u) const { return Bt + (size_t)u.pn * ((size_t)BM * K * 2); }
};

__device__ __forceinline__ unsigned cvt_pk_bf16(float lo, float hi) { unsigned r; asm volatile("v_cvt_pk_bf16_f32 %0, %1, %2" : "=v"(r) : "v"(lo), "v"(hi)); return r; }

__device__ __forceinline__ float row_rs(const float* rss, int row, int fq) {
    const f32x4 p = *(const f32x4*)(rss + (size_t)row * 16 + 4 * fq); float s = (p[0] + p[1]) + (p[2] + p[3]);
    s += __shfl_xor(s, 16); s += __shfl_xor(s, 32); return 1.0f / sqrtf(s * (1.0f / 1024.0f) + 1e-6f);
}
__device__ __forceinline__ void put_hb_rss(const f32x4 (&v)[2][2], bf16* hb_row  , float* rss_row  , int fq) {
    float q = 0.f;
#pragma unroll
    for (int bj = 0; bj < 2; ++bj) { const f32x4 x = v[bj][0], y = v[bj][1];
        q += ((x[0] * x[0] + x[1] * x[1]) + (x[2] * x[2] + x[3] * x[3])) + ((y[0] * y[0] + y[1] * y[1]) + (y[2] * y[2] + y[3] * y[3]));
        u32x4 w; w.x = cvt_pk_bf16(x[0], x[1]); w.y = cvt_pk_bf16(x[2], x[3]); w.z = cvt_pk_bf16(y[0], y[1]); w.w = cvt_pk_bf16(y[2], y[3]); *(u32x4*)(hb_row + bj * HALF) = w; }
    q += __shfl_xor(q, 16); q += __shfl_xor(q, 32);
    if (fq == 0) *rss_row = q;
}
__device__ __forceinline__ void put_hb_rss4(const f32x4 (&v)[2][2], bf16* hb_row  , float* rss_row  , int fq) {
    float q = 0.f;
#pragma unroll
    for (int bj = 0; bj < 2; ++bj)
#pragma unroll
        for (int n = 0; n < 2; ++n) { const f32x4 x = v[bj][n]; q += (x[0] * x[0] + x[1] * x[1]) + (x[2] * x[2] + x[3] * x[3]);
            u32x2 w; w.x = cvt_pk_bf16(x[0], x[1]); w.y = cvt_pk_bf16(x[2], x[3]); *(u32x2*)(hb_row + bj * HALF + n * 16) = w; }
    q += __shfl_xor(q, 16); q += __shfl_xor(q, 32);
    if (fq == 0) *rss_row = q;
}
struct EpiBf16Store {
    static constexpr bool PERM = true;
    bf16* O; int ldc; const LAS float* rstab;
    __device__ __forceinline__ void operator()(const f32x4 (&acc)[2][2][4][2], const Unit& u, int ui, int wr, int wc, int fr, int fq) const {
        const int row0 = u.pm * BM + wr * 64 + fr, col0 = u.pn * BM + wc * 32 + 8 * fq;
        float rsv[2][4];
#pragma unroll
        for (int ai = 0; ai < 2; ++ai)
#pragma unroll
            for (int m = 0; m < 4; ++m) rsv[ai][m] = rstab ? rstab[ui * 256 + ai * HALF + wr * 64 + m * 16 + fr] : 1.0f;
#pragma unroll
        for (int ai = 0; ai < 2; ++ai)
#pragma unroll
            for (int m = 0; m < 4; ++m) { const int row = row0 + ai * HALF + m * 16; bf16* rowp = O + (size_t)row * ldc + col0; const float rs = rsv[ai][m];
#pragma unroll
                for (int bj = 0; bj < 2; ++bj) { const f32x4 v0 = acc[ai][bj][m][0] * rs, v1 = acc[ai][bj][m][1] * rs;
                    u32x4 w; w.x = cvt_pk_bf16(v0[0], v0[1]); w.y = cvt_pk_bf16(v0[2], v0[3]); w.z = cvt_pk_bf16(v1[0], v1[1]); w.w = cvt_pk_bf16(v1[2], v1[3]);
                    *(u32x4*)(rowp + bj * HALF) = w; } }
    }
};
struct EpiResAdd {
    static constexpr bool PERM = true;
    float* H; int ldc; bf16* hb; float* rss_out;
    __device__ __forceinline__ void operator()(const f32x4 (&acc)[2][2][4][2], const Unit& u, int ui, int wr, int wc, int fr, int fq) const {
        const int row0 = u.pm * BM + wr * 64 + fr, col0 = u.pn * BM + wc * 32 + 8 * fq;
#pragma unroll
        for (int ai = 0; ai < 2; ++ai)
#pragma unroll
            for (int m = 0; m < 4; ++m) { const int row = row0 + ai * HALF + m * 16; float* rowp = H + (size_t)row * ldc + col0; f32x4 v[2][2];
#pragma unroll
                for (int bj = 0; bj < 2; ++bj)
#pragma unroll
                    for (int n = 0; n < 2; ++n) { f32x4* p = (f32x4*)(rowp + bj * HALF + n * 4); v[bj][n] = *p + acc[ai][bj][m][n]; *p = v[bj][n]; }
                put_hb_rss(v, hb + (size_t)row * ldc + col0, rss_out + (size_t)row * 16 + u.pn * 4 + wc, fq); }
    }
};
struct EpiSwiglu {
    static constexpr bool PERM = true;
    bf16* O; int ldc; const LAS float* rstab;
    __device__ __forceinline__ void operator()(const f32x4 (&acc)[2][2][4][2], const Unit& u, int ui, int wr, int wc, int fr, int fq) const {
        const int row0 = u.pm * BM + wr * 64 + fr, col0 = u.pn * HALF + wc * 32 + 8 * fq;
#pragma unroll
        for (int ai = 0; ai < 2; ++ai)
#pragma unroll
            for (int m = 0; m < 4; ++m) { const int row = row0 + ai * HALF + m * 16; bf16* rowp = O + (size_t)row * ldc + col0;
                const float rs = rstab[ui * 256 + ai * HALF + wr * 64 + m * 16 + fr];
                float o[8];
#pragma unroll
                for (int n = 0; n < 2; ++n)
#pragma unroll
                    for (int i = 0; i < 4; ++i) { const float a = acc[ai][0][m][n][i] * rs, b = acc[ai][1][m][n][i] * rs; o[n * 4 + i] = a * b / (1.0f + __expf(-a)); }
                u32x4 w; w.x = cvt_pk_bf16(o[0], o[1]); w.y = cvt_pk_bf16(o[2], o[3]); w.z = cvt_pk_bf16(o[4], o[5]); w.w = cvt_pk_bf16(o[6], o[7]);
                *(u32x4*)rowp = w; __builtin_amdgcn_sched_barrier(0); }
    }
};
struct EpiPle {
    static constexpr bool PERM = false;
    float* H; unsigned char* ws; const LAS float* rstab; size_t off_pp, off_hb, off_rss;
    __device__ __forceinline__ void operator()(const f32x4 (&acc)[2][2][4][2], const Unit& u, int ui, int wr, int wc, int fr, int fq) const {
        const int row0 = u.pm * BM + wr * 64 + fr, col0 = u.pn * BM + wc * 32 + 4 * fq;
        const bf16* PP = (const bf16*)(ws + off_pp); bf16* hb = (bf16*)(ws + off_hb); float* rss_out = (float*)(ws + off_rss);
#pragma unroll
        for (int ai = 0; ai < 2; ++ai)
#pragma unroll
            for (int m = 0; m < 4; ++m) { const int row = row0 + ai * HALF + m * 16; const size_t off = (size_t)row * 1024 + col0; const float rs = rstab[ui * 256 + ai * HALF + wr * 64 + m * 16 + fr]; f32x4 v[2][2];
#pragma unroll
                for (int bj = 0; bj < 2; ++bj)
#pragma unroll
                    for (int n = 0; n < 2; ++n) { const size_t o2 = off + bj * HALF + n * 16; const u32x2 pw = *(const u32x2*)(PP + o2); const f32x4 a = acc[ai][bj][m][n] * rs;
                        f32x4 g; g[0] = bflo(pw.x) * sigmoidf_(a[0]); g[1] = bfhi(pw.x) * sigmoidf_(a[1]); g[2] = bflo(pw.y) * sigmoidf_(a[2]); g[3] = bfhi(pw.y) * sigmoidf_(a[3]);
                        f32x4* p = (f32x4*)(H + o2); v[bj][n] = *p + g; *p = v[bj][n]; }
                put_hb_rss4(v, hb + off, rss_out + (size_t)row * 16 + u.pn * 4 + wc, fq);
                if (m & 1) __builtin_amdgcn_sched_barrier(0); }
    }
};
template <bool FINAL> struct EpiMoe2 {
    static constexpr bool PERM = true;
    float* H; const int* slot_tok; const float* slot_gate; int ldc; bf16* hb; float* rss_out;
    __device__ __forceinline__ void operator()(const f32x4 (&acc)[2][2][4][2], const Unit& u, int ui, int wr, int wc, int fr, int fq) const {
        const int row0 = u.pm * BM + wr * 64 + fr, col0 = u.pn * BM + wc * 32 + 8 * fq;
        int tokv[2][4]; float gtv[2][4];
#pragma unroll
        for (int ai = 0; ai < 2; ++ai)
#pragma unroll
            for (int m = 0; m < 4; ++m) { const int slot = row0 + ai * HALF + m * 16; tokv[ai][m] = slot_tok[slot]; gtv[ai][m] = slot_gate[slot]; }
#pragma unroll
        for (int ai = 0; ai < 2; ++ai)
#pragma unroll
            for (int m = 0; m < 4; ++m) { const int tok = tokv[ai][m]; const float gt = gtv[ai][m];
                const int tk = tok < 0 ? 0 : tok; float* rowp = H + (size_t)tk * ldc + col0; f32x4 v[2][2];
#pragma unroll
                for (int bj = 0; bj < 2; ++bj)
#pragma unroll
                    for (int n = 0; n < 2; ++n) { f32x4* p = (f32x4*)(rowp + bj * HALF + n * 4); v[bj][n] = *p + acc[ai][bj][m][n] * gt; if (tok >= 0) *p = v[bj][n]; }
                if (FINAL) { float q = 0.f;
#pragma unroll
                    for (int bj = 0; bj < 2; ++bj) { const f32x4 x = v[bj][0], y = v[bj][1];
                        q += ((x[0] * x[0] + x[1] * x[1]) + (x[2] * x[2] + x[3] * x[3])) + ((y[0] * y[0] + y[1] * y[1]) + (y[2] * y[2] + y[3] * y[3]));
                        u32x4 w; w.x = cvt_pk_bf16(x[0], x[1]); w.y = cvt_pk_bf16(x[2], x[3]); w.z = cvt_pk_bf16(y[0], y[1]); w.w = cvt_pk_bf16(y[2], y[3]);
                        if (tok >= 0) *(u32x4*)(hb + (size_t)tk * ldc + col0 + bj * HALF) = w; }
                    q += __shfl_xor(q, 16); q += __shfl_xor(q, 32);
                    if (fq == 0 && tok >= 0) rss_out[(size_t)tk * 16 + u.pn * 4 + wc] = q; }
                if (m & 1) __builtin_amdgcn_sched_barrier(0); }
    }
};

template <class Epi, class Sched, bool ALIGN_EPI = true, bool SP2 = true>
__device__ __forceinline__ void gemm_phase(LAS unsigned char* lds, const int K, const Sched& S, const Epi& E) {
    int tid = threadIdx.x; asm volatile("" : "+v"(tid));
    const int wid = __builtin_amdgcn_readfirstlane(tid >> 6), lane = tid & 63, wr = wid >> 2, wc = wid & 3, fr = lane & 15, fq = lane >> 4;
    const int nt = K / BK;
    unsigned voffA[2], voffB[2];
#pragma unroll
    for (int i = 0; i < 2; ++i) { int R, C; stage_rc(tid * 16 + i * 8192, R, C); const int Rb = Epi::PERM ? ((R & ~31) + perm32(R & 31)) : R;
        voffA[i] = (unsigned)(R * K + C) * 2u; voffB[i] = (unsigned)(Rb * K + C) * 2u; }
    const size_t kstep = (size_t)(BK * 2);
    const size_t hstep = (size_t)HALF * K * 2;
    const unsigned ldsw = (unsigned)wid * 1024u;
    const int aoff = lds_byte(wr * 64 + fr, fq * 8), boff = lds_byte(wc * 32 + fr, fq * 8);
#define PG8_SA(b, h) (((b) * 2 + (h)) * HTB)
#define PG8_SB(b, h) ((4 + (b) * 2 + (h)) * HTB)
#define PG8_STAGE(bufoff, gbase, voff) do { _Pragma("unroll") for (int _i = 0; _i < 2; ++_i) \
        __builtin_amdgcn_global_load_lds((const unsigned*)((const char*)(gbase) + (voff)[_i]), (LAS unsigned*)(lds + (bufoff) + ldsw + _i * 8192), 16, 0, 0); } while (0)
#define PG8_LDA(dst, b, h) do { _Pragma("unroll") for (int m = 0; m < 4; ++m) _Pragma("unroll") for (int k = 0; k < 2; ++k) dst[m][k] = *(const LAS bf16x8*)(lds + PG8_SA(b, h) + aoff + m * 2048 + k * 1024); } while (0)
#define PG8_LDB(dst, b, h) do { _Pragma("unroll") for (int n = 0; n < 2; ++n) _Pragma("unroll") for (int k = 0; k < 2; ++k) dst[n][k] = *(const LAS bf16x8*)(lds + PG8_SB(b, h) + boff + n * 2048 + k * 1024); } while (0)
#define PG8_MMA(ai, bj, At, Bt) do { __builtin_amdgcn_s_setprio(1); _Pragma("unroll") for (int m = 0; m < 4; ++m) _Pragma("unroll") for (int n = 0; n < 2; ++n) _Pragma("unroll") for (int k = 0; k < 2; ++k) \
        acc[ai][bj][m][n] = __builtin_amdgcn_mfma_f32_16x16x32_bf16(Bt[n][k], At[m][k], acc[ai][bj][m][n], 0, 0, 0); __builtin_amdgcn_s_setprio(0); } while (0)
#define PG8_WAIT_V(n) asm volatile("s_waitcnt vmcnt(" #n ")" ::: "memory")
#define PG8_WAIT_L(n) asm volatile("s_waitcnt lgkmcnt(" #n ")" ::: "memory")
#define PG8_BAR __builtin_amdgcn_s_barrier()
#define PG8_SCHED __builtin_amdgcn_sched_barrier(0)
    Unit cur, nxt; int ui = 0;
    if (!S.next(0, cur)) return;
    f32x4 acc[2][2][4][2];
#pragma unroll
    for (int a = 0; a < 2; ++a)
#pragma unroll
        for (int b = 0; b < 2; ++b)
#pragma unroll
            for (int m = 0; m < 4; ++m)
#pragma unroll
                for (int n = 0; n < 2; ++n) acc[a][b][m][n] = (f32x4){0.f, 0.f, 0.f, 0.f};
    bf16x8 At[4][2], B0[2][2], B1[2][2];
    const char* cA = S.abase(cur); const char* cB = S.bbase(cur);
    if constexpr (SP2) {
        PG8_STAGE(PG8_SB(0, 0), cB, voffB); PG8_STAGE(PG8_SB(0, 1), cB + hstep, voffB); PG8_STAGE(PG8_SA(0, 0), cA, voffA); PG8_STAGE(PG8_SA(0, 1), cA + hstep, voffA);
        if (wr == 1) PG8_BAR;
        PG8_WAIT_V(2); PG8_BAR;
        PG8_STAGE(PG8_SB(1, 0), cB + kstep, voffB); PG8_STAGE(PG8_SA(1, 0), cA + kstep, voffA); PG8_STAGE(PG8_SB(1, 1), cB + hstep + kstep, voffB);
        PG8_WAIT_V(6); PG8_BAR;
    } else {
        PG8_STAGE(PG8_SB(0, 0), cB, voffB); PG8_STAGE(PG8_SA(0, 0), cA, voffA); PG8_STAGE(PG8_SB(0, 1), cB + hstep, voffB); PG8_STAGE(PG8_SA(0, 1), cA + hstep, voffA);
        if (wr == 1) PG8_BAR;
        PG8_WAIT_V(4); PG8_BAR;
        PG8_STAGE(PG8_SB(1, 0), cB + kstep, voffB); PG8_STAGE(PG8_SA(1, 0), cA + kstep, voffA); PG8_STAGE(PG8_SB(1, 1), cB + hstep + kstep, voffB);
        PG8_WAIT_V(6); PG8_BAR;
    }
    for (;;) {
        const bool has_next = S.next(ui + 1, nxt);
        const char* nA = has_next ? S.abase(nxt) : cA; const char* nB = has_next ? S.bbase(nxt) : cB;
        for (int t = 0; t < nt; t += 2) {
            const bool last = (t == nt - 2);
            const char* a1 = cA + (size_t)(t + 1) * kstep;
            const char* a2 = last ? nA : cA + (size_t)(t + 2) * kstep; const char* b2 = last ? nB : cB + (size_t)(t + 2) * kstep;
            const char* a3 = a2 + kstep; const char* b3 = b2 + kstep;
            if constexpr (SP2) {
            PG8_LDB(B0, 0, 0); PG8_LDB(B1, 0, 1); PG8_SCHED; PG8_LDA(At, 0, 0); PG8_STAGE(PG8_SA(1, 1), a1 + hstep, voffA);
            PG8_WAIT_V(8); PG8_WAIT_L(0); PG8_BAR; PG8_MMA(0, 0, At, B0); PG8_MMA(0, 1, At, B1); PG8_BAR; PG8_SCHED;
            PG8_LDA(At, 0, 1); PG8_STAGE(PG8_SB(0, 0), b2, voffB); PG8_STAGE(PG8_SB(0, 1), b2 + hstep, voffB); PG8_STAGE(PG8_SA(0, 0), a2, voffA);
            PG8_WAIT_V(8); PG8_WAIT_L(0); PG8_BAR; PG8_MMA(1, 0, At, B0); PG8_MMA(1, 1, At, B1); PG8_BAR; PG8_SCHED;
            PG8_LDB(B0, 1, 0); PG8_LDB(B1, 1, 1); PG8_SCHED; PG8_LDA(At, 1, 0); PG8_STAGE(PG8_SA(0, 1), a2 + hstep, voffA);
            PG8_WAIT_V(8); PG8_WAIT_L(0); PG8_BAR; PG8_MMA(0, 0, At, B0); PG8_MMA(0, 1, At, B1); PG8_BAR; PG8_SCHED;
            PG8_LDA(At, 1, 1); PG8_STAGE(PG8_SB(1, 0), b3, voffB); PG8_STAGE(PG8_SB(1, 1), b3 + hstep, voffB); PG8_STAGE(PG8_SA(1, 0), a3, voffA);
            PG8_WAIT_V(8); PG8_WAIT_L(0); PG8_BAR; PG8_MMA(1, 0, At, B0); PG8_MMA(1, 1, At, B1); PG8_BAR; PG8_SCHED;
            } else {
            PG8_LDB(B0, 0, 0); PG8_SCHED; PG8_LDA(At, 0, 0); PG8_STAGE(PG8_SA(1, 1), a1 + hstep, voffA);
            PG8_WAIT_L(8); PG8_BAR; PG8_WAIT_L(0); PG8_MMA(0, 0, At, B0); PG8_BAR; PG8_SCHED;
            PG8_LDB(B1, 0, 1); PG8_STAGE(PG8_SB(0, 0), b2, voffB);
            PG8_BAR; PG8_WAIT_L(0); PG8_MMA(0, 1, At, B1); PG8_BAR;
            PG8_LDA(At, 0, 1); PG8_STAGE(PG8_SA(0, 0), a2, voffA);
            PG8_BAR; PG8_WAIT_L(0); PG8_MMA(1, 0, At, B0); PG8_BAR; PG8_SCHED;
            PG8_STAGE(PG8_SB(0, 1), b2 + hstep, voffB);
            PG8_WAIT_V(6); PG8_BAR; PG8_MMA(1, 1, At, B1); PG8_BAR;
            PG8_LDB(B0, 1, 0); PG8_SCHED; PG8_LDA(At, 1, 0); PG8_STAGE(PG8_SA(0, 1), a2 + hstep, voffA);
            PG8_WAIT_L(8); PG8_BAR; PG8_WAIT_L(0); PG8_MMA(0, 0, At, B0); PG8_BAR; PG8_SCHED;
            PG8_LDB(B1, 1, 1); PG8_STAGE(PG8_SB(1, 0), b3, voffB);
            PG8_BAR; PG8_WAIT_L(0); PG8_MMA(0, 1, At, B1); PG8_BAR;
            PG8_LDA(At, 1, 1); PG8_STAGE(PG8_SA(1, 0), a3, voffA);
            PG8_BAR; PG8_WAIT_L(0); PG8_MMA(1, 0, At, B0); PG8_BAR; PG8_SCHED;
            PG8_STAGE(PG8_SB(1, 1), b3 + hstep, voffB);
            PG8_WAIT_V(6); PG8_BAR; PG8_MMA(1, 1, At, B1); PG8_BAR;
            }
        }
        if constexpr (ALIGN_EPI) { if (wr == 0) PG8_BAR; }
        E(acc, cur, ui, wr, wc, fr, fq);
        if (!has_next) break;
#pragma unroll
        for (int a = 0; a < 2; ++a)
#pragma unroll
            for (int b = 0; b < 2; ++b)
#pragma unroll
                for (int m = 0; m < 4; ++m)
#pragma unroll
                    for (int n = 0; n < 2; ++n) acc[a][b][m][n] = (f32x4){0.f, 0.f, 0.f, 0.f};
        cur = nxt; cA = nA; cB = nB; ++ui;
        if constexpr (ALIGN_EPI) { if (wr == 1) PG8_BAR; }
    }
    PG8_WAIT_V(0);
    if constexpr (!ALIGN_EPI) { if (wr == 0) PG8_BAR; }
    PG8_BAR;
#undef PG8_SA
#undef PG8_SB
#undef PG8_STAGE
#undef PG8_LDA
#undef PG8_LDB
#undef PG8_MMA
#undef PG8_WAIT_V
#undef PG8_WAIT_L
#undef PG8_BAR
#undef PG8_SCHED
}
}

constexpr size_t MiB = 1u << 20;
constexpr size_t WS_CTL = 0, CTL_ZERO_BYTES = 65536;
constexpr size_t WS_WIN = 1 * MiB;
constexpr size_t WS_WOUT = 13 * MiB;
constexpr size_t WS_W13 = 17 * MiB;
constexpr size_t WS_W2 = 28 * MiB;
constexpr size_t WS_WG = 34 * MiB;
constexpr size_t WS_WP = 38 * MiB;
constexpr size_t WS_CW1 = 39 * MiB;
constexpr size_t WS_LORA = 41 * MiB;
constexpr size_t WS_ROPE = 41 * MiB + 512 * 1024;
constexpr size_t WS_CBIAS = 42 * MiB + 512 * 1024;
constexpr size_t WS_PB = 43 * MiB;
constexpr size_t WS_HN = 60 * MiB;
constexpr size_t WS_Z = 92 * MiB;
constexpr size_t WS_YCAT = 188 * MiB;
constexpr size_t WS_QROT = 220 * MiB;
constexpr size_t WS_KSR = 236 * MiB, WS_KWR = 240 * MiB, WS_VST = 244 * MiB, WS_VWT = 248 * MiB;
constexpr size_t WS_KCMP = 252 * MiB, WS_VCMPT = 252 * MiB + 512 * 1024;
constexpr size_t WS_REC = 253 * MiB;
constexpr size_t WS_G = 349 * MiB;
constexpr size_t WS_YRAW = 365 * MiB;
constexpr size_t WS_BONUS = 381 * MiB;
constexpr size_t WS_ACT = 92 * MiB;
constexpr size_t WS_HNS = 92 * MiB;
constexpr size_t WS_ACTM = 128 * MiB;
constexpr size_t WS_MW13 = 227 * MiB;
constexpr size_t WS_MW2 = 315 * MiB;
constexpr size_t WS_SLOT = 359 * MiB;
constexpr size_t WS_PP = 92 * MiB;
constexpr size_t WS_YP = 382 * MiB;
constexpr size_t WS_SEGE = 398 * MiB;
constexpr size_t WS_SST = 406 * MiB;
constexpr size_t WS_END = 412 * MiB;
constexpr size_t WS_HB2 = 188 * MiB;
constexpr size_t WS_RSS = 410 * MiB;
constexpr int NSEG = 16, SEGLEN = SEQ / NSEG;
constexpr int MOE_SLOTS = 18432;
constexpr size_t SL_TOK = 0;
constexpr size_t SL_GATE = SL_TOK + 2 * MOE_SLOTS * 4;
constexpr size_t SL_TOKE = SL_GATE + 2 * MOE_SLOTS * 4;
constexpr size_t SL_TOKG = SL_TOKE + (size_t)MT * 2 * 4;
constexpr size_t SL_TOKS = SL_TOKG + (size_t)MT * 2 * 4;
constexpr size_t SL_BCNT = SL_TOKS + (size_t)MT * 2 * 4;
constexpr size_t SL_TST = SL_BCNT + 256 * 16 * 4;
static_assert(SL_TST + 128 <= 1 * MiB, "slot tables");
constexpr int CW_BAR = 4096;
constexpr int CW_Q = 8192;

constexpr int RING_BYTES = 131072;
constexpr int MISC_OFF = 161792;
constexpr int RSTAB_OFF = RING_BYTES;
constexpr int RSTAB_MAX_UNITS = 30;
constexpr int LDS_BYTES = 163840;

#define XB_TMO      128
#define XB_XCNT(j)  (256  + 64 * (j))
#define XB_XSUB(j)  (1280 + 64 * (j))
#define XB_XGEN(j)  (2304 + 64 * (j))
#define XB_TOP      3328
#define XB_TOPGEN   3392
#define XCD_BAR_WORDS 3456
#define XB_SPIN_CAP (1u << 18)
__device__ __forceinline__ unsigned xb_ld(unsigned* p)              { return __hip_atomic_load(p, __ATOMIC_RELAXED, __HIP_MEMORY_SCOPE_AGENT); }
__device__ __forceinline__ unsigned xb_add(unsigned* p, unsigned v) { return __hip_atomic_fetch_add(p, v, __ATOMIC_RELAXED, __HIP_MEMORY_SCOPE_AGENT); }
__device__ __forceinline__ unsigned xb_xcc_id() { return (unsigned)__builtin_amdgcn_s_getreg((3 << 11) | 20) & 0xFu; }
#define XB_SPIN(cond, bar) do { unsigned _sp = 0; while (cond) { __builtin_amdgcn_s_sleep(1); \
    if ((++_sp & 255u) == 0u) { if (xb_ld(&(bar)[XB_TMO])) break; if (_sp > XB_SPIN_CAP) { atomicAdd(&(bar)[XB_TMO], 1u); break; } } } } while (0)
struct XcdBarrier { unsigned* bar; unsigned x; volatile LAS unsigned* st; };
__device__ __forceinline__ XcdBarrier xcd_barrier_post(unsigned* bar, volatile LAS unsigned* st) {
    XcdBarrier b; b.bar = bar; b.x = xb_xcc_id(); b.st = st;
    if (threadIdx.x == 0) (void)xb_add(&bar[XB_XCNT(b.x)], 1u);
    return b;
}
__device__ __noinline__ unsigned long long xcd_barrier_complete(unsigned* bar, unsigned x) {
    const unsigned G = gridDim.x * gridDim.y * gridDim.z;
    unsigned sum, cnt, mine, sp = 0u;
    for (;;) {
        sum = 0u; cnt = 0u; mine = 0u;
        for (unsigned j = 0; j < 16; ++j) { const unsigned c = xb_ld(&bar[XB_XCNT(j)]); sum += c; cnt += (c > 0u) ? 1u : 0u; mine = (j == x) ? c : mine; }
        if (sum == G) break;
        __builtin_amdgcn_s_sleep(1);
        if ((++sp & 255u) == 0u) { if (xb_ld(&bar[XB_TMO])) break; if (sp > XB_SPIN_CAP) { atomicAdd(&bar[XB_TMO], 1u); break; } }
    }
    const unsigned nloc = mine > 0u ? mine : 1u, nx = cnt > 0u ? cnt : 1u;
    return (unsigned long long)nloc | ((unsigned long long)nx << 32);
}
__device__ __forceinline__ void xcd_barrier(const XcdBarrier& b) {
    asm volatile("s_waitcnt vmcnt(0)" ::: "memory");
    __syncthreads();
    if (threadIdx.x == 0) {
        unsigned* bar = b.bar;
        __builtin_amdgcn_s_waitcnt(0);
        unsigned nloc = b.st[0], nx = b.st[1];
        if (nloc == 0u) { const unsigned long long r = xcd_barrier_complete(bar, b.x); nloc = (unsigned)r; nx = (unsigned)(r >> 32); b.st[0] = nloc; b.st[1] = nx; }
        const unsigned old = xb_add(&bar[XB_XSUB(b.x)], 1u);
        const unsigned gen = old / nloc;
        if (old + 1u == (gen + 1u) * nloc) {
            __builtin_amdgcn_fence(__ATOMIC_RELEASE, "agent");
            asm volatile("s_waitcnt vmcnt(0)" ::: "memory");
            const unsigned og = xb_add(&bar[XB_TOP], 1u);
            const unsigned tg = og / nx;
            if (og + 1u == (tg + 1u) * nx) xb_add(&bar[XB_TOPGEN], 1u);
            else XB_SPIN(xb_ld(&bar[XB_TOPGEN]) == tg, bar);
            __builtin_amdgcn_fence(__ATOMIC_ACQUIRE, "agent");
            xb_add(&bar[XB_XGEN(b.x)], 1u);
            asm volatile("s_waitcnt vmcnt(0)" ::: "memory");
        } else {
            XB_SPIN(xb_ld(&bar[XB_XGEN(b.x)]) == gen, bar);
            __builtin_amdgcn_fence(__ATOMIC_ACQUIRE, "agent");
            asm volatile("s_waitcnt vmcnt(0)" ::: "memory");
        }
    }
    __syncthreads();
}

enum { IN_X = 0, IN_P, IN_POS, IN_GMIX, IN_WIN, IN_WOUT, IN_GMLNG, IN_GMLNB, IN_GMWS, IN_GMBS, IN_RWMU, IN_RWW0, IN_RWWUP, IN_RWA0, IN_RWAUP, IN_RWGUP,
       IN_RWKK, IN_RWKA, IN_RWRK, IN_RWGNG, IN_RWGNB, IN_CMPPOS, IN_KCW1, IN_KCW2, IN_VCW1, IN_VCW2, IN_GFFN, IN_FW1, IN_FW3, IN_FW2, IN_RTW, IN_RTB,
       IN_MW1, IN_MW3, IN_MW2, IN_GPLE, IN_PLEG, IN_PLEP, IN_GFINAL, N_INPUTS };
struct Args { const void* in[N_INPUTS]; float* out; unsigned char* ws; int ph_lo, ph_hi; };
constexpr int PTAB_OFF = 161792 + 256;
__device__ __forceinline__ const void* ldptr(int k) {
    extern __shared__ __attribute__((aligned(16))) unsigned char lds_raw[];
    const LAS unsigned* t = (const LAS unsigned*)((LAS unsigned char*)lds_raw + PTAB_OFF) + 2 * k;
    const unsigned lo = __builtin_amdgcn_readfirstlane(t[0]), hi = __builtin_amdgcn_readfirstlane(t[1]);
    return (const void*)(const GAS char*)(((unsigned long long)hi << 32) | lo);
}
#define INF(k) ((const float*)ldptr(k))
__device__ __forceinline__ unsigned char* ws_of(const Args& a) { unsigned long long z = 0; asm volatile("" : "+s"(z)); return a.ws + z; }

__device__ __forceinline__ void conv_matrix(const float* W, int K, int N, bf16* dst, int mode, int gw, int NGW, LAS float* scr, int lane, const float* gk = nullptr) {
    (void)scr;
    const int nblk = (N + 63) / 64, nit = (K / 64) * nblk;
    for (int it = gw; it < nit; it += NGW) {
        const int kb = it / nblk, nb = it % nblk, n = nb * 64 + lane, k0 = kb * 64; const bool ok = n < N;
        const int drow = mode == 0 ? n : ((n >> 7) * 256 + (n & 127) + (mode == 2 ? 128 : 0));
        const float* src = W + (size_t)k0 * N + (ok ? n : 0);
        float v[64];
#pragma unroll
        for (int k = 0; k < 64; ++k) v[k] = src[(size_t)k * N];
        if (gk) {
#pragma unroll
            for (int k = 0; k < 64; ++k) v[k] *= gk[k0 + k]; }
        if (ok) { u32x4* d = (u32x4*)(dst + (size_t)drow * K + k0);
#pragma unroll
            for (int c = 0; c < 8; ++c) { u32x4 o; o.x = pk2(v[8 * c], v[8 * c + 1]); o.y = pk2(v[8 * c + 2], v[8 * c + 3]); o.z = pk2(v[8 * c + 4], v[8 * c + 5]); o.w = pk2(v[8 * c + 6], v[8 * c + 7]); d[c] = o; } }
    }
}
__device__ __forceinline__ void init_row(const float* xrow, bf16* orow, float* cp, float* rss_row, int lane) {
    const f32x4* xr = (const f32x4*)xrow + lane; f32x4 v[4]; float s = 0.f;
#pragma unroll
    for (int j = 0; j < 4; ++j) { v[j] = xr[64 * j]; s += (v[j].x * v[j].x + v[j].y * v[j].y) + (v[j].z * v[j].z + v[j].w * v[j].w); }
    s = wave_sum(s);
#pragma unroll
    for (int j = 0; j < 4; ++j) ((f32x4*)cp + lane)[64 * j] = v[j];
    u32x2* o8 = (u32x2*)orow + lane;
#pragma unroll
    for (int j = 0; j < 4; ++j) { u32x2 w; w.x = pk2(v[j].x, v[j].y); w.y = pk2(v[j].z, v[j].w); o8[64 * j] = w; }
    if (lane < 16) rss_row[lane] = lane == 0 ? s : 0.f;
}

__device__ __forceinline__ void phase_prologue(const Args& a, LAS unsigned char* lds) {
    const int tid = opaque_tid(), lane = tid & 63, wave = __builtin_amdgcn_readfirstlane(tid >> 6);
    const int G = gridDim.x, gw = blockIdx.x * NWAVES + wave, NGW = G * NWAVES;
    const size_t gt = (size_t)blockIdx.x * NTHR + tid, NGT = (size_t)G * NTHR;
    unsigned char* ws = ws_of(a);
    LAS float* scr = (LAS float*)(lds + wave * 16384);
    for (int l = 0; l < 2; ++l) {
        conv_matrix(INF(IN_WIN) + (size_t)l * DM * DIN, DM, DIN, (bf16*)(ws + WS_WIN) + (size_t)l * ZLD * DM, 0, gw, NGW, scr, lane, INF(IN_GMIX) + l * DM);
        conv_matrix(INF(IN_WOUT) + (size_t)l * DM * DM, DM, DM, (bf16*)(ws + WS_WOUT) + (size_t)l * DM * DM, 0, gw, NGW, scr, lane);
        conv_matrix(INF(IN_PLEG) + (size_t)l * DM * DM, DM, DM, (bf16*)(ws + WS_WG) + (size_t)l * DM * DM, 0, gw, NGW, scr, lane, INF(IN_GPLE) + l * DM);
        conv_matrix(INF(IN_PLEP) + (size_t)l * 256 * DM, 256, DM, (bf16*)(ws + WS_WP) + (size_t)l * DM * 256, 0, gw, NGW, scr, lane);
        conv_matrix(INF(IN_KCW1) + (size_t)l * 2048 * 128, 2048, 128, (bf16*)(ws + WS_CW1) + (size_t)(l * 2 + 0) * 128 * 2048, 0, gw, NGW, scr, lane);
        conv_matrix(INF(IN_VCW1) + (size_t)l * 2048 * 128, 2048, 128, (bf16*)(ws + WS_CW1) + (size_t)(l * 2 + 1) * 128 * 2048, 0, gw, NGW, scr, lane);
        bf16* lora = (bf16*)(ws + WS_LORA) + (size_t)l * 65536;
        conv_matrix(INF(IN_RWWUP) + (size_t)l * 64 * 256, 64, 256, lora, 0, gw, NGW, scr, lane);
        conv_matrix(INF(IN_RWAUP) + (size_t)l * 64 * 256, 64, 256, lora + 16384, 0, gw, NGW, scr, lane);
        conv_matrix(INF(IN_RWGUP) + (size_t)l * 128 * 256, 128, 256, lora + 32768, 0, gw, NGW, scr, lane);
        { u32x4* zr = (u32x4*)((bf16*)(ws + WS_WIN) + ((size_t)l * ZLD + DIN) * DM); const size_t n16 = (size_t)(ZLD - DIN) * DM * 2 / 16;
          for (size_t i = gt; i < n16; i += NGT) zr[i] = (u32x4){0u, 0u, 0u, 0u}; }
    }
    conv_matrix(INF(IN_FW1), DM, DFF, (bf16*)(ws + WS_W13), 1, gw, NGW, scr, lane, INF(IN_GFFN));
    conv_matrix(INF(IN_FW3), DM, DFF, (bf16*)(ws + WS_W13), 2, gw, NGW, scr, lane, INF(IN_GFFN));
    conv_matrix(INF(IN_FW2), DFF, DM, (bf16*)(ws + WS_W2), 0, gw, NGW, scr, lane);
    { const f32x4* src = (const f32x4*)INF(IN_P); u32x2* dst = (u32x2*)(ws + WS_PB); const size_t n4 = (size_t)2 * MT * 256 / 4;
      for (size_t i = gt; i < n4; i += NGT) { const f32x4 v = src[i]; u32x2 w; w.x = pk2(v.x, v.y); w.y = pk2(v.z, v.w); dst[i] = w; } }
    { const int* pos = (const int*)ldptr(IN_POS); float* ct = (float*)(ws + WS_ROPE); float* st = ct + (size_t)MT * 8;
      const float inv[8] = {1.0f, 0.1939227432012558f, 0.03760603070259094f, 0.007292664609849453f, 0.0014142135623842478f, 0.00027424818836152554f, 5.3182957344688475e-05f, 1.0313385246263351e-05f};
      for (size_t i = gt; i < (size_t)MT * 8; i += NGT) { const int m = (int)(i >> 3), k = (int)(i & 7);
          float iv = inv[0];
#pragma unroll
          for (int q = 1; q < 8; ++q) iv = (k == q) ? inv[q] : iv;
          const float ang = (float)pos[m] * iv;
          const double ad = (double)ang; const double kq = __builtin_rint(ad * 0.15915494309189535); const float red = (float)(ad - kq * 6.283185307179586);
          ct[i] = __cosf(red); st[i] = __sinf(red); } }
    if (blockIdx.x < 64) {
        const int lk = blockIdx.x >> 4, ck = blockIdx.x & 15, l = lk >> 1, kv = lk & 1; const float* W1 = INF(kv ? IN_VCW1 : IN_KCW1) + (size_t)l * 2048 * 128; const float* pos = INF(IN_CMPPOS) + (size_t)l * 2048;
        LAS float* red = (LAS float*)(lds + 8448);
        const int hid = tid & 127, part = tid >> 7; const int kb = ck * 128 + part * 32; float s = 0.f;
#pragma unroll
        for (int k = 0; k < 32; ++k) s += pos[kb + k] * W1[(size_t)(kb + k) * 128 + hid];
        red[part * 128 + hid] = s; __syncthreads();
        if (tid < 128) ((float*)(ws + WS_CBIAS))[(lk * 16 + ck) * 128 + tid] = red[tid] + red[128 + tid] + red[256 + tid] + red[384 + tid];
    }
    for (int m = gw; m < MT; m += NGW) init_row(INF(IN_X) + (size_t)m * DM, (bf16*)(ws + WS_HN) + (size_t)m * DM, a.out + (size_t)m * DM, (float*)(ws + WS_RSS) + (size_t)m * 16, lane);
}

template <int MODE>
__device__ __forceinline__ void phase_norm(const Args& a, LAS unsigned char* lds, const float* g) {
    const int tid = opaque_tid(), lane = tid & 63, wave = __builtin_amdgcn_readfirstlane(tid >> 6);
    unsigned char* ws = ws_of(a);
    LAS int* lcnt = (LAS int*)lds;
    if (MODE == 1) { if (tid < 16) lcnt[tid] = 0; __syncthreads(); }
    for (int rb = blockIdx.x; rb < MT / 64; rb += gridDim.x) {
        for (int i = 0; i < 8; ++i) {
            const int m = rb * 64 + wave * 8 + i;
            float* hrow = a.out + (size_t)m * DM;
            const f32x4* xr = (const f32x4*)hrow + lane; f32x4 v[4]; float s = 0.f;
#pragma unroll
            for (int j = 0; j < 4; ++j) { v[j] = xr[64 * j]; s += (v[j].x * v[j].x + v[j].y * v[j].y) + (v[j].z * v[j].z + v[j].w * v[j].w); }
            const float rs = 1.0f / sqrtf(wave_sum(s) * (1.0f / 1024.0f) + 1e-6f);
#pragma unroll
            for (int j = 0; j < 4; ++j) { const f32x4 gg = ((const f32x4*)g + lane)[64 * j]; v[j].x *= rs * gg.x; v[j].y *= rs * gg.y; v[j].z *= rs * gg.z; v[j].w *= rs * gg.w; }
            if (MODE == 2) {
#pragma unroll
                for (int j = 0; j < 4; ++j) ((f32x4*)hrow + lane)[64 * j] = v[j];
            } else if (MODE == 0) {
                u32x2* o8 = (u32x2*)((bf16*)(ws + WS_HN) + (size_t)m * DM) + lane;
#pragma unroll
                for (int j = 0; j < 4; ++j) { u32x2 w; w.x = pk2(v[j].x, v[j].y); w.y = pk2(v[j].z, v[j].w); o8[64 * j] = w; }
            }
            if (MODE == 1) {
                const float* rw = INF(IN_RTW); float lg[8];
#pragma unroll
                for (int e = 0; e < 8; ++e) lg[e] = 0.f;
#pragma unroll
                for (int j = 0; j < 4; ++j)
#pragma unroll
                    for (int c = 0; c < 4; ++c) { const int k = 4 * (lane + 64 * j) + c; const f32x4 w0 = *(const f32x4*)(rw + (size_t)k * 8), w1 = *(const f32x4*)(rw + (size_t)k * 8 + 4); const float x = v[j][c];
                        lg[0] += x * w0.x; lg[1] += x * w0.y; lg[2] += x * w0.z; lg[3] += x * w0.w; lg[4] += x * w1.x; lg[5] += x * w1.y; lg[6] += x * w1.z; lg[7] += x * w1.w; }
#pragma unroll
                for (int e = 0; e < 8; ++e) lg[e] = wave_sum(lg[e]) + INF(IN_RTB)[e];
                int e0 = 0; float v0 = lg[0];
#pragma unroll
                for (int e = 1; e < 8; ++e) if (lg[e] > v0) { v0 = lg[e]; e0 = e; }
                int e1 = -1; float v1 = -3.0e38f;
#pragma unroll
                for (int e = 0; e < 8; ++e) if (e != e0 && lg[e] > v1) { v1 = lg[e]; e1 = e; }
                const float p1 = 1.0f / (1.0f + __expf(v0 - v1)), p0 = 1.0f - p1;
                if (lane == 0) { int* te = (int*)(ws + WS_SLOT + SL_TOKE); float* tg = (float*)(ws + WS_SLOT + SL_TOKG); te[2 * m] = e0; te[2 * m + 1] = e1; tg[2 * m] = p0; tg[2 * m + 1] = p1;
                    atomicAdd((int*)&lcnt[e0], 1); atomicAdd((int*)&lcnt[8 + e1], 1); }
            }
        }
        if (MODE == 1) { __syncthreads(); if (tid < 16) { ((int*)(ws + WS_SLOT + SL_BCNT))[rb * 16 + tid] = lcnt[tid]; lcnt[tid] = 0; } __syncthreads(); }
    }
}

__device__ __forceinline__ bf16x8 ld_bf8(const bf16* p) { return *(const bf16x8*)p; }
__device__ __forceinline__ float tanhf_(float x) { const float e = __expf(2.0f * x); return 1.0f - 2.0f / (e + 1.0f); }

__device__ __forceinline__ void rw_shift8(const bf16* z, const float* mu, int m, int tpos, int c, float (&o)[8]) {
    const u32x4 cur = *(const u32x4*)(z + (size_t)m * ZLD + ZC_B + c);
    u32x4 prv = (u32x4){0u, 0u, 0u, 0u}; if (tpos > 0) prv = *(const u32x4*)(z + (size_t)(m - 1) * ZLD + ZC_B + c);
    const f32x4 m0 = *(const f32x4*)(mu + c), m1 = *(const f32x4*)(mu + c + 4);
    float cu[8] = {bflo(cur.x), bfhi(cur.x), bflo(cur.y), bfhi(cur.y), bflo(cur.z), bfhi(cur.z), bflo(cur.w), bfhi(cur.w)};
    float pv[8] = {bflo(prv.x), bfhi(prv.x), bflo(prv.y), bfhi(prv.y), bflo(prv.z), bfhi(prv.z), bflo(prv.w), bfhi(prv.w)};
    float mm[8] = {m0.x, m0.y, m0.z, m0.w, m1.x, m1.y, m1.z, m1.w};
#pragma unroll
    for (int j = 0; j < 8; ++j) o[j] = cu[j] + (pv[j] - cu[j]) * mm[j];
}
__device__ __forceinline__ void rw_shift4(const bf16* z, const float* mu, int m, int tpos, int c, float (&o)[4]) {
    const u32x2 cur = *(const u32x2*)(z + (size_t)m * ZLD + ZC_B + c);
    u32x2 prv = (u32x2){0u, 0u}; if (tpos > 0) prv = *(const u32x2*)(z + (size_t)(m - 1) * ZLD + ZC_B + c);
    const f32x4 m0 = *(const f32x4*)(mu + c);
    o[0] = bflo(cur.x) + (bflo(prv.x) - bflo(cur.x)) * m0.x; o[1] = bfhi(cur.x) + (bfhi(prv.x) - bfhi(cur.x)) * m0.y;
    o[2] = bflo(cur.y) + (bflo(prv.y) - bflo(cur.y)) * m0.z; o[3] = bfhi(cur.y) + (bfhi(prv.y) - bfhi(cur.y)) * m0.w;
}
__device__ __forceinline__ bf16x8 pack8(const float (&x)[8]) {
    u32x4 w; w.x = pk2(x[0], x[1]); w.y = pk2(x[2], x[3]); w.z = pk2(x[4], x[5]); w.w = pk2(x[6], x[7]);
    return __builtin_bit_cast(bf16x8, w);
}

__device__ __forceinline__ void rwkv_prep_tile(const Args& a, int layer, int m0, int lane, int hc_lo, int hc_hi) {
    unsigned char* ws = ws_of(a);
    const bf16* z = (const bf16*)(ws + WS_Z);
    const float* mu = INF(IN_RWMU) + (size_t)layer * 1024;
    const bf16* lora = (const bf16*)(ws + WS_LORA) + (size_t)layer * 65536;
    const bf16* wupT = lora; const bf16* aupT = lora + 16384; const bf16* gupT = lora + 32768;
    const int fq = lane >> 4, fr = lane & 15;
    const int m = m0 + fr, tpos = m & (SEQ - 1), bb = m >> 12;
    bf16x8 wdB[2], adB[2], gdB[4];
#pragma unroll
    for (int ks = 0; ks < 2; ++ks) { float x[8]; rw_shift8(z, mu, m, tpos, 768 + 32 * ks + 8 * fq, x);
#pragma unroll
        for (int j = 0; j < 8; ++j) x[j] = tanhf_(x[j]);
        wdB[ks] = pack8(x);
        rw_shift8(z, mu, m, tpos, 832 + 32 * ks + 8 * fq, x); adB[ks] = pack8(x); }
#pragma unroll
    for (int ks = 0; ks < 4; ++ks) { float x[8]; rw_shift8(z, mu, m, tpos, 896 + 32 * ks + 8 * fq, x);
#pragma unroll
        for (int j = 0; j < 8; ++j) x[j] = sigmoidf_(x[j]);
        gdB[ks] = pack8(x); }
    const float* w0p = INF(IN_RWW0) + layer * 256; const float* a0p = INF(IN_RWA0) + layer * 256; const float* kkp = INF(IN_RWKK) + layer * 256;
    const float* kap = INF(IN_RWKA) + layer * 256; const float* rkp = INF(IN_RWRK) + layer * 256;
    float* rec = (float*)(ws + WS_REC); float* gbuf = (float*)(ws + WS_G); float* bonus = (float*)(ws + WS_BONUS);
    float ss = 0.f, bs = 0.f, inv = 0.f;
#pragma unroll 1
    for (int hc = hc_lo; hc < hc_hi; ++hc) {
        const int h = hc >> 2, ct = hc & 3;
        if (ct == 0) {
            ss = 0.f; bs = 0.f;
#pragma unroll
            for (int c2 = 0; c2 < 4; ++c2) { const int c0 = h * 64 + 16 * c2 + 4 * fq; float k4[4]; rw_shift4(z, mu, m, tpos, 256 + c0, k4); const f32x4 k_k = *(const f32x4*)(kkp + c0);
#pragma unroll
                for (int i = 0; i < 4; ++i) { const float kx = k4[i] * k_k[i]; ss += kx * kx; } }
            ss += __shfl_xor(ss, 16); ss += __shfl_xor(ss, 32);
            inv = 1.0f / sqrtf(fmaxf(ss, 1e-24f));
        }
        f32x4 aw = (f32x4){0.f, 0.f, 0.f, 0.f}, aa = aw, ag = aw;
        const int chr = h * 64 + 16 * ct + fr;
#pragma unroll
        for (int ks = 0; ks < 2; ++ks) { const bf16x8 A1 = ld_bf8(wupT + chr * 64 + 32 * ks + 8 * fq), A2 = ld_bf8(aupT + chr * 64 + 32 * ks + 8 * fq);
            aw = __builtin_amdgcn_mfma_f32_16x16x32_bf16(A1, wdB[ks], aw, 0, 0, 0); aa = __builtin_amdgcn_mfma_f32_16x16x32_bf16(A2, adB[ks], aa, 0, 0, 0); }
#pragma unroll
        for (int ks = 0; ks < 4; ++ks) { const bf16x8 A3 = ld_bf8(gupT + chr * 128 + 32 * ks + 8 * fq); ag = __builtin_amdgcn_mfma_f32_16x16x32_bf16(A3, gdB[ks], ag, 0, 0, 0); }
        float* rp = rec + ((size_t)(bb * 4 + h) * SEQ + tpos) * 384;
        const int c0 = h * 64 + 16 * ct + 4 * fq, d0 = 16 * ct + 4 * fq;
        float r4[4], k4[4], v4[4]; rw_shift4(z, mu, m, tpos, c0, r4); rw_shift4(z, mu, m, tpos, 256 + c0, k4); rw_shift4(z, mu, m, tpos, 512 + c0, v4);
        const f32x4 w0 = *(const f32x4*)(w0p + c0), a0 = *(const f32x4*)(a0p + c0), k_k = *(const f32x4*)(kkp + c0), k_a = *(const f32x4*)(kap + c0), r_k = *(const f32x4*)(rkp + c0);
        f32x4 odw, okk, ob, okp;
#pragma unroll
        for (int i = 0; i < 4; ++i) {
            const float wl = w0[i] + aw[i]; const float nx = -wl; const float sp = fmaxf(nx, 0.f) + log1pf(__expf(-fabsf(nx)));
            const float wlog = -sp - 0.5f; odw[i] = __expf(-__expf(wlog));
            const float aval = sigmoidf_(a0[i] + aa[i]);
            const float kkn = k4[i] * k_k[i] * inv; okk[i] = kkn; ob[i] = kkn * aval;
            const float kpv = k4[i] * (1.0f + (aval - 1.0f) * k_a[i]); okp[i] = kpv;
            bs += r4[i] * kpv * r_k[i];
        }
        *(f32x4*)(rp + d0) = odw; *(f32x4*)(rp + 64 + d0) = okk; *(f32x4*)(rp + 128 + d0) = ob; *(f32x4*)(rp + 192 + d0) = okp;
        *(f32x4*)(rp + 256 + d0) = (f32x4){r4[0], r4[1], r4[2], r4[3]}; *(f32x4*)(rp + 320 + d0) = (f32x4){v4[0], v4[1], v4[2], v4[3]};
        *(f32x4*)(gbuf + (size_t)m * 256 + c0) = ag;
        if (ct == 3) { float b2 = bs; b2 += __shfl_xor(b2, 16); b2 += __shfl_xor(b2, 32); if (fq == 0) bonus[(size_t)m * 4 + h] = b2; }
    }
}

__host__ __device__ constexpr int vperm_src(int p) { return (p & ~31) + 16 * ((p & 7) >> 2) + 4 * ((p & 31) >> 3) + (p & 3); }
__host__ __device__ constexpr int vperm_pos(int k) { return (k & ~31) + 8 * ((k & 15) >> 2) + 4 * ((k & 31) >> 4) + (k & 3); }
__device__ __forceinline__ void nsa_prep_item(const Args& a, LAS unsigned char* lds, int b, int tt) {
    unsigned char* ws = ws_of(a); const int tid = opaque_tid();
    const bf16* z = (const bf16*)(ws + WS_Z);
    const float* ct = (const float*)(ws + WS_ROPE); const float* st = ct + (size_t)MT * 8;
    const int mb = b * SEQ + tt * 64;
    for (int task = tid; task < 64 * 12; task += NTHR) {
        const int tok = task / 12, unit = task % 12, m = mb + tok;
        const bf16* src; bf16* dst;
        if (unit < 8) { src = z + (size_t)m * ZLD + ZC_Q + unit * 64; dst = (bf16*)(ws + WS_QROT) + (size_t)m * 512 + unit * 64; }
        else if (unit < 10) { src = z + (size_t)m * ZLD + ZC_KS + (unit - 8) * 64; dst = (bf16*)(ws + WS_KSR) + (size_t)m * 128 + (unit - 8) * 64; }
        else { src = z + (size_t)m * ZLD + ZC_KW + (unit - 10) * 64; dst = (bf16*)(ws + WS_KWR) + (size_t)m * 128 + (unit - 10) * 64; }
        u32x4 v[8];
#pragma unroll
        for (int i = 0; i < 8; ++i) v[i] = ((const u32x4*)src)[i];
        const f32x4 c0 = *(const f32x4*)(ct + (size_t)m * 8), c1 = *(const f32x4*)(ct + (size_t)m * 8 + 4), s0 = *(const f32x4*)(st + (size_t)m * 8), s1 = *(const f32x4*)(st + (size_t)m * 8 + 4);
        const float cc[8] = {c0.x, c0.y, c0.z, c0.w, c1.x, c1.y, c1.z, c1.w}, sn[8] = {s0.x, s0.y, s0.z, s0.w, s1.x, s1.y, s1.z, s1.w};
        const float x1[8] = {bflo(v[0].x), bfhi(v[0].x), bflo(v[0].y), bfhi(v[0].y), bflo(v[0].z), bfhi(v[0].z), bflo(v[0].w), bfhi(v[0].w)};
        const float x2[8] = {bflo(v[1].x), bfhi(v[1].x), bflo(v[1].y), bfhi(v[1].y), bflo(v[1].z), bfhi(v[1].z), bflo(v[1].w), bfhi(v[1].w)};
        float o1[8], o2[8];
#pragma unroll
        for (int i = 0; i < 8; ++i) { o1[i] = x1[i] * cc[i] - x2[i] * sn[i]; o2[i] = x1[i] * sn[i] + x2[i] * cc[i]; }
        v[0] = (u32x4){pk2(o1[0], o1[1]), pk2(o1[2], o1[3]), pk2(o1[4], o1[5]), pk2(o1[6], o1[7])};
        v[1] = (u32x4){pk2(o2[0], o2[1]), pk2(o2[2], o2[3]), pk2(o2[4], o2[5]), pk2(o2[6], o2[7])};
#pragma unroll
        for (int i = 0; i < 8; ++i) ((u32x4*)dst)[i] = v[i];
    }
    LAS bf16* tile = (LAS bf16*)lds;
    { const int tok = tid >> 3, ch = tid & 7;
#pragma unroll
      for (int mi = 0; mi < 4; ++mi) { const int col = (mi < 2 ? ZC_VS : ZC_VW) + (mi & 1) * 64;
          *(LAS u32x4*)(tile + mi * 4608 + tok * 72 + ch * 8) = *(const u32x4*)(z + (size_t)(mb + tok) * ZLD + col + ch * 8); } }
    __syncthreads();
    { const int d = tid >> 3, tc = tid & 7;
#pragma unroll
      for (int mi = 0; mi < 4; ++mi) { unsigned e[8];
#pragma unroll
          for (int j = 0; j < 8; ++j) e[j] = tile[mi * 4608 + vperm_src(tc * 8 + j) * 72 + d];
          u32x4 w; w.x = e[0] | (e[1] << 16); w.y = e[2] | (e[3] << 16); w.z = e[4] | (e[5] << 16); w.w = e[6] | (e[7] << 16);
          bf16* dst = (bf16*)(ws + (mi < 2 ? WS_VST : WS_VWT)) + ((size_t)(b * 2 + (mi & 1)) * 64 + d) * SEQ + tt * 64 + tc * 8;
          *(u32x4*)dst = w; } }
    __syncthreads();
}

__device__ __forceinline__ void nsa_compress_item(const Args& a, int layer, LAS unsigned char* lds, int b, int g, int kv, int nt) {
    unsigned char* ws = ws_of(a); const int tid = opaque_tid(), lane = tid & 63, wave = __builtin_amdgcn_readfirstlane(tid >> 6), fq = lane >> 4, fr = lane & 15;
    const bf16* z = (const bf16*)(ws + WS_Z);
    const bf16* w1t = (const bf16*)(ws + WS_CW1) + (size_t)(layer * 2 + kv) * 128 * 2048;
    const int colb = (kv ? ZC_VC : ZC_KC) + g * 64;
    f32x4 acc[8];
#pragma unroll
    for (int ht = 0; ht < 8; ++ht) acc[ht] = (f32x4){0.f, 0.f, 0.f, 0.f};
    for (int li = 0; li < 4; ++li) { const int l = wave * 4 + li;
        int tok = 256 * nt + 16 * fr + l; tok = tok > SEQ - 1 ? SEQ - 1 : tok;
#pragma unroll
        for (int hf = 0; hf < 2; ++hf) {
            const bf16x8 B = ld_bf8(z + (size_t)(b * SEQ + tok) * ZLD + colb + 32 * hf + 8 * fq);
#pragma unroll
            for (int ht = 0; ht < 8; ++ht) { const bf16x8 A = ld_bf8(w1t + (size_t)(16 * ht + fr) * 2048 + 64 * l + 32 * hf + 8 * fq);
                acc[ht] = __builtin_amdgcn_mfma_f32_16x16x32_bf16(A, B, acc[ht], 0, 0, 0); } } }
    LAS float* part = (LAS float*)lds;
    LAS float* hid = (LAS float*)(lds + 65536);
#pragma unroll
    for (int ht = 0; ht < 8; ++ht)
#pragma unroll
        for (int r = 0; r < 4; ++r) part[(wave * 128 + 16 * ht + 4 * fq + r) * 16 + fr] = acc[ht][r];
    __syncthreads();
    { const int hh = tid >> 2, nq = tid & 3; f32x4 s = (f32x4){0.f, 0.f, 0.f, 0.f};
#pragma unroll
      for (int w = 0; w < 8; ++w) s = s + *(LAS f32x4*)(part + (w * 128 + hh) * 16 + 4 * nq);
      float cb = 0.f; { const float* cbp = (const float*)(ws + WS_CBIAS) + (size_t)(layer * 2 + kv) * 16 * 128 + hh;
#pragma unroll
        for (int c = 0; c < 16; ++c) cb += cbp[c * 128]; }
      f32x4 o; o.x = gelu_tanh(s.x + cb); o.y = gelu_tanh(s.y + cb); o.z = gelu_tanh(s.z + cb); o.w = gelu_tanh(s.w + cb);
      *(LAS f32x4*)(hid + hh * 16 + 4 * nq) = o; }
    __syncthreads();
    { const float* W2 = INF(kv ? IN_VCW2 : IN_KCW2) + (size_t)layer * 128 * 64; const int n = tid & 15, dg = tid >> 4; float o0 = 0.f, o1 = 0.f;
      for (int hh = 0; hh < 128; ++hh) { const float x = hid[hh * 16 + n]; o0 += x * W2[hh * 64 + dg]; o1 += x * W2[hh * 64 + dg + 32]; }
      const int ng = 16 * nt + n; if (ng >= NCMP) { o0 = 0.f; o1 = 0.f; }
      if (kv == 0) { bf16* kc = (bf16*)(ws + WS_KCMP) + ((size_t)(b * 2 + g) * 256 + ng) * 64; kc[dg] = (bf16)f2bf(o0); kc[dg + 32] = (bf16)f2bf(o1); }
      else { bf16* vc = (bf16*)(ws + WS_VCMPT) + (size_t)(b * 2 + g) * 64 * 256; const int np = vperm_pos(ng); vc[(size_t)dg * 256 + np] = (bf16)f2bf(o0); vc[(size_t)(dg + 32) * 256 + np] = (bf16)f2bf(o1); } }
    __syncthreads();
}

__device__ __forceinline__ void phase_prep(const Args& a, int layer, LAS unsigned char* lds) {
    const int tid = opaque_tid(), lane = tid & 63, wave = __builtin_amdgcn_readfirstlane(tid >> 6);
#ifndef NO_RWP
    for (int tile = blockIdx.x * 4 + (wave & 3); tile < MT / 16; tile += gridDim.x * 4) rwkv_prep_tile(a, layer, tile * 16, lane, 8 * (wave >> 2), 8 * (wave >> 2) + 8);
#endif
#ifndef NO_NSAP
    for (int it = blockIdx.x; it < NB * 64; it += gridDim.x) nsa_prep_item(a, lds, it >> 6, it & 63);
#endif
#ifndef NO_CMP
    for (int it = blockIdx.x; it < NB * 2 * 2 * 16; it += gridDim.x) nsa_compress_item(a, layer, lds, it >> 6, (it >> 5) & 1, (it >> 4) & 1, it & 15);
#endif
}

__device__ __forceinline__ float dpp_xor1(float x) { return __builtin_bit_cast(float, __builtin_amdgcn_update_dpp(0, __builtin_bit_cast(int, x), 0xB1, 0xf, 0xf, true)); }
__device__ __forceinline__ float dpp_xor2(float x) { return __builtin_bit_cast(float, __builtin_amdgcn_update_dpp(0, __builtin_bit_cast(int, x), 0x4E, 0xf, 0xf, true)); }
__device__ __forceinline__ float dpp_hmir(float x) { return __builtin_bit_cast(float, __builtin_amdgcn_update_dpp(0, __builtin_bit_cast(int, x), 0x141, 0xf, 0xf, true)); }
__device__ __forceinline__ float red8(float x) { x += dpp_xor1(x); x += dpp_xor2(x); x += dpp_hmir(x); return x; }

__device__ __forceinline__ void rwkv_scan_seg(const Args& a, LAS unsigned char* lds, int bh, int seg) {
    unsigned char* ws = ws_of(a); const int tid = opaque_tid(), lane = tid & 63, wave = __builtin_amdgcn_readfirstlane(tid >> 6);
    const int row = wave * 8 + (lane >> 3), kq = lane & 7;
    const f32x4* rec4 = (const f32x4*)(ws + WS_REC) + ((size_t)bh * SEQ + (size_t)seg * SEGLEN) * 96;
    const size_t yoff = ((size_t)(bh >> 2) * SEQ + (size_t)seg * SEGLEN) * 256 + (bh & 3) * 64 + row;
    float* yraw = (float*)(ws + WS_YRAW) + yoff; float* ypb = (float*)(ws + WS_YP) + yoff;
    LAS f32x4* buf = (LAS f32x4*)lds;
    float s[8], q[8];
#pragma unroll
    for (int j = 0; j < 8; ++j) { s[j] = 0.f; q[j] = (8 * kq + j == row) ? 1.f : 0.f; }
    __syncthreads();
    { f32x4 p0 = rec4[tid], p1 = rec4[tid + 512], p2 = rec4[tid + 1024]; buf[tid] = p0; buf[tid + 512] = p1; buf[tid + 1024] = p2; }
    __syncthreads();
    for (int c = 0; c < SEGLEN / 16; ++c) {
        const int p = c & 1;
        f32x4 n0, n1, n2; const bool more = (c + 1 < SEGLEN / 16);
        if (more) { const f32x4* src = rec4 + (size_t)(c + 1) * 1536; n0 = src[tid]; n1 = src[tid + 512]; n2 = src[tid + 1024]; }
        const LAS f32x4* bp = buf + p * 1536;
#pragma unroll 2
        for (int st = 0; st < 16; ++st) {
            const LAS f32x4* sp = bp + st * 96;
            const f32x4 w0 = sp[2 * kq], w1 = sp[2 * kq + 1], k0 = sp[16 + 2 * kq], k1 = sp[16 + 2 * kq + 1], b0 = sp[32 + 2 * kq], b1 = sp[32 + 2 * kq + 1];
            const f32x4 q0 = sp[48 + 2 * kq], q1 = sp[48 + 2 * kq + 1], r0 = sp[64 + 2 * kq], r1 = sp[64 + 2 * kq + 1];
            const float vv = ((const LAS float*)(sp + 80))[row];
            const float wv[8] = {w0.x, w0.y, w0.z, w0.w, w1.x, w1.y, w1.z, w1.w}, kk[8] = {k0.x, k0.y, k0.z, k0.w, k1.x, k1.y, k1.z, k1.w};
            const float bv[8] = {b0.x, b0.y, b0.z, b0.w, b1.x, b1.y, b1.z, b1.w}, kp[8] = {q0.x, q0.y, q0.z, q0.w, q1.x, q1.y, q1.z, q1.w};
            const float rr[8] = {r0.x, r0.y, r0.z, r0.w, r1.x, r1.y, r1.z, r1.w};
            float d1 = (s[0] * kk[0] + s[1] * kk[1]) + (s[2] * kk[2] + s[3] * kk[3]) + ((s[4] * kk[4] + s[5] * kk[5]) + (s[6] * kk[6] + s[7] * kk[7]));
            float e1 = (q[0] * kk[0] + q[1] * kk[1]) + (q[2] * kk[2] + q[3] * kk[3]) + ((q[4] * kk[4] + q[5] * kk[5]) + (q[6] * kk[6] + q[7] * kk[7]));
            d1 += dpp_xor1(d1); e1 += dpp_xor1(e1); d1 += dpp_xor2(d1); e1 += dpp_xor2(e1); d1 += dpp_hmir(d1); e1 += dpp_hmir(e1);
            const float sa = -d1, sq = -e1;
            float d2 = 0.f, e2 = 0.f;
#pragma unroll
            for (int j = 0; j < 8; ++j) { s[j] = s[j] * wv[j] + (sa * bv[j] + vv * kp[j]); d2 += s[j] * rr[j]; q[j] = q[j] * wv[j] + sq * bv[j]; e2 += q[j] * rr[j]; }
            d2 += dpp_xor1(d2); e2 += dpp_xor1(e2); d2 += dpp_xor2(d2); e2 += dpp_xor2(e2); d2 += dpp_hmir(d2); e2 += dpp_hmir(e2);
            if (kq == 0) { yraw[(size_t)(c * 16 + st) * 256] = d2; ypb[(size_t)(c * 16 + st) * 256] = e2; }
        }
        if (more) { LAS f32x4* dp = buf + (p ^ 1) * 1536; dp[tid] = n0; dp[tid + 512] = n1; dp[tid + 1024] = n2; }
        __syncthreads();
    }
    float* se = (float*)(ws + WS_SEGE) + ((size_t)(bh * NSEG + seg) * 2) * 4096 + row * 64 + 8 * kq;
    *(f32x4*)se = (f32x4){s[0], s[1], s[2], s[3]}; *(f32x4*)(se + 4) = (f32x4){s[4], s[5], s[6], s[7]};
    *(f32x4*)(se + 4096) = (f32x4){q[0], q[1], q[2], q[3]}; *(f32x4*)(se + 4096 + 4) = (f32x4){q[4], q[5], q[6], q[7]};
}

__device__ __forceinline__ void rwkv_chain(const Args& a, LAS unsigned char* lds, int bh) {
    unsigned char* ws = ws_of(a); const int tid = opaque_tid();
    LAS float* S = (LAS float*)lds;
    LAS float* P = S + 64 * 68;
    const int v = tid >> 3, kg = tid & 7;
    float* sst = (float*)(ws + WS_SST) + (size_t)bh * NSEG * 4096;
    const float* sege = (const float*)(ws + WS_SEGE) + (size_t)bh * NSEG * 2 * 4096;
    __syncthreads();
    for (int i = tid; i < 64 * 68; i += NTHR) S[i] = 0.f;
    for (int i = tid; i < 4096; i += NTHR) sst[i] = 0.f;
    __syncthreads();
    for (int sg = 1; sg < NSEG; ++sg) {
        const float* e0 = sege + (size_t)(sg - 1) * 2 * 4096;
        for (int i = tid; i < 1024; i += NTHR) *(LAS f32x4*)(P + 4 * i) = *(const f32x4*)(e0 + 4096 + 4 * i);
        f32x4 o0 = *(const f32x4*)(e0 + v * 64 + 8 * kg), o1 = *(const f32x4*)(e0 + v * 64 + 8 * kg + 4);
        __syncthreads();
#pragma unroll 4
        for (int i = 0; i < 64; ++i) { const float sv = S[v * 68 + i]; const f32x4 p0 = *(const LAS f32x4*)(P + i * 64 + 8 * kg), p1 = *(const LAS f32x4*)(P + i * 64 + 8 * kg + 4);
            o0 = o0 + p0 * sv; o1 = o1 + p1 * sv; }
        __syncthreads();
        *(LAS f32x4*)(S + v * 68 + 8 * kg) = o0; *(LAS f32x4*)(S + v * 68 + 8 * kg + 4) = o1;
        *(f32x4*)(sst + (size_t)sg * 4096 + v * 64 + 8 * kg) = o0; *(f32x4*)(sst + (size_t)sg * 4096 + v * 64 + 8 * kg + 4) = o1;
        __syncthreads();
    }
}

__device__ __forceinline__ void rwkv_post_item(const Args& a, int layer, LAS unsigned char* lds, int bh, int tile) {
    unsigned char* ws = ws_of(a); const int tid = opaque_tid();
    const int seg = tile / (SEGLEN / 64), bb = bh >> 2, h = bh & 3;
    LAS float* S = (LAS float*)lds;
    LAS float* YP = S + 64 * 68;
    const float* sst = (const float*)(ws + WS_SST) + (size_t)(bh * NSEG + seg) * 4096;
    const size_t m0 = (size_t)bb * SEQ + (size_t)tile * 64;
    __syncthreads();
    for (int i = tid; i < 1024; i += NTHR) { const int r = i >> 4, c4 = i & 15; *(LAS f32x4*)(S + r * 68 + 4 * c4) = *(const f32x4*)(sst + r * 64 + 4 * c4);
        *(LAS f32x4*)(YP + r * 68 + 4 * c4) = *(const f32x4*)((const float*)(ws + WS_YP) + (m0 + r) * 256 + h * 64 + 4 * c4); }
    __syncthreads();
    const int tok = tid >> 3, vg = tid & 7; const size_t m = m0 + tok; const int c0 = h * 64 + 8 * vg;
    const f32x4 ya = *(const f32x4*)((const float*)(ws + WS_YRAW) + m * 256 + c0), yb = *(const f32x4*)((const float*)(ws + WS_YRAW) + m * 256 + c0 + 4);
    float y[8] = {ya.x, ya.y, ya.z, ya.w, yb.x, yb.y, yb.z, yb.w};
    if (seg > 0) {
#pragma unroll 4
        for (int i = 0; i < 64; i += 4) { const f32x4 yp = *(const LAS f32x4*)(YP + tok * 68 + i);
#pragma unroll
            for (int j = 0; j < 8; ++j) { const f32x4 sr = *(const LAS f32x4*)(S + (8 * vg + j) * 68 + i); y[j] += (sr.x * yp.x + sr.y * yp.y) + (sr.z * yp.z + sr.w * yp.w); } }
    }
    float sm = 0.f;
#pragma unroll
    for (int j = 0; j < 8; ++j) sm += y[j];
    sm += __shfl_xor(sm, 1); sm += __shfl_xor(sm, 2); sm += __shfl_xor(sm, 4);
    const float mean = sm * (1.0f / 64.0f); float qq = 0.f;
#pragma unroll
    for (int j = 0; j < 8; ++j) { y[j] -= mean; qq += y[j] * y[j]; }
    qq += __shfl_xor(qq, 1); qq += __shfl_xor(qq, 2); qq += __shfl_xor(qq, 4);
    const float rstd = 1.0f / sqrtf(qq * (1.0f / 64.0f) + 64e-5f);
    const float* gng = INF(IN_RWGNG) + layer * 256 + c0; const float* gnb = INF(IN_RWGNB) + layer * 256 + c0;
    const float* gt = (const float*)(ws + WS_G) + m * 256 + c0;
    const float* vv = (const float*)(ws + WS_REC) + ((size_t)bh * SEQ + (size_t)tile * 64 + tok) * 384 + 320 + 8 * vg;
    const float bo = ((const float*)(ws + WS_BONUS))[m * 4 + h];
    float o[8];
#pragma unroll
    for (int j = 0; j < 8; ++j) o[j] = (y[j] * rstd * gng[j] + gnb[j] + vv[j] * bo) * gt[j];
    u32x4 w; w.x = pk2(o[0], o[1]); w.y = pk2(o[2], o[3]); w.z = pk2(o[4], o[5]); w.w = pk2(o[6], o[7]);
    *(u32x4*)((bf16*)(ws + WS_YCAT) + m * DM + 256 + c0) = w;
}

__device__ __forceinline__ void gmlp_item(const Args& a, int layer, LAS unsigned char* lds, int b, int n, int h) {
    unsigned char* ws = ws_of(a); const int tid = opaque_tid(), lane = tid & 63, wave = __builtin_amdgcn_readfirstlane(tid >> 6), fq = lane >> 4, fr = lane & 15;
    const bf16* z = (const bf16*)(ws + WS_Z); bf16* ycat = (bf16*)(ws + WS_YCAT);
    LAS bf16* vt = (LAS bf16*)lds;
    const int mb = b * SEQ + n * 128;
    { const int s = tid >> 2, part = tid & 3; const bf16* src = z + (size_t)(mb + s) * ZLD + ZC_V + h * 64 + part * 16;
      const u32x4 v0 = ((const u32x4*)src)[0], v1 = ((const u32x4*)src)[1];
      float x[16] = {bflo(v0.x), bfhi(v0.x), bflo(v0.y), bfhi(v0.y), bflo(v0.z), bfhi(v0.z), bflo(v0.w), bfhi(v0.w), bflo(v1.x), bfhi(v1.x), bflo(v1.y), bfhi(v1.y), bflo(v1.z), bfhi(v1.z), bflo(v1.w), bfhi(v1.w)};
      float sm = 0.f;
#pragma unroll
      for (int j = 0; j < 16; ++j) { x[j] = gelu_tanh(x[j]); sm += x[j]; }
      sm += __shfl_xor(sm, 1); sm += __shfl_xor(sm, 2);
      const float mean = sm * (1.0f / 64.0f); float q = 0.f;
#pragma unroll
      for (int j = 0; j < 16; ++j) { x[j] -= mean; q += x[j] * x[j]; }
      q += __shfl_xor(q, 1); q += __shfl_xor(q, 2);
      const float rstd = 1.0f / sqrtf(q * (1.0f / 64.0f) + 1e-5f);
      const float* lg = INF(IN_GMLNG) + (layer * 4 + h) * 64 + part * 16; const float* lb = INF(IN_GMLNB) + (layer * 4 + h) * 64 + part * 16;
#pragma unroll
      for (int j = 0; j < 16; ++j) vt[(part * 16 + j) * 136 + s] = (bf16)f2bf(x[j] * rstd * lg[j] + lb[j]); }
    __syncthreads();
    {
        const float* W = INF(IN_GMWS) + ((size_t)(layer * 4 + h) * 128 + 16 * wave + fr) * 128;
        f32x4 acc[4];
#pragma unroll
        for (int dt = 0; dt < 4; ++dt) acc[dt] = (f32x4){0.f, 0.f, 0.f, 0.f};
        const int trow = 16 * wave + fr; const int nks = (wave >> 1) + 1;
        for (int ks = 0; ks < nks; ++ks) {
            const int s0 = 32 * ks + 8 * fq; const f32x4 wa = *(const f32x4*)(W + s0), wb = *(const f32x4*)(W + s0 + 4);
            float wv[8] = {wa.x, wa.y, wa.z, wa.w, wb.x, wb.y, wb.z, wb.w};
#pragma unroll
            for (int j = 0; j < 8; ++j) wv[j] = (s0 + j <= trow) ? wv[j] : 0.f;
            const bf16x8 A = pack8(wv);
#pragma unroll
            for (int dt = 0; dt < 4; ++dt) { const bf16x8 B = *(const LAS bf16x8*)(vt + (16 * dt + fr) * 136 + s0); acc[dt] = __builtin_amdgcn_mfma_f32_16x16x32_bf16(A, B, acc[dt], 0, 0, 0); } }
        const float* bs = INF(IN_GMBS) + (layer * 4 + h) * 128;
#pragma unroll
        for (int r = 0; r < 4; ++r) { const int t = 16 * wave + 4 * fq + r; const float bias = bs[t];
#pragma unroll
            for (int dt = 0; dt < 4; ++dt) { const int d = 16 * dt + fr; const float u = gelu_tanh(bf2f(z[(size_t)(mb + t) * ZLD + ZC_U + h * 64 + d]));
                ycat[(size_t)(mb + t) * DM + h * 64 + d] = (bf16)f2bf(u * (acc[dt][r] + bias)); } }
    }
    __syncthreads();
}

constexpr int NSA_OT = 0, NSA_KB = 65536, NSA_VB = 93184, NSA_IMP = 120832, NSA_SELM = 137216, NSA_UNI = 137728;
struct NsaTileSrc { const bf16* kbase; int kld; const bf16* vbase; int vld; };

__device__ __forceinline__ void nsa_tile_load(const NsaTileSrc& S, int kb, int tid, u32x4& kr, u32x4& vr) {
    const int row = tid >> 3, ch = tid & 7;
    kr = *(const u32x4*)(S.kbase + (size_t)(kb * 64 + row) * S.kld + ch * 8);
    vr = *(const u32x4*)(S.vbase + (size_t)row * S.vld + kb * 64 + ch * 8);
}
__device__ __forceinline__ void nsa_tile_store(LAS unsigned char* lds, int p, int tid, const u32x4& kr, const u32x4& vr) {
    const int row = tid >> 3, ch = tid & 7;
    *(LAS u32x4*)(lds + NSA_KB + p * 9216 + (row * 72 + ch * 8) * 2) = kr;
    *(LAS u32x4*)(lds + NSA_VB + p * 9216 + (row * 72 + ch * 8) * 2) = vr;
}
__device__ __forceinline__ float max3f(float a, float b, float c) { float r; asm("v_max3_f32 %0, %1, %2, %3" : "=v"(r) : "v"(a), "v"(b), "v"(c)); return r; }
__device__ __forceinline__ void nsa_scores(LAS unsigned char* lds, int p, const bf16x8 (&Q)[2][2], f32x4 (&sc)[4][2], int fq, int fr) {
#pragma unroll
    for (int kt = 0; kt < 4; ++kt) {
        const LAS unsigned char* kp = lds + NSA_KB + p * 9216 + ((16 * kt + fr) * 72 + 8 * fq) * 2;
        const bf16x8 K0 = *(const LAS bf16x8*)kp, K1 = *(const LAS bf16x8*)(kp + 64);
#pragma unroll
        for (int qg = 0; qg < 2; ++qg) { f32x4 c = (f32x4){0.f, 0.f, 0.f, 0.f};
            c = __builtin_amdgcn_mfma_f32_16x16x32_bf16(K0, Q[qg][0], c, 0, 0, 0); c = __builtin_amdgcn_mfma_f32_16x16x32_bf16(K1, Q[qg][1], c, 0, 0, 0); sc[kt][qg] = c; } }
}
template <int MODE>
__device__ __forceinline__ bool nsa_allowed(int kidx, int t, int kb, unsigned long long selm) {
    if (MODE == 0) return (16 * kidx + 31 <= t) && (kidx < NCMP);
    if (MODE == 1) return (kidx <= t) && ((selm >> kb) & 1ull);
    return (kidx <= t) && (kidx + 512 > t);
}
template <int MODE, int MM>
__device__ __forceinline__ void nsa_tile_compute(LAS unsigned char* lds, int p, int kb, const bf16x8 (&Q)[2][2], const int (&tq)[2], const unsigned long long (&selm)[2],
                                                 float (&m_run)[2], float (&l_run)[2], f32x4 (&O)[4][2], int fq, int fr) {
    f32x4 sc[4][2];
    nsa_scores(lds, p, Q, sc, fq, fr);
    const float SC = 0.125f * 1.4426950408889634f;
    bf16x8 P[2][2]; float alpha[2];
#pragma unroll
    for (int qg = 0; qg < 2; ++qg) {
        float mx = -1e30f; bool tok_ok = true;
        if (MM == 2) {
#pragma unroll
            for (int kt = 0; kt < 4; ++kt)
#pragma unroll
                for (int r = 0; r < 4; ++r) { const int kidx = kb * 64 + 16 * kt + 4 * fq + r;
                    const float v = nsa_allowed<MODE>(kidx, tq[qg], kb, selm[qg]) ? sc[kt][qg][r] * SC : -1e30f; sc[kt][qg][r] = v; mx = fmaxf(mx, v); }
        } else {
#pragma unroll
            for (int kt = 0; kt < 4; ++kt) { sc[kt][qg] = sc[kt][qg] * SC;
                mx = fmaxf(fmaxf(mx, sc[kt][qg][0]), sc[kt][qg][1]); mx = fmaxf(fmaxf(mx, sc[kt][qg][2]), sc[kt][qg][3]); }
            if (MM == 1) { tok_ok = (selm[qg] >> kb) & 1ull; mx = tok_ok ? mx : -1e30f; }
        }
        mx = fmaxf(mx, __shfl_xor(mx, 16)); mx = fmaxf(mx, __shfl_xor(mx, 32));
        const float mn = fmaxf(m_run[qg], mx); alpha[qg] = __builtin_amdgcn_exp2f(m_run[qg] - mn); m_run[qg] = mn;
        const float msub = (MM == 1 && !tok_ok) ? 1e30f : mn;
        float ls = 0.f; float pv[4][4];
#pragma unroll
        for (int kt = 0; kt < 4; ++kt)
#pragma unroll
            for (int r = 0; r < 4; ++r) { float e;
                if (MM == 2) { const float sv = sc[kt][qg][r]; e = (sv > -1e29f) ? __builtin_amdgcn_exp2f(sv - mn) : 0.f; }
                else e = __builtin_amdgcn_exp2f(sc[kt][qg][r] - msub);
                pv[kt][r] = e; ls += e; }
        l_run[qg] = l_run[qg] * alpha[qg] + ls;
#pragma unroll
        for (int s = 0; s < 2; ++s) { u32x4 w; w.x = pg8::cvt_pk_bf16(pv[2 * s][0], pv[2 * s][1]); w.y = pg8::cvt_pk_bf16(pv[2 * s][2], pv[2 * s][3]); w.z = pg8::cvt_pk_bf16(pv[2 * s + 1][0], pv[2 * s + 1][1]); w.w = pg8::cvt_pk_bf16(pv[2 * s + 1][2], pv[2 * s + 1][3]);
            P[qg][s] = __builtin_bit_cast(bf16x8, w); }
    }
    if (!__all(alpha[0] == 1.0f && alpha[1] == 1.0f)) {
#pragma unroll
        for (int qg = 0; qg < 2; ++qg)
#pragma unroll
            for (int dt = 0; dt < 4; ++dt) O[dt][qg] = O[dt][qg] * alpha[qg];
    }
#pragma unroll
    for (int dt = 0; dt < 4; ++dt)
#pragma unroll
        for (int s = 0; s < 2; ++s) {
            const bf16x8 A = *(const LAS bf16x8*)(lds + NSA_VB + p * 9216 + ((16 * dt + fr) * 72 + 32 * s + 8 * fq) * 2);
#pragma unroll
            for (int qg = 0; qg < 2; ++qg) O[dt][qg] = __builtin_amdgcn_mfma_f32_16x16x32_bf16(A, P[qg][s], O[dt][qg], 0, 0, 0);
        }
}

template <int MODE>
__device__ __forceinline__ void nsa_branch(LAS unsigned char* lds, const NsaTileSrc& S, int kb_lo, int kb_hi, int full_lo, int full_hi, unsigned long long tilemask, const bf16x8 (&Q)[2][2], const int (&tq)[2],
                                           const unsigned long long (&selm)[2], const float (&gate)[2], const bool first, float (&m_out)[2], float (&l_out)[2], int tid, int fq, int fr) {
    float m_run[2] = {-1e30f, -1e30f}, l_run[2] = {0.f, 0.f}; f32x4 O[4][2];
#pragma unroll
    for (int dt = 0; dt < 4; ++dt)
#pragma unroll
        for (int qg = 0; qg < 2; ++qg) O[dt][qg] = (f32x4){0.f, 0.f, 0.f, 0.f};
#define NSA_NEXT(x) ({ int _n = (x) + 1; while (_n <= kb_hi && !((tilemask >> _n) & 1ull)) ++_n; _n; })
#define NSA_COMPUTE(p_, t_) do { if (MODE != 0 && (t_) >= full_lo && (t_) <= full_hi) nsa_tile_compute<MODE, (MODE == 1 ? 1 : 0)>(lds, p_, t_, Q, tq, selm, m_run, l_run, O, fq, fr); \
        else nsa_tile_compute<MODE, 2>(lds, p_, t_, Q, tq, selm, m_run, l_run, O, fq, fr); } while (0)
    int t0 = kb_lo; while (t0 <= kb_hi && !((tilemask >> t0) & 1ull)) ++t0;
    if (t0 <= kb_hi) {
        u32x4 ka, va, kb_, vb_; int p = 0;
        nsa_tile_load(S, t0, tid, ka, va); nsa_tile_store(lds, 0, tid, ka, va);
        int t1 = NSA_NEXT(t0);
        if (t1 <= kb_hi) nsa_tile_load(S, t1, tid, kb_, vb_);
        __syncthreads();
        for (;;) {
            int t2 = t1 <= kb_hi ? NSA_NEXT(t1) : t1;
            if (t2 <= kb_hi) nsa_tile_load(S, t2, tid, ka, va);
            NSA_COMPUTE(p, t0);
            const int p1 = p == 2 ? 0 : p + 1;
            if (t1 <= kb_hi) nsa_tile_store(lds, p1, tid, kb_, vb_);
            __syncthreads();
            if (t1 > kb_hi) break;
            int t3 = t2 <= kb_hi ? NSA_NEXT(t2) : t2;
            if (t3 <= kb_hi) nsa_tile_load(S, t3, tid, kb_, vb_);
            NSA_COMPUTE(p1, t1);
            const int p2 = p1 == 2 ? 0 : p1 + 1;
            if (t2 <= kb_hi) nsa_tile_store(lds, p2, tid, ka, va);
            __syncthreads();
            if (t2 > kb_hi) break;
            t0 = t2; t1 = t3; p = p2;
        }
    }
#undef NSA_NEXT
#undef NSA_COMPUTE
#pragma unroll
    for (int qg = 0; qg < 2; ++qg) { float l = l_run[qg]; l += __shfl_xor(l, 16); l += __shfl_xor(l, 32); l_out[qg] = l; m_out[qg] = m_run[qg];
        const float sc = l > 0.f ? gate[qg] / l : 0.f;
        LAS float* ot = (LAS float*)(lds + NSA_OT) + tid;
#pragma unroll
        for (int dt = 0; dt < 4; ++dt)
#pragma unroll
            for (int r = 0; r < 4; ++r) { LAS float* pp = ot + ((dt * 2 + qg) * 4 + r) * 512; const float v = O[dt][qg][r] * sc; *pp = first ? v : (*pp + v); } }
}

__device__ __forceinline__ void nsa_item(const Args& a, LAS unsigned char* lds, int b, int g, int T) {
    unsigned char* ws = ws_of(a); const int tid = opaque_tid(), lane = tid & 63, wave = __builtin_amdgcn_readfirstlane(tid >> 6), fq = lane >> 4, fr = lane & 15;
    const bf16* z = (const bf16*)(ws + WS_Z);
    const int head = g * 4 + (fr & 3);
    int tq[2], mq[2]; bf16x8 Qraw[2][2]; float gt[2][3];
#pragma unroll
    for (int qg = 0; qg < 2; ++qg) { const int tl = 8 * wave + 4 * qg + (fr >> 2); tq[qg] = T * 64 + tl; mq[qg] = b * SEQ + tq[qg];
#pragma unroll
        for (int ks = 0; ks < 2; ++ks) Qraw[qg][ks] = ld_bf8(z + (size_t)mq[qg] * ZLD + ZC_Q + head * 64 + 32 * ks + 8 * fq);
#pragma unroll
        for (int br = 0; br < 3; ++br) gt[qg][br] = sigmoidf_(bf2f(z[(size_t)mq[qg] * ZLD + ZC_GT + head * 3 + br])); }
    if (tid < 64) { ((LAS unsigned long long*)(lds + NSA_SELM))[tid] = 0ull; if (tid < 2) ((LAS unsigned*)(lds + NSA_UNI))[tid] = 0u; }
    const unsigned long long nosel[2] = {0ull, 0ull};
    NsaTileSrc SC_; SC_.kbase = (const bf16*)(ws + WS_KCMP) + (size_t)(b * 2 + g) * 256 * 64; SC_.kld = 64; SC_.vbase = (const bf16*)(ws + WS_VCMPT) + (size_t)(b * 2 + g) * 64 * 256; SC_.vld = 256;
    float mc[2], lc[2];
    { float gc[2] = {gt[0][0], gt[1][0]};
      nsa_branch<0>(lds, SC_, 0, 3, 1, 0, ~0ull, Qraw, tq, nosel, gc, true, mc, lc, tid, fq, fr); }
    {
        LAS float* imp = (LAS float*)(lds + NSA_IMP);
        float carry[2] = {0.f, 0.f}; const float SCL = 0.125f * 1.4426950408889634f;
        float invl[2] = {lc[0] > 0.f ? 1.0f / lc[0] : 0.f, lc[1] > 0.f ? 1.0f / lc[1] : 0.f};
        for (int kb = 0; kb < 4; ++kb) {
            { const int row = tid >> 3, ch = tid & 7; *(LAS u32x4*)(lds + NSA_KB + (row * 72 + ch * 8) * 2) = *(const u32x4*)(SC_.kbase + (size_t)(kb * 64 + row) * 64 + ch * 8); }
            __syncthreads();
            f32x4 sc[4][2]; nsa_scores(lds, 0, Qraw, sc, fq, fr);
#pragma unroll
            for (int kt = 0; kt < 4; ++kt)
#pragma unroll
                for (int qg = 0; qg < 2; ++qg) { float pn[4];
#pragma unroll
                    for (int r = 0; r < 4; ++r) { const int kidx = kb * 64 + 16 * kt + 4 * fq + r; const bool al = nsa_allowed<0>(kidx, tq[qg], kb, 0ull);
                        pn[r] = al ? __builtin_amdgcn_exp2f(sc[kt][qg][r] * SCL - mc[qg]) * invl[qg] : 0.f; }
                    const float y = __shfl(pn[3], (lane + 48) & 63);
                    float v = (pn[0] + pn[1]) + (pn[2] + pn[3]) + (fq == 0 ? carry[qg] : y); carry[qg] = y;
                    v += __shfl_xor(v, 1); v += __shfl_xor(v, 2);
                    if ((fr & 3) == 0) imp[(8 * wave + 4 * qg + (fr >> 2)) * 64 + 16 * kb + 4 * kt + fq] = v; }
            __syncthreads();
        }
    }
    {
        const LAS float* imp = (const LAS float*)(lds + NSA_IMP);
        const int tl = tid >> 3, part = tid & 7; float vm[8]; int cnt[8];
        { const f32x4 x0 = *(const LAS f32x4*)(imp + tl * 64 + part * 8), x1 = *(const LAS f32x4*)(imp + tl * 64 + part * 8 + 4);
          const float xx[8] = {x0.x, x0.y, x0.z, x0.w, x1.x, x1.y, x1.z, x1.w};
#pragma unroll
          for (int j = 0; j < 8; ++j) { const int mi = part * 8 + j; const bool valid = mi <= T; const bool forced = (mi == 0) || (mi == T) || (mi == T - 1);
              vm[j] = valid ? xx[j] + (forced ? 1e4f : 0.f) : -1e4f; cnt[j] = 0; } }
        for (int q4 = 0; q4 < 16; ++q4) { const f32x4 x = *(const LAS f32x4*)(imp + tl * 64 + 4 * q4); const float xq[4] = {x.x, x.y, x.z, x.w};
#pragma unroll
            for (int i = 0; i < 4; ++i) { const int q = 4 * q4 + i; const bool valid = q <= T; const bool forced = (q == 0) || (q == T) || (q == T - 1);
                const float vq = valid ? xq[i] + (forced ? 1e4f : 0.f) : -1e4f;
#pragma unroll
                for (int j = 0; j < 8; ++j) { const int mi = part * 8 + j; cnt[j] += (vq > vm[j] || (vq == vm[j] && q < mi)) ? 1 : 0; } } }
        unsigned bits = 0u;
#pragma unroll
        for (int j = 0; j < 8; ++j) if (cnt[j] < 16 && vm[j] > -5000.f) bits |= 1u << j;
        atomicOr((unsigned*)(lds + NSA_SELM) + tl * 2 + (part >> 2), bits << (8 * (part & 3)));
        atomicOr((unsigned*)(lds + NSA_UNI) + (part >> 2), bits << (8 * (part & 3)));
    }
    __syncthreads();
    bf16x8 Qrot[2][2];
#pragma unroll
    for (int qg = 0; qg < 2; ++qg)
#pragma unroll
        for (int ks = 0; ks < 2; ++ks) Qrot[qg][ks] = ld_bf8((const bf16*)(ws + WS_QROT) + (size_t)mq[qg] * 512 + head * 64 + 32 * ks + 8 * fq);
    unsigned long long selm[2], uni;
    { const LAS unsigned long long* sm = (const LAS unsigned long long*)(lds + NSA_SELM); selm[0] = sm[8 * wave + (fr >> 2)]; selm[1] = sm[8 * wave + 4 + (fr >> 2)]; const LAS unsigned* up = (const LAS unsigned*)(lds + NSA_UNI); uni = ((unsigned long long)(unsigned)__builtin_amdgcn_readfirstlane(up[1]) << 32) | (unsigned)__builtin_amdgcn_readfirstlane(up[0]); }
    { NsaTileSrc SS; SS.kbase = (const bf16*)(ws + WS_KSR) + (size_t)b * SEQ * 128 + g * 64; SS.kld = 128; SS.vbase = (const bf16*)(ws + WS_VST) + (size_t)(b * 2 + g) * 64 * SEQ; SS.vld = SEQ;
      float gs[2] = {gt[0][1], gt[1][1]}, mo[2], lo[2];
      nsa_branch<1>(lds, SS, 0, T, 0, T - 1, uni, Qrot, tq, selm, gs, false, mo, lo, tid, fq, fr); }
    { NsaTileSrc SW; SW.kbase = (const bf16*)(ws + WS_KWR) + (size_t)b * SEQ * 128 + g * 64; SW.kld = 128; SW.vbase = (const bf16*)(ws + WS_VWT) + (size_t)(b * 2 + g) * 64 * SEQ; SW.vld = SEQ;
      float gw_[2] = {gt[0][2], gt[1][2]}, mo[2], lo[2]; const int lo_kb = T >= 8 ? T - 8 : 0;
      nsa_branch<2>(lds, SW, lo_kb, T, T - 7, T - 1, ~0ull, Qrot, tq, nosel, gw_, false, mo, lo, tid, fq, fr); }
    bf16* ycat = (bf16*)(ws + WS_YCAT);
#pragma unroll
    for (int qg = 0; qg < 2; ++qg)
#pragma unroll
        for (int dt = 0; dt < 4; ++dt) { const LAS float* ot = (const LAS float*)(lds + NSA_OT) + tid + ((dt * 2 + qg) * 4) * 512;
            u32x2 w; w.x = pk2(ot[0], ot[512]); w.y = pk2(ot[1024], ot[1536]);
            *(u32x2*)(ycat + (size_t)mq[qg] * DM + 512 + head * 64 + 16 * dt + 4 * fq) = w; }
}

struct MoeOrder {
    const char* A; const char* W; size_t estride; int K, nct, G, c; int tst[9];
    __device__ bool next(int i, pg8::Unit& u) const {
        const long L = (long)i * G + c; if (L >= (long)tst[8] * nct) return false;
        const int rt = (int)(L / nct), ct = (int)(L % nct); int e = 0;
#pragma unroll
        for (int j = 1; j < 8; ++j) e += (rt >= tst[j]) ? 1 : 0;
        u.pm = rt; u.pn = ct; u.aux = e; return true;
    }
    __device__ __forceinline__ const char* abase(const pg8::Unit& u) const { return A + (size_t)u.pm * ((size_t)256 * K * 2); }
    __device__ __forceinline__ const char* bbase(const pg8::Unit& u) const { return W + (size_t)u.aux * estride + (size_t)u.pn * ((size_t)256 * K * 2); }
};
__device__ __forceinline__ void moe_order_init(MoeOrder& S, const Args& a, int rank, const void* A, const void* W, size_t estride, int K, int nct) {
    S.A = (const char*)A; S.W = (const char*)W; S.estride = estride; S.K = K; S.nct = nct; S.G = gridDim.x; S.c = blockIdx.x;
    const int* t = (const int*)(ws_of(a) + WS_SLOT + SL_TST) + rank * 16;
#pragma unroll
    for (int j = 0; j < 9; ++j) S.tst[j] = __builtin_amdgcn_readfirstlane(t[j]);
}
__device__ __forceinline__ void moe_gather(const Args& a, int rb, int r) {
    unsigned char* ws = ws_of(a); const int tid = opaque_tid();
    const int* toks = (const int*)(ws + WS_SLOT + SL_TOKS);
    const u32x4* hn = (const u32x4*)(ws + WS_HN); u32x4* hns = (u32x4*)(ws + WS_HNS);
    for (int i = tid; i < 64 * 128; i += NTHR) { const int tl = i >> 7, ch = i & 127, m = rb * 64 + tl; const int slot = toks[2 * m + r];
        hns[(size_t)slot * 128 + ch] = hn[(size_t)m * 128 + ch]; }
}
__device__ __forceinline__ void phase_moe_assign(const Args& a, LAS unsigned char* lds) {
    unsigned char* ws = ws_of(a); const int tid = opaque_tid(), lane = tid & 63, wave = __builtin_amdgcn_readfirstlane(tid >> 6);
    LAS int* cn = (LAS int*)lds;
    LAS int* tot = cn + 4096; LAS int* base = tot + 16; LAS int* pre = base + 16;
    const int* bcnt = (const int*)(ws + WS_SLOT + SL_BCNT);
    for (int i = tid; i < 4096; i += NTHR) cn[i] = bcnt[i];
    __syncthreads();
    if (tid < 16) { int s = 0; for (int bb = 0; bb < 256; ++bb) s += cn[bb * 16 + tid]; tot[tid] = s; }
    __syncthreads();
    if (tid < 2) { int run = 0; int* tstg = (int*)(ws + WS_SLOT + SL_TST) + tid * 16;
        for (int e = 0; e < 8; ++e) { base[tid * 8 + e] = run * 256; if (blockIdx.x == 0) tstg[e] = run; run += (tot[tid * 8 + e] + 255) >> 8; }
        if (blockIdx.x == 0) tstg[8] = run; }
    __syncthreads();
    int* stok = (int*)(ws + WS_SLOT + SL_TOK); float* sgate = (float*)(ws + WS_SLOT + SL_GATE);
    if (blockIdx.x == 0) {
        for (int grp = 0; grp < 16; ++grp) { const int r = grp >> 3, lo = base[grp] + tot[grp], hi = base[grp] + (((tot[grp] + 255) >> 8) << 8);
            for (int s = lo + tid; s < hi; s += NTHR) { stok[r * MOE_SLOTS + s] = -1; sgate[r * MOE_SLOTS + s] = 0.f; } }
    }
    const int* te = (const int*)(ws + WS_SLOT + SL_TOKE); const float* tg = (const float*)(ws + WS_SLOT + SL_TOKG); int* toks = (int*)(ws + WS_SLOT + SL_TOKS);
    for (int rb = blockIdx.x; rb < MT / 64; rb += gridDim.x) {
        __syncthreads();
        if (tid < 16) { int s = 0; for (int bb = 0; bb < rb; ++bb) s += cn[bb * 16 + tid]; pre[tid] = s; }
        __syncthreads();
        if (wave == 0) { const int m = rb * 64 + lane;
#pragma unroll
            for (int r = 0; r < 2; ++r) { const int e = te[2 * m + r]; int slot = 0;
#pragma unroll
                for (int ee = 0; ee < 8; ++ee) { const unsigned long long mk = __ballot(e == ee); const int rk = __popcll(mk & ((1ull << lane) - 1ull)); if (e == ee) slot = base[r * 8 + ee] + pre[r * 8 + ee] + rk; }
                stok[r * MOE_SLOTS + slot] = m; sgate[r * MOE_SLOTS + slot] = tg[2 * m + r]; toks[2 * m + r] = slot; } }
        asm volatile("s_waitcnt vmcnt(0)" ::: "memory");
        __syncthreads();
        moe_gather(a, rb, 0);
    }
}
__device__ __forceinline__ void moe_convert_weights(const Args& a, LAS unsigned char* lds) {
    const int tid = opaque_tid(), lane = tid & 63, wave = __builtin_amdgcn_readfirstlane(tid >> 6);
    const int gw = blockIdx.x * NWAVES + wave, NGW = gridDim.x * NWAVES; LAS float* scr = (LAS float*)(lds + 1024 + wave * 16384);
    for (int e = 0; e < NEXP; ++e) {
        conv_matrix(INF(IN_MW1) + (size_t)e * DM * DFF, DM, DFF, (bf16*)(ws_of(a) + WS_MW13) + (size_t)e * 5632 * DM, 1, gw, NGW, scr, lane, INF(IN_GFFN) + DM);
        conv_matrix(INF(IN_MW3) + (size_t)e * DM * DFF, DM, DFF, (bf16*)(ws_of(a) + WS_MW13) + (size_t)e * 5632 * DM, 2, gw, NGW, scr, lane, INF(IN_GFFN) + DM);
        conv_matrix(INF(IN_MW2) + (size_t)e * DFF * DM, DFF, DM, (bf16*)(ws_of(a) + WS_MW2) + (size_t)e * DM * DFF, 0, gw, NGW, scr, lane);
    }
}

template <class Sched>
__device__ __forceinline__ void fill_rs_table(LAS unsigned char* lds, const Sched& S, const float* rss, const int* slot_tok) {
    const int tid = opaque_tid(); LAS float* tab = (LAS float*)(lds + RSTAB_OFF);
    const int rl = tid & 255;
    for (int i = tid >> 8; i < RSTAB_MAX_UNITS; i += 2) { pg8::Unit u; if (!S.next(i, u)) break;
        int row = u.pm * 256 + rl; if (slot_tok) { row = slot_tok[row]; row = row < 0 ? 0 : row; }
        const f32x4* p = (const f32x4*)(rss + (size_t)row * 16); const f32x4 a = p[0], b = p[1], c = p[2], d = p[3];
        const float sm = ((a[0] + a[1]) + (a[2] + a[3])) + ((b[0] + b[1]) + (b[2] + b[3])) + (((c[0] + c[1]) + (c[2] + c[3])) + ((d[0] + d[1]) + (d[2] + d[3])));
        tab[i * 256 + rl] = 1.0f / sqrtf(sm * (1.0f / 1024.0f) + 1e-6f); }
    __syncthreads();
}

constexpr int NPL = 15, NPHASES = 1 + 2 * NPL;
__host__ __device__ constexpr bool phase_empty(int k) { if (k < 1) return false; const int l = (k - 1) / NPL, j = (k - 1) % NPL; if (j == 12) return true; if (l == 0) return j == 6 || (j >= 9 && j <= 11) || j == 14; return false; }

#ifndef PHSEL
#define PHSEL -1
#endif
#ifndef REP_GIN
#define REP_GIN 1
#endif
#ifndef REP_PREP
#define REP_PREP 1
#endif
#ifndef REP_NSA
#define REP_NSA 1
#endif
#ifndef REP_SCAN
#define REP_SCAN 1
#endif
#ifndef REP_GMLP
#define REP_GMLP 1
#endif
#ifndef REP_F1
#define REP_F1 1
#endif
#ifndef REP_PRO
#define REP_PRO 1
#endif
#define IN(k) (lo <= (k) && (k) < hi)
#define INL(j) ((PHSEL == -1 || PHSEL == (j)) && IN(pb + (j)))
#define SEAM(k) do { if ((k) + 1 < hi) xcd_barrier(bar); } while (0)
#define WSP ({ unsigned long long _z = 0; asm volatile("" : "+s"(_z)); wsbase_ + _z; })

template <int L>
__device__ __forceinline__ void run_layer(const Args& a, LAS unsigned char* lds, volatile LAS unsigned* MISC, const XcdBarrier& bar, const int lo, const int hi) {
    constexpr int l = L;
    unsigned char* const wsbase_ = a.ws;
    const int G = gridDim.x, bx = blockIdx.x, tid = opaque_tid();
        const int pb = 1 + l * NPL;
#define ws WSP
#define ctl ((unsigned*)WSP)
#define hbA ((bf16*)(WSP + WS_HN))
#define hbB ((bf16*)(WSP + WS_HB2))
#define rssA ((float*)(WSP + WS_RSS))
#define rssB ((float*)(WSP + WS_RSS) + (size_t)MT * 16)
#define hb_in (l == 0 ? hbA : hbB)
#define rss_in (l == 0 ? rssA : rssB)
        if (INL(0)) for (int rep = 0; rep < REP_GIN; ++rep) { pg8::StaticOrder S; S.init(hb_in, (bf16*)(ws + WS_WIN) + (size_t)l * ZLD * DM, MT, ZLD, DM, G, bx);
            fill_rs_table(lds, S, rss_in, nullptr); pg8::EpiBf16Store E{(bf16*)(ws + WS_Z), ZLD, (const LAS float*)(lds + RSTAB_OFF)}; pg8::gemm_phase(lds, DM, S, E); if (rep == REP_GIN - 1) SEAM(pb + 0); }
        if (INL(1)) { for (int rep = 0; rep < REP_PREP; ++rep) phase_prep(a, l, lds); SEAM(pb + 1); }
        if (INL(2)) {
#ifndef NO_SCAN
            for (int rep = 0; rep < REP_SCAN; ++rep) for (int it = bx; it < 16 * NSEG; it += G) rwkv_scan_seg(a, lds, it & 15, it >> 4);
#endif
#ifndef NO_NSA
            {
                const unsigned xcc = xb_xcc_id() & 7u;
                for (unsigned k = 0; k < 8; ++k) { const unsigned qi = (xcc + k) & 7u; unsigned* qn = ctl + CW_Q + 64 * (4 + l * 8 + qi);
                    for (;;) { __syncthreads(); if (tid == 0) MISC[16] = __hip_atomic_fetch_add(qn, 1u, __ATOMIC_RELAXED, __HIP_MEMORY_SCOPE_AGENT); __syncthreads();
                        const int it = (int)MISC[16]; if (it >= 64 * REP_NSA) break; nsa_item(a, lds, (int)(qi >> 1), (int)(qi & 1), 63 - (it & 63)); } }
            }
#endif
            SEAM(pb + 2); }
        if (INL(3)) {
            for (int bh = bx; bh < 16; bh += G) rwkv_chain(a, lds, bh);
            unsigned* qg = ctl + CW_Q + 64 * (l * 2 + 1);
#ifndef NO_GMLP
            for (;;) { __syncthreads(); if (tid == 0) MISC[16] = __hip_atomic_fetch_add(qg, 1u, __ATOMIC_RELAXED, __HIP_MEMORY_SCOPE_AGENT); __syncthreads();
                int it = (int)MISC[16]; if (it >= 512 * REP_GMLP) break; it &= 511; gmlp_item(a, l, lds, it >> 7, (it >> 2) & 31, it & 3); }
#endif
            SEAM(pb + 3); }
        if (INL(4)) { for (int it = bx; it < 16 * 64; it += G) rwkv_post_item(a, l, lds, it & 15, it >> 4); SEAM(pb + 4); }
        if (INL(5)) { pg8::StaticOrder S; S.init(ws + WS_YCAT, (bf16*)(ws + WS_WOUT) + (size_t)l * DM * DM, MT, DM, DM, G, bx);
            pg8::EpiResAdd E{a.out, DM, hbA, rssA}; pg8::gemm_phase(lds, DM, S, E); SEAM(pb + 5); }
        if (l == 0) {
            if (INL(7)) { pg8::StaticOrder S; S.init(hbA, ws + WS_W13, MT, 2 * DFF, DM, G, bx); fill_rs_table(lds, S, rssA, nullptr); pg8::EpiSwiglu E{(bf16*)(ws + WS_ACT), DFF, (const LAS float*)(lds + RSTAB_OFF)}; pg8::gemm_phase(lds, DM, S, E); SEAM(pb + 7); }
            if (INL(8)) { pg8::StaticOrder S; S.init(ws + WS_ACT, ws + WS_W2, MT, DM, DFF, G, bx); pg8::EpiResAdd E{a.out, DM, hbA, rssA}; pg8::gemm_phase(lds, DFF, S, E); if (pb + 13 < hi) xcd_barrier(bar); }
        } else {
            if (INL(6)) { for (int rep = 0; rep < REP_PRO; ++rep) { moe_convert_weights(a, lds); __syncthreads(); } phase_norm<1>(a, lds, INF(IN_GFFN) + DM); SEAM(pb + 6); }
            if (INL(7)) { phase_moe_assign(a, lds); SEAM(pb + 7); }
            if (INL(8)) { MoeOrder S; moe_order_init(S, a, 0, ws + WS_HNS, ws + WS_MW13, (size_t)5632 * DM * 2, DM, 22);
                fill_rs_table(lds, S, rssA, (const int*)(ws + WS_SLOT + SL_TOK)); pg8::EpiSwiglu E{(bf16*)(ws + WS_ACTM), DFF, (const LAS float*)(lds + RSTAB_OFF)}; pg8::gemm_phase(lds, DM, S, E); SEAM(pb + 8); }
            if (INL(9)) { for (int rb = bx; rb < MT / 64; rb += G) moe_gather(a, rb, 1);
                MoeOrder S; moe_order_init(S, a, 0, ws + WS_ACTM, ws + WS_MW2, (size_t)DM * DFF * 2, DFF, 4);
                pg8::EpiMoe2<false> E{a.out, (const int*)(ws + WS_SLOT + SL_TOK), (const float*)(ws + WS_SLOT + SL_GATE), DM, hbA, rssA}; pg8::gemm_phase(lds, DFF, S, E); SEAM(pb + 9); }
            if (INL(10)) { MoeOrder S; moe_order_init(S, a, 1, ws + WS_HNS, ws + WS_MW13, (size_t)5632 * DM * 2, DM, 22);
                fill_rs_table(lds, S, rssA, (const int*)(ws + WS_SLOT + SL_TOK) + MOE_SLOTS); pg8::EpiSwiglu E{(bf16*)(ws + WS_ACTM), DFF, (const LAS float*)(lds + RSTAB_OFF)}; pg8::gemm_phase(lds, DM, S, E); SEAM(pb + 10); }
            if (INL(11)) { MoeOrder S; moe_order_init(S, a, 1, ws + WS_ACTM, ws + WS_MW2, (size_t)DM * DFF * 2, DFF, 4);
                pg8::EpiMoe2<true> E{a.out, (const int*)(ws + WS_SLOT + SL_TOK) + MOE_SLOTS, (const float*)(ws + WS_SLOT + SL_GATE) + MOE_SLOTS, DM, hbA, rssA}; pg8::gemm_phase(lds, DFF, S, E);
                if (pb + 13 < hi) xcd_barrier(bar); }
        }
        if (INL(13)) {
            { pg8::StaticOrder S; S.init((bf16*)(ws + WS_PB) + (size_t)l * MT * 256, (bf16*)(ws + WS_WP) + (size_t)l * DM * 256, MT, DM, 256, G, bx); pg8::EpiBf16Store E{(bf16*)(ws + WS_PP), DM, nullptr}; pg8::gemm_phase(lds, 256, S, E); }
            { pg8::StaticOrder S; S.init(hbA, (bf16*)(ws + WS_WG) + (size_t)l * DM * DM, MT, DM, DM, G, bx); fill_rs_table(lds, S, rssA, nullptr); pg8::EpiPle E{a.out, ws, (const LAS float*)(lds + RSTAB_OFF), WS_PP, WS_HB2, WS_RSS + (size_t)MT * 16 * 4}; pg8::gemm_phase(lds, DM, S, E); }
            SEAM(pb + 13); }
        if (INL(14)) { if (l == 1) phase_norm<2>(a, lds, INF(IN_GFINAL)); }

}

#undef ws
#undef ctl
#undef hbA
#undef hbB
#undef rssA
#undef rssB
#undef hb_in
#undef rss_in

__global__ void __launch_bounds__(NTHR, 2) hybrid_fwd(Args a) {
    extern __shared__ __attribute__((aligned(16))) unsigned char lds_raw[];
    LAS unsigned char* lds = (LAS unsigned char*)lds_raw;
    volatile LAS unsigned* MISC = (volatile LAS unsigned*)(lds + MISC_OFF);
    const int tid = opaque_tid();
    unsigned char* ws = ws_of(a); unsigned* ctl = (unsigned*)(ws + WS_CTL);
    for (int u = tid; u < (LDS_BYTES - MISC_OFF) / 4; u += NTHR) MISC[u] = 0u;
    __syncthreads();
    if (tid < N_INPUTS) *(LAS unsigned long long*)(lds + PTAB_OFF + 8 * tid) = (unsigned long long)a.in[tid];
    __syncthreads();
    const int lo = a.ph_lo, hi = a.ph_hi;
    const bool multi = (hi - lo) > 1;
    XcdBarrier bar; bar.bar = ctl + CW_BAR; bar.x = 0; bar.st = nullptr;
    if (multi) bar = xcd_barrier_post(ctl + CW_BAR, MISC + 8);
    const int G = gridDim.x, bx = blockIdx.x;

    if ((PHSEL == -1 || PHSEL == 100) && IN(0)) { for (int rep = 0; rep < REP_PRO; ++rep) { phase_prologue(a, lds); __syncthreads(); } SEAM(0); }

    run_layer<0>(a, lds, MISC, bar, lo, hi);
    run_layer<1>(a, lds, MISC, bar, lo, hi);
}

extern "C" void kernel_launch(void* const* d_in, const int* in_sizes, int n_in, void* d_out, int out_size, void* d_ws, size_t ws_size, hipStream_t stream) {
    static int grid = 0;
    if (grid == 0) {
        if (n_in != N_INPUTS || out_size != MT * DM || ws_size < WS_END) { fprintf(stderr, "kernel_launch: unexpected shapes (n_in %d, out %d, ws %zu)\n", n_in, out_size, ws_size); grid = -1; return; }
        int dev = 0, cus = 0, per_cu = 0;
        if (hipGetDevice(&dev) != hipSuccess || hipDeviceGetAttribute(&cus, hipDeviceAttributeMultiprocessorCount, dev) != hipSuccess) { grid = -1; return; }
        if (hipFuncSetAttribute((const void*)hybrid_fwd, hipFuncAttributeMaxDynamicSharedMemorySize, LDS_BYTES) != hipSuccess) { fprintf(stderr, "kernel_launch: hipFuncSetAttribute failed\n"); grid = -1; return; }
        if (hipOccupancyMaxActiveBlocksPerMultiprocessor(&per_cu, (const void*)hybrid_fwd, NTHR, LDS_BYTES) != hipSuccess || per_cu < 1) fprintf(stderr, "kernel_launch: occupancy query reports %d\n", per_cu);
        (void)hipGetLastError();
        grid = cus;
    }
    if (grid < 0) return;
    (void)hipMemsetAsync((char*)d_ws + WS_CTL, 0, CTL_ZERO_BYTES, stream);
    Args a{};
    for (int i = 0; i < N_INPUTS; ++i) a.in[i] = d_in[i];
    a.out = (float*)d_out; a.ws = (unsigned char*)d_ws;
#if MK_ONE_LAUNCH
    a.ph_lo = 0; a.ph_hi = NPHASES;
    hipLaunchKernelGGL(hybrid_fwd, dim3(grid), dim3(NTHR), LDS_BYTES, stream, a);
#else
    for (int k = 0; k < NPHASES; ++k) { if (phase_empty(k)) continue; a.ph_lo = k; a.ph_hi = k + 1;
        hipLaunchKernelGGL(hybrid_fwd, dim3(grid), dim3(NTHR), LDS_BYTES, stream, a); }
#endif
}
```

```cpp
#include <hip/hip_runtime.h>
#include <cstdio>
#include <cstdint>

#ifndef MK_ONE_LAUNCH
#define MK_ONE_LAUNCH 1
#endif

#define LAS __attribute__((address_space(3)))
#define GAS __attribute__((address_space(1)))
typedef unsigned short bf16;
typedef short bf16x8 __attribute__((ext_vector_type(8)));
typedef float f32x4 __attribute__((ext_vector_type(4)));
typedef float f32x2 __attribute__((ext_vector_type(2)));
typedef unsigned u32x4 __attribute__((ext_vector_type(4)));
typedef unsigned u32x2 __attribute__((ext_vector_type(2)));

constexpr int NB = 4, SEQ = 4096, DM = 1024, MT = NB * SEQ;
constexpr int DIN = 2840, ZLD = 3072;
constexpr int DFF = 2816, NEXP = 8;
constexpr int ZC_U = 0, ZC_V = 256, ZC_B = 512, ZC_Q = 1536, ZC_KC = 2048, ZC_VC = 2176, ZC_KS = 2304, ZC_VS = 2432, ZC_KW = 2560, ZC_VW = 2688, ZC_GT = 2816;
constexpr int NCMP = 255;
constexpr int NWAVES = 8, NTHR = 512;

__device__ __forceinline__ unsigned f2bf(float f) { unsigned u = __builtin_bit_cast(unsigned, f); return (u + 0x7fffu + ((u >> 16) & 1u)) >> 16; }
__device__ __forceinline__ float bf2f(unsigned b) { return __builtin_bit_cast(float, b << 16); }
__device__ __forceinline__ unsigned pk2(float lo, float hi) { return f2bf(lo) | (f2bf(hi) << 16); }
__device__ __forceinline__ float bflo(unsigned w) { return __builtin_bit_cast(float, w << 16); }
__device__ __forceinline__ float bfhi(unsigned w) { return __builtin_bit_cast(float, w & 0xffff0000u); }
__device__ __forceinline__ float sigmoidf_(float x) { return 1.0f / (1.0f + __expf(-x)); }
__device__ __forceinline__ float gelu_tanh(float x) { const float u = 0.7978845608028654f * (x + 0.044715f * x * x * x); const float e = __expf(-2.0f * fabsf(u)); float t = (1.0f - e) / (1.0f + e); t = u < 0.f ? -t : t; return 0.5f * x * (1.0f + t); }
__device__ __forceinline__ float wave_sum(float v) {
#pragma unroll
    for (int o = 1; o < 64; o <<= 1) v += __shfl_xor(v, o);
    return v;
}
__device__ __forceinline__ int opaque_tid() { int t = threadIdx.x; asm volatile("" : "+v"(t)); return t; }
#define LDS_WAIT() asm volatile("s_waitcnt lgkmcnt(0)" ::: "memory")
#define VM_WAIT() asm volatile("s_waitcnt vmcnt(0)" ::: "memory")

namespace pg8 {
constexpr int BM = 256, BK = 64, HALF = 128, HTB = HALF * BK * 2  , STAGE_BYTES = 8 * HTB, NXCD = 8, WGM = 8;
__host__ __device__ __forceinline__ int lds_byte(int r, int c) { const int st = (r >> 4) * 2 + (c >> 5), rr = r & 15, cc = c & 31, ob = rr * 64 + cc * 2; return st * 1024 + (ob ^ (((ob >> 9) & 1) << 5)); }
__host__ __device__ __forceinline__ void stage_rc(int b, int& R, int& C) { const int st = b / 1024, sb = b % 1024, swz = sb ^ (((sb >> 9) & 1) << 5); R = (st >> 1) * 16 + swz / 64; C = (st & 1) * 32 + (swz % 64) / 2; }
__host__ __device__ __forceinline__ int perm32(int rho) { const int n = rho >> 4, i = rho & 15; return 8 * (i >> 2) + 4 * n + (i & 3); }

struct Unit { int pm, pn, aux; };

struct StaticOrder {
    const char* A; const char* Bt; int K; int nM, nN, nwg, G, c;
    __device__ void init(const void* A_, const void* Bt_, int M, int N, int K_, int G_, int c_) { A = (const char*)A_; Bt = (const char*)Bt_; K = K_; nM = M / BM; nN = N / BM; nwg = nM * nN; G = G_; c = c_; }
    __device__ bool next(int i, Unit& u) const {
        const long L = (long)i * G + c; if (L >= nwg) return false;
        int wgid = (int)L; { const int q = nwg / NXCD, r = nwg % NXCD, xcd = wgid % NXCD, off = wgid / NXCD; wgid = (xcd < r ? xcd * (q + 1) : r * (q + 1) + (xcd - r) * q) + off; }
        const int nig = WGM * nN, gid = wgid / nig, fm = gid * WGM, gsz = (nM - fm) < WGM ? (nM - fm) : WGM;
        u.pm = fm + ((wgid % nig) % gsz); u.pn = (wgid % nig) / gsz; u.aux = 0; return true;
    }
    __device__ __forceinline__ const char* abase(const Unit& u) const { return A + (size_t)u.pm * ((size_t)BM * K * 2); }
    __device__ __forceinline__ const char* bbase(const Unit& u) const { return Bt + (size_t)u.pn * ((size_t)BM * K * 2); }
};

__device__ __forceinline__ unsigned cvt_pk_bf16(float lo, float hi) { unsigned r; asm volatile("v_cvt_pk_bf16_f32 %0, %1, %2" : "=v"(r) : "v"(lo), "v"(hi)); return r; }

__device__ __forceinline__ float row_rs(const float* rss, int row, int fq) {
    const f32x4 p = *(const f32x4*)(rss + (size_t)row * 16 + 4 * fq); float s = (p[0] + p[1]) + (p[2] + p[3]);
    s += __shfl_xor(s, 16); s += __shfl_xor(s, 32); return 1.0f / sqrtf(s * (1.0f / 1024.0f) + 1e-6f);
}
__device__ __forceinline__ void put_hb_rss(const f32x4 (&v)[2][2], bf16* hb_row  , float* rss_row  , int fq) {
    float q = 0.f;
#pragma unroll
    for (int bj = 0; bj < 2; ++bj) { const f32x4 x = v[bj][0], y = v[bj][1];
        q += ((x[0] * x[0] + x[1] * x[1]) + (x[2] * x[2] + x[3] * x[3])) + ((y[0] * y[0] + y[1] * y[1]) + (y[2] * y[2] + y[3] * y[3]));
        u32x4 w; w.x = cvt_pk_bf16(x[0], x[1]); w.y = cvt_pk_bf16(x[2], x[3]); w.z = cvt_pk_bf16(y[0], y[1]); w.w = cvt_pk_bf16(y[2], y[3]); *(u32x4*)(hb_row + bj * HALF) = w; }
    q += __shfl_xor(q, 16); q += __shfl_xor(q, 32);
    if (fq == 0) *rss_row = q;
}
__device__ __forceinline__ void put_hb_rss4(const f32x4 (&v)[2][2], bf16* hb_row  , float* rss_row  , int fq) {
    float q = 0.f;
#pragma unroll
    for (int bj = 0; bj < 2; ++bj)
#pragma unroll
        for (int n = 0; n < 2; ++n) { const f32x4 x = v[bj][n]; q += (x[0] * x[0] + x[1] * x[1]) + (x[2] * x[2] + x[3] * x[3]);
            u32x2 w; w.x = cvt_pk_bf16(x[0], x[1]); w.y = cvt_pk_bf16(x[2], x[3]); *(u32x2*)(hb_row + bj * HALF + n * 16) = w; }
    q += __shfl_xor(q, 16); q += __shfl_xor(q, 32);
    if (fq == 0) *rss_row = q;
}
struct EpiBf16Store {
    static constexpr bool PERM = true;
    bf16* O; int ldc; const LAS float* rstab;
    __device__ __forceinline__ void operator()(const f32x4 (&acc)[2][2][4][2], const Unit& u, int ui, int wr, int wc, int fr, int fq) const {
        const int row0 = u.pm * BM + wr * 64 + fr, col0 = u.pn * BM + wc * 32 + 8 * fq;
        float rsv[2][4];
#pragma unroll
        for (int ai = 0; ai < 2; ++ai)
#pragma unroll
            for (int m = 0; m < 4; ++m) rsv[ai][m] = rstab ? rstab[ui * 256 + ai * HALF + wr * 64 + m * 16 + fr] : 1.0f;
#pragma unroll
        for (int ai = 0; ai < 2; ++ai)
#pragma unroll
            for (int m = 0; m < 4; ++m) { const int row = row0 + ai * HALF + m * 16; bf16* rowp = O + (size_t)row * ldc + col0; const float rs = rsv[ai][m];
#pragma unroll
                for (int bj = 0; bj < 2; ++bj) { const f32x4 v0 = acc[ai][bj][m][0] * rs, v1 = acc[ai][bj][m][1] * rs;
                    u32x4 w; w.x = cvt_pk_bf16(v0[0], v0[1]); w.y = cvt_pk_bf16(v0[2], v0[3]); w.z = cvt_pk_bf16(v1[0], v1[1]); w.w = cvt_pk_bf16(v1[2], v1[3]);
                    *(u32x4*)(rowp + bj * HALF) = w; } }
    }
};
struct EpiResAdd {
    static constexpr bool PERM = true;
    float* H; int ldc; bf16* hb; float* rss_out;
    __device__ __forceinline__ void operator()(const f32x4 (&acc)[2][2][4][2], const Unit& u, int ui, int wr, int wc, int fr, int fq) const {
        const int row0 = u.pm * BM + wr * 64 + fr, col0 = u.pn * BM + wc * 32 + 8 * fq;
#pragma unroll
        for (int ai = 0; ai < 2; ++ai)
#pragma unroll
            for (int m = 0; m < 4; ++m) { const int row = row0 + ai * HALF + m * 16; float* rowp = H + (size_t)row * ldc + col0; f32x4 v[2][2];
#pragma unroll
                for (int bj = 0; bj < 2; ++bj)
#pragma unroll
                    for (int n = 0; n < 2; ++n) { f32x4* p = (f32x4*)(rowp + bj * HALF + n * 4); v[bj][n] = *p + acc[ai][bj][m][n]; *p = v[bj][n]; }
                put_hb_rss(v, hb + (size_t)row * ldc + col0, rss_out + (size_t)row * 16 + u.pn * 4 + wc, fq); }
    }
};
struct EpiSwiglu {
    static constexpr bool PERM = true;
    bf16* O; int ldc; const LAS float* rstab;
    __device__ __forceinline__ void operator()(const f32x4 (&acc)[2][2][4][2], const Unit& u, int ui, int wr, int wc, int fr, int fq) const {
        const int row0 = u.pm * BM + wr * 64 + fr, col0 = u.pn * HALF + wc * 32 + 8 * fq;
#pragma unroll
        for (int ai = 0; ai < 2; ++ai)
#pragma unroll
            for (int m = 0; m < 4; ++m) { const int row = row0 + ai * HALF + m * 16; bf16* rowp = O + (size_t)row * ldc + col0;
                const float rs = rstab[ui * 256 + ai * HALF + wr * 64 + m * 16 + fr];
                float o[8];
#pragma unroll
                for (int n = 0; n < 2; ++n)
#pragma unroll
                    for (int i = 0; i < 4; ++i) { const float a = acc[ai][0][m][n][i] * rs, b = acc[ai][1][m][n][i] * rs; o[n * 4 + i] = a * b / (1.0f + __expf(-a)); }
                u32x4 w; w.x = cvt_pk_bf16(o[0], o[1]); w.y = cvt_pk_bf16(o[2], o[3]); w.z = cvt_pk_bf16(o[4], o[5]); w.w = cvt_pk_bf16(o[6], o[7]);
                *(u32x4*)rowp = w; __builtin_amdgcn_sched_barrier(0); }
    }
};
struct EpiPle {
    static constexpr bool PERM = false;
    float* H; unsigned char* ws; const LAS float* rstab; size_t off_pp, off_hb, off_rss;
    __device__ __forceinline__ void operator()(const f32x4 (&acc)[2][2][4][2], const Unit& u, int ui, int wr, int wc, int fr, int fq) const {
        const int row0 = u.pm * BM + wr * 64 + fr, col0 = u.pn * BM + wc * 32 + 4 * fq;
        const bf16* PP = (const bf16*)(ws + off_pp); bf16* hb = (bf16*)(ws + off_hb); float* rss_out = (float*)(ws + off_rss);
#pragma unroll
        for (int ai = 0; ai < 2; ++ai)
#pragma unroll
            for (int m = 0; m < 4; ++m) { const int row = row0 + ai * HALF + m * 16; const size_t off = (size_t)row * 1024 + col0; const float rs = rstab[ui * 256 + ai * HALF + wr * 64 + m * 16 + fr]; f32x4 v[2][2];
#pragma unroll
                for (int bj = 0; bj < 2; ++bj)
#pragma unroll
                    for (int n = 0; n < 2; ++n) { const size_t o2 = off + bj * HALF + n * 16; const u32x2 pw = *(const u32x2*)(PP + o2); const f32x4 a = acc[ai][bj][m][n] * rs;
                        f32x4 g; g[0] = bflo(pw.x) * sigmoidf_(a[0]); g[1] = bfhi(pw.x) * sigmoidf_(a[1]); g[2] = bflo(pw.y) * sigmoidf_(a[2]); g[3] = bfhi(pw.y) * sigmoidf_(a[3]);
                        f32x4* p = (f32x4*)(H + o2); v[bj][n] = *p + g; *p = v[bj][n]; }
                put_hb_rss4(v, hb + off, rss_out + (size_t)row * 16 + u.pn * 4 + wc, fq);
                if (m & 1) __builtin_amdgcn_sched_barrier(0); }
    }
};
template <bool FINAL> struct EpiMoe2 {
    static constexpr bool PERM = true;
    float* H; const int* slot_tok; const float* slot_gate; int ldc; bf16* hb; float* rss_out;
    __device__ __forceinline__ void operator()(const f32x4 (&acc)[2][2][4][2], const Unit& u, int ui, int wr, int wc, int fr, int fq) const {
        const int row0 = u.pm * BM + wr * 64 + fr, col0 = u.pn * BM + wc * 32 + 8 * fq;
        int tokv[2][4]; float gtv[2][4];
#pragma unroll
        for (int ai = 0; ai < 2; ++ai)
#pragma unroll
            for (int m = 0; m < 4; ++m) { const int slot = row0 + ai * HALF + m * 16; tokv[ai][m] = slot_tok[slot]; gtv[ai][m] = slot_gate[slot]; }
#pragma unroll
        for (int ai = 0; ai < 2; ++ai)
#pragma unroll
            for (int m = 0; m < 4; ++m) { const int tok = tokv[ai][m]; const float gt = gtv[ai][m];
                const int tk = tok < 0 ? 0 : tok; float* rowp = H + (size_t)tk * ldc + col0; f32x4 v[2][2];
#pragma unroll
                for (int bj = 0; bj < 2; ++bj)
#pragma unroll
                    for (int n = 0; n < 2; ++n) { f32x4* p = (f32x4*)(rowp + bj * HALF + n * 4); v[bj][n] = *p + acc[ai][bj][m][n] * gt; if (tok >= 0) *p = v[bj][n]; }
                if (FINAL) { float q = 0.f;
#pragma unroll
                    for (int bj = 0; bj < 2; ++bj) { const f32x4 x = v[bj][0], y = v[bj][1];
                        q += ((x[0] * x[0] + x[1] * x[1]) + (x[2] * x[2] + x[3] * x[3])) + ((y[0] * y[0] + y[1] * y[1]) + (y[2] * y[2] + y[3] * y[3]));
                        u32x4 w; w.x = cvt_pk_bf16(x[0], x[1]); w.y = cvt_pk_bf16(x[2], x[3]); w.z = cvt_pk_bf16(y[0], y[1]); w.w = cvt_pk_bf16(y[2], y[3]);
                        if (tok >= 0) *(u32x4*)(hb + (size_t)tk * ldc + col0 + bj * HALF) = w; }
                    q += __shfl_xor(q, 16); q += __shfl_xor(q, 32);
                    if (fq == 0 && tok >= 0) rss_out[(size_t)tk * 16 + u.pn * 4 + wc] = q; }
                if (m & 1) __builtin_amdgcn_sched_barrier(0); }
    }
};

template <class Epi, class Sched, bool ALIGN_EPI = true, bool SP2 = true>
__device__ __forceinline__ void gemm_phase(LAS unsigned char* lds, const int K, const Sched& S, const Epi& E) {
    int tid = threadIdx.x; asm volatile("" : "+v"(tid));
    const int wid = __builtin_amdgcn_readfirstlane(tid >> 6), lane = tid & 63, wr = wid >> 2, wc = wid & 3, fr = lane & 15, fq = lane >> 4;
    const int nt = K / BK;
    unsigned voffA[2], voffB[2];
#pragma unroll
    for (int i = 0; i < 2; ++i) { int R, C; stage_rc(tid * 16 + i * 8192, R, C); const int Rb = Epi::PERM ? ((R & ~31) + perm32(R & 31)) : R;
        voffA[i] = (unsigned)(R * K + C) * 2u; voffB[i] = (unsigned)(Rb * K + C) * 2u; }
    const size_t kstep = (size_t)(BK * 2);
    const size_t hstep = (size_t)HALF * K * 2;
    const unsigned ldsw = (unsigned)wid * 1024u;
    const int aoff = lds_byte(wr * 64 + fr, fq * 8), boff = lds_byte(wc * 32 + fr, fq * 8);
#define PG8_SA(b, h) (((b) * 2 + (h)) * HTB)
#define PG8_SB(b, h) ((4 + (b) * 2 + (h)) * HTB)
#define PG8_STAGE(bufoff, gbase, voff) do { _Pragma("unroll") for (int _i = 0; _i < 2; ++_i) \
        __builtin_amdgcn_global_load_lds((const unsigned*)((const char*)(gbase) + (voff)[_i]), (LAS unsigned*)(lds + (bufoff) + ldsw + _i * 8192), 16, 0, 0); } while (0)
#define PG8_LDA(dst, b, h) do { _Pragma("unroll") for (int m = 0; m < 4; ++m) _Pragma("unroll") for (int k = 0; k < 2; ++k) dst[m][k] = *(const LAS bf16x8*)(lds + PG8_SA(b, h) + aoff + m * 2048 + k * 1024); } while (0)
#define PG8_LDB(dst, b, h) do { _Pragma("unroll") for (int n = 0; n < 2; ++n) _Pragma("unroll") for (int k = 0; k < 2; ++k) dst[n][k] = *(const LAS bf16x8*)(lds + PG8_SB(b, h) + boff + n * 2048 + k * 1024); } while (0)
#define PG8_MMA(ai, bj, At, Bt) do { __builtin_amdgcn_s_setprio(1); _Pragma("unroll") for (int m = 0; m < 4; ++m) _Pragma("unroll") for (int n = 0; n < 2; ++n) _Pragma("unroll") for (int k = 0; k < 2; ++k) \
        acc[ai][bj][m][n] = __builtin_amdgcn_mfma_f32_16x16x32_bf16(Bt[n][k], At[m][k], acc[ai][bj][m][n], 0, 0, 0); __builtin_amdgcn_s_setprio(0); } while (0)
#define PG8_WAIT_V(n) asm volatile("s_waitcnt vmcnt(" #n ")" ::: "memory")
#define PG8_WAIT_L(n) asm volatile("s_waitcnt lgkmcnt(" #n ")" ::: "memory")
#define PG8_BAR __builtin_amdgcn_s_barrier()
#define PG8_SCHED __builtin_amdgcn_sched_barrier(0)
    Unit cur, nxt; int ui = 0;
    if (!S.next(0, cur)) return;
    f32x4 acc[2][2][4][2];
#pragma unroll
    for (int a = 0; a < 2; ++a)
#pragma unroll
        for (int b = 0; b < 2; ++b)
#pragma unroll
            for (int m = 0; m < 4; ++m)
#pragma unroll
                for (int n = 0; n < 2; ++n) acc[a][b][m][n] = (f32x4){0.f, 0.f, 0.f, 0.f};
    bf16x8 At[4][2], B0[2][2], B1[2][2];
    const char* cA = S.abase(cur); const char* cB = S.bbase(cur);
    if constexpr (SP2) {
        PG8_STAGE(PG8_SB(0, 0), cB, voffB); PG8_STAGE(PG8_SB(0, 1), cB + hstep, voffB); PG8_STAGE(PG8_SA(0, 0), cA, voffA); PG8_STAGE(PG8_SA(0, 1), cA + hstep, voffA);
        if (wr == 1) PG8_BAR;
        PG8_WAIT_V(2); PG8_BAR;
        PG8_STAGE(PG8_SB(1, 0), cB + kstep, voffB); PG8_STAGE(PG8_SA(1, 0), cA + kstep, voffA); PG8_STAGE(PG8_SB(1, 1), cB + hstep + kstep, voffB);
        PG8_WAIT_V(6); PG8_BAR;
    } else {
        PG8_STAGE(PG8_SB(0, 0), cB, voffB); PG8_STAGE(PG8_SA(0, 0), cA, voffA); PG8_STAGE(PG8_SB(0, 1), cB + hstep, voffB); PG8_STAGE(PG8_SA(0, 1), cA + hstep, voffA);
        if (wr == 1) PG8_BAR;
        PG8_WAIT_V(4); PG8_BAR;
        PG8_STAGE(PG8_SB(1, 0), cB + kstep, voffB); PG8_STAGE(PG8_SA(1, 0), cA + kstep, voffA); PG8_STAGE(PG8_SB(1, 1), cB + hstep + kstep, voffB);
        PG8_WAIT_V(6); PG8_BAR;
    }
    for (;;) {
        const bool has_next = S.next(ui + 1, nxt);
        const char* nA = has_next ? S.abase(nxt) : cA; const char* nB = has_next ? S.bbase(nxt) : cB;
        for (int t = 0; t < nt; t += 2) {
            const bool last = (t == nt - 2);
            const char* a1 = cA + (size_t)(t + 1) * kstep;
            const char* a2 = last ? nA : cA + (size_t)(t + 2) * kstep; const char* b2 = last ? nB : cB + (size_t)(t + 2) * kstep;
            const char* a3 = a2 + kstep; const char* b3 = b2 + kstep;
            if constexpr (SP2) {
            PG8_LDB(B0, 0, 0); PG8_LDB(B1, 0, 1); PG8_SCHED; PG8_LDA(At, 0, 0); PG8_STAGE(PG8_SA(1, 1), a1 + hstep, voffA);
            PG8_WAIT_V(8); PG8_WAIT_L(0); PG8_BAR; PG8_MMA(0, 0, At, B0); PG8_MMA(0, 1, At, B1); PG8_BAR; PG8_SCHED;
            PG8_LDA(At, 0, 1); PG8_STAGE(PG8_SB(0, 0), b2, voffB); PG8_STAGE(PG8_SB(0, 1), b2 + hstep, voffB); PG8_STAGE(PG8_SA(0, 0), a2, voffA);
            PG8_WAIT_V(8); PG8_WAIT_L(0); PG8_BAR; PG8_MMA(1, 0, At, B0); PG8_MMA(1, 1, At, B1); PG8_BAR; PG8_SCHED;
            PG8_LDB(B0, 1, 0); PG8_LDB(B1, 1, 1); PG8_SCHED; PG8_LDA(At, 1, 0); PG8_STAGE(PG8_SA(0, 1), a2 + hstep, voffA);
            PG8_WAIT_V(8); PG8_WAIT_L(0); PG8_BAR; PG8_MMA(0, 0, At, B0); PG8_MMA(0, 1, At, B1); PG8_BAR; PG8_SCHED;
            PG8_LDA(At, 1, 1); PG8_STAGE(PG8_SB(1, 0), b3, voffB); PG8_STAGE(PG8_SB(1, 1), b3 + hstep, voffB); PG8_STAGE(PG8_SA(1, 0), a3, voffA);
            PG8_WAIT_V(8); PG8_WAIT_L(0); PG8_BAR; PG8_MMA(1, 0, At, B0); PG8_MMA(1, 1, At, B1); PG8_BAR; PG8_SCHED;
            } else {
            PG8_LDB(B0, 0, 0); PG8_SCHED; PG8_LDA(At, 0, 0); PG8_STAGE(PG8_SA(1, 1), a1 + hstep, voffA);
            PG8_WAIT_L(8); PG8_BAR; PG8_WAIT_L(0); PG8_MMA(0, 0, At, B0); PG8_BAR; PG8_SCHED;
            PG8_LDB(B1, 0, 1); PG8_STAGE(PG8_SB(0, 0), b2, voffB);
            PG8_BAR; PG8_WAIT_L(0); PG8_MMA(0, 1, At, B1); PG8_BAR;
            PG8_LDA(At, 0, 1); PG8_STAGE(PG8_SA(0, 0), a2, voffA);
            PG8_BAR; PG8_WAIT_L(0); PG8_MMA(1, 0, At, B0); PG8_BAR; PG8_SCHED;
            PG8_STAGE(PG8_SB(0, 1), b2 + hstep, voffB);
            PG8_WAIT_V(6); PG8_BAR; PG8_MMA(1, 1, At, B1); PG8_BAR;
            PG8_LDB(B0, 1, 0); PG8_SCHED; PG8_LDA(At, 1, 0); PG8_STAGE(PG8_SA(0, 1), a2 + hstep, voffA);
            PG8_WAIT_L(8); PG8_BAR; PG8_WAIT_L(0); PG8_MMA(0, 0, At, B0); PG8_BAR; PG8_SCHED;
            PG8_LDB(B1, 1, 1); PG8_STAGE(PG8_SB(1, 0), b3, voffB);
            PG8_BAR; PG8_WAIT_L(0); PG8_MMA(0, 1, At, B1); PG8_BAR;
            PG8_LDA(At, 1, 1); PG8_STAGE(PG8_SA(1, 0), a3, voffA);
            PG8_BAR; PG8_WAIT_L(0); PG8_MMA(1, 0, At, B0); PG8_BAR; PG8_SCHED;
            PG8_STAGE(PG8_SB(1, 1), b3 + hstep, voffB);
            PG8_WAIT_V(6); PG8_BAR; PG8_MMA(1, 1, At, B1); PG8_BAR;
            }
        }
        if constexpr (ALIGN_EPI) { if (wr == 0) PG8_BAR; }
        E(acc, cur, ui, wr, wc, fr, fq);
        if (!has_next) break;
#pragma unroll
        for (int a = 0; a < 2; ++a)
#pragma unroll
            for (int b = 0; b < 2; ++b)
#pragma unroll
                for (int m = 0; m < 4; ++m)
#pragma unroll
                    for (int n = 0; n < 2; ++n) acc[a][b][m][n] = (f32x4){0.f, 0.f, 0.f, 0.f};
        cur = nxt; cA = nA; cB = nB; ++ui;
        if constexpr (ALIGN_EPI) { if (wr == 1) PG8_BAR; }
    }
    PG8_WAIT_V(0);
    if constexpr (!ALIGN_EPI) { if (wr == 0) PG8_BAR; }
    PG8_BAR;
#undef PG8_SA
#undef PG8_SB
#undef PG8_STAGE
#undef PG8_LDA
#undef PG8_LDB
#undef PG8_MMA
#undef PG8_WAIT_V
#undef PG8_WAIT_L
#undef PG8_BAR
#undef PG8_SCHED
}
}

constexpr size_t MiB = 1u << 20;
constexpr size_t WS_CTL = 0, CTL_ZERO_BYTES = 65536;
constexpr size_t WS_WIN = 1 * MiB;
constexpr size_t WS_WOUT = 13 * MiB;
constexpr size_t WS_W13 = 17 * MiB;
constexpr size_t WS_W2 = 28 * MiB;
constexpr size_t WS_WG = 34 * MiB;
constexpr size_t WS_WP = 38 * MiB;
constexpr size_t WS_CW1 = 39 * MiB;
constexpr size_t WS_LORA = 41 * MiB;
constexpr size_t WS_ROPE = 41 * MiB + 512 * 1024;
constexpr size_t WS_CBIAS = 42 * MiB + 512 * 1024;
constexpr size_t WS_PB = 43 * MiB;
constexpr size_t WS_HN = 60 * MiB;
constexpr size_t WS_Z = 92 * MiB;
constexpr size_t WS_YCAT = 188 * MiB;
constexpr size_t WS_QROT = 220 * MiB;
constexpr size_t WS_KSR = 236 * MiB, WS_KWR = 240 * MiB, WS_VST = 244 * MiB, WS_VWT = 248 * MiB;
constexpr size_t WS_KCMP = 252 * MiB, WS_VCMPT = 252 * MiB + 512 * 1024;
constexpr size_t WS_REC = 253 * MiB;
constexpr size_t WS_G = 349 * MiB;
constexpr size_t WS_YRAW = 365 * MiB;
constexpr size_t WS_BONUS = 381 * MiB;
constexpr size_t WS_ACT = 92 * MiB;
constexpr size_t WS_HNS = 92 * MiB;
constexpr size_t WS_ACTM = 128 * MiB;
constexpr size_t WS_MW13 = 227 * MiB;
constexpr size_t WS_MW2 = 315 * MiB;
constexpr size_t WS_SLOT = 359 * MiB;
constexpr size_t WS_PP = 92 * MiB;
constexpr size_t WS_YP = 382 * MiB;
constexpr size_t WS_SEGE = 398 * MiB;
constexpr size_t WS_SST = 406 * MiB;
constexpr size_t WS_END = 412 * MiB;
constexpr size_t WS_HB2 = 188 * MiB;
constexpr size_t WS_RSS = 410 * MiB;
constexpr int NSEG = 16, SEGLEN = SEQ / NSEG;
constexpr int MOE_SLOTS = 18432;
constexpr size_t SL_TOK = 0;
constexpr size_t SL_GATE = SL_TOK + 2 * MOE_SLOTS * 4;
constexpr size_t SL_TOKE = SL_GATE + 2 * MOE_SLOTS * 4;
constexpr size_t SL_TOKG = SL_TOKE + (size_t)MT * 2 * 4;
constexpr size_t SL_TOKS = SL_TOKG + (size_t)MT * 2 * 4;
constexpr size_t SL_BCNT = SL_TOKS + (size_t)MT * 2 * 4;
constexpr size_t SL_TST = SL_BCNT + 256 * 16 * 4;
static_assert(SL_TST + 128 <= 1 * MiB, "slot tables");
constexpr int CW_BAR = 4096;
constexpr int CW_Q = 8192;

constexpr int RING_BYTES = 131072;
constexpr int MISC_OFF = 161792;
constexpr int RSTAB_OFF = RING_BYTES;
constexpr int RSTAB_MAX_UNITS = 30;
constexpr int LDS_BYTES = 163840;

#define XB_TMO      128
#define XB_XCNT(j)  (256  + 64 * (j))
#define XB_XSUB(j)  (1280 + 64 * (j))
#define XB_XGEN(j)  (2304 + 64 * (j))
#define XB_TOP      3328
#define XB_TOPGEN   3392
#define XCD_BAR_WORDS 3456
#define XB_SPIN_CAP (1u << 18)
__device__ __forceinline__ unsigned xb_ld(unsigned* p)              { return __hip_atomic_load(p, __ATOMIC_RELAXED, __HIP_MEMORY_SCOPE_AGENT); }
__device__ __forceinline__ unsigned xb_add(unsigned* p, unsigned v) { return __hip_atomic_fetch_add(p, v, __ATOMIC_RELAXED, __HIP_MEMORY_SCOPE_AGENT); }
__device__ __forceinline__ unsigned xb_xcc_id() { return (unsigned)__builtin_amdgcn_s_getreg((3 << 11) | 20) & 0xFu; }
#define XB_SPIN(cond, bar) do { unsigned _sp = 0; while (cond) { __builtin_amdgcn_s_sleep(1); \
    if ((++_sp & 255u) == 0u) { if (xb_ld(&(bar)[XB_TMO])) break; if (_sp > XB_SPIN_CAP) { atomicAdd(&(bar)[XB_TMO], 1u); break; } } } } while (0)
struct XcdBarrier { unsigned* bar; unsigned x; volatile LAS unsigned* st; };
__device__ __forceinline__ XcdBarrier xcd_barrier_post(unsigned* bar, volatile LAS unsigned* st) {
    XcdBarrier b; b.bar = bar; b.x = xb_xcc_id(); b.st = st;
    if (threadIdx.x == 0) (void)xb_add(&bar[XB_XCNT(b.x)], 1u);
    return b;
}
__device__ __noinline__ unsigned long long xcd_barrier_complete(unsigned* bar, unsigned x) {
    const unsigned G = gridDim.x * gridDim.y * gridDim.z;
    unsigned sum, cnt, mine, sp = 0u;
    for (;;) {
        sum = 0u; cnt = 0u; mine = 0u;
        for (unsigned j = 0; j < 16; ++j) { const unsigned c = xb_ld(&bar[XB_XCNT(j)]); sum += c; cnt += (c > 0u) ? 1u : 0u; mine = (j == x) ? c : mine; }
        if (sum == G) break;
        __builtin_amdgcn_s_sleep(1);
        if ((++sp & 255u) == 0u) { if (xb_ld(&bar[XB_TMO])) break; if (sp > XB_SPIN_CAP) { atomicAdd(&bar[XB_TMO], 1u); break; } }
    }
    const unsigned nloc = mine > 0u ? mine : 1u, nx = cnt > 0u ? cnt : 1u;
    return (unsigned long long)nloc | ((unsigned long long)nx << 32);
}
__device__ __forceinline__ void xcd_barrier(const XcdBarrier& b) {
    asm volatile("s_waitcnt vmcnt(0)" ::: "memory");
    __syncthreads();
    if (threadIdx.x == 0) {
        unsigned* bar = b.bar;
        __builtin_amdgcn_s_waitcnt(0);
        unsigned nloc = b.st[0], nx = b.st[1];
        if (nloc == 0u) { const unsigned long long r = xcd_barrier_complete(bar, b.x); nloc = (unsigned)r; nx = (unsigned)(r >> 32); b.st[0] = nloc; b.st[1] = nx; }
        const unsigned old = xb_add(&bar[XB_XSUB(b.x)], 1u);
        const unsigned gen = old / nloc;
        if (old + 1u == (gen + 1u) * nloc) {
            __builtin_amdgcn_fence(__ATOMIC_RELEASE, "agent");
            asm volatile("s_waitcnt vmcnt(0)" ::: "memory");
            const unsigned og = xb_add(&bar[XB_TOP], 1u);
            const unsigned tg = og / nx;
            if (og + 1u == (tg + 1u) * nx) xb_add(&bar[XB_TOPGEN], 1u);
            else XB_SPIN(xb_ld(&bar[XB_TOPGEN]) == tg, bar);
            __builtin_amdgcn_fence(__ATOMIC_ACQUIRE, "agent");
            xb_add(&bar[XB_XGEN(b.x)], 1u);
            asm volatile("s_waitcnt vmcnt(0)" ::: "memory");
        } else {
            XB_SPIN(xb_ld(&bar[XB_XGEN(b.x)]) == gen, bar);
            __builtin_amdgcn_fence(__ATOMIC_ACQUIRE, "agent");
            asm volatile("s_waitcnt vmcnt(0)" ::: "memory");
        }
    }
    __syncthreads();
}

enum { IN_X = 0, IN_P, IN_POS, IN_GMIX, IN_WIN, IN_WOUT, IN_GMLNG, IN_GMLNB, IN_GMWS, IN_GMBS, IN_RWMU, IN_RWW0, IN_RWWUP, IN_RWA0, IN_RWAUP, IN_RWGUP,
       IN_RWKK, IN_RWKA, IN_RWRK, IN_RWGNG, IN_RWGNB, IN_CMPPOS, IN_KCW1, IN_KCW2, IN_VCW1, IN_VCW2, IN_GFFN, IN_FW1, IN_FW3, IN_FW2, IN_RTW, IN_RTB,
       IN_MW1, IN_MW3, IN_MW2, IN_GPLE, IN_PLEG, IN_PLEP, IN_GFINAL, N_INPUTS };
struct Args { const void* in[N_INPUTS]; float* out; unsigned char* ws; int ph_lo, ph_hi; };
constexpr int PTAB_OFF = 161792 + 256;
__device__ __forceinline__ const void* ldptr(int k) {
    extern __shared__ __attribute__((aligned(16))) unsigned char lds_raw[];
    const LAS unsigned* t = (const LAS unsigned*)((LAS unsigned char*)lds_raw + PTAB_OFF) + 2 * k;
    const unsigned lo = __builtin_amdgcn_readfirstlane(t[0]), hi = __builtin_amdgcn_readfirstlane(t[1]);
    return (const void*)(const GAS char*)(((unsigned long long)hi << 32) | lo);
}
#define INF(k) ((const float*)ldptr(k))
__device__ __forceinline__ unsigned char* ws_of(const Args& a) { unsigned long long z = 0; asm volatile("" : "+s"(z)); return a.ws + z; }

__device__ __forceinline__ void conv_matrix(const float* W, int K, int N, bf16* dst, int mode, int gw, int NGW, LAS float* scr, int lane, const float* gk = nullptr) {
    (void)scr;
    const int nblk = (N + 63) / 64, nit = (K / 64) * nblk;
    for (int it = gw; it < nit; it += NGW) {
        const int kb = it / nblk, nb = it % nblk, n = nb * 64 + lane, k0 = kb * 64; const bool ok = n < N;
        const int drow = mode == 0 ? n : ((n >> 7) * 256 + (n & 127) + (mode == 2 ? 128 : 0));
        const float* src = W + (size_t)k0 * N + (ok ? n : 0);
        float v[64];
#pragma unroll
        for (int k = 0; k < 64; ++k) v[k] = src[(size_t)k * N];
        if (gk) {
#pragma unroll
            for (int k = 0; k < 64; ++k) v[k] *= gk[k0 + k]; }
        if (ok) { u32x4* d = (u32x4*)(dst + (size_t)drow * K + k0);
#pragma unroll
            for (int c = 0; c < 8; ++c) { u32x4 o; o.x = pk2(v[8 * c], v[8 * c + 1]); o.y = pk2(v[8 * c + 2], v[8 * c + 3]); o.z = pk2(v[8 * c + 4], v[8 * c + 5]); o.w = pk2(v[8 * c + 6], v[8 * c + 7]); d[c] = o; } }
    }
}
__device__ __forceinline__ void init_row(const float* xrow, bf16* orow, float* cp, float* rss_row, int lane) {
    const f32x4* xr = (const f32x4*)xrow + lane; f32x4 v[4]; float s = 0.f;
#pragma unroll
    for (int j = 0; j < 4; ++j) { v[j] = xr[64 * j]; s += (v[j].x * v[j].x + v[j].y * v[j].y) + (v[j].z * v[j].z + v[j].w * v[j].w); }
    s = wave_sum(s);
#pragma unroll
    for (int j = 0; j < 4; ++j) ((f32x4*)cp + lane)[64 * j] = v[j];
    u32x2* o8 = (u32x2*)orow + lane;
#pragma unroll
    for (int j = 0; j < 4; ++j) { u32x2 w; w.x = pk2(v[j].x, v[j].y); w.y = pk2(v[j].z, v[j].w); o8[64 * j] = w; }
    if (lane < 16) rss_row[lane] = lane == 0 ? s : 0.f;
}

__device__ __forceinline__ void phase_prologue(const Args& a, LAS unsigned char* lds) {
    const int tid = opaque_tid(), lane = tid & 63, wave = __builtin_amdgcn_readfirstlane(tid >> 6);
    const int G = gridDim.x, gw = blockIdx.x * NWAVES + wave, NGW = G * NWAVES;
    const size_t gt = (size_t)blockIdx.x * NTHR + tid, NGT = (size_t)G * NTHR;
    unsigned char* ws = ws_of(a);
    LAS float* scr = (LAS float*)(lds + wave * 16384);
    for (int l = 0; l < 2; ++l) {
        conv_matrix(INF(IN_WIN) + (size_t)l * DM * DIN, DM, DIN, (bf16*)(ws + WS_WIN) + (size_t)l * ZLD * DM, 0, gw, NGW, scr, lane, INF(IN_GMIX) + l * DM);
        conv_matrix(INF(IN_WOUT) + (size_t)l * DM * DM, DM, DM, (bf16*)(ws + WS_WOUT) + (size_t)l * DM * DM, 0, gw, NGW, scr, lane);
        conv_matrix(INF(IN_PLEG) + (size_t)l * DM * DM, DM, DM, (bf16*)(ws + WS_WG) + (size_t)l * DM * DM, 0, gw, NGW, scr, lane, INF(IN_GPLE) + l * DM);
        conv_matrix(INF(IN_PLEP) + (size_t)l * 256 * DM, 256, DM, (bf16*)(ws + WS_WP) + (size_t)l * DM * 256, 0, gw, NGW, scr, lane);
        conv_matrix(INF(IN_KCW1) + (size_t)l * 2048 * 128, 2048, 128, (bf16*)(ws + WS_CW1) + (size_t)(l * 2 + 0) * 128 * 2048, 0, gw, NGW, scr, lane);
        conv_matrix(INF(IN_VCW1) + (size_t)l * 2048 * 128, 2048, 128, (bf16*)(ws + WS_CW1) + (size_t)(l * 2 + 1) * 128 * 2048, 0, gw, NGW, scr, lane);
        bf16* lora = (bf16*)(ws + WS_LORA) + (size_t)l * 65536;
        conv_matrix(INF(IN_RWWUP) + (size_t)l * 64 * 256, 64, 256, lora, 0, gw, NGW, scr, lane);
        conv_matrix(INF(IN_RWAUP) + (size_t)l * 64 * 256, 64, 256, lora + 16384, 0, gw, NGW, scr, lane);
        conv_matrix(INF(IN_RWGUP) + (size_t)l * 128 * 256, 128, 256, lora + 32768, 0, gw, NGW, scr, lane);
        { u32x4* zr = (u32x4*)((bf16*)(ws + WS_WIN) + ((size_t)l * ZLD + DIN) * DM); const size_t n16 = (size_t)(ZLD - DIN) * DM * 2 / 16;
          for (size_t i = gt; i < n16; i += NGT) zr[i] = (u32x4){0u, 0u, 0u, 0u}; }
    }
    conv_matrix(INF(IN_FW1), DM, DFF, (bf16*)(ws + WS_W13), 1, gw, NGW, scr, lane, INF(IN_GFFN));
    conv_matrix(INF(IN_FW3), DM, DFF, (bf16*)(ws + WS_W13), 2, gw, NGW, scr, lane, INF(IN_GFFN));
    conv_matrix(INF(IN_FW2), DFF, DM, (bf16*)(ws + WS_W2), 0, gw, NGW, scr, lane);
    { const f32x4* src = (const f32x4*)INF(IN_P); u32x2* dst = (u32x2*)(ws + WS_PB); const size_t n4 = (size_t)2 * MT * 256 / 4;
      for (size_t i = gt; i < n4; i += NGT) { const f32x4 v = src[i]; u32x2 w; w.x = pk2(v.x, v.y); w.y = pk2(v.z, v.w); dst[i] = w; } }
    { const int* pos = (const int*)ldptr(IN_POS); float* ct = (float*)(ws + WS_ROPE); float* st = ct + (size_t)MT * 8;
      const float inv[8] = {1.0f, 0.1939227432012558f, 0.03760603070259094f, 0.007292664609849453f, 0.0014142135623842478f, 0.00027424818836152554f, 5.3182957344688475e-05f, 1.0313385246263351e-05f};
      for (size_t i = gt; i < (size_t)MT * 8; i += NGT) { const int m = (int)(i >> 3), k = (int)(i & 7);
          float iv = inv[0];
#pragma unroll
          for (int q = 1; q < 8; ++q) iv = (k == q) ? inv[q] : iv;
          const float ang = (float)pos[m] * iv;
          const double ad = (double)ang; const double kq = __builtin_rint(ad * 0.15915494309189535); const float red = (float)(ad - kq * 6.283185307179586);
          ct[i] = __cosf(red); st[i] = __sinf(red); } }
    if (blockIdx.x < 64) {
        const int lk = blockIdx.x >> 4, ck = blockIdx.x & 15, l = lk >> 1, kv = lk & 1; const float* W1 = INF(kv ? IN_VCW1 : IN_KCW1) + (size_t)l * 2048 * 128; const float* pos = INF(IN_CMPPOS) + (size_t)l * 2048;
        LAS float* red = (LAS float*)(lds + 8448);
        const int hid = tid & 127, part = tid >> 7; const int kb = ck * 128 + part * 32; float s = 0.f;
#pragma unroll
        for (int k = 0; k < 32; ++k) s += pos[kb + k] * W1[(size_t)(kb + k) * 128 + hid];
        red[part * 128 + hid] = s; __syncthreads();
        if (tid < 128) ((float*)(ws + WS_CBIAS))[(lk * 16 + ck) * 128 + tid] = red[tid] + red[128 + tid] + red[256 + tid] + red[384 + tid];
    }
    for (int m = gw; m < MT; m += NGW) init_row(INF(IN_X) + (size_t)m * DM, (bf16*)(ws + WS_HN) + (size_t)m * DM, a.out + (size_t)m * DM, (float*)(ws + WS_RSS) + (size_t)m * 16, lane);
}

template <int MODE>
__device__ __forceinline__ void phase_norm(const Args& a, LAS unsigned char* lds, const float* g) {
    const int tid = opaque_tid(), lane = tid & 63, wave = __builtin_amdgcn_readfirstlane(tid >> 6);
    unsigned char* ws = ws_of(a);
    LAS int* lcnt = (LAS int*)lds;
    if (MODE == 1) { if (tid < 16) lcnt[tid] = 0; __syncthreads(); }
    for (int rb = blockIdx.x; rb < MT / 64; rb += gridDim.x) {
        for (int i = 0; i < 8; ++i) {
            const int m = rb * 64 + wave * 8 + i;
            float* hrow = a.out + (size_t)m * DM;
            const f32x4* xr = (const f32x4*)hrow + lane; f32x4 v[4]; float s = 0.f;
#pragma unroll
            for (int j = 0; j < 4; ++j) { v[j] = xr[64 * j]; s += (v[j].x * v[j].x + v[j].y * v[j].y) + (v[j].z * v[j].z + v[j].w * v[j].w); }
            const float rs = 1.0f / sqrtf(wave_sum(s) * (1.0f / 1024.0f) + 1e-6f);
#pragma unroll
            for (int j = 0; j < 4; ++j) { const f32x4 gg = ((const f32x4*)g + lane)[64 * j]; v[j].x *= rs * gg.x; v[j].y *= rs * gg.y; v[j].z *= rs * gg.z; v[j].w *= rs * gg.w; }
            if (MODE == 2) {
#pragma unroll
                for (int j = 0; j < 4; ++j) ((f32x4*)hrow + lane)[64 * j] = v[j];
            } else if (MODE == 0) {
                u32x2* o8 = (u32x2*)((bf16*)(ws + WS_HN) + (size_t)m * DM) + lane;
#pragma unroll
                for (int j = 0; j < 4; ++j) { u32x2 w; w.x = pk2(v[j].x, v[j].y); w.y = pk2(v[j].z, v[j].w); o8[64 * j] = w; }
            }
            if (MODE == 1) {
                const float* rw = INF(IN_RTW); float lg[8];
#pragma unroll
                for (int e = 0; e < 8; ++e) lg[e] = 0.f;
#pragma unroll
                for (int j = 0; j < 4; ++j)
#pragma unroll
                    for (int c = 0; c < 4; ++c) { const int k = 4 * (lane + 64 * j) + c; const f32x4 w0 = *(const f32x4*)(rw + (size_t)k * 8), w1 = *(const f32x4*)(rw + (size_t)k * 8 + 4); const float x = v[j][c];
                        lg[0] += x * w0.x; lg[1] += x * w0.y; lg[2] += x * w0.z; lg[3] += x * w0.w; lg[4] += x * w1.x; lg[5] += x * w1.y; lg[6] += x * w1.z; lg[7] += x * w1.w; }
#pragma unroll
                for (int e = 0; e < 8; ++e) lg[e] = wave_sum(lg[e]) + INF(IN_RTB)[e];
                int e0 = 0; float v0 = lg[0];
#pragma unroll
                for (int e = 1; e < 8; ++e) if (lg[e] > v0) { v0 = lg[e]; e0 = e; }
                int e1 = -1; float v1 = -3.0e38f;
#pragma unroll
                for (int e = 0; e < 8; ++e) if (e != e0 && lg[e] > v1) { v1 = lg[e]; e1 = e; }
                const float p1 = 1.0f / (1.0f + __expf(v0 - v1)), p0 = 1.0f - p1;
                if (lane == 0) { int* te = (int*)(ws + WS_SLOT + SL_TOKE); float* tg = (float*)(ws + WS_SLOT + SL_TOKG); te[2 * m] = e0; te[2 * m + 1] = e1; tg[2 * m] = p0; tg[2 * m + 1] = p1;
                    atomicAdd((int*)&lcnt[e0], 1); atomicAdd((int*)&lcnt[8 + e1], 1); }
            }
        }
        if (MODE == 1) { __syncthreads(); if (tid < 16) { ((int*)(ws + WS_SLOT + SL_BCNT))[rb * 16 + tid] = lcnt[tid]; lcnt[tid] = 0; } __syncthreads(); }
    }
}

__device__ __forceinline__ bf16x8 ld_bf8(const bf16* p) { return *(const bf16x8*)p; }
__device__ __forceinline__ float tanhf_(float x) { const float e = __expf(2.0f * x); return 1.0f - 2.0f / (e + 1.0f); }

__device__ __forceinline__ void rw_shift8(const bf16* z, const float* mu, int m, int tpos, int c, float (&o)[8]) {
    const u32x4 cur = *(const u32x4*)(z + (size_t)m * ZLD + ZC_B + c);
    u32x4 prv = (u32x4){0u, 0u, 0u, 0u}; if (tpos > 0) prv = *(const u32x4*)(z + (size_t)(m - 1) * ZLD + ZC_B + c);
    const f32x4 m0 = *(const f32x4*)(mu + c), m1 = *(const f32x4*)(mu + c + 4);
    float cu[8] = {bflo(cur.x), bfhi(cur.x), bflo(cur.y), bfhi(cur.y), bflo(cur.z), bfhi(cur.z), bflo(cur.w), bfhi(cur.w)};
    float pv[8] = {bflo(prv.x), bfhi(prv.x), bflo(prv.y), bfhi(prv.y), bflo(prv.z), bfhi(prv.z), bflo(prv.w), bfhi(prv.w)};
    float mm[8] = {m0.x, m0.y, m0.z, m0.w, m1.x, m1.y, m1.z, m1.w};
#pragma unroll
    for (int j = 0; j < 8; ++j) o[j] = cu[j] + (pv[j] - cu[j]) * mm[j];
}
__device__ __forceinline__ void rw_shift4(const bf16* z, const float* mu, int m, int tpos, int c, float (&o)[4]) {
    const u32x2 cur = *(const u32x2*)(z + (size_t)m * ZLD + ZC_B + c);
    u32x2 prv = (u32x2){0u, 0u}; if (tpos > 0) prv = *(const u32x2*)(z + (size_t)(m - 1) * ZLD + ZC_B + c);
    const f32x4 m0 = *(const f32x4*)(mu + c);
    o[0] = bflo(cur.x) + (bflo(prv.x) - bflo(cur.x)) * m0.x; o[1] = bfhi(cur.x) + (bfhi(prv.x) - bfhi(cur.x)) * m0.y;
    o[2] = bflo(cur.y) + (bflo(prv.y) - bflo(cur.y)) * m0.z; o[3] = bfhi(cur.y) + (bfhi(prv.y) - bfhi(cur.y)) * m0.w;
}
__device__ __forceinline__ bf16x8 pack8(const float (&x)[8]) {
    u32x4 w; w.x = pk2(x[0], x[1]); w.y = pk2(x[2], x[3]); w.z = pk2(x[4], x[5]); w.w = pk2(x[6], x[7]);
    return __builtin_bit_cast(bf16x8, w);
}

__device__ __forceinline__ void rwkv_prep_tile(const Args& a, int layer, int m0, int lane, int hc_lo, int hc_hi) {
    unsigned char* ws = ws_of(a);
    const bf16* z = (const bf16*)(ws + WS_Z);
    const float* mu = INF(IN_RWMU) + (size_t)layer * 1024;
    const bf16* lora = (const bf16*)(ws + WS_LORA) + (size_t)layer * 65536;
    const bf16* wupT = lora; const bf16* aupT = lora + 16384; const bf16* gupT = lora + 32768;
    const int fq = lane >> 4, fr = lane & 15;
    const int m = m0 + fr, tpos = m & (SEQ - 1), bb = m >> 12;
    bf16x8 wdB[2], adB[2], gdB[4];
#pragma unroll
    for (int ks = 0; ks < 2; ++ks) { float x[8]; rw_shift8(z, mu, m, tpos, 768 + 32 * ks + 8 * fq, x);
#pragma unroll
        for (int j = 0; j < 8; ++j) x[j] = tanhf_(x[j]);
        wdB[ks] = pack8(x);
        rw_shift8(z, mu, m, tpos, 832 + 32 * ks + 8 * fq, x); adB[ks] = pack8(x); }
#pragma unroll
    for (int ks = 0; ks < 4; ++ks) { float x[8]; rw_shift8(z, mu, m, tpos, 896 + 32 * ks + 8 * fq, x);
#pragma unroll
        for (int j = 0; j < 8; ++j) x[j] = sigmoidf_(x[j]);
        gdB[ks] = pack8(x); }
    const float* w0p = INF(IN_RWW0) + layer * 256; const float* a0p = INF(IN_RWA0) + layer * 256; const float* kkp = INF(IN_RWKK) + layer * 256;
    const float* kap = INF(IN_RWKA) + layer * 256; const float* rkp = INF(IN_RWRK) + layer * 256;
    float* rec = (float*)(ws + WS_REC); float* gbuf = (float*)(ws + WS_G); float* bonus = (float*)(ws + WS_BONUS);
    float ss = 0.f, bs = 0.f, inv = 0.f;
#pragma unroll 1
    for (int hc = hc_lo; hc < hc_hi; ++hc) {
        const int h = hc >> 2, ct = hc & 3;
        if (ct == 0) {
            ss = 0.f; bs = 0.f;
#pragma unroll
            for (int c2 = 0; c2 < 4; ++c2) { const int c0 = h * 64 + 16 * c2 + 4 * fq; float k4[4]; rw_shift4(z, mu, m, tpos, 256 + c0, k4); const f32x4 k_k = *(const f32x4*)(kkp + c0);
#pragma unroll
                for (int i = 0; i < 4; ++i) { const float kx = k4[i] * k_k[i]; ss += kx * kx; } }
            ss += __shfl_xor(ss, 16); ss += __shfl_xor(ss, 32);
            inv = 1.0f / sqrtf(fmaxf(ss, 1e-24f));
        }
        f32x4 aw = (f32x4){0.f, 0.f, 0.f, 0.f}, aa = aw, ag = aw;
        const int chr = h * 64 + 16 * ct + fr;
#pragma unroll
        for (int ks = 0; ks < 2; ++ks) { const bf16x8 A1 = ld_bf8(wupT + chr * 64 + 32 * ks + 8 * fq), A2 = ld_bf8(aupT + chr * 64 + 32 * ks + 8 * fq);
            aw = __builtin_amdgcn_mfma_f32_16x16x32_bf16(A1, wdB[ks], aw, 0, 0, 0); aa = __builtin_amdgcn_mfma_f32_16x16x32_bf16(A2, adB[ks], aa, 0, 0, 0); }
#pragma unroll
        for (int ks = 0; ks < 4; ++ks) { const bf16x8 A3 = ld_bf8(gupT + chr * 128 + 32 * ks + 8 * fq); ag = __builtin_amdgcn_mfma_f32_16x16x32_bf16(A3, gdB[ks], ag, 0, 0, 0); }
        float* rp = rec + ((size_t)(bb * 4 + h) * SEQ + tpos) * 384;
        const int c0 = h * 64 + 16 * ct + 4 * fq, d0 = 16 * ct + 4 * fq;
        float r4[4], k4[4], v4[4]; rw_shift4(z, mu, m, tpos, c0, r4); rw_shift4(z, mu, m, tpos, 256 + c0, k4); rw_shift4(z, mu, m, tpos, 512 + c0, v4);
        const f32x4 w0 = *(const f32x4*)(w0p + c0), a0 = *(const f32x4*)(a0p + c0), k_k = *(const f32x4*)(kkp + c0), k_a = *(const f32x4*)(kap + c0), r_k = *(const f32x4*)(rkp + c0);
        f32x4 odw, okk, ob, okp;
#pragma unroll
        for (int i = 0; i < 4; ++i) {
            const float wl = w0[i] + aw[i]; const float nx = -wl; const float sp = fmaxf(nx, 0.f) + log1pf(__expf(-fabsf(nx)));
            const float wlog = -sp - 0.5f; odw[i] = __expf(-__expf(wlog));
            const float aval = sigmoidf_(a0[i] + aa[i]);
            const float kkn = k4[i] * k_k[i] * inv; okk[i] = kkn; ob[i] = kkn * aval;
            const float kpv = k4[i] * (1.0f + (aval - 1.0f) * k_a[i]); okp[i] = kpv;
            bs += r4[i] * kpv * r_k[i];
        }
        *(f32x4*)(rp + d0) = odw; *(f32x4*)(rp + 64 + d0) = okk; *(f32x4*)(rp + 128 + d0) = ob; *(f32x4*)(rp + 192 + d0) = okp;
        *(f32x4*)(rp + 256 + d0) = (f32x4){r4[0], r4[1], r4[2], r4[3]}; *(f32x4*)(rp + 320 + d0) = (f32x4){v4[0], v4[1], v4[2], v4[3]};
        *(f32x4*)(gbuf + (size_t)m * 256 + c0) = ag;
        if (ct == 3) { float b2 = bs; b2 += __shfl_xor(b2, 16); b2 += __shfl_xor(b2, 32); if (fq == 0) bonus[(size_t)m * 4 + h] = b2; }
    }
}

__host__ __device__ constexpr int vperm_src(int p) { return (p & ~31) + 16 * ((p & 7) >> 2) + 4 * ((p & 31) >> 3) + (p & 3); }
__host__ __device__ constexpr int vperm_pos(int k) { return (k & ~31) + 8 * ((k & 15) >> 2) + 4 * ((k & 31) >> 4) + (k & 3); }
__device__ __forceinline__ void nsa_prep_item(const Args& a, LAS unsigned char* lds, int b, int tt) {
    unsigned char* ws = ws_of(a); const int tid = opaque_tid();
    const bf16* z = (const bf16*)(ws + WS_Z);
    const float* ct = (const float*)(ws + WS_ROPE); const float* st = ct + (size_t)MT * 8;
    const int mb = b * SEQ + tt * 64;
    for (int task = tid; task < 64 * 12; task += NTHR) {
        const int tok = task / 12, unit = task % 12, m = mb + tok;
        const bf16* src; bf16* dst;
        if (unit < 8) { src = z + (size_t)m * ZLD + ZC_Q + unit * 64; dst = (bf16*)(ws + WS_QROT) + (size_t)m * 512 + unit * 64; }
        else if (unit < 10) { src = z + (size_t)m * ZLD + ZC_KS + (unit - 8) * 64; dst = (bf16*)(ws + WS_KSR) + (size_t)m * 128 + (unit - 8) * 64; }
        else { src = z + (size_t)m * ZLD + ZC_KW + (unit - 10) * 64; dst = (bf16*)(ws + WS_KWR) + (size_t)m * 128 + (unit - 10) * 64; }
        u32x4 v[8];
#pragma unroll
        for (int i = 0; i < 8; ++i) v[i] = ((const u32x4*)src)[i];
        const f32x4 c0 = *(const f32x4*)(ct + (size_t)m * 8), c1 = *(const f32x4*)(ct + (size_t)m * 8 + 4), s0 = *(const f32x4*)(st + (size_t)m * 8), s1 = *(const f32x4*)(st + (size_t)m * 8 + 4);
        const float cc[8] = {c0.x, c0.y, c0.z, c0.w, c1.x, c1.y, c1.z, c1.w}, sn[8] = {s0.x, s0.y, s0.z, s0.w, s1.x, s1.y, s1.z, s1.w};
        const float x1[8] = {bflo(v[0].x), bfhi(v[0].x), bflo(v[0].y), bfhi(v[0].y), bflo(v[0].z), bfhi(v[0].z), bflo(v[0].w), bfhi(v[0].w)};
        const float x2[8] = {bflo(v[1].x), bfhi(v[1].x), bflo(v[1].y), bfhi(v[1].y), bflo(v[1].z), bfhi(v[1].z), bflo(v[1].w), bfhi(v[1].w)};
        float o1[8], o2[8];
#pragma unroll
        for (int i = 0; i < 8; ++i) { o1[i] = x1[i] * cc[i] - x2[i] * sn[i]; o2[i] = x1[i] * sn[i] + x2[i] * cc[i]; }
        v[0] = (u32x4){pk2(o1[0], o1[1]), pk2(o1[2], o1[3]), pk2(o1[4], o1[5]), pk2(o1[6], o1[7])};
        v[1] = (u32x4){pk2(o2[0], o2[1]), pk2(o2[2], o2[3]), pk2(o2[4], o2[5]), pk2(o2[6], o2[7])};
#pragma unroll
        for (int i = 0; i < 8; ++i) ((u32x4*)dst)[i] = v[i];
    }
    LAS bf16* tile = (LAS bf16*)lds;
    { const int tok = tid >> 3, ch = tid & 7;
#pragma unroll
      for (int mi = 0; mi < 4; ++mi) { const int col = (mi < 2 ? ZC_VS : ZC_VW) + (mi & 1) * 64;
          *(LAS u32x4*)(tile + mi * 4608 + tok * 72 + ch * 8) = *(const u32x4*)(z + (size_t)(mb + tok) * ZLD + col + ch * 8); } }
    __syncthreads();
    { const int d = tid >> 3, tc = tid & 7;
#pragma unroll
      for (int mi = 0; mi < 4; ++mi) { unsigned e[8];
#pragma unroll
          for (int j = 0; j < 8; ++j) e[j] = tile[mi * 4608 + vperm_src(tc * 8 + j) * 72 + d];
          u32x4 w; w.x = e[0] | (e[1] << 16); w.y = e[2] | (e[3] << 16); w.z = e[4] | (e[5] << 16); w.w = e[6] | (e[7] << 16);
          bf16* dst = (bf16*)(ws + (mi < 2 ? WS_VST : WS_VWT)) + ((size_t)(b * 2 + (mi & 1)) * 64 + d) * SEQ + tt * 64 + tc * 8;
          *(u32x4*)dst = w; } }
    __syncthreads();
}

__device__ __forceinline__ void nsa_compress_item(const Args& a, int layer, LAS unsigned char* lds, int b, int g, int kv, int nt) {
    unsigned char* ws = ws_of(a); const int tid = opaque_tid(), lane = tid & 63, wave = __builtin_amdgcn_readfirstlane(tid >> 6), fq = lane >> 4, fr = lane & 15;
    const bf16* z = (const bf16*)(ws + WS_Z);
    const bf16* w1t = (const bf16*)(ws + WS_CW1) + (size_t)(layer * 2 + kv) * 128 * 2048;
    const int colb = (kv ? ZC_VC : ZC_KC) + g * 64;
    f32x4 acc[8];
#pragma unroll
    for (int ht = 0; ht < 8; ++ht) acc[ht] = (f32x4){0.f, 0.f, 0.f, 0.f};
    for (int li = 0; li < 4; ++li) { const int l = wave * 4 + li;
        int tok = 256 * nt + 16 * fr + l; tok = tok > SEQ - 1 ? SEQ - 1 : tok;
#pragma unroll
        for (int hf = 0; hf < 2; ++hf) {
            const bf16x8 B = ld_bf8(z + (size_t)(b * SEQ + tok) * ZLD + colb + 32 * hf + 8 * fq);
#pragma unroll
            for (int ht = 0; ht < 8; ++ht) { const bf16x8 A = ld_bf8(w1t + (size_t)(16 * ht + fr) * 2048 + 64 * l + 32 * hf + 8 * fq);
                acc[ht] = __builtin_amdgcn_mfma_f32_16x16x32_bf16(A, B, acc[ht], 0, 0, 0); } } }
    LAS float* part = (LAS float*)lds;
    LAS float* hid = (LAS float*)(lds + 65536);
#pragma unroll
    for (int ht = 0; ht < 8; ++ht)
#pragma unroll
        for (int r = 0; r < 4; ++r) part[(wave * 128 + 16 * ht + 4 * fq + r) * 16 + fr] = acc[ht][r];
    __syncthreads();
    { const int hh = tid >> 2, nq = tid & 3; f32x4 s = (f32x4){0.f, 0.f, 0.f, 0.f};
#pragma unroll
      for (int w = 0; w < 8; ++w) s = s + *(LAS f32x4*)(part + (w * 128 + hh) * 16 + 4 * nq);
      float cb = 0.f; { const float* cbp = (const float*)(ws + WS_CBIAS) + (size_t)(layer * 2 + kv) * 16 * 128 + hh;
#pragma unroll
        for (int c = 0; c < 16; ++c) cb += cbp[c * 128]; }
      f32x4 o; o.x = gelu_tanh(s.x + cb); o.y = gelu_tanh(s.y + cb); o.z = gelu_tanh(s.z + cb); o.w = gelu_tanh(s.w + cb);
      *(LAS f32x4*)(hid + hh * 16 + 4 * nq) = o; }
    __syncthreads();
    { const float* W2 = INF(kv ? IN_VCW2 : IN_KCW2) + (size_t)layer * 128 * 64; const int n = tid & 15, dg = tid >> 4; float o0 = 0.f, o1 = 0.f;
      for (int hh = 0; hh < 128; ++hh) { const float x = hid[hh * 16 + n]; o0 += x * W2[hh * 64 + dg]; o1 += x * W2[hh * 64 + dg + 32]; }
      const int ng = 16 * nt + n; if (ng >= NCMP) { o0 = 0.f; o1 = 0.f; }
      if (kv == 0) { bf16* kc = (bf16*)(ws + WS_KCMP) + ((size_t)(b * 2 + g) * 256 + ng) * 64; kc[dg] = (bf16)f2bf(o0); kc[dg + 32] = (bf16)f2bf(o1); }
      else { bf16* vc = (bf16*)(ws + WS_VCMPT) + (size_t)(b * 2 + g) * 64 * 256; const int np = vperm_pos(ng); vc[(size_t)dg * 256 + np] = (bf16)f2bf(o0); vc[(size_t)(dg + 32) * 256 + np] = (bf16)f2bf(o1); } }
    __syncthreads();
}

__device__ __forceinline__ void phase_prep(const Args& a, int layer, LAS unsigned char* lds) {
    const int tid = opaque_tid(), lane = tid & 63, wave = __builtin_amdgcn_readfirstlane(tid >> 6);
#ifndef NO_RWP
    for (int tile = blockIdx.x * 4 + (wave & 3); tile < MT / 16; tile += gridDim.x * 4) rwkv_prep_tile(a, layer, tile * 16, lane, 8 * (wave >> 2), 8 * (wave >> 2) + 8);
#endif
#ifndef NO_NSAP
    for (int it = blockIdx.x; it < NB * 64; it += gridDim.x) nsa_prep_item(a, lds, it >> 6, it & 63);
#endif
#ifndef NO_CMP
    for (int it = blockIdx.x; it < NB * 2 * 2 * 16; it += gridDim.x) nsa_compress_item(a, layer, lds, it >> 6, (it >> 5) & 1, (it >> 4) & 1, it & 15);
#endif
}

__device__ __forceinline__ float dpp_xor1(float x) { return __builtin_bit_cast(float, __builtin_amdgcn_update_dpp(0, __builtin_bit_cast(int, x), 0xB1, 0xf, 0xf, true)); }
__device__ __forceinline__ float dpp_xor2(float x) { return __builtin_bit_cast(float, __builtin_amdgcn_update_dpp(0, __builtin_bit_cast(int, x), 0x4E, 0xf, 0xf, true)); }
__device__ __forceinline__ float dpp_hmir(float x) { return __builtin_bit_cast(float, __builtin_amdgcn_update_dpp(0, __builtin_bit_cast(int, x), 0x141, 0xf, 0xf, true)); }
__device__ __forceinline__ float red8(float x) { x += dpp_xor1(x); x += dpp_xor2(x); x += dpp_hmir(x); return x; }

__device__ __forceinline__ void rwkv_scan_seg(const Args& a, LAS unsigned char* lds, int bh, int seg) {
    unsigned char* ws = ws_of(a); const int tid = opaque_tid(), lane = tid & 63, wave = __builtin_amdgcn_readfirstlane(tid >> 6);
    const int row = wave * 8 + (lane >> 3), kq = lane & 7;
    const f32x4* rec4 = (const f32x4*)(ws + WS_REC) + ((size_t)bh * SEQ + (size_t)seg * SEGLEN) * 96;
    const size_t yoff = ((size_t)(bh >> 2) * SEQ + (size_t)seg * SEGLEN) * 256 + (bh & 3) * 64 + row;
    float* yraw = (float*)(ws + WS_YRAW) + yoff; float* ypb = (float*)(ws + WS_YP) + yoff;
    LAS f32x4* buf = (LAS f32x4*)lds;
    f32x2 s2[4], q2[4];
#pragma unroll
    for (int j = 0; j < 4; ++j) { s2[j] = (f32x2){0.f, 0.f}; q2[j] = (f32x2){(8 * kq + 2 * j == row) ? 1.f : 0.f, (8 * kq + 2 * j + 1 == row) ? 1.f : 0.f}; }
    __syncthreads();
    { f32x4 p0 = rec4[tid], p1 = rec4[tid + 512], p2 = rec4[tid + 1024]; buf[tid] = p0; buf[tid + 512] = p1; buf[tid + 1024] = p2; }
    __syncthreads();
    for (int c = 0; c < SEGLEN / 16; ++c) {
        const int p = c & 1;
        f32x4 n0, n1, n2; const bool more = (c + 1 < SEGLEN / 16);
        if (more) { const f32x4* src = rec4 + (size_t)(c + 1) * 1536; n0 = src[tid]; n1 = src[tid + 512]; n2 = src[tid + 1024]; }
        const LAS f32x4* bp = buf + p * 1536;
#pragma unroll 2
        for (int st = 0; st < 16; ++st) {
            const LAS f32x4* sp = bp + st * 96;
            const f32x4 w0 = sp[2 * kq], w1 = sp[2 * kq + 1], k0 = sp[16 + 2 * kq], k1 = sp[16 + 2 * kq + 1], b0 = sp[32 + 2 * kq], b1 = sp[32 + 2 * kq + 1];
            const f32x4 q0 = sp[48 + 2 * kq], q1 = sp[48 + 2 * kq + 1], r0 = sp[64 + 2 * kq], r1 = sp[64 + 2 * kq + 1];
            const float vv = ((const LAS float*)(sp + 80))[row];
            const f32x2 wv[4] = {{w0.x, w0.y}, {w0.z, w0.w}, {w1.x, w1.y}, {w1.z, w1.w}}, kk[4] = {{k0.x, k0.y}, {k0.z, k0.w}, {k1.x, k1.y}, {k1.z, k1.w}};
            const f32x2 bv[4] = {{b0.x, b0.y}, {b0.z, b0.w}, {b1.x, b1.y}, {b1.z, b1.w}}, kp[4] = {{q0.x, q0.y}, {q0.z, q0.w}, {q1.x, q1.y}, {q1.z, q1.w}};
            const f32x2 rr[4] = {{r0.x, r0.y}, {r0.z, r0.w}, {r1.x, r1.y}, {r1.z, r1.w}};
            f32x2 da = s2[0] * kk[0], ea = q2[0] * kk[0];
#pragma unroll
            for (int j = 1; j < 4; ++j) { da = __builtin_elementwise_fma(s2[j], kk[j], da); ea = __builtin_elementwise_fma(q2[j], kk[j], ea); }
            float d1 = da.x + da.y, e1 = ea.x + ea.y;
            d1 += dpp_xor1(d1); e1 += dpp_xor1(e1); d1 += dpp_xor2(d1); e1 += dpp_xor2(e1); d1 += dpp_hmir(d1); e1 += dpp_hmir(e1);
            const f32x2 sa = {-d1, -d1}, sq = {-e1, -e1}, v2 = {vv, vv};
            f32x2 db = {0.f, 0.f}, eb = {0.f, 0.f};
#pragma unroll
            for (int j = 0; j < 4; ++j) { const f32x2 t = __builtin_elementwise_fma(sa, bv[j], v2 * kp[j]); s2[j] = __builtin_elementwise_fma(s2[j], wv[j], t); db = __builtin_elementwise_fma(s2[j], rr[j], db);
                q2[j] = __builtin_elementwise_fma(q2[j], wv[j], sq * bv[j]); eb = __builtin_elementwise_fma(q2[j], rr[j], eb); }
            float d2 = db.x + db.y, e2 = eb.x + eb.y;
            d2 += dpp_xor1(d2); e2 += dpp_xor1(e2); d2 += dpp_xor2(d2); e2 += dpp_xor2(e2); d2 += dpp_hmir(d2); e2 += dpp_hmir(e2);
            if (kq == 0) { yraw[(size_t)(c * 16 + st) * 256] = d2; ypb[(size_t)(c * 16 + st) * 256] = e2; }
        }
        if (more) { LAS f32x4* dp = buf + (p ^ 1) * 1536; dp[tid] = n0; dp[tid + 512] = n1; dp[tid + 1024] = n2; }
        __syncthreads();
    }
    float* se = (float*)(ws + WS_SEGE) + ((size_t)(bh * NSEG + seg) * 2) * 4096 + row * 64 + 8 * kq;
    *(f32x4*)se = (f32x4){s2[0].x, s2[0].y, s2[1].x, s2[1].y}; *(f32x4*)(se + 4) = (f32x4){s2[2].x, s2[2].y, s2[3].x, s2[3].y};
    *(f32x4*)(se + 4096) = (f32x4){q2[0].x, q2[0].y, q2[1].x, q2[1].y}; *(f32x4*)(se + 4096 + 4) = (f32x4){q2[2].x, q2[2].y, q2[3].x, q2[3].y};
}

__device__ __forceinline__ void rwkv_chain(const Args& a, LAS unsigned char* lds, int bh) {
    unsigned char* ws = ws_of(a); const int tid = opaque_tid();
    LAS float* S = (LAS float*)lds;
    LAS float* P = S + 64 * 68;
    const int v = tid >> 3, kg = tid & 7;
    float* sst = (float*)(ws + WS_SST) + (size_t)bh * NSEG * 4096;
    const float* sege = (const float*)(ws + WS_SEGE) + (size_t)bh * NSEG * 2 * 4096;
    __syncthreads();
    for (int i = tid; i < 64 * 68; i += NTHR) S[i] = 0.f;
    for (int i = tid; i < 4096; i += NTHR) sst[i] = 0.f;
    __syncthreads();
    for (int sg = 1; sg < NSEG; ++sg) {
        const float* e0 = sege + (size_t)(sg - 1) * 2 * 4096;
        for (int i = tid; i < 1024; i += NTHR) *(LAS f32x4*)(P + 4 * i) = *(const f32x4*)(e0 + 4096 + 4 * i);
        f32x4 o0 = *(const f32x4*)(e0 + v * 64 + 8 * kg), o1 = *(const f32x4*)(e0 + v * 64 + 8 * kg + 4);
        __syncthreads();
#pragma unroll 4
        for (int i = 0; i < 64; ++i) { const float sv = S[v * 68 + i]; const f32x4 p0 = *(const LAS f32x4*)(P + i * 64 + 8 * kg), p1 = *(const LAS f32x4*)(P + i * 64 + 8 * kg + 4);
            o0 = o0 + p0 * sv; o1 = o1 + p1 * sv; }
        __syncthreads();
        *(LAS f32x4*)(S + v * 68 + 8 * kg) = o0; *(LAS f32x4*)(S + v * 68 + 8 * kg + 4) = o1;
        *(f32x4*)(sst + (size_t)sg * 4096 + v * 64 + 8 * kg) = o0; *(f32x4*)(sst + (size_t)sg * 4096 + v * 64 + 8 * kg + 4) = o1;
        __syncthreads();
    }
}

__device__ __forceinline__ void rwkv_post_item(const Args& a, int layer, LAS unsigned char* lds, int bh, int tile) {
    unsigned char* ws = ws_of(a); const int tid = opaque_tid();
    const int seg = tile / (SEGLEN / 64), bb = bh >> 2, h = bh & 3;
    LAS float* S = (LAS float*)lds;
    LAS float* YP = S + 64 * 68;
    const float* sst = (const float*)(ws + WS_SST) + (size_t)(bh * NSEG + seg) * 4096;
    const size_t m0 = (size_t)bb * SEQ + (size_t)tile * 64;
    __syncthreads();
    for (int i = tid; i < 1024; i += NTHR) { const int r = i >> 4, c4 = i & 15; *(LAS f32x4*)(S + r * 68 + 4 * c4) = *(const f32x4*)(sst + r * 64 + 4 * c4);
        *(LAS f32x4*)(YP + r * 68 + 4 * c4) = *(const f32x4*)((const float*)(ws + WS_YP) + (m0 + r) * 256 + h * 64 + 4 * c4); }
    __syncthreads();
    const int tok = tid >> 3, vg = tid & 7; const size_t m = m0 + tok; const int c0 = h * 64 + 8 * vg;
    const f32x4 ya = *(const f32x4*)((const float*)(ws + WS_YRAW) + m * 256 + c0), yb = *(const f32x4*)((const float*)(ws + WS_YRAW) + m * 256 + c0 + 4);
    float y[8] = {ya.x, ya.y, ya.z, ya.w, yb.x, yb.y, yb.z, yb.w};
    if (seg > 0) {
#pragma unroll 4
        for (int i = 0; i < 64; i += 4) { const f32x4 yp = *(const LAS f32x4*)(YP + tok * 68 + i);
#pragma unroll
            for (int j = 0; j < 8; ++j) { const f32x4 sr = *(const LAS f32x4*)(S + (8 * vg + j) * 68 + i); y[j] += (sr.x * yp.x + sr.y * yp.y) + (sr.z * yp.z + sr.w * yp.w); } }
    }
    float sm = 0.f;
#pragma unroll
    for (int j = 0; j < 8; ++j) sm += y[j];
    sm += __shfl_xor(sm, 1); sm += __shfl_xor(sm, 2); sm += __shfl_xor(sm, 4);
    const float mean = sm * (1.0f / 64.0f); float qq = 0.f;
#pragma unroll
    for (int j = 0; j < 8; ++j) { y[j] -= mean; qq += y[j] * y[j]; }
    qq += __shfl_xor(qq, 1); qq += __shfl_xor(qq, 2); qq += __shfl_xor(qq, 4);
    const float rstd = 1.0f / sqrtf(qq * (1.0f / 64.0f) + 64e-5f);
    const float* gng = INF(IN_RWGNG) + layer * 256 + c0; const float* gnb = INF(IN_RWGNB) + layer * 256 + c0;
    const float* gt = (const float*)(ws + WS_G) + m * 256 + c0;
    const float* vv = (const float*)(ws + WS_REC) + ((size_t)bh * SEQ + (size_t)tile * 64 + tok) * 384 + 320 + 8 * vg;
    const float bo = ((const float*)(ws + WS_BONUS))[m * 4 + h];
    float o[8];
#pragma unroll
    for (int j = 0; j < 8; ++j) o[j] = (y[j] * rstd * gng[j] + gnb[j] + vv[j] * bo) * gt[j];
    u32x4 w; w.x = pk2(o[0], o[1]); w.y = pk2(o[2], o[3]); w.z = pk2(o[4], o[5]); w.w = pk2(o[6], o[7]);
    *(u32x4*)((bf16*)(ws + WS_YCAT) + m * DM + 256 + c0) = w;
}

__device__ __forceinline__ void gmlp_item(const Args& a, int layer, LAS unsigned char* lds, int b, int n, int h) {
    unsigned char* ws = ws_of(a); const int tid = opaque_tid(), lane = tid & 63, wave = __builtin_amdgcn_readfirstlane(tid >> 6), fq = lane >> 4, fr = lane & 15;
    const bf16* z = (const bf16*)(ws + WS_Z); bf16* ycat = (bf16*)(ws + WS_YCAT);
    LAS bf16* vt = (LAS bf16*)lds;
    const int mb = b * SEQ + n * 128;
    { const int s = tid >> 2, part = tid & 3; const bf16* src = z + (size_t)(mb + s) * ZLD + ZC_V + h * 64 + part * 16;
      const u32x4 v0 = ((const u32x4*)src)[0], v1 = ((const u32x4*)src)[1];
      float x[16] = {bflo(v0.x), bfhi(v0.x), bflo(v0.y), bfhi(v0.y), bflo(v0.z), bfhi(v0.z), bflo(v0.w), bfhi(v0.w), bflo(v1.x), bfhi(v1.x), bflo(v1.y), bfhi(v1.y), bflo(v1.z), bfhi(v1.z), bflo(v1.w), bfhi(v1.w)};
      float sm = 0.f;
#pragma unroll
      for (int j = 0; j < 16; ++j) { x[j] = gelu_tanh(x[j]); sm += x[j]; }
      sm += __shfl_xor(sm, 1); sm += __shfl_xor(sm, 2);
      const float mean = sm * (1.0f / 64.0f); float q = 0.f;
#pragma unroll
      for (int j = 0; j < 16; ++j) { x[j] -= mean; q += x[j] * x[j]; }
      q += __shfl_xor(q, 1); q += __shfl_xor(q, 2);
      const float rstd = 1.0f / sqrtf(q * (1.0f / 64.0f) + 1e-5f);
      const float* lg = INF(IN_GMLNG) + (layer * 4 + h) * 64 + part * 16; const float* lb = INF(IN_GMLNB) + (layer * 4 + h) * 64 + part * 16;
#pragma unroll
      for (int j = 0; j < 16; ++j) vt[(part * 16 + j) * 136 + s] = (bf16)f2bf(x[j] * rstd * lg[j] + lb[j]); }
    __syncthreads();
    {
        const float* W = INF(IN_GMWS) + ((size_t)(layer * 4 + h) * 128 + 16 * wave + fr) * 128;
        f32x4 acc[4];
#pragma unroll
        for (int dt = 0; dt < 4; ++dt) acc[dt] = (f32x4){0.f, 0.f, 0.f, 0.f};
        const int trow = 16 * wave + fr; const int nks = (wave >> 1) + 1;
        for (int ks = 0; ks < nks; ++ks) {
            const int s0 = 32 * ks + 8 * fq; const f32x4 wa = *(const f32x4*)(W + s0), wb = *(const f32x4*)(W + s0 + 4);
            float wv[8] = {wa.x, wa.y, wa.z, wa.w, wb.x, wb.y, wb.z, wb.w};
#pragma unroll
            for (int j = 0; j < 8; ++j) wv[j] = (s0 + j <= trow) ? wv[j] : 0.f;
            const bf16x8 A = pack8(wv);
#pragma unroll
            for (int dt = 0; dt < 4; ++dt) { const bf16x8 B = *(const LAS bf16x8*)(vt + (16 * dt + fr) * 136 + s0); acc[dt] = __builtin_amdgcn_mfma_f32_16x16x32_bf16(A, B, acc[dt], 0, 0, 0); } }
        const float* bs = INF(IN_GMBS) + (layer * 4 + h) * 128;
#pragma unroll
        for (int r = 0; r < 4; ++r) { const int t = 16 * wave + 4 * fq + r; const float bias = bs[t];
#pragma unroll
            for (int dt = 0; dt < 4; ++dt) { const int d = 16 * dt + fr; const float u = gelu_tanh(bf2f(z[(size_t)(mb + t) * ZLD + ZC_U + h * 64 + d]));
                ycat[(size_t)(mb + t) * DM + h * 64 + d] = (bf16)f2bf(u * (acc[dt][r] + bias)); } }
    }
    __syncthreads();
}

constexpr int NSA_OT = 0, NSA_KB = 65536, NSA_VB = 93184, NSA_IMP = 120832, NSA_SELM = 137216, NSA_UNI = 137728;
struct NsaTileSrc { const bf16* kbase; int kld; const bf16* vbase; int vld; };

__device__ __forceinline__ void nsa_tile_load(const NsaTileSrc& S, int kb, int tid, u32x4& kr, u32x4& vr) {
    const int row = tid >> 3, ch = tid & 7;
    kr = *(const u32x4*)(S.kbase + (size_t)(kb * 64 + row) * S.kld + ch * 8);
    vr = *(const u32x4*)(S.vbase + (size_t)row * S.vld + kb * 64 + ch * 8);
}
__device__ __forceinline__ void nsa_tile_load_async(const NsaTileSrc& S, int kb, int tid, u32x4& kr, u32x4& vr) {
    const int row = tid >> 3, ch = tid & 7;
    const bf16* kp = S.kbase + (size_t)(kb * 64 + row) * S.kld + ch * 8; const bf16* vp = S.vbase + (size_t)row * S.vld + kb * 64 + ch * 8;
    asm volatile("global_load_dwordx4 %0, %1, off" : "=v"(kr) : "v"(kp) : "memory");
    asm volatile("global_load_dwordx4 %0, %1, off" : "=v"(vr) : "v"(vp) : "memory");
}
template <int N> __device__ __forceinline__ void nsa_tile_wait(u32x4& kr, u32x4& vr) { asm volatile("s_waitcnt vmcnt(%2)" : "+v"(kr), "+v"(vr) : "i"(N) : "memory"); }
__device__ __forceinline__ void nsa_tile_store(LAS unsigned char* lds, int p, int tid, const u32x4& kr, const u32x4& vr) {
    const int row = tid >> 3, ch = tid & 7;
    *(LAS u32x4*)(lds + NSA_KB + p * 9216 + (row * 72 + ch * 8) * 2) = kr;
    *(LAS u32x4*)(lds + NSA_VB + p * 9216 + (row * 72 + ch * 8) * 2) = vr;
}
__device__ __forceinline__ float max3f(float a, float b, float c) { float r; asm("v_max3_f32 %0, %1, %2, %3" : "=v"(r) : "v"(a), "v"(b), "v"(c)); return r; }
__device__ __forceinline__ void nsa_scores(LAS unsigned char* lds, int p, const bf16x8 (&Q)[2][2], f32x4 (&sc)[4][2], int fq, int fr) {
    bf16x8 K[4][2];
#pragma unroll
    for (int kt = 0; kt < 4; ++kt) { const LAS unsigned char* kp = lds + NSA_KB + p * 9216 + ((16 * kt + fr) * 72 + 8 * fq) * 2; K[kt][0] = *(const LAS bf16x8*)kp; K[kt][1] = *(const LAS bf16x8*)(kp + 64); }
    __builtin_amdgcn_sched_barrier(0);
#pragma unroll
    for (int kt = 0; kt < 4; ++kt)
#pragma unroll
        for (int qg = 0; qg < 2; ++qg) { f32x4 c = (f32x4){0.f, 0.f, 0.f, 0.f};
            c = __builtin_amdgcn_mfma_f32_16x16x32_bf16(K[kt][0], Q[qg][0], c, 0, 0, 0); c = __builtin_amdgcn_mfma_f32_16x16x32_bf16(K[kt][1], Q[qg][1], c, 0, 0, 0); sc[kt][qg] = c; }
}
template <int MODE>
__device__ __forceinline__ bool nsa_allowed(int kidx, int t, int kb, unsigned long long selm) {
    if (MODE == 0) return (16 * kidx + 31 <= t) && (kidx < NCMP);
    if (MODE == 1) return (kidx <= t) && ((selm >> kb) & 1ull);
    return (kidx <= t) && (kidx + 512 > t);
}
template <int MODE, int MM>
__device__ __forceinline__ void nsa_tile_compute(LAS unsigned char* lds, int p, int kb, const bf16x8 (&Q)[2][2], const int (&tq)[2], const unsigned long long (&selm)[2],
                                                 float (&m_run)[2], float (&l_run)[2], f32x4 (&O)[4][2], int fq, int fr) {
    f32x4 sc[4][2];
    nsa_scores(lds, p, Q, sc, fq, fr);
    const float SC = 0.125f * 1.4426950408889634f;
    bf16x8 P[2][2]; float alpha[2];
#pragma unroll
    for (int qg = 0; qg < 2; ++qg) {
        float mx = -1e30f; bool tok_ok = true;
        if (MM == 2) {
#pragma unroll
            for (int kt = 0; kt < 4; ++kt)
#pragma unroll
                for (int r = 0; r < 4; ++r) { const int kidx = kb * 64 + 16 * kt + 4 * fq + r;
                    const float v = nsa_allowed<MODE>(kidx, tq[qg], kb, selm[qg]) ? sc[kt][qg][r] * SC : -1e30f; sc[kt][qg][r] = v; mx = fmaxf(mx, v); }
        } else {
#pragma unroll
            for (int kt = 0; kt < 4; ++kt) { sc[kt][qg] = sc[kt][qg] * SC;
                mx = fmaxf(fmaxf(mx, sc[kt][qg][0]), sc[kt][qg][1]); mx = fmaxf(fmaxf(mx, sc[kt][qg][2]), sc[kt][qg][3]); }
            if (MM == 1) { tok_ok = (selm[qg] >> kb) & 1ull; mx = tok_ok ? mx : -1e30f; }
        }
        mx = fmaxf(mx, __shfl_xor(mx, 16)); mx = fmaxf(mx, __shfl_xor(mx, 32));
        const float mn = fmaxf(m_run[qg], mx); alpha[qg] = __builtin_amdgcn_exp2f(m_run[qg] - mn); m_run[qg] = mn;
        const float msub = (MM == 1 && !tok_ok) ? 1e30f : mn;
        float ls; float pv[4][4];
        if (MM == 2) { ls = 0.f;
#pragma unroll
            for (int kt = 0; kt < 4; ++kt)
#pragma unroll
                for (int r = 0; r < 4; ++r) { const float sv = sc[kt][qg][r]; const float e = (sv > -1e29f) ? __builtin_amdgcn_exp2f(sv - mn) : 0.f; pv[kt][r] = e; ls += e; }
        } else { const f32x2 m2 = {msub, msub}; f32x2 l2 = {0.f, 0.f};
#pragma unroll
            for (int kt = 0; kt < 4; ++kt)
#pragma unroll
                for (int h = 0; h < 2; ++h) { const f32x2 t = (f32x2){sc[kt][qg][2 * h], sc[kt][qg][2 * h + 1]} - m2; f32x2 e; e.x = __builtin_amdgcn_exp2f(t.x); e.y = __builtin_amdgcn_exp2f(t.y);
                    pv[kt][2 * h] = e.x; pv[kt][2 * h + 1] = e.y; l2 = l2 + e; }
            ls = l2.x + l2.y; }
        l_run[qg] = l_run[qg] * alpha[qg] + ls;
#pragma unroll
        for (int s = 0; s < 2; ++s) { u32x4 w; w.x = pg8::cvt_pk_bf16(pv[2 * s][0], pv[2 * s][1]); w.y = pg8::cvt_pk_bf16(pv[2 * s][2], pv[2 * s][3]); w.z = pg8::cvt_pk_bf16(pv[2 * s + 1][0], pv[2 * s + 1][1]); w.w = pg8::cvt_pk_bf16(pv[2 * s + 1][2], pv[2 * s + 1][3]);
            P[qg][s] = __builtin_bit_cast(bf16x8, w); }
    }
    if (!__all(alpha[0] == 1.0f && alpha[1] == 1.0f)) {
#pragma unroll
        for (int qg = 0; qg < 2; ++qg)
#pragma unroll
            for (int dt = 0; dt < 4; ++dt) O[dt][qg] = O[dt][qg] * alpha[qg];
    }
    bf16x8 V[4][2];
#pragma unroll
    for (int dt = 0; dt < 4; ++dt)
#pragma unroll
        for (int s = 0; s < 2; ++s) V[dt][s] = *(const LAS bf16x8*)(lds + NSA_VB + p * 9216 + ((16 * dt + fr) * 72 + 32 * s + 8 * fq) * 2);
    __builtin_amdgcn_sched_barrier(0);
#pragma unroll
    for (int dt = 0; dt < 4; ++dt)
#pragma unroll
        for (int s = 0; s < 2; ++s) {
#pragma unroll
            for (int qg = 0; qg < 2; ++qg) O[dt][qg] = __builtin_amdgcn_mfma_f32_16x16x32_bf16(V[dt][s], P[qg][s], O[dt][qg], 0, 0, 0);
        }
}

template <int MODE>
__device__ __forceinline__ void nsa_branch(LAS unsigned char* lds, const NsaTileSrc& S, int kb_lo, int kb_hi, int full_lo, int full_hi, unsigned long long tilemask, const bf16x8 (&Q)[2][2], const int (&tq)[2],
                                           const unsigned long long (&selm)[2], const float (&gate)[2], const bool first, float (&m_out)[2], float (&l_out)[2], int tid, int fq, int fr) {
    float m_run[2] = {-1e30f, -1e30f}, l_run[2] = {0.f, 0.f}; f32x4 O[4][2];
#pragma unroll
    for (int dt = 0; dt < 4; ++dt)
#pragma unroll
        for (int qg = 0; qg < 2; ++qg) O[dt][qg] = (f32x4){0.f, 0.f, 0.f, 0.f};
#define NSA_NEXT(x) ({ int _n = (x) + 1; while (_n <= kb_hi && !((tilemask >> _n) & 1ull)) ++_n; _n; })
#define NSA_COMPUTE(p_, t_) do { if (MODE != 0 && (t_) >= full_lo && (t_) <= full_hi) nsa_tile_compute<MODE, (MODE == 1 ? 1 : 0)>(lds, p_, t_, Q, tq, selm, m_run, l_run, O, fq, fr); \
        else nsa_tile_compute<MODE, 2>(lds, p_, t_, Q, tq, selm, m_run, l_run, O, fq, fr); } while (0)
    int t0 = kb_lo; while (t0 <= kb_hi && !((tilemask >> t0) & 1ull)) ++t0;
    if (t0 <= kb_hi) {
        u32x4 ka, va, kb_, vb_; int p = 0;
        asm volatile("" :: "v"(Q[0][0]), "v"(Q[0][1]), "v"(Q[1][0]), "v"(Q[1][1]));
        VM_WAIT();
        nsa_tile_load_async(S, t0, tid, ka, va); nsa_tile_wait<0>(ka, va); nsa_tile_store(lds, 0, tid, ka, va);
        int t1 = NSA_NEXT(t0);
        nsa_tile_load_async(S, t1 <= kb_hi ? t1 : t0, tid, kb_, vb_);
        __syncthreads();
        for (;;) {
            const int t2 = t1 <= kb_hi ? NSA_NEXT(t1) : t1;
            nsa_tile_load_async(S, t2 <= kb_hi ? t2 : t0, tid, ka, va);
            NSA_COMPUTE(p, t0);
            const int p1 = p == 2 ? 0 : p + 1;
            nsa_tile_wait<2>(kb_, vb_); nsa_tile_store(lds, p1, tid, kb_, vb_);
            __syncthreads();
            if (t1 > kb_hi) break;
            const int t3 = t2 <= kb_hi ? NSA_NEXT(t2) : t2;
            nsa_tile_load_async(S, t3 <= kb_hi ? t3 : t0, tid, kb_, vb_);
            NSA_COMPUTE(p1, t1);
            const int p2 = p1 == 2 ? 0 : p1 + 1;
            nsa_tile_wait<2>(ka, va); nsa_tile_store(lds, p2, tid, ka, va);
            __syncthreads();
            if (t2 > kb_hi) break;
            t0 = t2; t1 = t3; p = p2;
        }
        nsa_tile_wait<0>(ka, va); nsa_tile_wait<0>(kb_, vb_);
    }
#undef NSA_NEXT
#undef NSA_COMPUTE
#pragma unroll
    for (int qg = 0; qg < 2; ++qg) { float l = l_run[qg]; l += __shfl_xor(l, 16); l += __shfl_xor(l, 32); l_out[qg] = l; m_out[qg] = m_run[qg];
        const float sc = l > 0.f ? gate[qg] / l : 0.f;
        LAS float* ot = (LAS float*)(lds + NSA_OT) + tid;
#pragma unroll
        for (int dt = 0; dt < 4; ++dt)
#pragma unroll
            for (int r = 0; r < 4; ++r) { LAS float* pp = ot + ((dt * 2 + qg) * 4 + r) * 512; const float v = O[dt][qg][r] * sc; *pp = first ? v : (*pp + v); } }
}

__device__ __forceinline__ void nsa_item(const Args& a, LAS unsigned char* lds, int b, int g, int T) {
    unsigned char* ws = ws_of(a); const int tid = opaque_tid(), lane = tid & 63, wave = __builtin_amdgcn_readfirstlane(tid >> 6), fq = lane >> 4, fr = lane & 15;
    const bf16* z = (const bf16*)(ws + WS_Z);
    const int head = g * 4 + (fr & 3);
    int tq[2], mq[2]; bf16x8 Qraw[2][2]; float gt[2][3];
#pragma unroll
    for (int qg = 0; qg < 2; ++qg) { const int tl = 8 * wave + 4 * qg + (fr >> 2); tq[qg] = T * 64 + tl; mq[qg] = b * SEQ + tq[qg];
#pragma unroll
        for (int ks = 0; ks < 2; ++ks) Qraw[qg][ks] = ld_bf8(z + (size_t)mq[qg] * ZLD + ZC_Q + head * 64 + 32 * ks + 8 * fq);
#pragma unroll
        for (int br = 0; br < 3; ++br) gt[qg][br] = sigmoidf_(bf2f(z[(size_t)mq[qg] * ZLD + ZC_GT + head * 3 + br])); }
    if (tid < 64) { ((LAS unsigned long long*)(lds + NSA_SELM))[tid] = 0ull; if (tid < 2) ((LAS unsigned*)(lds + NSA_UNI))[tid] = 0u; }
    const unsigned long long nosel[2] = {0ull, 0ull};
    NsaTileSrc SC_; SC_.kbase = (const bf16*)(ws + WS_KCMP) + (size_t)(b * 2 + g) * 256 * 64; SC_.kld = 64; SC_.vbase = (const bf16*)(ws + WS_VCMPT) + (size_t)(b * 2 + g) * 64 * 256; SC_.vld = 256;
    float mc[2], lc[2];
    { float gc[2] = {gt[0][0], gt[1][0]};
      nsa_branch<0>(lds, SC_, 0, 3, 1, 0, ~0ull, Qraw, tq, nosel, gc, true, mc, lc, tid, fq, fr); }
    {
        LAS float* imp = (LAS float*)(lds + NSA_IMP);
        float carry[2] = {0.f, 0.f}; const float SCL = 0.125f * 1.4426950408889634f;
        float invl[2] = {lc[0] > 0.f ? 1.0f / lc[0] : 0.f, lc[1] > 0.f ? 1.0f / lc[1] : 0.f};
        for (int kb = 0; kb < 4; ++kb) {
            { const int row = tid >> 3, ch = tid & 7; *(LAS u32x4*)(lds + NSA_KB + (row * 72 + ch * 8) * 2) = *(const u32x4*)(SC_.kbase + (size_t)(kb * 64 + row) * 64 + ch * 8); }
            __syncthreads();
            f32x4 sc[4][2]; nsa_scores(lds, 0, Qraw, sc, fq, fr);
#pragma unroll
            for (int kt = 0; kt < 4; ++kt)
#pragma unroll
                for (int qg = 0; qg < 2; ++qg) { float pn[4];
#pragma unroll
                    for (int r = 0; r < 4; ++r) { const int kidx = kb * 64 + 16 * kt + 4 * fq + r; const bool al = nsa_allowed<0>(kidx, tq[qg], kb, 0ull);
                        pn[r] = al ? __builtin_amdgcn_exp2f(sc[kt][qg][r] * SCL - mc[qg]) * invl[qg] : 0.f; }
                    const float y = __shfl(pn[3], (lane + 48) & 63);
                    float v = (pn[0] + pn[1]) + (pn[2] + pn[3]) + (fq == 0 ? carry[qg] : y); carry[qg] = y;
                    v += __shfl_xor(v, 1); v += __shfl_xor(v, 2);
                    if ((fr & 3) == 0) imp[(8 * wave + 4 * qg + (fr >> 2)) * 64 + 16 * kb + 4 * kt + fq] = v; }
            __syncthreads();
        }
    }
    {
        const LAS float* imp = (const LAS float*)(lds + NSA_IMP);
        const int tl = tid >> 3, part = tid & 7; float vm[8]; int cnt[8];
        { const f32x4 x0 = *(const LAS f32x4*)(imp + tl * 64 + part * 8), x1 = *(const LAS f32x4*)(imp + tl * 64 + part * 8 + 4);
          const float xx[8] = {x0.x, x0.y, x0.z, x0.w, x1.x, x1.y, x1.z, x1.w};
#pragma unroll
          for (int j = 0; j < 8; ++j) { const int mi = part * 8 + j; const bool valid = mi <= T; const bool forced = (mi == 0) || (mi == T) || (mi == T - 1);
              vm[j] = valid ? xx[j] + (forced ? 1e4f : 0.f) : -1e4f; cnt[j] = 0; } }
        for (int q4 = 0; q4 < 16; ++q4) { const f32x4 x = *(const LAS f32x4*)(imp + tl * 64 + 4 * q4); const float xq[4] = {x.x, x.y, x.z, x.w};
#pragma unroll
            for (int i = 0; i < 4; ++i) { const int q = 4 * q4 + i; const bool valid = q <= T; const bool forced = (q == 0) || (q == T) || (q == T - 1);
                const float vq = valid ? xq[i] + (forced ? 1e4f : 0.f) : -1e4f;
#pragma unroll
                for (int j = 0; j < 8; ++j) { const int mi = part * 8 + j; cnt[j] += (vq > vm[j] || (vq == vm[j] && q < mi)) ? 1 : 0; } } }
        unsigned bits = 0u;
#pragma unroll
        for (int j = 0; j < 8; ++j) if (cnt[j] < 16 && vm[j] > -5000.f) bits |= 1u << j;
        atomicOr((unsigned*)(lds + NSA_SELM) + tl * 2 + (part >> 2), bits << (8 * (part & 3)));
        atomicOr((unsigned*)(lds + NSA_UNI) + (part >> 2), bits << (8 * (part & 3)));
    }
    __syncthreads();
    bf16x8 Qrot[2][2];
#pragma unroll
    for (int qg = 0; qg < 2; ++qg)
#pragma unroll
        for (int ks = 0; ks < 2; ++ks) Qrot[qg][ks] = ld_bf8((const bf16*)(ws + WS_QROT) + (size_t)mq[qg] * 512 + head * 64 + 32 * ks + 8 * fq);
    unsigned long long selm[2], uni;
    { const LAS unsigned long long* sm = (const LAS unsigned long long*)(lds + NSA_SELM); selm[0] = sm[8 * wave + (fr >> 2)]; selm[1] = sm[8 * wave + 4 + (fr >> 2)]; const LAS unsigned* up = (const LAS unsigned*)(lds + NSA_UNI); uni = ((unsigned long long)(unsigned)__builtin_amdgcn_readfirstlane(up[1]) << 32) | (unsigned)__builtin_amdgcn_readfirstlane(up[0]); }
    { NsaTileSrc SS; SS.kbase = (const bf16*)(ws + WS_KSR) + (size_t)b * SEQ * 128 + g * 64; SS.kld = 128; SS.vbase = (const bf16*)(ws + WS_VST) + (size_t)(b * 2 + g) * 64 * SEQ; SS.vld = SEQ;
      float gs[2] = {gt[0][1], gt[1][1]}, mo[2], lo[2];
      nsa_branch<1>(lds, SS, 0, T, 0, T - 1, uni, Qrot, tq, selm, gs, false, mo, lo, tid, fq, fr); }
    { NsaTileSrc SW; SW.kbase = (const bf16*)(ws + WS_KWR) + (size_t)b * SEQ * 128 + g * 64; SW.kld = 128; SW.vbase = (const bf16*)(ws + WS_VWT) + (size_t)(b * 2 + g) * 64 * SEQ; SW.vld = SEQ;
      float gw_[2] = {gt[0][2], gt[1][2]}, mo[2], lo[2]; const int lo_kb = T >= 8 ? T - 8 : 0;
      nsa_branch<2>(lds, SW, lo_kb, T, T - 7, T - 1, ~0ull, Qrot, tq, nosel, gw_, false, mo, lo, tid, fq, fr); }
    bf16* ycat = (bf16*)(ws + WS_YCAT);
#pragma unroll
    for (int qg = 0; qg < 2; ++qg)
#pragma unroll
        for (int dt = 0; dt < 4; ++dt) { const LAS float* ot = (const LAS float*)(lds + NSA_OT) + tid + ((dt * 2 + qg) * 4) * 512;
            u32x2 w; w.x = pk2(ot[0], ot[512]); w.y = pk2(ot[1024], ot[1536]);
            *(u32x2*)(ycat + (size_t)mq[qg] * DM + 512 + head * 64 + 16 * dt + 4 * fq) = w; }
}

struct MoeOrder {
    const char* A; const char* W; size_t estride; int K, nct, G, c; int tst[9];
    __device__ bool next(int i, pg8::Unit& u) const {
        const long L = (long)i * G + c; if (L >= (long)tst[8] * nct) return false;
        const int rt = (int)(L / nct), ct = (int)(L % nct); int e = 0;
#pragma unroll
        for (int j = 1; j < 8; ++j) e += (rt >= tst[j]) ? 1 : 0;
        u.pm = rt; u.pn = ct; u.aux = e; return true;
    }
    __device__ __forceinline__ const char* abase(const pg8::Unit& u) const { return A + (size_t)u.pm * ((size_t)256 * K * 2); }
    __device__ __forceinline__ const char* bbase(const pg8::Unit& u) const { return W + (size_t)u.aux * estride + (size_t)u.pn * ((size_t)256 * K * 2); }
};
__device__ __forceinline__ void moe_order_init(MoeOrder& S, const Args& a, int rank, const void* A, const void* W, size_t estride, int K, int nct) {
    S.A = (const char*)A; S.W = (const char*)W; S.estride = estride; S.K = K; S.nct = nct; S.G = gridDim.x; S.c = blockIdx.x;
    const int* t = (const int*)(ws_of(a) + WS_SLOT + SL_TST) + rank * 16;
#pragma unroll
    for (int j = 0; j < 9; ++j) S.tst[j] = __builtin_amdgcn_readfirstlane(t[j]);
}
__device__ __forceinline__ void moe_gather(const Args& a, int rb, int r) {
    unsigned char* ws = ws_of(a); const int tid = opaque_tid();
    const int* toks = (const int*)(ws + WS_SLOT + SL_TOKS);
    const u32x4* hn = (const u32x4*)(ws + WS_HN); u32x4* hns = (u32x4*)(ws + WS_HNS);
    for (int i = tid; i < 64 * 128; i += NTHR) { const int tl = i >> 7, ch = i & 127, m = rb * 64 + tl; const int slot = toks[2 * m + r];
        hns[(size_t)slot * 128 + ch] = hn[(size_t)m * 128 + ch]; }
}
__device__ __forceinline__ void phase_moe_assign(const Args& a, LAS unsigned char* lds) {
    unsigned char* ws = ws_of(a); const int tid = opaque_tid(), lane = tid & 63, wave = __builtin_amdgcn_readfirstlane(tid >> 6);
    LAS int* cn = (LAS int*)lds;
    LAS int* tot = cn + 4096; LAS int* base = tot + 16; LAS int* pre = base + 16;
    const int* bcnt = (const int*)(ws + WS_SLOT + SL_BCNT);
    for (int i = tid; i < 4096; i += NTHR) cn[i] = bcnt[i];
    __syncthreads();
    if (tid < 16) { int s = 0; for (int bb = 0; bb < 256; ++bb) s += cn[bb * 16 + tid]; tot[tid] = s; }
    __syncthreads();
    if (tid < 2) { int run = 0; int* tstg = (int*)(ws + WS_SLOT + SL_TST) + tid * 16;
        for (int e = 0; e < 8; ++e) { base[tid * 8 + e] = run * 256; if (blockIdx.x == 0) tstg[e] = run; run += (tot[tid * 8 + e] + 255) >> 8; }
        if (blockIdx.x == 0) tstg[8] = run; }
    __syncthreads();
    int* stok = (int*)(ws + WS_SLOT + SL_TOK); float* sgate = (float*)(ws + WS_SLOT + SL_GATE);
    if (blockIdx.x == 0) {
        for (int grp = 0; grp < 16; ++grp) { const int r = grp >> 3, lo = base[grp] + tot[grp], hi = base[grp] + (((tot[grp] + 255) >> 8) << 8);
            for (int s = lo + tid; s < hi; s += NTHR) { stok[r * MOE_SLOTS + s] = -1; sgate[r * MOE_SLOTS + s] = 0.f; } }
    }
    const int* te = (const int*)(ws + WS_SLOT + SL_TOKE); const float* tg = (const float*)(ws + WS_SLOT + SL_TOKG); int* toks = (int*)(ws + WS_SLOT + SL_TOKS);
    for (int rb = blockIdx.x; rb < MT / 64; rb += gridDim.x) {
        __syncthreads();
        if (tid < 16) { int s = 0; for (int bb = 0; bb < rb; ++bb) s += cn[bb * 16 + tid]; pre[tid] = s; }
        __syncthreads();
        if (wave == 0) { const int m = rb * 64 + lane;
#pragma unroll
            for (int r = 0; r < 2; ++r) { const int e = te[2 * m + r]; int slot = 0;
#pragma unroll
                for (int ee = 0; ee < 8; ++ee) { const unsigned long long mk = __ballot(e == ee); const int rk = __popcll(mk & ((1ull << lane) - 1ull)); if (e == ee) slot = base[r * 8 + ee] + pre[r * 8 + ee] + rk; }
                stok[r * MOE_SLOTS + slot] = m; sgate[r * MOE_SLOTS + slot] = tg[2 * m + r]; toks[2 * m + r] = slot; } }
        asm volatile("s_waitcnt vmcnt(0)" ::: "memory");
        __syncthreads();
        moe_gather(a, rb, 0);
    }
}
__device__ __forceinline__ void moe_convert_weights(const Args& a, LAS unsigned char* lds) {
    const int tid = opaque_tid(), lane = tid & 63, wave = __builtin_amdgcn_readfirstlane(tid >> 6);
    const int gw = blockIdx.x * NWAVES + wave, NGW = gridDim.x * NWAVES; LAS float* scr = (LAS float*)(lds + 1024 + wave * 16384);
    for (int e = 0; e < NEXP; ++e) {
        conv_matrix(INF(IN_MW1) + (size_t)e * DM * DFF, DM, DFF, (bf16*)(ws_of(a) + WS_MW13) + (size_t)e * 5632 * DM, 1, gw, NGW, scr, lane, INF(IN_GFFN) + DM);
        conv_matrix(INF(IN_MW3) + (size_t)e * DM * DFF, DM, DFF, (bf16*)(ws_of(a) + WS_MW13) + (size_t)e * 5632 * DM, 2, gw, NGW, scr, lane, INF(IN_GFFN) + DM);
        conv_matrix(INF(IN_MW2) + (size_t)e * DFF * DM, DFF, DM, (bf16*)(ws_of(a) + WS_MW2) + (size_t)e * DM * DFF, 0, gw, NGW, scr, lane);
    }
}

template <class Sched>
__device__ __forceinline__ void fill_rs_table(LAS unsigned char* lds, const Sched& S, const float* rss, const int* slot_tok) {
    const int tid = opaque_tid(); LAS float* tab = (LAS float*)(lds + RSTAB_OFF);
    const int rl = tid & 255;
    for (int i = tid >> 8; i < RSTAB_MAX_UNITS; i += 2) { pg8::Unit u; if (!S.next(i, u)) break;
        int row = u.pm * 256 + rl; if (slot_tok) { row = slot_tok[row]; row = row < 0 ? 0 : row; }
        const f32x4* p = (const f32x4*)(rss + (size_t)row * 16); const f32x4 a = p[0], b = p[1], c = p[2], d = p[3];
        const float sm = ((a[0] + a[1]) + (a[2] + a[3])) + ((b[0] + b[1]) + (b[2] + b[3])) + (((c[0] + c[1]) + (c[2] + c[3])) + ((d[0] + d[1]) + (d[2] + d[3])));
        tab[i * 256 + rl] = 1.0f / sqrtf(sm * (1.0f / 1024.0f) + 1e-6f); }
    __syncthreads();
}

constexpr int NPL = 15, NPHASES = 1 + 2 * NPL;
__host__ __device__ constexpr bool phase_empty(int k) { if (k < 1) return false; const int l = (k - 1) / NPL, j = (k - 1) % NPL; if (j == 12) return true; if (l == 0) return j == 6 || (j >= 9 && j <= 11) || j == 14; return false; }

#ifndef PHSEL
#define PHSEL -1
#endif
#ifndef REP_GIN
#define REP_GIN 1
#endif
#ifndef REP_PREP
#define REP_PREP 1
#endif
#ifndef REP_NSA
#define REP_NSA 1
#endif
#ifndef REP_SCAN
#define REP_SCAN 1
#endif
#ifndef REP_GMLP
#define REP_GMLP 1
#endif
#ifndef REP_F1
#define REP_F1 1
#endif
#ifndef REP_PRO
#define REP_PRO 1
#endif
#ifndef REP_POST
#define REP_POST 1
#endif
#ifndef REP_CHAIN
#define REP_CHAIN 1
#endif
#define IN(k) (lo <= (k) && (k) < hi)
#define INL(j) ((PHSEL == -1 || PHSEL == (j)) && IN(pb + (j)))
#define SEAM(k) do { if ((k) + 1 < hi) xcd_barrier(bar); } while (0)
#define WSP ({ unsigned long long _z = 0; asm volatile("" : "+s"(_z)); wsbase_ + _z; })

template <int L>
__device__ __forceinline__ void run_layer(const Args& a, LAS unsigned char* lds, volatile LAS unsigned* MISC, const XcdBarrier& bar, const int lo, const int hi) {
    constexpr int l = L;
    unsigned char* const wsbase_ = a.ws;
    const int G = gridDim.x, bx = blockIdx.x, tid = opaque_tid();
        const int pb = 1 + l * NPL;
#define ws WSP
#define ctl ((unsigned*)WSP)
#define hbA ((bf16*)(WSP + WS_HN))
#define hbB ((bf16*)(WSP + WS_HB2))
#define rssA ((float*)(WSP + WS_RSS))
#define rssB ((float*)(WSP + WS_RSS) + (size_t)MT * 16)
#define hb_in (l == 0 ? hbA : hbB)
#define rss_in (l == 0 ? rssA : rssB)
        if (INL(0)) for (int rep = 0; rep < REP_GIN; ++rep) { pg8::StaticOrder S; S.init(hb_in, (bf16*)(ws + WS_WIN) + (size_t)l * ZLD * DM, MT, ZLD, DM, G, bx);
            fill_rs_table(lds, S, rss_in, nullptr); pg8::EpiBf16Store E{(bf16*)(ws + WS_Z), ZLD, (const LAS float*)(lds + RSTAB_OFF)}; pg8::gemm_phase(lds, DM, S, E); if (rep == REP_GIN - 1) SEAM(pb + 0); }
        if (INL(1)) { for (int rep = 0; rep < REP_PREP; ++rep) phase_prep(a, l, lds); SEAM(pb + 1); }
        if (INL(2)) {
#ifndef NO_SCAN
            for (int rep = 0; rep < REP_SCAN; ++rep) for (int it = bx; it < 16 * NSEG; it += G) rwkv_scan_seg(a, lds, it & 15, it >> 4);
#endif
#ifndef NO_NSA
            {
                const unsigned xcc = xb_xcc_id() & 7u;
                for (unsigned k = 0; k < 8; ++k) { const unsigned qi = (xcc + k) & 7u; unsigned* qn = ctl + CW_Q + 64 * (4 + l * 8 + qi);
                    for (;;) { __syncthreads(); if (tid == 0) MISC[16] = __hip_atomic_fetch_add(qn, 1u, __ATOMIC_RELAXED, __HIP_MEMORY_SCOPE_AGENT); __syncthreads();
                        const int it = (int)MISC[16]; if (it >= 64 * REP_NSA) break; nsa_item(a, lds, (int)(qi >> 1), (int)(qi & 1), 63 - (it & 63)); } }
            }
#endif
            SEAM(pb + 2); }
        if (INL(3)) {
            for (int rep = 0; rep < REP_CHAIN; ++rep) for (int bh = bx; bh < 16; bh += G) rwkv_chain(a, lds, bh);
            unsigned* qg = ctl + CW_Q + 64 * (l * 2 + 1);
#ifndef NO_GMLP
            for (;;) { __syncthreads(); if (tid == 0) MISC[16] = __hip_atomic_fetch_add(qg, 1u, __ATOMIC_RELAXED, __HIP_MEMORY_SCOPE_AGENT); __syncthreads();
                int it = (int)MISC[16]; if (it >= 512 * REP_GMLP) break; it &= 511; gmlp_item(a, l, lds, it >> 7, (it >> 2) & 31, it & 3); }
#endif
            SEAM(pb + 3); }
        if (INL(4)) { for (int rep = 0; rep < REP_POST; ++rep) for (int it = bx; it < 16 * 64; it += G) rwkv_post_item(a, l, lds, it & 15, it >> 4); SEAM(pb + 4); }
        if (INL(5)) { pg8::StaticOrder S; S.init(ws + WS_YCAT, (bf16*)(ws + WS_WOUT) + (size_t)l * DM * DM, MT, DM, DM, G, bx);
            pg8::EpiResAdd E{a.out, DM, hbA, rssA}; pg8::gemm_phase(lds, DM, S, E); SEAM(pb + 5); }
        if (l == 0) {
            if (INL(7)) { pg8::StaticOrder S; S.init(hbA, ws + WS_W13, MT, 2 * DFF, DM, G, bx); fill_rs_table(lds, S, rssA, nullptr); pg8::EpiSwiglu E{(bf16*)(ws + WS_ACT), DFF, (const LAS float*)(lds + RSTAB_OFF)}; pg8::gemm_phase(lds, DM, S, E); SEAM(pb + 7); }
            if (INL(8)) { pg8::StaticOrder S; S.init(ws + WS_ACT, ws + WS_W2, MT, DM, DFF, G, bx); pg8::EpiResAdd E{a.out, DM, hbA, rssA}; pg8::gemm_phase(lds, DFF, S, E); if (pb + 13 < hi) xcd_barrier(bar); }
        } else {
            if (INL(6)) { for (int rep = 0; rep < REP_PRO; ++rep) { moe_convert_weights(a, lds); __syncthreads(); } phase_norm<1>(a, lds, INF(IN_GFFN) + DM); SEAM(pb + 6); }
            if (INL(7)) { phase_moe_assign(a, lds); SEAM(pb + 7); }
            if (INL(8)) { MoeOrder S; moe_order_init(S, a, 0, ws + WS_HNS, ws + WS_MW13, (size_t)5632 * DM * 2, DM, 22);
                fill_rs_table(lds, S, rssA, (const int*)(ws + WS_SLOT + SL_TOK)); pg8::EpiSwiglu E{(bf16*)(ws + WS_ACTM), DFF, (const LAS float*)(lds + RSTAB_OFF)}; pg8::gemm_phase(lds, DM, S, E); SEAM(pb + 8); }
            if (INL(9)) { for (int rb = bx; rb < MT / 64; rb += G) moe_gather(a, rb, 1);
                MoeOrder S; moe_order_init(S, a, 0, ws + WS_ACTM, ws + WS_MW2, (size_t)DM * DFF * 2, DFF, 4);
                pg8::EpiMoe2<false> E{a.out, (const int*)(ws + WS_SLOT + SL_TOK), (const float*)(ws + WS_SLOT + SL_GATE), DM, hbA, rssA}; pg8::gemm_phase(lds, DFF, S, E); SEAM(pb + 9); }
            if (INL(10)) { MoeOrder S; moe_order_init(S, a, 1, ws + WS_HNS, ws + WS_MW13, (size_t)5632 * DM * 2, DM, 22);
                fill_rs_table(lds, S, rssA, (const int*)(ws + WS_SLOT + SL_TOK) + MOE_SLOTS); pg8::EpiSwiglu E{(bf16*)(ws + WS_ACTM), DFF, (const LAS float*)(lds + RSTAB_OFF)}; pg8::gemm_phase(lds, DM, S, E); SEAM(pb + 10); }
            if (INL(11)) { MoeOrder S; moe_order_init(S, a, 1, ws + WS_ACTM, ws + WS_MW2, (size_t)DM * DFF * 2, DFF, 4);
                pg8::EpiMoe2<true> E{a.out, (const int*)(ws + WS_SLOT + SL_TOK) + MOE_SLOTS, (const float*)(ws + WS_SLOT + SL_GATE) + MOE_SLOTS, DM, hbA, rssA}; pg8::gemm_phase(lds, DFF, S, E);
                if (pb + 13 < hi) xcd_barrier(bar); }
        }
        if (INL(13)) {
            { pg8::StaticOrder S; S.init((bf16*)(ws + WS_PB) + (size_t)l * MT * 256, (bf16*)(ws + WS_WP) + (size_t)l * DM * 256, MT, DM, 256, G, bx); pg8::EpiBf16Store E{(bf16*)(ws + WS_PP), DM, nullptr}; pg8::gemm_phase(lds, 256, S, E); }
            { pg8::StaticOrder S; S.init(hbA, (bf16*)(ws + WS_WG) + (size_t)l * DM * DM, MT, DM, DM, G, bx); fill_rs_table(lds, S, rssA, nullptr); pg8::EpiPle E{a.out, ws, (const LAS float*)(lds + RSTAB_OFF), WS_PP, WS_HB2, WS_RSS + (size_t)MT * 16 * 4}; pg8::gemm_phase(lds, DM, S, E); }
            SEAM(pb + 13); }
        if (INL(14)) { if (l == 1) phase_norm<2>(a, lds, INF(IN_GFINAL)); }

}

#undef ws
#undef ctl
#undef hbA
#undef hbB
#undef rssA
#undef rssB
#undef hb_in
#undef rss_in

__global__ void __launch_bounds__(NTHR, 2) hybrid_fwd(Args a) {
    extern __shared__ __attribute__((aligned(16))) unsigned char lds_raw[];
    LAS unsigned char* lds = (LAS unsigned char*)lds_raw;
    volatile LAS unsigned* MISC = (volatile LAS unsigned*)(lds + MISC_OFF);
    const int tid = opaque_tid();
    unsigned char* ws = ws_of(a); unsigned* ctl = (unsigned*)(ws + WS_CTL);
    for (int u = tid; u < (LDS_BYTES - MISC_OFF) / 4; u += NTHR) MISC[u] = 0u;
    __syncthreads();
    if (tid < N_INPUTS) *(LAS unsigned long long*)(lds + PTAB_OFF + 8 * tid) = (unsigned long long)a.in[tid];
    __syncthreads();
    const int lo = a.ph_lo, hi = a.ph_hi;
    const bool multi = (hi - lo) > 1;
    XcdBarrier bar; bar.bar = ctl + CW_BAR; bar.x = 0; bar.st = nullptr;
    if (multi) bar = xcd_barrier_post(ctl + CW_BAR, MISC + 8);
    const int G = gridDim.x, bx = blockIdx.x;

    if ((PHSEL == -1 || PHSEL == 100) && IN(0)) { for (int rep = 0; rep < REP_PRO; ++rep) { phase_prologue(a, lds); __syncthreads(); } SEAM(0); }

    run_layer<0>(a, lds, MISC, bar, lo, hi);
    run_layer<1>(a, lds, MISC, bar, lo, hi);
}

extern "C" void kernel_launch(void* const* d_in, const int* in_sizes, int n_in, void* d_out, int out_size, void* d_ws, size_t ws_size, hipStream_t stream) {
    static int grid = 0;
    if (grid == 0) {
        if (n_in != N_INPUTS || out_size != MT * DM || ws_size < WS_END) { fprintf(stderr, "kernel_launch: unexpected shapes (n_in %d, out %d, ws %zu)\n", n_in, out_size, ws_size); grid = -1; return; }
        int dev = 0, cus = 0, per_cu = 0;
        if (hipGetDevice(&dev) != hipSuccess || hipDeviceGetAttribute(&cus, hipDeviceAttributeMultiprocessorCount, dev) != hipSuccess) { grid = -1; return; }
        if (hipFuncSetAttribute((const void*)hybrid_fwd, hipFuncAttributeMaxDynamicSharedMemorySize, LDS_BYTES) != hipSuccess) { fprintf(stderr, "kernel_launch: hipFuncSetAttribute failed\n"); grid = -1; return; }
        if (hipOccupancyMaxActiveBlocksPerMultiprocessor(&per_cu, (const void*)hybrid_fwd, NTHR, LDS_BYTES) != hipSuccess || per_cu < 1) fprintf(stderr, "kernel_launch: occupancy query reports %d\n", per_cu);
        (void)hipGetLastError();
        grid = cus;
    }
    if (grid < 0) return;
    (void)hipMemsetAsync((char*)d_ws + WS_CTL, 0, CTL_ZERO_BYTES, stream);
    Args a{};
    for (int i = 0; i < N_INPUTS; ++i) a.in[i] = d_in[i];
    a.out = (float*)d_out; a.ws = (unsigned char*)d_ws;
#if MK_ONE_LAUNCH
    a.ph_lo = 0; a.ph_hi = NPHASES;
    hipLaunchKernelGGL(hybrid_fwd, dim3(grid), dim3(NTHR), LDS_BYTES, stream, a);
#else
    for (int k = 0; k < NPHASES; ++k) { if (phase_empty(k)) continue; a.ph_lo = k; a.ph_hi = k + 1;
        hipLaunchKernelGGL(hybrid_fwd, dim3(grid), dim3(NTHR), LDS_BYTES, stream, a); }
#endif
}
```

```cpp
#include <hip/hip_runtime.h>
#include <cstdio>
#include <cstdint>

#ifndef MK_ONE_LAUNCH
#define MK_ONE_LAUNCH 1
#endif

#define LAS __attribute__((address_space(3)))
#define GAS __attribute__((address_space(1)))
typedef unsigned short bf16;
typedef short bf16x8 __attribute__((ext_vector_type(8)));
typedef float f32x4 __attribute__((ext_vector_type(4)));
typedef float f32x2 __attribute__((ext_vector_type(2)));
typedef unsigned u32x4 __attribute__((ext_vector_type(4)));
typedef unsigned u32x2 __attribute__((ext_vector_type(2)));

constexpr int NB = 4, SEQ = 4096, DM = 1024, MT = NB * SEQ;
constexpr int DIN = 2840, ZLD = 3072;
constexpr int DFF = 2816, NEXP = 8;
constexpr int ZC_U = 0, ZC_V = 256, ZC_B = 512, ZC_Q = 1536, ZC_KC = 2048, ZC_VC = 2176, ZC_KS = 2304, ZC_VS = 2432, ZC_KW = 2560, ZC_VW = 2688, ZC_GT = 2816;
constexpr int NCMP = 255;
constexpr int NWAVES = 8, NTHR = 512;

__device__ __forceinline__ unsigned f2bf(float f) { unsigned u = __builtin_bit_cast(unsigned, f); return (u + 0x7fffu + ((u >> 16) & 1u)) >> 16; }
__device__ __forceinline__ float bf2f(unsigned b) { return __builtin_bit_cast(float, b << 16); }
__device__ __forceinline__ unsigned pk2(float lo, float hi) { return f2bf(lo) | (f2bf(hi) << 16); }
__device__ __forceinline__ float bflo(unsigned w) { return __builtin_bit_cast(float, w << 16); }
__device__ __forceinline__ float bfhi(unsigned w) { return __builtin_bit_cast(float, w & 0xffff0000u); }
__device__ __forceinline__ float sigmoidf_(float x) { return 1.0f / (1.0f + __expf(-x)); }
__device__ __forceinline__ float gelu_tanh(float x) { const float u = 0.7978845608028654f * (x + 0.044715f * x * x * x); const float e = __expf(-2.0f * fabsf(u)); float t = (1.0f - e) / (1.0f + e); t = u < 0.f ? -t : t; return 0.5f * x * (1.0f + t); }
__device__ __forceinline__ float wave_sum(float v) {
#pragma unroll
    for (int o = 1; o < 64; o <<= 1) v += __shfl_xor(v, o);
    return v;
}
__device__ __forceinline__ int opaque_tid() { int t = threadIdx.x; asm volatile("" : "+v"(t)); return t; }
#define LDS_WAIT() asm volatile("s_waitcnt lgkmcnt(0)" ::: "memory")
#define VM_WAIT() asm volatile("s_waitcnt vmcnt(0)" ::: "memory")

namespace pg8 {
constexpr int BM = 256, BK = 64, HALF = 128, HTB = HALF * BK * 2  , STAGE_BYTES = 8 * HTB, NXCD = 8, WGM = 8;
__host__ __device__ __forceinline__ int lds_byte(int r, int c) { const int st = (r >> 4) * 2 + (c >> 5), rr = r & 15, cc = c & 31, ob = rr * 64 + cc * 2; return st * 1024 + (ob ^ (((ob >> 9) & 1) << 5)); }
__host__ __device__ __forceinline__ void stage_rc(int b, int& R, int& C) { const int st = b / 1024, sb = b % 1024, swz = sb ^ (((sb >> 9) & 1) << 5); R = (st >> 1) * 16 + swz / 64; C = (st & 1) * 32 + (swz % 64) / 2; }
__host__ __device__ __forceinline__ int perm32(int rho) { const int n = rho >> 4, i = rho & 15; return 8 * (i >> 2) + 4 * n + (i & 3); }

struct Unit { int pm, pn, aux; };

struct StaticOrder {
    const char* A; const char* Bt; int K; int nM, nN, nwg, G, c;
    __device__ void init(const void* A_, const void* Bt_, int M, int N, int K_, int G_, int c_) { A = (const char*)A_; Bt = (const char*)Bt_; K = K_; nM = M / BM; nN = N / BM; nwg = nM * nN; G = G_; c = c_; }
    __device__ bool next(int i, Unit& u) const {
        const long L = (long)i * G + c; if (L >= nwg) return false;
        int wgid = (int)L; { const int q = nwg / NXCD, r = nwg % NXCD, xcd = wgid % NXCD, off = wgid / NXCD; wgid = (xcd < r ? xcd * (q + 1) : r * (q + 1) + (xcd - r) * q) + off; }
        const int nig = WGM * nN, gid = wgid / nig, fm = gid * WGM, gsz = (nM - fm) < WGM ? (nM - fm) : WGM;
        u.pm = fm + ((wgid % nig) % gsz); u.pn = (wgid % nig) / gsz; u.aux = 0; return true;
    }
    __device__ __forceinline__ const char* abase(const Unit& u) const { return A + (size_t)u.pm * ((size_t)BM * K * 2); }
    __device__ __forceinline__ const char* bbase(const Unit& u) const { return Bt + (size_t)u.pn * ((size_t)BM * K * 2); }
};

__device__ __forceinline__ unsigned cvt_pk_bf16(float lo, float hi) { unsigned r; asm volatile("v_cvt_pk_bf16_f32 %0, %1, %2" : "=v"(r) : "v"(lo), "v"(hi)); return r; }

__device__ __forceinline__ float row_rs(const float* rss, int row, int fq) {
    const f32x4 p = *(const f32x4*)(rss + (size_t)row * 16 + 4 * fq); float s = (p[0] + p[1]) + (p[2] + p[3]);
    s += __shfl_xor(s, 16); s += __shfl_xor(s, 32); return 1.0f / sqrtf(s * (1.0f / 1024.0f) + 1e-6f);
}
__device__ __forceinline__ void put_hb_rss(const f32x4 (&v)[2][2], bf16* hb_row  , float* rss_row  , int fq) {
    float q = 0.f;
#pragma unroll
    for (int bj = 0; bj < 2; ++bj) { const f32x4 x = v[bj][0], y = v[bj][1];
        q += ((x[0] * x[0] + x[1] * x[1]) + (x[2] * x[2] + x[3] * x[3])) + ((y[0] * y[0] + y[1] * y[1]) + (y[2] * y[2] + y[3] * y[3]));
        u32x4 w; w.x = cvt_pk_bf16(x[0], x[1]); w.y = cvt_pk_bf16(x[2], x[3]); w.z = cvt_pk_bf16(y[0], y[1]); w.w = cvt_pk_bf16(y[2], y[3]); *(u32x4*)(hb_row + bj * HALF) = w; }
    q += __shfl_xor(q, 16); q += __shfl_xor(q, 32);
    if (fq == 0) *rss_row = q;
}
__device__ __forceinline__ void put_hb_rss4(const f32x4 (&v)[2][2], bf16* hb_row  , float* rss_row  , int fq) {
    float q = 0.f;
#pragma unroll
    for (int bj = 0; bj < 2; ++bj)
#pragma unroll
        for (int n = 0; n < 2; ++n) { const f32x4 x = v[bj][n]; q += (x[0] * x[0] + x[1] * x[1]) + (x[2] * x[2] + x[3] * x[3]);
            u32x2 w; w.x = cvt_pk_bf16(x[0], x[1]); w.y = cvt_pk_bf16(x[2], x[3]); *(u32x2*)(hb_row + bj * HALF + n * 16) = w; }
    q += __shfl_xor(q, 16); q += __shfl_xor(q, 32);
    if (fq == 0) *rss_row = q;
}
struct EpiBf16Store {
    static constexpr bool PERM = true;
    bf16* O; int ldc; const LAS float* rstab;
    __device__ __forceinline__ void operator()(const f32x4 (&acc)[2][2][4][2], const Unit& u, int ui, int wr, int wc, int fr, int fq) const {
        const int row0 = u.pm * BM + wr * 64 + fr, col0 = u.pn * BM + wc * 32 + 8 * fq;
        float rsv[2][4];
#pragma unroll
        for (int ai = 0; ai < 2; ++ai)
#pragma unroll
            for (int m = 0; m < 4; ++m) rsv[ai][m] = rstab ? rstab[ui * 256 + ai * HALF + wr * 64 + m * 16 + fr] : 1.0f;
#pragma unroll
        for (int ai = 0; ai < 2; ++ai)
#pragma unroll
            for (int m = 0; m < 4; ++m) { const int row = row0 + ai * HALF + m * 16; bf16* rowp = O + (size_t)row * ldc + col0; const float rs = rsv[ai][m];
#pragma unroll
                for (int bj = 0; bj < 2; ++bj) { const f32x4 v0 = acc[ai][bj][m][0] * rs, v1 = acc[ai][bj][m][1] * rs;
                    u32x4 w; w.x = cvt_pk_bf16(v0[0], v0[1]); w.y = cvt_pk_bf16(v0[2], v0[3]); w.z = cvt_pk_bf16(v1[0], v1[1]); w.w = cvt_pk_bf16(v1[2], v1[3]);
                    *(u32x4*)(rowp + bj * HALF) = w; } }
    }
};
struct EpiResAdd {
    static constexpr bool PERM = true;
    float* H; int ldc; bf16* hb; float* rss_out;
    __device__ __forceinline__ void operator()(const f32x4 (&acc)[2][2][4][2], const Unit& u, int ui, int wr, int wc, int fr, int fq) const {
        const int row0 = u.pm * BM + wr * 64 + fr, col0 = u.pn * BM + wc * 32 + 8 * fq;
#pragma unroll
        for (int ai = 0; ai < 2; ++ai)
#pragma unroll
            for (int m = 0; m < 4; ++m) { const int row = row0 + ai * HALF + m * 16; float* rowp = H + (size_t)row * ldc + col0; f32x4 v[2][2];
#pragma unroll
                for (int bj = 0; bj < 2; ++bj)
#pragma unroll
                    for (int n = 0; n < 2; ++n) { f32x4* p = (f32x4*)(rowp + bj * HALF + n * 4); v[bj][n] = *p + acc[ai][bj][m][n]; *p = v[bj][n]; }
                put_hb_rss(v, hb + (size_t)row * ldc + col0, rss_out + (size_t)row * 16 + u.pn * 4 + wc, fq); }
    }
};
struct EpiSwiglu {
    static constexpr bool PERM = true;
    bf16* O; int ldc; const LAS float* rstab;
    __device__ __forceinline__ void operator()(const f32x4 (&acc)[2][2][4][2], const Unit& u, int ui, int wr, int wc, int fr, int fq) const {
        const int row0 = u.pm * BM + wr * 64 + fr, col0 = u.pn * HALF + wc * 32 + 8 * fq;
#pragma unroll
        for (int ai = 0; ai < 2; ++ai)
#pragma unroll
            for (int m = 0; m < 4; ++m) { const int row = row0 + ai * HALF + m * 16; bf16* rowp = O + (size_t)row * ldc + col0;
                const float rs = rstab[ui * 256 + ai * HALF + wr * 64 + m * 16 + fr];
                float o[8];
#pragma unroll
                for (int n = 0; n < 2; ++n)
#pragma unroll
                    for (int i = 0; i < 4; ++i) { const float a = acc[ai][0][m][n][i] * rs, b = acc[ai][1][m][n][i] * rs; o[n * 4 + i] = a * b / (1.0f + __expf(-a)); }
                u32x4 w; w.x = cvt_pk_bf16(o[0], o[1]); w.y = cvt_pk_bf16(o[2], o[3]); w.z = cvt_pk_bf16(o[4], o[5]); w.w = cvt_pk_bf16(o[6], o[7]);
                *(u32x4*)rowp = w; __builtin_amdgcn_sched_barrier(0); }
    }
};
struct EpiPle {
    static constexpr bool PERM = false;
    float* H; unsigned char* ws; const LAS float* rstab; size_t off_pp, off_hb, off_rss;
    __device__ __forceinline__ void operator()(const f32x4 (&acc)[2][2][4][2], const Unit& u, int ui, int wr, int wc, int fr, int fq) const {
        const int row0 = u.pm * BM + wr * 64 + fr, col0 = u.pn * BM + wc * 32 + 4 * fq;
        const bf16* PP = (const bf16*)(ws + off_pp); bf16* hb = (bf16*)(ws + off_hb); float* rss_out = (float*)(ws + off_rss);
#pragma unroll
        for (int ai = 0; ai < 2; ++ai)
#pragma unroll
            for (int m = 0; m < 4; ++m) { const int row = row0 + ai * HALF + m * 16; const size_t off = (size_t)row * 1024 + col0; const float rs = rstab[ui * 256 + ai * HALF + wr * 64 + m * 16 + fr]; f32x4 v[2][2];
#pragma unroll
                for (int bj = 0; bj < 2; ++bj)
#pragma unroll
                    for (int n = 0; n < 2; ++n) { const size_t o2 = off + bj * HALF + n * 16; const u32x2 pw = *(const u32x2*)(PP + o2); const f32x4 a = acc[ai][bj][m][n] * rs;
                        f32x4 g; g[0] = bflo(pw.x) * sigmoidf_(a[0]); g[1] = bfhi(pw.x) * sigmoidf_(a[1]); g[2] = bflo(pw.y) * sigmoidf_(a[2]); g[3] = bfhi(pw.y) * sigmoidf_(a[3]);
                        f32x4* p = (f32x4*)(H + o2); v[bj][n] = *p + g; *p = v[bj][n]; }
                put_hb_rss4(v, hb + off, rss_out + (size_t)row * 16 + u.pn * 4 + wc, fq);
                if (m & 1) __builtin_amdgcn_sched_barrier(0); }
    }
};
template <bool FINAL> struct EpiMoe2 {
    static constexpr bool PERM = true;
    float* H; const int* slot_tok; const float* slot_gate; int ldc; bf16* hb; float* rss_out;
    __device__ __forceinline__ void operator()(const f32x4 (&acc)[2][2][4][2], const Unit& u, int ui, int wr, int wc, int fr, int fq) const {
        const int row0 = u.pm * BM + wr * 64 + fr, col0 = u.pn * BM + wc * 32 + 8 * fq;
        int tokv[2][4]; float gtv[2][4];
#pragma unroll
        for (int ai = 0; ai < 2; ++ai)
#pragma unroll
            for (int m = 0; m < 4; ++m) { const int slot = row0 + ai * HALF + m * 16; tokv[ai][m] = slot_tok[slot]; gtv[ai][m] = slot_gate[slot]; }
#pragma unroll
        for (int ai = 0; ai < 2; ++ai)
#pragma unroll
            for (int m = 0; m < 4; ++m) { const int tok = tokv[ai][m]; const float gt = gtv[ai][m];
                const int tk = tok < 0 ? 0 : tok; float* rowp = H + (size_t)tk * ldc + col0; f32x4 v[2][2];
#pragma unroll
                for (int bj = 0; bj < 2; ++bj)
#pragma unroll
                    for (int n = 0; n < 2; ++n) { f32x4* p = (f32x4*)(rowp + bj * HALF + n * 4); v[bj][n] = *p + acc[ai][bj][m][n] * gt; if (tok >= 0) *p = v[bj][n]; }
                if (FINAL) { float q = 0.f;
#pragma unroll
                    for (int bj = 0; bj < 2; ++bj) { const f32x4 x = v[bj][0], y = v[bj][1];
                        q += ((x[0] * x[0] + x[1] * x[1]) + (x[2] * x[2] + x[3] * x[3])) + ((y[0] * y[0] + y[1] * y[1]) + (y[2] * y[2] + y[3] * y[3]));
                        u32x4 w; w.x = cvt_pk_bf16(x[0], x[1]); w.y = cvt_pk_bf16(x[2], x[3]); w.z = cvt_pk_bf16(y[0], y[1]); w.w = cvt_pk_bf16(y[2], y[3]);
                        if (tok >= 0) *(u32x4*)(hb + (size_t)tk * ldc + col0 + bj * HALF) = w; }
                    q += __shfl_xor(q, 16); q += __shfl_xor(q, 32);
                    if (fq == 0 && tok >= 0) rss_out[(size_t)tk * 16 + u.pn * 4 + wc] = q; }
                if (m & 1) __builtin_amdgcn_sched_barrier(0); }
    }
};

template <class Epi, class Sched, bool ALIGN_EPI = true, bool SP2 = true>
__device__ __forceinline__ void gemm_phase(LAS unsigned char* lds, const int K, const Sched& S, const Epi& E) {
    int tid = threadIdx.x; asm volatile("" : "+v"(tid));
    const int wid = __builtin_amdgcn_readfirstlane(tid >> 6), lane = tid & 63, wr = wid >> 2, wc = wid & 3, fr = lane & 15, fq = lane >> 4;
    const int nt = K / BK;
    unsigned voffA[2], voffB[2];
#pragma unroll
    for (int i = 0; i < 2; ++i) { int R, C; stage_rc(tid * 16 + i * 8192, R, C); const int Rb = Epi::PERM ? ((R & ~31) + perm32(R & 31)) : R;
        voffA[i] = (unsigned)(R * K + C) * 2u; voffB[i] = (unsigned)(Rb * K + C) * 2u; }
    const size_t kstep = (size_t)(BK * 2);
    const size_t hstep = (size_t)HALF * K * 2;
    const unsigned ldsw = (unsigned)wid * 1024u;
    const int aoff = lds_byte(wr * 64 + fr, fq * 8), boff = lds_byte(wc * 32 + fr, fq * 8);
#define PG8_SA(b, h) (((b) * 2 + (h)) * HTB)
#define PG8_SB(b, h) ((4 + (b) * 2 + (h)) * HTB)
#define PG8_STAGE(bufoff, gbase, voff) do { _Pragma("unroll") for (int _i = 0; _i < 2; ++_i) \
        __builtin_amdgcn_global_load_lds((const unsigned*)((const char*)(gbase) + (voff)[_i]), (LAS unsigned*)(lds + (bufoff) + ldsw + _i * 8192), 16, 0, 0); } while (0)
#define PG8_LDA(dst, b, h) do { _Pragma("unroll") for (int m = 0; m < 4; ++m) _Pragma("unroll") for (int k = 0; k < 2; ++k) dst[m][k] = *(const LAS bf16x8*)(lds + PG8_SA(b, h) + aoff + m * 2048 + k * 1024); } while (0)
#define PG8_LDB(dst, b, h) do { _Pragma("unroll") for (int n = 0; n < 2; ++n) _Pragma("unroll") for (int k = 0; k < 2; ++k) dst[n][k] = *(const LAS bf16x8*)(lds + PG8_SB(b, h) + boff + n * 2048 + k * 1024); } while (0)
#define PG8_MMA(ai, bj, At, Bt) do { __builtin_amdgcn_s_setprio(1); _Pragma("unroll") for (int m = 0; m < 4; ++m) _Pragma("unroll") for (int n = 0; n < 2; ++n) _Pragma("unroll") for (int k = 0; k < 2; ++k) \
        acc[ai][bj][m][n] = __builtin_amdgcn_mfma_f32_16x16x32_bf16(Bt[n][k], At[m][k], acc[ai][bj][m][n], 0, 0, 0); __builtin_amdgcn_s_setprio(0); } while (0)
#define PG8_WAIT_V(n) asm volatile("s_waitcnt vmcnt(" #n ")" ::: "memory")
#define PG8_WAIT_L(n) asm volatile("s_waitcnt lgkmcnt(" #n ")" ::: "memory")
#define PG8_BAR __builtin_amdgcn_s_barrier()
#define PG8_SCHED __builtin_amdgcn_sched_barrier(0)
    Unit cur, nxt; int ui = 0;
    if (!S.next(0, cur)) return;
    f32x4 acc[2][2][4][2];
#pragma unroll
    for (int a = 0; a < 2; ++a)
#pragma unroll
        for (int b = 0; b < 2; ++b)
#pragma unroll
            for (int m = 0; m < 4; ++m)
#pragma unroll
                for (int n = 0; n < 2; ++n) acc[a][b][m][n] = (f32x4){0.f, 0.f, 0.f, 0.f};
    bf16x8 At[4][2], B0[2][2], B1[2][2];
    const char* cA = S.abase(cur); const char* cB = S.bbase(cur);
    if constexpr (SP2) {
        PG8_STAGE(PG8_SB(0, 0), cB, voffB); PG8_STAGE(PG8_SB(0, 1), cB + hstep, voffB); PG8_STAGE(PG8_SA(0, 0), cA, voffA); PG8_STAGE(PG8_SA(0, 1), cA + hstep, voffA);
        if (wr == 1) PG8_BAR;
        PG8_WAIT_V(2); PG8_BAR;
        PG8_STAGE(PG8_SB(1, 0), cB + kstep, voffB); PG8_STAGE(PG8_SA(1, 0), cA + kstep, voffA); PG8_STAGE(PG8_SB(1, 1), cB + hstep + kstep, voffB);
        PG8_WAIT_V(6); PG8_BAR;
    } else {
        PG8_STAGE(PG8_SB(0, 0), cB, voffB); PG8_STAGE(PG8_SA(0, 0), cA, voffA); PG8_STAGE(PG8_SB(0, 1), cB + hstep, voffB); PG8_STAGE(PG8_SA(0, 1), cA + hstep, voffA);
        if (wr == 1) PG8_BAR;
        PG8_WAIT_V(4); PG8_BAR;
        PG8_STAGE(PG8_SB(1, 0), cB + kstep, voffB); PG8_STAGE(PG8_SA(1, 0), cA + kstep, voffA); PG8_STAGE(PG8_SB(1, 1), cB + hstep + kstep, voffB);
        PG8_WAIT_V(6); PG8_BAR;
    }
    for (;;) {
        const bool has_next = S.next(ui + 1, nxt);
        const char* nA = has_next ? S.abase(nxt) : cA; const char* nB = has_next ? S.bbase(nxt) : cB;
        for (int t = 0; t < nt; t += 2) {
            const bool last = (t == nt - 2);
            const char* a1 = cA + (size_t)(t + 1) * kstep;
            const char* a2 = last ? nA : cA + (size_t)(t + 2) * kstep; const char* b2 = last ? nB : cB + (size_t)(t + 2) * kstep;
            const char* a3 = a2 + kstep; const char* b3 = b2 + kstep;
            if constexpr (SP2) {
            PG8_LDB(B0, 0, 0); PG8_LDB(B1, 0, 1); PG8_SCHED; PG8_LDA(At, 0, 0); PG8_STAGE(PG8_SA(1, 1), a1 + hstep, voffA);
            PG8_WAIT_V(8); PG8_WAIT_L(0); PG8_BAR; PG8_MMA(0, 0, At, B0); PG8_MMA(0, 1, At, B1); PG8_BAR; PG8_SCHED;
            PG8_LDA(At, 0, 1); PG8_STAGE(PG8_SB(0, 0), b2, voffB); PG8_STAGE(PG8_SB(0, 1), b2 + hstep, voffB); PG8_STAGE(PG8_SA(0, 0), a2, voffA);
            PG8_WAIT_V(8); PG8_WAIT_L(0); PG8_BAR; PG8_MMA(1, 0, At, B0); PG8_MMA(1, 1, At, B1); PG8_BAR; PG8_SCHED;
            PG8_LDB(B0, 1, 0); PG8_LDB(B1, 1, 1); PG8_SCHED; PG8_LDA(At, 1, 0); PG8_STAGE(PG8_SA(0, 1), a2 + hstep, voffA);
            PG8_WAIT_V(8); PG8_WAIT_L(0); PG8_BAR; PG8_MMA(0, 0, At, B0); PG8_MMA(0, 1, At, B1); PG8_BAR; PG8_SCHED;
            PG8_LDA(At, 1, 1); PG8_STAGE(PG8_SB(1, 0), b3, voffB); PG8_STAGE(PG8_SB(1, 1), b3 + hstep, voffB); PG8_STAGE(PG8_SA(1, 0), a3, voffA);
            PG8_WAIT_V(8); PG8_WAIT_L(0); PG8_BAR; PG8_MMA(1, 0, At, B0); PG8_MMA(1, 1, At, B1); PG8_BAR; PG8_SCHED;
            } else {
            PG8_LDB(B0, 0, 0); PG8_SCHED; PG8_LDA(At, 0, 0); PG8_STAGE(PG8_SA(1, 1), a1 + hstep, voffA);
            PG8_WAIT_L(8); PG8_BAR; PG8_WAIT_L(0); PG8_MMA(0, 0, At, B0); PG8_BAR; PG8_SCHED;
            PG8_LDB(B1, 0, 1); PG8_STAGE(PG8_SB(0, 0), b2, voffB);
            PG8_BAR; PG8_WAIT_L(0); PG8_MMA(0, 1, At, B1); PG8_BAR;
            PG8_LDA(At, 0, 1); PG8_STAGE(PG8_SA(0, 0), a2, voffA);
            PG8_BAR; PG8_WAIT_L(0); PG8_MMA(1, 0, At, B0); PG8_BAR; PG8_SCHED;
            PG8_STAGE(PG8_SB(0, 1), b2 + hstep, voffB);
            PG8_WAIT_V(6); PG8_BAR; PG8_MMA(1, 1, At, B1); PG8_BAR;
            PG8_LDB(B0, 1, 0); PG8_SCHED; PG8_LDA(At, 1, 0); PG8_STAGE(PG8_SA(0, 1), a2 + hstep, voffA);
            PG8_WAIT_L(8); PG8_BAR; PG8_WAIT_L(0); PG8_MMA(0, 0, At, B0); PG8_BAR; PG8_SCHED;
            PG8_LDB(B1, 1, 1); PG8_STAGE(PG8_SB(1, 0), b3, voffB);
            PG8_BAR; PG8_WAIT_L(0); PG8_MMA(0, 1, At, B1); PG8_BAR;
            PG8_LDA(At, 1, 1); PG8_STAGE(PG8_SA(1, 0), a3, voffA);
            PG8_BAR; PG8_WAIT_L(0); PG8_MMA(1, 0, At, B0); PG8_BAR; PG8_SCHED;
            PG8_STAGE(PG8_SB(1, 1), b3 + hstep, voffB);
            PG8_WAIT_V(6); PG8_BAR; PG8_MMA(1, 1, At, B1); PG8_BAR;
            }
        }
        if constexpr (ALIGN_EPI) { if (wr == 0) PG8_BAR; }
        E(acc, cur, ui, wr, wc, fr, fq);
        if (!has_next) break;
#pragma unroll
        for (int a = 0; a < 2; ++a)
#pragma unroll
            for (int b = 0; b < 2; ++b)
#pragma unroll
                for (int m = 0; m < 4; ++m)
#pragma unroll
                    for (int n = 0; n < 2; ++n) acc[a][b][m][n] = (f32x4){0.f, 0.f, 0.f, 0.f};
        cur = nxt; cA = nA; cB = nB; ++ui;
        if constexpr (ALIGN_EPI) { if (wr == 1) PG8_BAR; }
    }
    PG8_WAIT_V(0);
    if constexpr (!ALIGN_EPI) { if (wr == 0) PG8_BAR; }
    PG8_BAR;
#undef PG8_SA
#undef PG8_SB
#undef PG8_STAGE
#undef PG8_LDA
#undef PG8_LDB
#undef PG8_MMA
#undef PG8_WAIT_V
#undef PG8_WAIT_L
#undef PG8_BAR
#undef PG8_SCHED
}
}

constexpr size_t MiB = 1u << 20;
constexpr size_t WS_CTL = 0, CTL_ZERO_BYTES = 65536;
constexpr size_t WS_WIN = 1 * MiB;
constexpr size_t WS_WOUT = 13 * MiB;
constexpr size_t WS_W13 = 17 * MiB;
constexpr size_t WS_W2 = 28 * MiB;
constexpr size_t WS_WG = 34 * MiB;
constexpr size_t WS_WP = 38 * MiB;
constexpr size_t WS_CW1 = 39 * MiB;
constexpr size_t WS_LORA = 41 * MiB;
constexpr size_t WS_ROPE = 41 * MiB + 512 * 1024;
constexpr size_t WS_CBIAS = 42 * MiB + 512 * 1024;
constexpr size_t WS_PB = 43 * MiB;
constexpr size_t WS_HN = 60 * MiB;
constexpr size_t WS_Z = 92 * MiB;
constexpr size_t WS_YCAT = 188 * MiB;
constexpr size_t WS_QROT = 220 * MiB;
constexpr size_t WS_KSR = 236 * MiB, WS_KWR = 240 * MiB, WS_VST = 244 * MiB, WS_VWT = 248 * MiB;
constexpr size_t WS_KCMP = 252 * MiB, WS_VCMPT = 252 * MiB + 512 * 1024;
constexpr size_t WS_REC = 253 * MiB;
constexpr size_t WS_G = 349 * MiB;
constexpr size_t WS_YRAW = 365 * MiB;
constexpr size_t WS_BONUS = 381 * MiB;
constexpr size_t WS_ACT = 92 * MiB;
constexpr size_t WS_HNS = 92 * MiB;
constexpr size_t WS_ACTM = 128 * MiB;
constexpr size_t WS_MW13 = 227 * MiB;
constexpr size_t WS_MW2 = 315 * MiB;
constexpr size_t WS_SLOT = 359 * MiB;
constexpr size_t WS_PP = 92 * MiB;
constexpr size_t WS_YP = 382 * MiB;
constexpr size_t WS_SEGE = 398 * MiB;
constexpr size_t WS_SST = 406 * MiB;
constexpr size_t WS_END = 412 * MiB;
constexpr size_t WS_HB2 = 188 * MiB;
constexpr size_t WS_RSS = 410 * MiB;
constexpr int NSEG = 16, SEGLEN = SEQ / NSEG;
constexpr int MOE_SLOTS = 18432;
constexpr size_t SL_TOK = 0;
constexpr size_t SL_GATE = SL_TOK + 2 * MOE_SLOTS * 4;
constexpr size_t SL_TOKE = SL_GATE + 2 * MOE_SLOTS * 4;
constexpr size_t SL_TOKG = SL_TOKE + (size_t)MT * 2 * 4;
constexpr size_t SL_TOKS = SL_TOKG + (size_t)MT * 2 * 4;
constexpr size_t SL_BCNT = SL_TOKS + (size_t)MT * 2 * 4;
constexpr size_t SL_TST = SL_BCNT + 256 * 16 * 4;
static_assert(SL_TST + 128 <= 1 * MiB, "slot tables");
constexpr int CW_BAR = 4096;
constexpr int CW_Q = 8192;

constexpr int RING_BYTES = 131072;
constexpr int MISC_OFF = 161792;
constexpr int RSTAB_OFF = RING_BYTES;
constexpr int RSTAB_MAX_UNITS = 30;
constexpr int LDS_BYTES = 163840;

#define XB_TMO      128
#define XB_XCNT(j)  (256  + 64 * (j))
#define XB_XSUB(j)  (1280 + 64 * (j))
#define XB_XGEN(j)  (2304 + 64 * (j))
#define XB_TOP      3328
#define XB_TOPGEN   3392
#define XCD_BAR_WORDS 3456
#define XB_SPIN_CAP (1u << 18)
__device__ __forceinline__ unsigned xb_ld(unsigned* p)              { return __hip_atomic_load(p, __ATOMIC_RELAXED, __HIP_MEMORY_SCOPE_AGENT); }
__device__ __forceinline__ unsigned xb_add(unsigned* p, unsigned v) { return __hip_atomic_fetch_add(p, v, __ATOMIC_RELAXED, __HIP_MEMORY_SCOPE_AGENT); }
__device__ __forceinline__ unsigned xb_xcc_id() { return (unsigned)__builtin_amdgcn_s_getreg((3 << 11) | 20) & 0xFu; }
#define XB_SPIN(cond, bar) do { unsigned _sp = 0; while (cond) { __builtin_amdgcn_s_sleep(1); \
    if ((++_sp & 255u) == 0u) { if (xb_ld(&(bar)[XB_TMO])) break; if (_sp > XB_SPIN_CAP) { atomicAdd(&(bar)[XB_TMO], 1u); break; } } } } while (0)
struct XcdBarrier { unsigned* bar; unsigned x; volatile LAS unsigned* st; };
__device__ __forceinline__ XcdBarrier xcd_barrier_post(unsigned* bar, volatile LAS unsigned* st) {
    XcdBarrier b; b.bar = bar; b.x = xb_xcc_id(); b.st = st;
    if (threadIdx.x == 0) (void)xb_add(&bar[XB_XCNT(b.x)], 1u);
    return b;
}
__device__ __noinline__ unsigned long long xcd_barrier_complete(unsigned* bar, unsigned x) {
    const unsigned G = gridDim.x * gridDim.y * gridDim.z;
    unsigned sum, cnt, mine, sp = 0u;
    for (;;) {
        sum = 0u; cnt = 0u; mine = 0u;
        for (unsigned j = 0; j < 16; ++j) { const unsigned c = xb_ld(&bar[XB_XCNT(j)]); sum += c; cnt += (c > 0u) ? 1u : 0u; mine = (j == x) ? c : mine; }
        if (sum == G) break;
        __builtin_amdgcn_s_sleep(1);
        if ((++sp & 255u) == 0u) { if (xb_ld(&bar[XB_TMO])) break; if (sp > XB_SPIN_CAP) { atomicAdd(&bar[XB_TMO], 1u); break; } }
    }
    const unsigned nloc = mine > 0u ? mine : 1u, nx = cnt > 0u ? cnt : 1u;
    return (unsigned long long)nloc | ((unsigned long long)nx << 32);
}
__device__ __forceinline__ void xcd_barrier(const XcdBarrier& b) {
    asm volatile("s_waitcnt vmcnt(0)" ::: "memory");
    __syncthreads();
    if (threadIdx.x == 0) {
        unsigned* bar = b.bar;
        __builtin_amdgcn_s_waitcnt(0);
        unsigned nloc = b.st[0], nx = b.st[1];
        if (nloc == 0u) { const unsigned long long r = xcd_barrier_complete(bar, b.x); nloc = (unsigned)r; nx = (unsigned)(r >> 32); b.st[0] = nloc; b.st[1] = nx; }
        const unsigned old = xb_add(&bar[XB_XSUB(b.x)], 1u);
        const unsigned gen = old / nloc;
        if (old + 1u == (gen + 1u) * nloc) {
            __builtin_amdgcn_fence(__ATOMIC_RELEASE, "agent");
            asm volatile("s_waitcnt vmcnt(0)" ::: "memory");
            const unsigned og = xb_add(&bar[XB_TOP], 1u);
            const unsigned tg = og / nx;
            if (og + 1u == (tg + 1u) * nx) xb_add(&bar[XB_TOPGEN], 1u);
            else XB_SPIN(xb_ld(&bar[XB_TOPGEN]) == tg, bar);
            __builtin_amdgcn_fence(__ATOMIC_ACQUIRE, "agent");
            xb_add(&bar[XB_XGEN(b.x)], 1u);
            asm volatile("s_waitcnt vmcnt(0)" ::: "memory");
        } else {
            XB_SPIN(xb_ld(&bar[XB_XGEN(b.x)]) == gen, bar);
            __builtin_amdgcn_fence(__ATOMIC_ACQUIRE, "agent");
            asm volatile("s_waitcnt vmcnt(0)" ::: "memory");
        }
    }
    __syncthreads();
}

enum { IN_X = 0, IN_P, IN_POS, IN_GMIX, IN_WIN, IN_WOUT, IN_GMLNG, IN_GMLNB, IN_GMWS, IN_GMBS, IN_RWMU, IN_RWW0, IN_RWWUP, IN_RWA0, IN_RWAUP, IN_RWGUP,
       IN_RWKK, IN_RWKA, IN_RWRK, IN_RWGNG, IN_RWGNB, IN_CMPPOS, IN_KCW1, IN_KCW2, IN_VCW1, IN_VCW2, IN_GFFN, IN_FW1, IN_FW3, IN_FW2, IN_RTW, IN_RTB,
       IN_MW1, IN_MW3, IN_MW2, IN_GPLE, IN_PLEG, IN_PLEP, IN_GFINAL, N_INPUTS };
struct Args { const void* in[N_INPUTS]; float* out; unsigned char* ws; int ph_lo, ph_hi; };
constexpr int PTAB_OFF = 161792 + 256;
__device__ __forceinline__ const void* ldptr(int k) {
    extern __shared__ __attribute__((aligned(16))) unsigned char lds_raw[];
    const LAS unsigned* t = (const LAS unsigned*)((LAS unsigned char*)lds_raw + PTAB_OFF) + 2 * k;
    const unsigned lo = __builtin_amdgcn_readfirstlane(t[0]), hi = __builtin_amdgcn_readfirstlane(t[1]);
    return (const void*)(const GAS char*)(((unsigned long long)hi << 32) | lo);
}
#define INF(k) ((const float*)ldptr(k))
__device__ __forceinline__ unsigned char* ws_of(const Args& a) { unsigned long long z = 0; asm volatile("" : "+s"(z)); return a.ws + z; }

__device__ __forceinline__ void conv_item(const float* W, int K, int N, bf16* dst, int mode, int it, int lane, const float* gk) {
    const int nblk = (N + 63) / 64;
    const int kb = it / nblk, nb = it % nblk, n = nb * 64 + lane, k0 = kb * 64; const bool ok = n < N;
    const int drow = mode == 0 ? n : ((n >> 7) * 256 + (n & 127) + (mode == 2 ? 128 : 0));
    const float* src = W + (size_t)k0 * N + (ok ? n : 0);
    float v[64];
#pragma unroll
    for (int k = 0; k < 64; ++k) v[k] = src[(size_t)k * N];
    if (gk) {
#pragma unroll
        for (int k = 0; k < 64; ++k) v[k] *= gk[k0 + k]; }
    if (ok) { u32x4* d = (u32x4*)(dst + (size_t)drow * K + k0);
#pragma unroll
        for (int c = 0; c < 8; ++c) { u32x4 o; o.x = pk2(v[8 * c], v[8 * c + 1]); o.y = pk2(v[8 * c + 2], v[8 * c + 3]); o.z = pk2(v[8 * c + 4], v[8 * c + 5]); o.w = pk2(v[8 * c + 6], v[8 * c + 7]); d[c] = o; } }
}
__host__ __device__ constexpr int conv_nitems(int K, int N) { return (K / 64) * ((N + 63) / 64); }
#define CONV_JOB(W_, K_, N_, dst_, mode_, gk_) { constexpr int _n = conv_nitems(K_, N_); if (it < _n) { conv_item(W_, K_, N_, dst_, mode_, it, lane, gk_); continue; } it -= _n; }

__device__ __forceinline__ void init_row(const float* xrow, bf16* orow, float* cp, float* rss_row, int lane) {
    const f32x4* xr = (const f32x4*)xrow + lane; f32x4 v[4]; float s = 0.f;
#pragma unroll
    for (int j = 0; j < 4; ++j) { v[j] = xr[64 * j]; s += (v[j].x * v[j].x + v[j].y * v[j].y) + (v[j].z * v[j].z + v[j].w * v[j].w); }
    s = wave_sum(s);
#pragma unroll
    for (int j = 0; j < 4; ++j) ((f32x4*)cp + lane)[64 * j] = v[j];
    u32x2* o8 = (u32x2*)orow + lane;
#pragma unroll
    for (int j = 0; j < 4; ++j) { u32x2 w; w.x = pk2(v[j].x, v[j].y); w.y = pk2(v[j].z, v[j].w); o8[64 * j] = w; }
    if (lane < 16) rss_row[lane] = lane == 0 ? s : 0.f;
}

__device__ __forceinline__ void phase_prologue(const Args& a, LAS unsigned char* lds) {
    const int tid = opaque_tid(), lane = tid & 63, wave = __builtin_amdgcn_readfirstlane(tid >> 6);
    const int G = gridDim.x, gw = blockIdx.x * NWAVES + wave, NGW = G * NWAVES;
    const size_t gt = (size_t)blockIdx.x * NTHR + tid, NGT = (size_t)G * NTHR;
    unsigned char* ws = ws_of(a);
    LAS float* scr = (LAS float*)(lds + wave * 16384);
    {
        constexpr int PER_LAYER = conv_nitems(DM, DIN) + 2 * conv_nitems(DM, DM) + conv_nitems(256, DM) + 2 * conv_nitems(2048, 128) + 2 * conv_nitems(64, 256) + conv_nitems(128, 256);
        constexpr int TOTAL = 2 * PER_LAYER + 2 * conv_nitems(DM, DFF) + conv_nitems(DFF, DM);
        for (int it0 = gw; it0 < TOTAL; it0 += NGW) {
            int it = it0;
            if (it < 2 * PER_LAYER) { const int l = it >= PER_LAYER ? 1 : 0; it -= l * PER_LAYER;
                bf16* lora = (bf16*)(ws + WS_LORA) + (size_t)l * 65536;
                CONV_JOB(INF(IN_WIN) + (size_t)l * DM * DIN, DM, DIN, (bf16*)(ws + WS_WIN) + (size_t)l * ZLD * DM, 0, INF(IN_GMIX) + l * DM)
                CONV_JOB(INF(IN_WOUT) + (size_t)l * DM * DM, DM, DM, (bf16*)(ws + WS_WOUT) + (size_t)l * DM * DM, 0, nullptr)
                CONV_JOB(INF(IN_PLEG) + (size_t)l * DM * DM, DM, DM, (bf16*)(ws + WS_WG) + (size_t)l * DM * DM, 0, INF(IN_GPLE) + l * DM)
                CONV_JOB(INF(IN_PLEP) + (size_t)l * 256 * DM, 256, DM, (bf16*)(ws + WS_WP) + (size_t)l * DM * 256, 0, nullptr)
                CONV_JOB(INF(IN_KCW1) + (size_t)l * 2048 * 128, 2048, 128, (bf16*)(ws + WS_CW1) + (size_t)(l * 2 + 0) * 128 * 2048, 0, nullptr)
                CONV_JOB(INF(IN_VCW1) + (size_t)l * 2048 * 128, 2048, 128, (bf16*)(ws + WS_CW1) + (size_t)(l * 2 + 1) * 128 * 2048, 0, nullptr)
                CONV_JOB(INF(IN_RWWUP) + (size_t)l * 64 * 256, 64, 256, lora, 0, nullptr)
                CONV_JOB(INF(IN_RWAUP) + (size_t)l * 64 * 256, 64, 256, lora + 16384, 0, nullptr)
                CONV_JOB(INF(IN_RWGUP) + (size_t)l * 128 * 256, 128, 256, lora + 32768, 0, nullptr)
                continue; }
            it -= 2 * PER_LAYER;
            CONV_JOB(INF(IN_FW1), DM, DFF, (bf16*)(ws + WS_W13), 1, INF(IN_GFFN))
            CONV_JOB(INF(IN_FW3), DM, DFF, (bf16*)(ws + WS_W13), 2, INF(IN_GFFN))
            CONV_JOB(INF(IN_FW2), DFF, DM, (bf16*)(ws + WS_W2), 0, nullptr)
        }
        for (int l = 0; l < 2; ++l) {
            u32x4* zr = (u32x4*)((bf16*)(ws + WS_WIN) + ((size_t)l * ZLD + DIN) * DM); const size_t n16 = (size_t)(ZLD - DIN) * DM * 2 / 16;
            for (size_t i = gt; i < n16; i += NGT) zr[i] = (u32x4){0u, 0u, 0u, 0u}; }
    }
    { const f32x4* src = (const f32x4*)INF(IN_P); u32x2* dst = (u32x2*)(ws + WS_PB); const size_t n4 = (size_t)2 * MT * 256 / 4;
      for (size_t i = gt; i < n4; i += NGT) { const f32x4 v = src[i]; u32x2 w; w.x = pk2(v.x, v.y); w.y = pk2(v.z, v.w); dst[i] = w; } }
    { const int* pos = (const int*)ldptr(IN_POS); float* ct = (float*)(ws + WS_ROPE); float* st = ct + (size_t)MT * 8;
      const float inv[8] = {1.0f, 0.1939227432012558f, 0.03760603070259094f, 0.007292664609849453f, 0.0014142135623842478f, 0.00027424818836152554f, 5.3182957344688475e-05f, 1.0313385246263351e-05f};
      for (size_t i = gt; i < (size_t)MT * 8; i += NGT) { const int m = (int)(i >> 3), k = (int)(i & 7);
          float iv = inv[0];
#pragma unroll
          for (int q = 1; q < 8; ++q) iv = (k == q) ? inv[q] : iv;
          const float ang = (float)pos[m] * iv;
          const double ad = (double)ang; const double kq = __builtin_rint(ad * 0.15915494309189535); const float red = (float)(ad - kq * 6.283185307179586);
          ct[i] = __cosf(red); st[i] = __sinf(red); } }
    if (blockIdx.x < 64) {
        const int lk = blockIdx.x >> 4, ck = blockIdx.x & 15, l = lk >> 1, kv = lk & 1; const float* W1 = INF(kv ? IN_VCW1 : IN_KCW1) + (size_t)l * 2048 * 128; const float* pos = INF(IN_CMPPOS) + (size_t)l * 2048;
        LAS float* red = (LAS float*)(lds + 8448);
        const int hid = tid & 127, part = tid >> 7; const int kb = ck * 128 + part * 32; float s = 0.f;
#pragma unroll
        for (int k = 0; k < 32; ++k) s += pos[kb + k] * W1[(size_t)(kb + k) * 128 + hid];
        red[part * 128 + hid] = s; __syncthreads();
        if (tid < 128) ((float*)(ws + WS_CBIAS))[(lk * 16 + ck) * 128 + tid] = red[tid] + red[128 + tid] + red[256 + tid] + red[384 + tid];
    }
    for (int m = gw; m < MT; m += NGW) init_row(INF(IN_X) + (size_t)m * DM, (bf16*)(ws + WS_HN) + (size_t)m * DM, a.out + (size_t)m * DM, (float*)(ws + WS_RSS) + (size_t)m * 16, lane);
}

template <int MODE>
__device__ __forceinline__ void phase_norm(const Args& a, LAS unsigned char* lds, const float* g) {
    const int tid = opaque_tid(), lane = tid & 63, wave = __builtin_amdgcn_readfirstlane(tid >> 6);
    unsigned char* ws = ws_of(a);
    LAS int* lcnt = (LAS int*)lds;
    if (MODE == 1) { if (tid < 16) lcnt[tid] = 0; __syncthreads(); }
    for (int rb = blockIdx.x; rb < MT / 64; rb += gridDim.x) {
        for (int i = 0; i < 8; ++i) {
            const int m = rb * 64 + wave * 8 + i;
            float* hrow = a.out + (size_t)m * DM;
            const f32x4* xr = (const f32x4*)hrow + lane; f32x4 v[4]; float s = 0.f;
#pragma unroll
            for (int j = 0; j < 4; ++j) { v[j] = xr[64 * j]; s += (v[j].x * v[j].x + v[j].y * v[j].y) + (v[j].z * v[j].z + v[j].w * v[j].w); }
            const float rs = 1.0f / sqrtf(wave_sum(s) * (1.0f / 1024.0f) + 1e-6f);
#pragma unroll
            for (int j = 0; j < 4; ++j) { const f32x4 gg = ((const f32x4*)g + lane)[64 * j]; v[j].x *= rs * gg.x; v[j].y *= rs * gg.y; v[j].z *= rs * gg.z; v[j].w *= rs * gg.w; }
            if (MODE == 2) {
#pragma unroll
                for (int j = 0; j < 4; ++j) ((f32x4*)hrow + lane)[64 * j] = v[j];
            } else if (MODE == 0) {
                u32x2* o8 = (u32x2*)((bf16*)(ws + WS_HN) + (size_t)m * DM) + lane;
#pragma unroll
                for (int j = 0; j < 4; ++j) { u32x2 w; w.x = pk2(v[j].x, v[j].y); w.y = pk2(v[j].z, v[j].w); o8[64 * j] = w; }
            }
            if (MODE == 1) {
                const float* rw = INF(IN_RTW); float lg[8];
#pragma unroll
                for (int e = 0; e < 8; ++e) lg[e] = 0.f;
#pragma unroll
                for (int j = 0; j < 4; ++j)
#pragma unroll
                    for (int c = 0; c < 4; ++c) { const int k = 4 * (lane + 64 * j) + c; const f32x4 w0 = *(const f32x4*)(rw + (size_t)k * 8), w1 = *(const f32x4*)(rw + (size_t)k * 8 + 4); const float x = v[j][c];
                        lg[0] += x * w0.x; lg[1] += x * w0.y; lg[2] += x * w0.z; lg[3] += x * w0.w; lg[4] += x * w1.x; lg[5] += x * w1.y; lg[6] += x * w1.z; lg[7] += x * w1.w; }
#pragma unroll
                for (int e = 0; e < 8; ++e) lg[e] = wave_sum(lg[e]) + INF(IN_RTB)[e];
                int e0 = 0; float v0 = lg[0];
#pragma unroll
                for (int e = 1; e < 8; ++e) if (lg[e] > v0) { v0 = lg[e]; e0 = e; }
                int e1 = -1; float v1 = -3.0e38f;
#pragma unroll
                for (int e = 0; e < 8; ++e) if (e != e0 && lg[e] > v1) { v1 = lg[e]; e1 = e; }
                const float p1 = 1.0f / (1.0f + __expf(v0 - v1)), p0 = 1.0f - p1;
                if (lane == 0) { int* te = (int*)(ws + WS_SLOT + SL_TOKE); float* tg = (float*)(ws + WS_SLOT + SL_TOKG); te[2 * m] = e0; te[2 * m + 1] = e1; tg[2 * m] = p0; tg[2 * m + 1] = p1;
                    atomicAdd((int*)&lcnt[e0], 1); atomicAdd((int*)&lcnt[8 + e1], 1); }
            }
        }
        if (MODE == 1) { __syncthreads(); if (tid < 16) { ((int*)(ws + WS_SLOT + SL_BCNT))[rb * 16 + tid] = lcnt[tid]; lcnt[tid] = 0; } __syncthreads(); }
    }
}

__device__ __forceinline__ bf16x8 ld_bf8(const bf16* p) { return *(const bf16x8*)p; }
__device__ __forceinline__ float tanhf_(float x) { const float e = __expf(2.0f * x); return 1.0f - 2.0f / (e + 1.0f); }

__device__ __forceinline__ void rw_shift8(const bf16* z, const float* mu, int m, int tpos, int c, float (&o)[8]) {
    const u32x4 cur = *(const u32x4*)(z + (size_t)m * ZLD + ZC_B + c);
    u32x4 prv = (u32x4){0u, 0u, 0u, 0u}; if (tpos > 0) prv = *(const u32x4*)(z + (size_t)(m - 1) * ZLD + ZC_B + c);
    const f32x4 m0 = *(const f32x4*)(mu + c), m1 = *(const f32x4*)(mu + c + 4);
    float cu[8] = {bflo(cur.x), bfhi(cur.x), bflo(cur.y), bfhi(cur.y), bflo(cur.z), bfhi(cur.z), bflo(cur.w), bfhi(cur.w)};
    float pv[8] = {bflo(prv.x), bfhi(prv.x), bflo(prv.y), bfhi(prv.y), bflo(prv.z), bfhi(prv.z), bflo(prv.w), bfhi(prv.w)};
    float mm[8] = {m0.x, m0.y, m0.z, m0.w, m1.x, m1.y, m1.z, m1.w};
#pragma unroll
    for (int j = 0; j < 8; ++j) o[j] = cu[j] + (pv[j] - cu[j]) * mm[j];
}
__device__ __forceinline__ void rw_shift4(const bf16* z, const float* mu, int m, int tpos, int c, float (&o)[4]) {
    const u32x2 cur = *(const u32x2*)(z + (size_t)m * ZLD + ZC_B + c);
    u32x2 prv = (u32x2){0u, 0u}; if (tpos > 0) prv = *(const u32x2*)(z + (size_t)(m - 1) * ZLD + ZC_B + c);
    const f32x4 m0 = *(const f32x4*)(mu + c);
    o[0] = bflo(cur.x) + (bflo(prv.x) - bflo(cur.x)) * m0.x; o[1] = bfhi(cur.x) + (bfhi(prv.x) - bfhi(cur.x)) * m0.y;
    o[2] = bflo(cur.y) + (bflo(prv.y) - bflo(cur.y)) * m0.z; o[3] = bfhi(cur.y) + (bfhi(prv.y) - bfhi(cur.y)) * m0.w;
}
__device__ __forceinline__ bf16x8 pack8(const float (&x)[8]) {
    u32x4 w; w.x = pk2(x[0], x[1]); w.y = pk2(x[2], x[3]); w.z = pk2(x[4], x[5]); w.w = pk2(x[6], x[7]);
    return __builtin_bit_cast(bf16x8, w);
}

__device__ __forceinline__ void rwkv_prep_tile(const Args& a, int layer, int m0, int lane, int hc_lo, int hc_hi) {
    unsigned char* ws = ws_of(a);
    const bf16* z = (const bf16*)(ws + WS_Z);
    const float* mu = INF(IN_RWMU) + (size_t)layer * 1024;
    const bf16* lora = (const bf16*)(ws + WS_LORA) + (size_t)layer * 65536;
    const bf16* wupT = lora; const bf16* aupT = lora + 16384; const bf16* gupT = lora + 32768;
    const int fq = lane >> 4, fr = lane & 15;
    const int m = m0 + fr, tpos = m & (SEQ - 1), bb = m >> 12;
    bf16x8 wdB[2], adB[2], gdB[4];
#pragma unroll
    for (int ks = 0; ks < 2; ++ks) { float x[8]; rw_shift8(z, mu, m, tpos, 768 + 32 * ks + 8 * fq, x);
#pragma unroll
        for (int j = 0; j < 8; ++j) x[j] = tanhf_(x[j]);
        wdB[ks] = pack8(x);
        rw_shift8(z, mu, m, tpos, 832 + 32 * ks + 8 * fq, x); adB[ks] = pack8(x); }
#pragma unroll
    for (int ks = 0; ks < 4; ++ks) { float x[8]; rw_shift8(z, mu, m, tpos, 896 + 32 * ks + 8 * fq, x);
#pragma unroll
        for (int j = 0; j < 8; ++j) x[j] = sigmoidf_(x[j]);
        gdB[ks] = pack8(x); }
    const float* w0p = INF(IN_RWW0) + layer * 256; const float* a0p = INF(IN_RWA0) + layer * 256; const float* kkp = INF(IN_RWKK) + layer * 256;
    const float* kap = INF(IN_RWKA) + layer * 256; const float* rkp = INF(IN_RWRK) + layer * 256;
    float* rec = (float*)(ws + WS_REC); float* gbuf = (float*)(ws + WS_G); float* bonus = (float*)(ws + WS_BONUS);
    float ss = 0.f, bs = 0.f, inv = 0.f;
#pragma unroll 1
    for (int hc = hc_lo; hc < hc_hi; ++hc) {
        const int h = hc >> 2, ct = hc & 3;
        if (ct == 0) {
            ss = 0.f; bs = 0.f;
#pragma unroll
            for (int c2 = 0; c2 < 4; ++c2) { const int c0 = h * 64 + 16 * c2 + 4 * fq; float k4[4]; rw_shift4(z, mu, m, tpos, 256 + c0, k4); const f32x4 k_k = *(const f32x4*)(kkp + c0);
#pragma unroll
                for (int i = 0; i < 4; ++i) { const float kx = k4[i] * k_k[i]; ss += kx * kx; } }
            ss += __shfl_xor(ss, 16); ss += __shfl_xor(ss, 32);
            inv = 1.0f / sqrtf(fmaxf(ss, 1e-24f));
        }
        f32x4 aw = (f32x4){0.f, 0.f, 0.f, 0.f}, aa = aw, ag = aw;
        const int chr = h * 64 + 16 * ct + fr;
#pragma unroll
        for (int ks = 0; ks < 2; ++ks) { const bf16x8 A1 = ld_bf8(wupT + chr * 64 + 32 * ks + 8 * fq), A2 = ld_bf8(aupT + chr * 64 + 32 * ks + 8 * fq);
            aw = __builtin_amdgcn_mfma_f32_16x16x32_bf16(A1, wdB[ks], aw, 0, 0, 0); aa = __builtin_amdgcn_mfma_f32_16x16x32_bf16(A2, adB[ks], aa, 0, 0, 0); }
#pragma unroll
        for (int ks = 0; ks < 4; ++ks) { const bf16x8 A3 = ld_bf8(gupT + chr * 128 + 32 * ks + 8 * fq); ag = __builtin_amdgcn_mfma_f32_16x16x32_bf16(A3, gdB[ks], ag, 0, 0, 0); }
        float* rp = rec + ((size_t)(bb * 4 + h) * SEQ + tpos) * 384;
        const int c0 = h * 64 + 16 * ct + 4 * fq, d0 = 16 * ct + 4 * fq;
        float r4[4], k4[4], v4[4]; rw_shift4(z, mu, m, tpos, c0, r4); rw_shift4(z, mu, m, tpos, 256 + c0, k4); rw_shift4(z, mu, m, tpos, 512 + c0, v4);
        const f32x4 w0 = *(const f32x4*)(w0p + c0), a0 = *(const f32x4*)(a0p + c0), k_k = *(const f32x4*)(kkp + c0), k_a = *(const f32x4*)(kap + c0), r_k = *(const f32x4*)(rkp + c0);
        f32x4 odw, okk, ob, okp;
#pragma unroll
        for (int i = 0; i < 4; ++i) {
            const float wl = w0[i] + aw[i]; const float nx = -wl; const float sp = fmaxf(nx, 0.f) + log1pf(__expf(-fabsf(nx)));
            const float wlog = -sp - 0.5f; odw[i] = __expf(-__expf(wlog));
            const float aval = sigmoidf_(a0[i] + aa[i]);
            const float kkn = k4[i] * k_k[i] * inv; okk[i] = kkn; ob[i] = kkn * aval;
            const float kpv = k4[i] * (1.0f + (aval - 1.0f) * k_a[i]); okp[i] = kpv;
            bs += r4[i] * kpv * r_k[i];
        }
        *(f32x4*)(rp + d0) = odw; *(f32x4*)(rp + 64 + d0) = okk; *(f32x4*)(rp + 128 + d0) = ob; *(f32x4*)(rp + 192 + d0) = okp;
        *(f32x4*)(rp + 256 + d0) = (f32x4){r4[0], r4[1], r4[2], r4[3]}; *(f32x4*)(rp + 320 + d0) = (f32x4){v4[0], v4[1], v4[2], v4[3]};
        *(f32x4*)(gbuf + (size_t)m * 256 + c0) = ag;
        if (ct == 3) { float b2 = bs; b2 += __shfl_xor(b2, 16); b2 += __shfl_xor(b2, 32); if (fq == 0) bonus[(size_t)m * 4 + h] = b2; }
    }
}

__host__ __device__ constexpr int vperm_src(int p) { return (p & ~31) + 16 * ((p & 7) >> 2) + 4 * ((p & 31) >> 3) + (p & 3); }
__host__ __device__ constexpr int vperm_pos(int k) { return (k & ~31) + 8 * ((k & 15) >> 2) + 4 * ((k & 31) >> 4) + (k & 3); }
__device__ __forceinline__ void nsa_prep_item(const Args& a, LAS unsigned char* lds, int b, int tt) {
    unsigned char* ws = ws_of(a); const int tid = opaque_tid();
    const bf16* z = (const bf16*)(ws + WS_Z);
    const float* ct = (const float*)(ws + WS_ROPE); const float* st = ct + (size_t)MT * 8;
    const int mb = b * SEQ + tt * 64;
    for (int task = tid; task < 64 * 12; task += NTHR) {
        const int tok = task / 12, unit = task % 12, m = mb + tok;
        const bf16* src; bf16* dst;
        if (unit < 8) { src = z + (size_t)m * ZLD + ZC_Q + unit * 64; dst = (bf16*)(ws + WS_QROT) + (size_t)m * 512 + unit * 64; }
        else if (unit < 10) { src = z + (size_t)m * ZLD + ZC_KS + (unit - 8) * 64; dst = (bf16*)(ws + WS_KSR) + (size_t)m * 128 + (unit - 8) * 64; }
        else { src = z + (size_t)m * ZLD + ZC_KW + (unit - 10) * 64; dst = (bf16*)(ws + WS_KWR) + (size_t)m * 128 + (unit - 10) * 64; }
        u32x4 v[8];
#pragma unroll
        for (int i = 0; i < 8; ++i) v[i] = ((const u32x4*)src)[i];
        const f32x4 c0 = *(const f32x4*)(ct + (size_t)m * 8), c1 = *(const f32x4*)(ct + (size_t)m * 8 + 4), s0 = *(const f32x4*)(st + (size_t)m * 8), s1 = *(const f32x4*)(st + (size_t)m * 8 + 4);
        const float cc[8] = {c0.x, c0.y, c0.z, c0.w, c1.x, c1.y, c1.z, c1.w}, sn[8] = {s0.x, s0.y, s0.z, s0.w, s1.x, s1.y, s1.z, s1.w};
        const float x1[8] = {bflo(v[0].x), bfhi(v[0].x), bflo(v[0].y), bfhi(v[0].y), bflo(v[0].z), bfhi(v[0].z), bflo(v[0].w), bfhi(v[0].w)};
        const float x2[8] = {bflo(v[1].x), bfhi(v[1].x), bflo(v[1].y), bfhi(v[1].y), bflo(v[1].z), bfhi(v[1].z), bflo(v[1].w), bfhi(v[1].w)};
        float o1[8], o2[8];
#pragma unroll
        for (int i = 0; i < 8; ++i) { o1[i] = x1[i] * cc[i] - x2[i] * sn[i]; o2[i] = x1[i] * sn[i] + x2[i] * cc[i]; }
        v[0] = (u32x4){pk2(o1[0], o1[1]), pk2(o1[2], o1[3]), pk2(o1[4], o1[5]), pk2(o1[6], o1[7])};
        v[1] = (u32x4){pk2(o2[0], o2[1]), pk2(o2[2], o2[3]), pk2(o2[4], o2[5]), pk2(o2[6], o2[7])};
#pragma unroll
        for (int i = 0; i < 8; ++i) ((u32x4*)dst)[i] = v[i];
    }
    LAS bf16* tile = (LAS bf16*)lds;
    { const int tok = tid >> 3, ch = tid & 7;
#pragma unroll
      for (int mi = 0; mi < 4; ++mi) { const int col = (mi < 2 ? ZC_VS : ZC_VW) + (mi & 1) * 64;
          *(LAS u32x4*)(tile + mi * 4608 + tok * 72 + ch * 8) = *(const u32x4*)(z + (size_t)(mb + tok) * ZLD + col + ch * 8); } }
    __syncthreads();
    { const int d = tid >> 3, tc = tid & 7;
#pragma unroll
      for (int mi = 0; mi < 4; ++mi) { unsigned e[8];
#pragma unroll
          for (int j = 0; j < 8; ++j) e[j] = tile[mi * 4608 + vperm_src(tc * 8 + j) * 72 + d];
          u32x4 w; w.x = e[0] | (e[1] << 16); w.y = e[2] | (e[3] << 16); w.z = e[4] | (e[5] << 16); w.w = e[6] | (e[7] << 16);
          bf16* dst = (bf16*)(ws + (mi < 2 ? WS_VST : WS_VWT)) + ((size_t)(b * 2 + (mi & 1)) * 64 + d) * SEQ + tt * 64 + tc * 8;
          *(u32x4*)dst = w; } }
    __syncthreads();
}

__device__ __forceinline__ void nsa_compress_item(const Args& a, int layer, LAS unsigned char* lds, int b, int g, int kv, int nt) {
    unsigned char* ws = ws_of(a); const int tid = opaque_tid(), lane = tid & 63, wave = __builtin_amdgcn_readfirstlane(tid >> 6), fq = lane >> 4, fr = lane & 15;
    const bf16* z = (const bf16*)(ws + WS_Z);
    const bf16* w1t = (const bf16*)(ws + WS_CW1) + (size_t)(layer * 2 + kv) * 128 * 2048;
    const int colb = (kv ? ZC_VC : ZC_KC) + g * 64;
    f32x4 acc[8];
#pragma unroll
    for (int ht = 0; ht < 8; ++ht) acc[ht] = (f32x4){0.f, 0.f, 0.f, 0.f};
    for (int li = 0; li < 4; ++li) { const int l = wave * 4 + li;
        int tok = 256 * nt + 16 * fr + l; tok = tok > SEQ - 1 ? SEQ - 1 : tok;
#pragma unroll
        for (int hf = 0; hf < 2; ++hf) {
            const bf16x8 B = ld_bf8(z + (size_t)(b * SEQ + tok) * ZLD + colb + 32 * hf + 8 * fq);
#pragma unroll
            for (int ht = 0; ht < 8; ++ht) { const bf16x8 A = ld_bf8(w1t + (size_t)(16 * ht + fr) * 2048 + 64 * l + 32 * hf + 8 * fq);
                acc[ht] = __builtin_amdgcn_mfma_f32_16x16x32_bf16(A, B, acc[ht], 0, 0, 0); } } }
    LAS float* part = (LAS float*)lds;
    LAS float* hid = (LAS float*)(lds + 65536);
#pragma unroll
    for (int ht = 0; ht < 8; ++ht)
#pragma unroll
        for (int r = 0; r < 4; ++r) part[(wave * 128 + 16 * ht + 4 * fq + r) * 16 + fr] = acc[ht][r];
    __syncthreads();
    { const int hh = tid >> 2, nq = tid & 3; f32x4 s = (f32x4){0.f, 0.f, 0.f, 0.f};
#pragma unroll
      for (int w = 0; w < 8; ++w) s = s + *(LAS f32x4*)(part + (w * 128 + hh) * 16 + 4 * nq);
      float cb = 0.f; { const float* cbp = (const float*)(ws + WS_CBIAS) + (size_t)(layer * 2 + kv) * 16 * 128 + hh;
#pragma unroll
        for (int c = 0; c < 16; ++c) cb += cbp[c * 128]; }
      f32x4 o; o.x = gelu_tanh(s.x + cb); o.y = gelu_tanh(s.y + cb); o.z = gelu_tanh(s.z + cb); o.w = gelu_tanh(s.w + cb);
      *(LAS f32x4*)(hid + hh * 16 + 4 * nq) = o; }
    __syncthreads();
    { const float* W2 = INF(kv ? IN_VCW2 : IN_KCW2) + (size_t)layer * 128 * 64; const int n = tid & 15, dg = tid >> 4; float o0 = 0.f, o1 = 0.f;
      for (int hh = 0; hh < 128; ++hh) { const float x = hid[hh * 16 + n]; o0 += x * W2[hh * 64 + dg]; o1 += x * W2[hh * 64 + dg + 32]; }
      const int ng = 16 * nt + n; if (ng >= NCMP) { o0 = 0.f; o1 = 0.f; }
      if (kv == 0) { bf16* kc = (bf16*)(ws + WS_KCMP) + ((size_t)(b * 2 + g) * 256 + ng) * 64; kc[dg] = (bf16)f2bf(o0); kc[dg + 32] = (bf16)f2bf(o1); }
      else { bf16* vc = (bf16*)(ws + WS_VCMPT) + (size_t)(b * 2 + g) * 64 * 256; const int np = vperm_pos(ng); vc[(size_t)dg * 256 + np] = (bf16)f2bf(o0); vc[(size_t)(dg + 32) * 256 + np] = (bf16)f2bf(o1); } }
    __syncthreads();
}

__device__ __forceinline__ void phase_prep(const Args& a, int layer, LAS unsigned char* lds) {
    const int tid = opaque_tid(), lane = tid & 63, wave = __builtin_amdgcn_readfirstlane(tid >> 6);
#ifndef NO_RWP
    for (int tile = blockIdx.x * 4 + (wave & 3); tile < MT / 16; tile += gridDim.x * 4) rwkv_prep_tile(a, layer, tile * 16, lane, 8 * (wave >> 2), 8 * (wave >> 2) + 8);
#endif
#ifndef NO_NSAP
    for (int it = blockIdx.x; it < NB * 64; it += gridDim.x) nsa_prep_item(a, lds, it >> 6, it & 63);
#endif
#ifndef NO_CMP
    for (int it = blockIdx.x; it < NB * 2 * 2 * 16; it += gridDim.x) nsa_compress_item(a, layer, lds, it >> 6, (it >> 5) & 1, (it >> 4) & 1, it & 15);
#endif
}

__device__ __forceinline__ float dpp_xor1(float x) { return __builtin_bit_cast(float, __builtin_amdgcn_update_dpp(0, __builtin_bit_cast(int, x), 0xB1, 0xf, 0xf, true)); }
__device__ __forceinline__ float dpp_xor2(float x) { return __builtin_bit_cast(float, __builtin_amdgcn_update_dpp(0, __builtin_bit_cast(int, x), 0x4E, 0xf, 0xf, true)); }
__device__ __forceinline__ float dpp_hmir(float x) { return __builtin_bit_cast(float, __builtin_amdgcn_update_dpp(0, __builtin_bit_cast(int, x), 0x141, 0xf, 0xf, true)); }
__device__ __forceinline__ float red8(float x) { x += dpp_xor1(x); x += dpp_xor2(x); x += dpp_hmir(x); return x; }

__device__ __forceinline__ void rwkv_scan_seg(const Args& a, LAS unsigned char* lds, int bh, int seg) {
    unsigned char* ws = ws_of(a); const int tid = opaque_tid(), lane = tid & 63, wave = __builtin_amdgcn_readfirstlane(tid >> 6);
    const int row = wave * 8 + (lane >> 3), kq = lane & 7;
    const f32x4* rec4 = (const f32x4*)(ws + WS_REC) + ((size_t)bh * SEQ + (size_t)seg * SEGLEN) * 96;
    const size_t yoff = ((size_t)(bh >> 2) * SEQ + (size_t)seg * SEGLEN) * 256 + (bh & 3) * 64 + row;
    float* yraw = (float*)(ws + WS_YRAW) + yoff; float* ypb = (float*)(ws + WS_YP) + yoff;
    LAS f32x4* buf = (LAS f32x4*)lds;
    f32x2 s2[4], q2[4];
#pragma unroll
    for (int j = 0; j < 4; ++j) { s2[j] = (f32x2){0.f, 0.f}; q2[j] = (f32x2){(8 * kq + 2 * j == row) ? 1.f : 0.f, (8 * kq + 2 * j + 1 == row) ? 1.f : 0.f}; }
    __syncthreads();
    { f32x4 p0 = rec4[tid], p1 = rec4[tid + 512], p2 = rec4[tid + 1024]; buf[tid] = p0; buf[tid + 512] = p1; buf[tid + 1024] = p2; }
    __syncthreads();
    for (int c = 0; c < SEGLEN / 16; ++c) {
        const int p = c & 1;
        f32x4 n0, n1, n2; const bool more = (c + 1 < SEGLEN / 16);
        if (more) { const f32x4* src = rec4 + (size_t)(c + 1) * 1536; n0 = src[tid]; n1 = src[tid + 512]; n2 = src[tid + 1024]; }
        const LAS f32x4* bp = buf + p * 1536;
#pragma unroll 2
        for (int st = 0; st < 16; ++st) {
            const LAS f32x4* sp = bp + st * 96;
            const f32x4 w0 = sp[2 * kq], w1 = sp[2 * kq + 1], k0 = sp[16 + 2 * kq], k1 = sp[16 + 2 * kq + 1], b0 = sp[32 + 2 * kq], b1 = sp[32 + 2 * kq + 1];
            const f32x4 q0 = sp[48 + 2 * kq], q1 = sp[48 + 2 * kq + 1], r0 = sp[64 + 2 * kq], r1 = sp[64 + 2 * kq + 1];
            const float vv = ((const LAS float*)(sp + 80))[row];
            const f32x2 wv[4] = {{w0.x, w0.y}, {w0.z, w0.w}, {w1.x, w1.y}, {w1.z, w1.w}}, kk[4] = {{k0.x, k0.y}, {k0.z, k0.w}, {k1.x, k1.y}, {k1.z, k1.w}};
            const f32x2 bv[4] = {{b0.x, b0.y}, {b0.z, b0.w}, {b1.x, b1.y}, {b1.z, b1.w}}, kp[4] = {{q0.x, q0.y}, {q0.z, q0.w}, {q1.x, q1.y}, {q1.z, q1.w}};
            const f32x2 rr[4] = {{r0.x, r0.y}, {r0.z, r0.w}, {r1.x, r1.y}, {r1.z, r1.w}};
            f32x2 da = s2[0] * kk[0], ea = q2[0] * kk[0];
#pragma unroll
            for (int j = 1; j < 4; ++j) { da = __builtin_elementwise_fma(s2[j], kk[j], da); ea = __builtin_elementwise_fma(q2[j], kk[j], ea); }
            float d1 = da.x + da.y, e1 = ea.x + ea.y;
            d1 += dpp_xor1(d1); e1 += dpp_xor1(e1); d1 += dpp_xor2(d1); e1 += dpp_xor2(e1); d1 += dpp_hmir(d1); e1 += dpp_hmir(e1);
            const f32x2 sa = {-d1, -d1}, sq = {-e1, -e1}, v2 = {vv, vv};
            f32x2 db = {0.f, 0.f}, eb = {0.f, 0.f};
#pragma unroll
            for (int j = 0; j < 4; ++j) { const f32x2 t = __builtin_elementwise_fma(sa, bv[j], v2 * kp[j]); s2[j] = __builtin_elementwise_fma(s2[j], wv[j], t); db = __builtin_elementwise_fma(s2[j], rr[j], db);
                q2[j] = __builtin_elementwise_fma(q2[j], wv[j], sq * bv[j]); eb = __builtin_elementwise_fma(q2[j], rr[j], eb); }
            float d2 = db.x + db.y, e2 = eb.x + eb.y;
            d2 += dpp_xor1(d2); e2 += dpp_xor1(e2); d2 += dpp_xor2(d2); e2 += dpp_xor2(e2); d2 += dpp_hmir(d2); e2 += dpp_hmir(e2);
            if (kq == 0) { yraw[(size_t)(c * 16 + st) * 256] = d2; ypb[(size_t)(c * 16 + st) * 256] = e2; }
        }
        if (more) { LAS f32x4* dp = buf + (p ^ 1) * 1536; dp[tid] = n0; dp[tid + 512] = n1; dp[tid + 1024] = n2; }
        __syncthreads();
    }
    float* se = (float*)(ws + WS_SEGE) + ((size_t)(bh * NSEG + seg) * 2) * 4096 + row * 64 + 8 * kq;
    *(f32x4*)se = (f32x4){s2[0].x, s2[0].y, s2[1].x, s2[1].y}; *(f32x4*)(se + 4) = (f32x4){s2[2].x, s2[2].y, s2[3].x, s2[3].y};
    *(f32x4*)(se + 4096) = (f32x4){q2[0].x, q2[0].y, q2[1].x, q2[1].y}; *(f32x4*)(se + 4096 + 4) = (f32x4){q2[2].x, q2[2].y, q2[3].x, q2[3].y};
}

__device__ __forceinline__ void rwkv_chain(const Args& a, LAS unsigned char* lds, int bh) {
    unsigned char* ws = ws_of(a); const int tid = opaque_tid();
    LAS float* S = (LAS float*)lds;
    LAS float* P = S + 64 * 68;
    const int v = tid >> 3, kg = tid & 7;
    float* sst = (float*)(ws + WS_SST) + (size_t)bh * NSEG * 4096;
    const float* sege = (const float*)(ws + WS_SEGE) + (size_t)bh * NSEG * 2 * 4096;
    __syncthreads();
    for (int i = tid; i < 64 * 68; i += NTHR) S[i] = 0.f;
    for (int i = tid; i < 4096; i += NTHR) sst[i] = 0.f;
    __syncthreads();
    for (int sg = 1; sg < NSEG; ++sg) {
        const float* e0 = sege + (size_t)(sg - 1) * 2 * 4096;
        for (int i = tid; i < 1024; i += NTHR) *(LAS f32x4*)(P + 4 * i) = *(const f32x4*)(e0 + 4096 + 4 * i);
        f32x4 o0 = *(const f32x4*)(e0 + v * 64 + 8 * kg), o1 = *(const f32x4*)(e0 + v * 64 + 8 * kg + 4);
        __syncthreads();
#pragma unroll 4
        for (int i = 0; i < 64; ++i) { const float sv = S[v * 68 + i]; const f32x4 p0 = *(const LAS f32x4*)(P + i * 64 + 8 * kg), p1 = *(const LAS f32x4*)(P + i * 64 + 8 * kg + 4);
            o0 = o0 + p0 * sv; o1 = o1 + p1 * sv; }
        __syncthreads();
        *(LAS f32x4*)(S + v * 68 + 8 * kg) = o0; *(LAS f32x4*)(S + v * 68 + 8 * kg + 4) = o1;
        *(f32x4*)(sst + (size_t)sg * 4096 + v * 64 + 8 * kg) = o0; *(f32x4*)(sst + (size_t)sg * 4096 + v * 64 + 8 * kg + 4) = o1;
        __syncthreads();
    }
}

__device__ __forceinline__ void rwkv_post_item(const Args& a, int layer, LAS unsigned char* lds, int bh, int tile) {
    unsigned char* ws = ws_of(a); const int tid = opaque_tid();
    const int seg = tile / (SEGLEN / 64), bb = bh >> 2, h = bh & 3;
    LAS float* S = (LAS float*)lds;
    LAS float* YP = S + 64 * 68;
    const float* sst = (const float*)(ws + WS_SST) + (size_t)(bh * NSEG + seg) * 4096;
    const size_t m0 = (size_t)bb * SEQ + (size_t)tile * 64;
    __syncthreads();
    for (int i = tid; i < 1024; i += NTHR) { const int r = i >> 4, c4 = i & 15; *(LAS f32x4*)(S + r * 68 + 4 * c4) = *(const f32x4*)(sst + r * 64 + 4 * c4);
        *(LAS f32x4*)(YP + r * 68 + 4 * c4) = *(const f32x4*)((const float*)(ws + WS_YP) + (m0 + r) * 256 + h * 64 + 4 * c4); }
    __syncthreads();
    const int tok = tid >> 3, vg = tid & 7; const size_t m = m0 + tok; const int c0 = h * 64 + 8 * vg;
    const f32x4 ya = *(const f32x4*)((const float*)(ws + WS_YRAW) + m * 256 + c0), yb = *(const f32x4*)((const float*)(ws + WS_YRAW) + m * 256 + c0 + 4);
    float y[8] = {ya.x, ya.y, ya.z, ya.w, yb.x, yb.y, yb.z, yb.w};
    if (seg > 0) {
#pragma unroll 4
        for (int i = 0; i < 64; i += 4) { const f32x4 yp = *(const LAS f32x4*)(YP + tok * 68 + i);
#pragma unroll
            for (int j = 0; j < 8; ++j) { const f32x4 sr = *(const LAS f32x4*)(S + (8 * vg + j) * 68 + i); y[j] += (sr.x * yp.x + sr.y * yp.y) + (sr.z * yp.z + sr.w * yp.w); } }
    }
    float sm = 0.f;
#pragma unroll
    for (int j = 0; j < 8; ++j) sm += y[j];
    sm += __shfl_xor(sm, 1); sm += __shfl_xor(sm, 2); sm += __shfl_xor(sm, 4);
    const float mean = sm * (1.0f / 64.0f); float qq = 0.f;
#pragma unroll
    for (int j = 0; j < 8; ++j) { y[j] -= mean; qq += y[j] * y[j]; }
    qq += __shfl_xor(qq, 1); qq += __shfl_xor(qq, 2); qq += __shfl_xor(qq, 4);
    const float rstd = 1.0f / sqrtf(qq * (1.0f / 64.0f) + 64e-5f);
    const float* gng = INF(IN_RWGNG) + layer * 256 + c0; const float* gnb = INF(IN_RWGNB) + layer * 256 + c0;
    const float* gt = (const float*)(ws + WS_G) + m * 256 + c0;
    const float* vv = (const float*)(ws + WS_REC) + ((size_t)bh * SEQ + (size_t)tile * 64 + tok) * 384 + 320 + 8 * vg;
    const float bo = ((const float*)(ws + WS_BONUS))[m * 4 + h];
    float o[8];
#pragma unroll
    for (int j = 0; j < 8; ++j) o[j] = (y[j] * rstd * gng[j] + gnb[j] + vv[j] * bo) * gt[j];
    u32x4 w; w.x = pk2(o[0], o[1]); w.y = pk2(o[2], o[3]); w.z = pk2(o[4], o[5]); w.w = pk2(o[6], o[7]);
    *(u32x4*)((bf16*)(ws + WS_YCAT) + m * DM + 256 + c0) = w;
}

__device__ __forceinline__ void gmlp_item(const Args& a, int layer, LAS unsigned char* lds, int b, int n, int h) {
    unsigned char* ws = ws_of(a); const int tid = opaque_tid(), lane = tid & 63, wave = __builtin_amdgcn_readfirstlane(tid >> 6), fq = lane >> 4, fr = lane & 15;
    const bf16* z = (const bf16*)(ws + WS_Z); bf16* ycat = (bf16*)(ws + WS_YCAT);
    LAS bf16* vt = (LAS bf16*)lds;
    const int mb = b * SEQ + n * 128;
    { const int s = tid >> 2, part = tid & 3; const bf16* src = z + (size_t)(mb + s) * ZLD + ZC_V + h * 64 + part * 16;
      const u32x4 v0 = ((const u32x4*)src)[0], v1 = ((const u32x4*)src)[1];
      float x[16] = {bflo(v0.x), bfhi(v0.x), bflo(v0.y), bfhi(v0.y), bflo(v0.z), bfhi(v0.z), bflo(v0.w), bfhi(v0.w), bflo(v1.x), bfhi(v1.x), bflo(v1.y), bfhi(v1.y), bflo(v1.z), bfhi(v1.z), bflo(v1.w), bfhi(v1.w)};
      float sm = 0.f;
#pragma unroll
      for (int j = 0; j < 16; ++j) { x[j] = gelu_tanh(x[j]); sm += x[j]; }
      sm += __shfl_xor(sm, 1); sm += __shfl_xor(sm, 2);
      const float mean = sm * (1.0f / 64.0f); float q = 0.f;
#pragma unroll
      for (int j = 0; j < 16; ++j) { x[j] -= mean; q += x[j] * x[j]; }
      q += __shfl_xor(q, 1); q += __shfl_xor(q, 2);
      const float rstd = 1.0f / sqrtf(q * (1.0f / 64.0f) + 1e-5f);
      const float* lg = INF(IN_GMLNG) + (layer * 4 + h) * 64 + part * 16; const float* lb = INF(IN_GMLNB) + (layer * 4 + h) * 64 + part * 16;
#pragma unroll
      for (int j = 0; j < 16; ++j) vt[(part * 16 + j) * 136 + s] = (bf16)f2bf(x[j] * rstd * lg[j] + lb[j]); }
    __syncthreads();
    {
        const float* W = INF(IN_GMWS) + ((size_t)(layer * 4 + h) * 128 + 16 * wave + fr) * 128;
        f32x4 acc[4];
#pragma unroll
        for (int dt = 0; dt < 4; ++dt) acc[dt] = (f32x4){0.f, 0.f, 0.f, 0.f};
        const int trow = 16 * wave + fr; const int nks = (wave >> 1) + 1;
        for (int ks = 0; ks < nks; ++ks) {
            const int s0 = 32 * ks + 8 * fq; const f32x4 wa = *(const f32x4*)(W + s0), wb = *(const f32x4*)(W + s0 + 4);
            float wv[8] = {wa.x, wa.y, wa.z, wa.w, wb.x, wb.y, wb.z, wb.w};
#pragma unroll
            for (int j = 0; j < 8; ++j) wv[j] = (s0 + j <= trow) ? wv[j] : 0.f;
            const bf16x8 A = pack8(wv);
#pragma unroll
            for (int dt = 0; dt < 4; ++dt) { const bf16x8 B = *(const LAS bf16x8*)(vt + (16 * dt + fr) * 136 + s0); acc[dt] = __builtin_amdgcn_mfma_f32_16x16x32_bf16(A, B, acc[dt], 0, 0, 0); } }
        const float* bs = INF(IN_GMBS) + (layer * 4 + h) * 128;
#pragma unroll
        for (int r = 0; r < 4; ++r) { const int t = 16 * wave + 4 * fq + r; const float bias = bs[t];
#pragma unroll
            for (int dt = 0; dt < 4; ++dt) { const int d = 16 * dt + fr; const float u = gelu_tanh(bf2f(z[(size_t)(mb + t) * ZLD + ZC_U + h * 64 + d]));
                ycat[(size_t)(mb + t) * DM + h * 64 + d] = (bf16)f2bf(u * (acc[dt][r] + bias)); } }
    }
    __syncthreads();
}

constexpr int NSA_OT = 0, NSA_KB = 65536, NSA_VB = 93184, NSA_IMP = 120832, NSA_SELM = 137216, NSA_UNI = 137728;
struct NsaTileSrc { const bf16* kbase; int kld; const bf16* vbase; int vld; };

__device__ __forceinline__ void nsa_tile_load(const NsaTileSrc& S, int kb, int tid, u32x4& kr, u32x4& vr) {
    const int row = tid >> 3, ch = tid & 7;
    kr = *(const u32x4*)(S.kbase + (size_t)(kb * 64 + row) * S.kld + ch * 8);
    vr = *(const u32x4*)(S.vbase + (size_t)row * S.vld + kb * 64 + ch * 8);
}
__device__ __forceinline__ void nsa_tile_load_async(const NsaTileSrc& S, int kb, int tid, u32x4& kr, u32x4& vr) {
    const int row = tid >> 3, ch = tid & 7;
    const bf16* kp = S.kbase + (size_t)(kb * 64 + row) * S.kld + ch * 8; const bf16* vp = S.vbase + (size_t)row * S.vld + kb * 64 + ch * 8;
    asm volatile("global_load_dwordx4 %0, %1, off" : "=v"(kr) : "v"(kp) : "memory");
    asm volatile("global_load_dwordx4 %0, %1, off" : "=v"(vr) : "v"(vp) : "memory");
}
template <int N> __device__ __forceinline__ void nsa_tile_wait(u32x4& kr, u32x4& vr) { asm volatile("s_waitcnt vmcnt(%2)" : "+v"(kr), "+v"(vr) : "i"(N) : "memory"); }
__device__ __forceinline__ void nsa_tile_store(LAS unsigned char* lds, int p, int tid, const u32x4& kr, const u32x4& vr) {
    const int row = tid >> 3, ch = tid & 7;
    *(LAS u32x4*)(lds + NSA_KB + p * 9216 + (row * 72 + ch * 8) * 2) = kr;
    *(LAS u32x4*)(lds + NSA_VB + p * 9216 + (row * 72 + ch * 8) * 2) = vr;
}
__device__ __forceinline__ float max3f(float a, float b, float c) { float r; asm("v_max3_f32 %0, %1, %2, %3" : "=v"(r) : "v"(a), "v"(b), "v"(c)); return r; }
__device__ __forceinline__ void nsa_scores(LAS unsigned char* lds, int p, const bf16x8 (&Q)[2][2], f32x4 (&sc)[4][2], int fq, int fr) {
    bf16x8 K[4][2];
#pragma unroll
    for (int kt = 0; kt < 4; ++kt) { const LAS unsigned char* kp = lds + NSA_KB + p * 9216 + ((16 * kt + fr) * 72 + 8 * fq) * 2; K[kt][0] = *(const LAS bf16x8*)kp; K[kt][1] = *(const LAS bf16x8*)(kp + 64); }
    __builtin_amdgcn_sched_barrier(0);
#pragma unroll
    for (int kt = 0; kt < 4; ++kt)
#pragma unroll
        for (int qg = 0; qg < 2; ++qg) { f32x4 c = (f32x4){0.f, 0.f, 0.f, 0.f};
            c = __builtin_amdgcn_mfma_f32_16x16x32_bf16(K[kt][0], Q[qg][0], c, 0, 0, 0); c = __builtin_amdgcn_mfma_f32_16x16x32_bf16(K[kt][1], Q[qg][1], c, 0, 0, 0); sc[kt][qg] = c; }
}
template <int MODE>
__device__ __forceinline__ bool nsa_allowed(int kidx, int t, int kb, unsigned long long selm) {
    if (MODE == 0) return (16 * kidx + 31 <= t) && (kidx < NCMP);
    if (MODE == 1) return (kidx <= t) && ((selm >> kb) & 1ull);
    return (kidx <= t) && (kidx + 512 > t);
}
template <int MODE, int MM>
__device__ __forceinline__ void nsa_tile_compute(LAS unsigned char* lds, int p, int kb, const bf16x8 (&Q)[2][2], const int (&tq)[2], const unsigned long long (&selm)[2],
                                                 float (&m_run)[2], float (&l_run)[2], f32x4 (&O)[4][2], int fq, int fr) {
    f32x4 sc[4][2];
    nsa_scores(lds, p, Q, sc, fq, fr);
    const float SC = 0.125f * 1.4426950408889634f;
    bf16x8 P[2][2]; float alpha[2];
#pragma unroll
    for (int qg = 0; qg < 2; ++qg) {
        float mx = -1e30f; bool tok_ok = true;
        if (MM == 2) {
#pragma unroll
            for (int kt = 0; kt < 4; ++kt)
#pragma unroll
                for (int r = 0; r < 4; ++r) { const int kidx = kb * 64 + 16 * kt + 4 * fq + r;
                    const float v = nsa_allowed<MODE>(kidx, tq[qg], kb, selm[qg]) ? sc[kt][qg][r] * SC : -1e30f; sc[kt][qg][r] = v; mx = fmaxf(mx, v); }
        } else {
#pragma unroll
            for (int kt = 0; kt < 4; ++kt) { sc[kt][qg] = sc[kt][qg] * SC;
                mx = fmaxf(fmaxf(mx, sc[kt][qg][0]), sc[kt][qg][1]); mx = fmaxf(fmaxf(mx, sc[kt][qg][2]), sc[kt][qg][3]); }
            if (MM == 1) { tok_ok = (selm[qg] >> kb) & 1ull; mx = tok_ok ? mx : -1e30f; }
        }
        mx = fmaxf(mx, __shfl_xor(mx, 16)); mx = fmaxf(mx, __shfl_xor(mx, 32));
        const float mn = fmaxf(m_run[qg], mx); alpha[qg] = __builtin_amdgcn_exp2f(m_run[qg] - mn); m_run[qg] = mn;
        const float msub = (MM == 1 && !tok_ok) ? 1e30f : mn;
        float ls; float pv[4][4];
        if (MM == 2) { ls = 0.f;
#pragma unroll
            for (int kt = 0; kt < 4; ++kt)
#pragma unroll
                for (int r = 0; r < 4; ++r) { const float sv = sc[kt][qg][r]; const float e = (sv > -1e29f) ? __builtin_amdgcn_exp2f(sv - mn) : 0.f; pv[kt][r] = e; ls += e; }
        } else { const f32x2 m2 = {msub, msub}; f32x2 l2 = {0.f, 0.f};
#pragma unroll
            for (int kt = 0; kt < 4; ++kt)
#pragma unroll
                for (int h = 0; h < 2; ++h) { const f32x2 t = (f32x2){sc[kt][qg][2 * h], sc[kt][qg][2 * h + 1]} - m2; f32x2 e; e.x = __builtin_amdgcn_exp2f(t.x); e.y = __builtin_amdgcn_exp2f(t.y);
                    pv[kt][2 * h] = e.x; pv[kt][2 * h + 1] = e.y; l2 = l2 + e; }
            ls = l2.x + l2.y; }
        l_run[qg] = l_run[qg] * alpha[qg] + ls;
#pragma unroll
        for (int s = 0; s < 2; ++s) { u32x4 w; w.x = pg8::cvt_pk_bf16(pv[2 * s][0], pv[2 * s][1]); w.y = pg8::cvt_pk_bf16(pv[2 * s][2], pv[2 * s][3]); w.z = pg8::cvt_pk_bf16(pv[2 * s + 1][0], pv[2 * s + 1][1]); w.w = pg8::cvt_pk_bf16(pv[2 * s + 1][2], pv[2 * s + 1][3]);
            P[qg][s] = __builtin_bit_cast(bf16x8, w); }
    }
    if (!__all(alpha[0] == 1.0f && alpha[1] == 1.0f)) {
#pragma unroll
        for (int qg = 0; qg < 2; ++qg)
#pragma unroll
            for (int dt = 0; dt < 4; ++dt) O[dt][qg] = O[dt][qg] * alpha[qg];
    }
    bf16x8 V[4][2];
#pragma unroll
    for (int dt = 0; dt < 4; ++dt)
#pragma unroll
        for (int s = 0; s < 2; ++s) V[dt][s] = *(const LAS bf16x8*)(lds + NSA_VB + p * 9216 + ((16 * dt + fr) * 72 + 32 * s + 8 * fq) * 2);
    __builtin_amdgcn_sched_barrier(0);
#pragma unroll
    for (int dt = 0; dt < 4; ++dt)
#pragma unroll
        for (int s = 0; s < 2; ++s) {
#pragma unroll
            for (int qg = 0; qg < 2; ++qg) O[dt][qg] = __builtin_amdgcn_mfma_f32_16x16x32_bf16(V[dt][s], P[qg][s], O[dt][qg], 0, 0, 0);
        }
}

template <int MODE>
__device__ __forceinline__ void nsa_branch(LAS unsigned char* lds, const NsaTileSrc& S, int kb_lo, int kb_hi, int full_lo, int full_hi, unsigned long long tilemask, const bf16x8 (&Q)[2][2], const int (&tq)[2],
                                           const unsigned long long (&selm)[2], const float (&gate)[2], const bool first, float (&m_out)[2], float (&l_out)[2], int tid, int fq, int fr) {
    float m_run[2] = {-1e30f, -1e30f}, l_run[2] = {0.f, 0.f}; f32x4 O[4][2];
#pragma unroll
    for (int dt = 0; dt < 4; ++dt)
#pragma unroll
        for (int qg = 0; qg < 2; ++qg) O[dt][qg] = (f32x4){0.f, 0.f, 0.f, 0.f};
#define NSA_NEXT(x) ({ int _n = (x) + 1; while (_n <= kb_hi && !((tilemask >> _n) & 1ull)) ++_n; _n; })
#define NSA_COMPUTE(p_, t_) do { if (MODE != 0 && (t_) >= full_lo && (t_) <= full_hi) nsa_tile_compute<MODE, (MODE == 1 ? 1 : 0)>(lds, p_, t_, Q, tq, selm, m_run, l_run, O, fq, fr); \
        else nsa_tile_compute<MODE, 2>(lds, p_, t_, Q, tq, selm, m_run, l_run, O, fq, fr); } while (0)
    int t0 = kb_lo; while (t0 <= kb_hi && !((tilemask >> t0) & 1ull)) ++t0;
    if (t0 <= kb_hi) {
        u32x4 ka, va, kb_, vb_; int p = 0;
        asm volatile("" :: "v"(Q[0][0]), "v"(Q[0][1]), "v"(Q[1][0]), "v"(Q[1][1]));
        VM_WAIT();
        nsa_tile_load_async(S, t0, tid, ka, va); nsa_tile_wait<0>(ka, va); nsa_tile_store(lds, 0, tid, ka, va);
        int t1 = NSA_NEXT(t0);
        nsa_tile_load_async(S, t1 <= kb_hi ? t1 : t0, tid, kb_, vb_);
        __syncthreads();
        for (;;) {
            const int t2 = t1 <= kb_hi ? NSA_NEXT(t1) : t1;
            nsa_tile_load_async(S, t2 <= kb_hi ? t2 : t0, tid, ka, va);
            NSA_COMPUTE(p, t0);
            const int p1 = p == 2 ? 0 : p + 1;
            nsa_tile_wait<2>(kb_, vb_); nsa_tile_store(lds, p1, tid, kb_, vb_);
            __syncthreads();
            if (t1 > kb_hi) break;
            const int t3 = t2 <= kb_hi ? NSA_NEXT(t2) : t2;
            nsa_tile_load_async(S, t3 <= kb_hi ? t3 : t0, tid, kb_, vb_);
            NSA_COMPUTE(p1, t1);
            const int p2 = p1 == 2 ? 0 : p1 + 1;
            nsa_tile_wait<2>(ka, va); nsa_tile_store(lds, p2, tid, ka, va);
            __syncthreads();
            if (t2 > kb_hi) break;
            t0 = t2; t1 = t3; p = p2;
        }
        nsa_tile_wait<0>(ka, va); nsa_tile_wait<0>(kb_, vb_);
    }
#undef NSA_NEXT
#undef NSA_COMPUTE
#pragma unroll
    for (int qg = 0; qg < 2; ++qg) { float l = l_run[qg]; l += __shfl_xor(l, 16); l += __shfl_xor(l, 32); l_out[qg] = l; m_out[qg] = m_run[qg];
        const float sc = l > 0.f ? gate[qg] / l : 0.f;
        LAS float* ot = (LAS float*)(lds + NSA_OT) + tid;
#pragma unroll
        for (int dt = 0; dt < 4; ++dt)
#pragma unroll
            for (int r = 0; r < 4; ++r) { LAS float* pp = ot + ((dt * 2 + qg) * 4 + r) * 512; const float v = O[dt][qg][r] * sc; *pp = first ? v : (*pp + v); } }
}

__device__ __forceinline__ void nsa_item(const Args& a, LAS unsigned char* lds, int b, int g, int T) {
    unsigned char* ws = ws_of(a); const int tid = opaque_tid(), lane = tid & 63, wave = __builtin_amdgcn_readfirstlane(tid >> 6), fq = lane >> 4, fr = lane & 15;
    const bf16* z = (const bf16*)(ws + WS_Z);
    const int head = g * 4 + (fr & 3);
    int tq[2], mq[2]; bf16x8 Qraw[2][2]; float gt[2][3];
#pragma unroll
    for (int qg = 0; qg < 2; ++qg) { const int tl = 8 * wave + 4 * qg + (fr >> 2); tq[qg] = T * 64 + tl; mq[qg] = b * SEQ + tq[qg];
#pragma unroll
        for (int ks = 0; ks < 2; ++ks) Qraw[qg][ks] = ld_bf8(z + (size_t)mq[qg] * ZLD + ZC_Q + head * 64 + 32 * ks + 8 * fq);
#pragma unroll
        for (int br = 0; br < 3; ++br) gt[qg][br] = sigmoidf_(bf2f(z[(size_t)mq[qg] * ZLD + ZC_GT + head * 3 + br])); }
    if (tid < 64) { ((LAS unsigned long long*)(lds + NSA_SELM))[tid] = 0ull; if (tid < 2) ((LAS unsigned*)(lds + NSA_UNI))[tid] = 0u; }
    const unsigned long long nosel[2] = {0ull, 0ull};
    NsaTileSrc SC_; SC_.kbase = (const bf16*)(ws + WS_KCMP) + (size_t)(b * 2 + g) * 256 * 64; SC_.kld = 64; SC_.vbase = (const bf16*)(ws + WS_VCMPT) + (size_t)(b * 2 + g) * 64 * 256; SC_.vld = 256;
    float mc[2], lc[2];
    { float gc[2] = {gt[0][0], gt[1][0]};
      nsa_branch<0>(lds, SC_, 0, 3, 1, 0, ~0ull, Qraw, tq, nosel, gc, true, mc, lc, tid, fq, fr); }
    {
        LAS float* imp = (LAS float*)(lds + NSA_IMP);
        float carry[2] = {0.f, 0.f}; const float SCL = 0.125f * 1.4426950408889634f;
        float invl[2] = {lc[0] > 0.f ? 1.0f / lc[0] : 0.f, lc[1] > 0.f ? 1.0f / lc[1] : 0.f};
        for (int kb = 0; kb < 4; ++kb) {
            { const int row = tid >> 3, ch = tid & 7; *(LAS u32x4*)(lds + NSA_KB + (row * 72 + ch * 8) * 2) = *(const u32x4*)(SC_.kbase + (size_t)(kb * 64 + row) * 64 + ch * 8); }
            __syncthreads();
            f32x4 sc[4][2]; nsa_scores(lds, 0, Qraw, sc, fq, fr);
#pragma unroll
            for (int kt = 0; kt < 4; ++kt)
#pragma unroll
                for (int qg = 0; qg < 2; ++qg) { float pn[4];
#pragma unroll
                    for (int r = 0; r < 4; ++r) { const int kidx = kb * 64 + 16 * kt + 4 * fq + r; const bool al = nsa_allowed<0>(kidx, tq[qg], kb, 0ull);
                        pn[r] = al ? __builtin_amdgcn_exp2f(sc[kt][qg][r] * SCL - mc[qg]) * invl[qg] : 0.f; }
                    const float y = __shfl(pn[3], (lane + 48) & 63);
                    float v = (pn[0] + pn[1]) + (pn[2] + pn[3]) + (fq == 0 ? carry[qg] : y); carry[qg] = y;
                    v += __shfl_xor(v, 1); v += __shfl_xor(v, 2);
                    if ((fr & 3) == 0) imp[(8 * wave + 4 * qg + (fr >> 2)) * 64 + 16 * kb + 4 * kt + fq] = v; }
            __syncthreads();
        }
    }
    {
        const LAS float* imp = (const LAS float*)(lds + NSA_IMP);
        const int tl = tid >> 3, part = tid & 7; float vm[8]; int cnt[8];
        { const f32x4 x0 = *(const LAS f32x4*)(imp + tl * 64 + part * 8), x1 = *(const LAS f32x4*)(imp + tl * 64 + part * 8 + 4);
          const float xx[8] = {x0.x, x0.y, x0.z, x0.w, x1.x, x1.y, x1.z, x1.w};
#pragma unroll
          for (int j = 0; j < 8; ++j) { const int mi = part * 8 + j; const bool valid = mi <= T; const bool forced = (mi == 0) || (mi == T) || (mi == T - 1);
              vm[j] = valid ? xx[j] + (forced ? 1e4f : 0.f) : -1e4f; cnt[j] = 0; } }
        for (int q4 = 0; q4 < 16; ++q4) { const f32x4 x = *(const LAS f32x4*)(imp + tl * 64 + 4 * q4); const float xq[4] = {x.x, x.y, x.z, x.w};
#pragma unroll
            for (int i = 0; i < 4; ++i) { const int q = 4 * q4 + i; const bool valid = q <= T; const bool forced = (q == 0) || (q == T) || (q == T - 1);
                const float vq = valid ? xq[i] + (forced ? 1e4f : 0.f) : -1e4f;
#pragma unroll
                for (int j = 0; j < 8; ++j) { const int mi = part * 8 + j; cnt[j] += (vq > vm[j] || (vq == vm[j] && q < mi)) ? 1 : 0; } } }
        unsigned bits = 0u;
#pragma unroll
        for (int j = 0; j < 8; ++j) if (cnt[j] < 16 && vm[j] > -5000.f) bits |= 1u << j;
        atomicOr((unsigned*)(lds + NSA_SELM) + tl * 2 + (part >> 2), bits << (8 * (part & 3)));
        atomicOr((unsigned*)(lds + NSA_UNI) + (part >> 2), bits << (8 * (part & 3)));
    }
    __syncthreads();
    bf16x8 Qrot[2][2];
#pragma unroll
    for (int qg = 0; qg < 2; ++qg)
#pragma unroll
        for (int ks = 0; ks < 2; ++ks) Qrot[qg][ks] = ld_bf8((const bf16*)(ws + WS_QROT) + (size_t)mq[qg] * 512 + head * 64 + 32 * ks + 8 * fq);
    unsigned long long selm[2], uni;
    { const LAS unsigned long long* sm = (const LAS unsigned long long*)(lds + NSA_SELM); selm[0] = sm[8 * wave + (fr >> 2)]; selm[1] = sm[8 * wave + 4 + (fr >> 2)]; const LAS unsigned* up = (const LAS unsigned*)(lds + NSA_UNI); uni = ((unsigned long long)(unsigned)__builtin_amdgcn_readfirstlane(up[1]) << 32) | (unsigned)__builtin_amdgcn_readfirstlane(up[0]); }
    { NsaTileSrc SS; SS.kbase = (const bf16*)(ws + WS_KSR) + (size_t)b * SEQ * 128 + g * 64; SS.kld = 128; SS.vbase = (const bf16*)(ws + WS_VST) + (size_t)(b * 2 + g) * 64 * SEQ; SS.vld = SEQ;
      float gs[2] = {gt[0][1], gt[1][1]}, mo[2], lo[2];
      nsa_branch<1>(lds, SS, 0, T, 0, T - 1, uni, Qrot, tq, selm, gs, false, mo, lo, tid, fq, fr); }
    { NsaTileSrc SW; SW.kbase = (const bf16*)(ws + WS_KWR) + (size_t)b * SEQ * 128 + g * 64; SW.kld = 128; SW.vbase = (const bf16*)(ws + WS_VWT) + (size_t)(b * 2 + g) * 64 * SEQ; SW.vld = SEQ;
      float gw_[2] = {gt[0][2], gt[1][2]}, mo[2], lo[2]; const int lo_kb = T >= 8 ? T - 8 : 0;
      nsa_branch<2>(lds, SW, lo_kb, T, T - 7, T - 1, ~0ull, Qrot, tq, nosel, gw_, false, mo, lo, tid, fq, fr); }
    bf16* ycat = (bf16*)(ws + WS_YCAT);
#pragma unroll
    for (int qg = 0; qg < 2; ++qg)
#pragma unroll
        for (int dt = 0; dt < 4; ++dt) { const LAS float* ot = (const LAS float*)(lds + NSA_OT) + tid + ((dt * 2 + qg) * 4) * 512;
            u32x2 w; w.x = pk2(ot[0], ot[512]); w.y = pk2(ot[1024], ot[1536]);
            *(u32x2*)(ycat + (size_t)mq[qg] * DM + 512 + head * 64 + 16 * dt + 4 * fq) = w; }
}

struct MoeOrder {
    const char* A; const char* W; size_t estride; int K, nct, G, c; int tst[9];
    __device__ bool next(int i, pg8::Unit& u) const {
        const long L = (long)i * G + c; if (L >= (long)tst[8] * nct) return false;
        const int rt = (int)(L / nct), ct = (int)(L % nct); int e = 0;
#pragma unroll
        for (int j = 1; j < 8; ++j) e += (rt >= tst[j]) ? 1 : 0;
        u.pm = rt; u.pn = ct; u.aux = e; return true;
    }
    __device__ __forceinline__ const char* abase(const pg8::Unit& u) const { return A + (size_t)u.pm * ((size_t)256 * K * 2); }
    __device__ __forceinline__ const char* bbase(const pg8::Unit& u) const { return W + (size_t)u.aux * estride + (size_t)u.pn * ((size_t)256 * K * 2); }
};
__device__ __forceinline__ void moe_order_init(MoeOrder& S, const Args& a, int rank, const void* A, const void* W, size_t estride, int K, int nct) {
    S.A = (const char*)A; S.W = (const char*)W; S.estride = estride; S.K = K; S.nct = nct; S.G = gridDim.x; S.c = blockIdx.x;
    const int* t = (const int*)(ws_of(a) + WS_SLOT + SL_TST) + rank * 16;
#pragma unroll
    for (int j = 0; j < 9; ++j) S.tst[j] = __builtin_amdgcn_readfirstlane(t[j]);
}
__device__ __forceinline__ void moe_gather(const Args& a, int rb, int r) {
    unsigned char* ws = ws_of(a); const int tid = opaque_tid();
    const int* toks = (const int*)(ws + WS_SLOT + SL_TOKS);
    const u32x4* hn = (const u32x4*)(ws + WS_HN); u32x4* hns = (u32x4*)(ws + WS_HNS);
    for (int i = tid; i < 64 * 128; i += NTHR) { const int tl = i >> 7, ch = i & 127, m = rb * 64 + tl; const int slot = toks[2 * m + r];
        hns[(size_t)slot * 128 + ch] = hn[(size_t)m * 128 + ch]; }
}
__device__ __forceinline__ void phase_moe_assign(const Args& a, LAS unsigned char* lds) {
    unsigned char* ws = ws_of(a); const int tid = opaque_tid(), lane = tid & 63, wave = __builtin_amdgcn_readfirstlane(tid >> 6);
    LAS int* cn = (LAS int*)lds;
    LAS int* tot = cn + 4096; LAS int* base = tot + 16; LAS int* pre = base + 16;
    const int* bcnt = (const int*)(ws + WS_SLOT + SL_BCNT);
    for (int i = tid; i < 4096; i += NTHR) cn[i] = bcnt[i];
    __syncthreads();
    if (tid < 16) { int s = 0; for (int bb = 0; bb < 256; ++bb) s += cn[bb * 16 + tid]; tot[tid] = s; }
    __syncthreads();
    if (tid < 2) { int run = 0; int* tstg = (int*)(ws + WS_SLOT + SL_TST) + tid * 16;
        for (int e = 0; e < 8; ++e) { base[tid * 8 + e] = run * 256; if (blockIdx.x == 0) tstg[e] = run; run += (tot[tid * 8 + e] + 255) >> 8; }
        if (blockIdx.x == 0) tstg[8] = run; }
    __syncthreads();
    int* stok = (int*)(ws + WS_SLOT + SL_TOK); float* sgate = (float*)(ws + WS_SLOT + SL_GATE);
    if (blockIdx.x == 0) {
        for (int grp = 0; grp < 16; ++grp) { const int r = grp >> 3, lo = base[grp] + tot[grp], hi = base[grp] + (((tot[grp] + 255) >> 8) << 8);
            for (int s = lo + tid; s < hi; s += NTHR) { stok[r * MOE_SLOTS + s] = -1; sgate[r * MOE_SLOTS + s] = 0.f; } }
    }
    const int* te = (const int*)(ws + WS_SLOT + SL_TOKE); const float* tg = (const float*)(ws + WS_SLOT + SL_TOKG); int* toks = (int*)(ws + WS_SLOT + SL_TOKS);
    for (int rb = blockIdx.x; rb < MT / 64; rb += gridDim.x) {
        __syncthreads();
        if (tid < 16) { int s = 0; for (int bb = 0; bb < rb; ++bb) s += cn[bb * 16 + tid]; pre[tid] = s; }
        __syncthreads();
        if (wave == 0) { const int m = rb * 64 + lane;
#pragma unroll
            for (int r = 0; r < 2; ++r) { const int e = te[2 * m + r]; int slot = 0;
#pragma unroll
                for (int ee = 0; ee < 8; ++ee) { const unsigned long long mk = __ballot(e == ee); const int rk = __popcll(mk & ((1ull << lane) - 1ull)); if (e == ee) slot = base[r * 8 + ee] + pre[r * 8 + ee] + rk; }
                stok[r * MOE_SLOTS + slot] = m; sgate[r * MOE_SLOTS + slot] = tg[2 * m + r]; toks[2 * m + r] = slot; } }
        asm volatile("s_waitcnt vmcnt(0)" ::: "memory");
        __syncthreads();
        moe_gather(a, rb, 0);
    }
}
__device__ __forceinline__ void moe_convert_weights(const Args& a, LAS unsigned char* lds) {
    const int tid = opaque_tid(), lane = tid & 63, wave = __builtin_amdgcn_readfirstlane(tid >> 6);
    const int gw = blockIdx.x * NWAVES + wave, NGW = gridDim.x * NWAVES; (void)lds;
    constexpr int PER_E = 2 * conv_nitems(DM, DFF) + conv_nitems(DFF, DM);
    unsigned char* ws = ws_of(a);
    for (int it0 = gw; it0 < NEXP * PER_E; it0 += NGW) {
        const int e = it0 / PER_E; int it = it0 - e * PER_E;
        CONV_JOB(INF(IN_MW1) + (size_t)e * DM * DFF, DM, DFF, (bf16*)(ws + WS_MW13) + (size_t)e * 5632 * DM, 1, INF(IN_GFFN) + DM)
        CONV_JOB(INF(IN_MW3) + (size_t)e * DM * DFF, DM, DFF, (bf16*)(ws + WS_MW13) + (size_t)e * 5632 * DM, 2, INF(IN_GFFN) + DM)
        CONV_JOB(INF(IN_MW2) + (size_t)e * DFF * DM, DFF, DM, (bf16*)(ws + WS_MW2) + (size_t)e * DM * DFF, 0, nullptr)
    }
}

template <class Sched>
__device__ __forceinline__ void fill_rs_table(LAS unsigned char* lds, const Sched& S, const float* rss, const int* slot_tok) {
    const int tid = opaque_tid(); LAS float* tab = (LAS float*)(lds + RSTAB_OFF);
    const int rl = tid & 255;
    for (int i = tid >> 8; i < RSTAB_MAX_UNITS; i += 2) { pg8::Unit u; if (!S.next(i, u)) break;
        int row = u.pm * 256 + rl; if (slot_tok) { row = slot_tok[row]; row = row < 0 ? 0 : row; }
        const f32x4* p = (const f32x4*)(rss + (size_t)row * 16); const f32x4 a = p[0], b = p[1], c = p[2], d = p[3];
        const float sm = ((a[0] + a[1]) + (a[2] + a[3])) + ((b[0] + b[1]) + (b[2] + b[3])) + (((c[0] + c[1]) + (c[2] + c[3])) + ((d[0] + d[1]) + (d[2] + d[3])));
        tab[i * 256 + rl] = 1.0f / sqrtf(sm * (1.0f / 1024.0f) + 1e-6f); }
    __syncthreads();
}

constexpr int NPL = 15, NPHASES = 1 + 2 * NPL;
__host__ __device__ constexpr bool phase_empty(int k) { if (k < 1) return false; const int l = (k - 1) / NPL, j = (k - 1) % NPL; if (j == 12) return true; if (l == 0) return j == 6 || (j >= 9 && j <= 11) || j == 14; return false; }

#ifndef PHSEL
#define PHSEL -1
#endif
#ifndef REP_GIN
#define REP_GIN 1
#endif
#ifndef REP_PREP
#define REP_PREP 1
#endif
#ifndef REP_NSA
#define REP_NSA 1
#endif
#ifndef REP_SCAN
#define REP_SCAN 1
#endif
#ifndef REP_GMLP
#define REP_GMLP 1
#endif
#ifndef REP_F1
#define REP_F1 1
#endif
#ifndef REP_PRO
#define REP_PRO 1
#endif
#ifndef REP_POST
#define REP_POST 1
#endif
#ifndef REP_CHAIN
#define REP_CHAIN 1
#endif
#define IN(k) (lo <= (k) && (k) < hi)
#define INL(j) ((PHSEL == -1 || PHSEL == (j)) && IN(pb + (j)))
#define SEAM(k) do { if ((k) + 1 < hi) xcd_barrier(bar); } while (0)
#define WSP ({ unsigned long long _z = 0; asm volatile("" : "+s"(_z)); wsbase_ + _z; })

template <int L>
__device__ __forceinline__ void run_layer(const Args& a, LAS unsigned char* lds, volatile LAS unsigned* MISC, const XcdBarrier& bar, const int lo, const int hi) {
    constexpr int l = L;
    unsigned char* const wsbase_ = a.ws;
    const int G = gridDim.x, bx = blockIdx.x, tid = opaque_tid();
        const int pb = 1 + l * NPL;
#define ws WSP
#define ctl ((unsigned*)WSP)
#define hbA ((bf16*)(WSP + WS_HN))
#define hbB ((bf16*)(WSP + WS_HB2))
#define rssA ((float*)(WSP + WS_RSS))
#define rssB ((float*)(WSP + WS_RSS) + (size_t)MT * 16)
#define hb_in (l == 0 ? hbA : hbB)
#define rss_in (l == 0 ? rssA : rssB)
        if (INL(0)) for (int rep = 0; rep < REP_GIN; ++rep) { pg8::StaticOrder S; S.init(hb_in, (bf16*)(ws + WS_WIN) + (size_t)l * ZLD * DM, MT, ZLD, DM, G, bx);
            fill_rs_table(lds, S, rss_in, nullptr); pg8::EpiBf16Store E{(bf16*)(ws + WS_Z), ZLD, (const LAS float*)(lds + RSTAB_OFF)}; pg8::gemm_phase(lds, DM, S, E); if (rep == REP_GIN - 1) SEAM(pb + 0); }
        if (INL(1)) { for (int rep = 0; rep < REP_PREP; ++rep) phase_prep(a, l, lds); SEAM(pb + 1); }
        if (INL(2)) {
#ifndef NO_SCAN
            for (int rep = 0; rep < REP_SCAN; ++rep) for (int it = bx; it < 16 * NSEG; it += G) rwkv_scan_seg(a, lds, it & 15, it >> 4);
#endif
#ifndef NO_NSA
            {
                const unsigned xcc = xb_xcc_id() & 7u;
                for (unsigned k = 0; k < 8; ++k) { const unsigned qi = (xcc + k) & 7u; unsigned* qn = ctl + CW_Q + 64 * (4 + l * 8 + qi);
                    for (;;) { __syncthreads(); if (tid == 0) MISC[16] = __hip_atomic_fetch_add(qn, 1u, __ATOMIC_RELAXED, __HIP_MEMORY_SCOPE_AGENT); __syncthreads();
                        const int it = (int)MISC[16]; if (it >= 64 * REP_NSA) break; nsa_item(a, lds, (int)(qi >> 1), (int)(qi & 1), 63 - (it & 63)); } }
            }
#endif
            SEAM(pb + 2); }
        if (INL(3)) {
            for (int rep = 0; rep < REP_CHAIN; ++rep) for (int bh = bx; bh < 16; bh += G) rwkv_chain(a, lds, bh);
            unsigned* qg = ctl + CW_Q + 64 * (l * 2 + 1);
#ifndef NO_GMLP
            for (;;) { __syncthreads(); if (tid == 0) MISC[16] = __hip_atomic_fetch_add(qg, 1u, __ATOMIC_RELAXED, __HIP_MEMORY_SCOPE_AGENT); __syncthreads();
                int it = (int)MISC[16]; if (it >= 512 * REP_GMLP) break; it &= 511; gmlp_item(a, l, lds, it >> 7, (it >> 2) & 31, it & 3); }
#endif
            SEAM(pb + 3); }
        if (INL(4)) { for (int rep = 0; rep < REP_POST; ++rep) for (int it = bx; it < 16 * 64; it += G) rwkv_post_item(a, l, lds, it & 15, it >> 4); SEAM(pb + 4); }
        if (INL(5)) { pg8::StaticOrder S; S.init(ws + WS_YCAT, (bf16*)(ws + WS_WOUT) + (size_t)l * DM * DM, MT, DM, DM, G, bx);
            pg8::EpiResAdd E{a.out, DM, hbA, rssA}; pg8::gemm_phase(lds, DM, S, E); SEAM(pb + 5); }
        if (l == 0) {
            if (INL(7)) { pg8::StaticOrder S; S.init(hbA, ws + WS_W13, MT, 2 * DFF, DM, G, bx); fill_rs_table(lds, S, rssA, nullptr); pg8::EpiSwiglu E{(bf16*)(ws + WS_ACT), DFF, (const LAS float*)(lds + RSTAB_OFF)}; pg8::gemm_phase(lds, DM, S, E); SEAM(pb + 7); }
            if (INL(8)) { pg8::StaticOrder S; S.init(ws + WS_ACT, ws + WS_W2, MT, DM, DFF, G, bx); pg8::EpiResAdd E{a.out, DM, hbA, rssA}; pg8::gemm_phase(lds, DFF, S, E); if (pb + 13 < hi) xcd_barrier(bar); }
        } else {
            if (INL(6)) { for (int rep = 0; rep < REP_PRO; ++rep) { moe_convert_weights(a, lds); __syncthreads(); } phase_norm<1>(a, lds, INF(IN_GFFN) + DM); SEAM(pb + 6); }
            if (INL(7)) { phase_moe_assign(a, lds); SEAM(pb + 7); }
            if (INL(8)) { MoeOrder S; moe_order_init(S, a, 0, ws + WS_HNS, ws + WS_MW13, (size_t)5632 * DM * 2, DM, 22);
                fill_rs_table(lds, S, rssA, (const int*)(ws + WS_SLOT + SL_TOK)); pg8::EpiSwiglu E{(bf16*)(ws + WS_ACTM), DFF, (const LAS float*)(lds + RSTAB_OFF)}; pg8::gemm_phase(lds, DM, S, E); SEAM(pb + 8); }
            if (INL(9)) { for (int rb = bx; rb < MT / 64; rb += G) moe_gather(a, rb, 1);
                MoeOrder S; moe_order_init(S, a, 0, ws + WS_ACTM, ws + WS_MW2, (size_t)DM * DFF * 2, DFF, 4);
                pg8::EpiMoe2<false> E{a.out, (const int*)(ws + WS_SLOT + SL_TOK), (const float*)(ws + WS_SLOT + SL_GATE), DM, hbA, rssA}; pg8::gemm_phase(lds, DFF, S, E); SEAM(pb + 9); }
            if (INL(10)) { MoeOrder S; moe_order_init(S, a, 1, ws + WS_HNS, ws + WS_MW13, (size_t)5632 * DM * 2, DM, 22);
                fill_rs_table(lds, S, rssA, (const int*)(ws + WS_SLOT + SL_TOK) + MOE_SLOTS); pg8::EpiSwiglu E{(bf16*)(ws + WS_ACTM), DFF, (const LAS float*)(lds + RSTAB_OFF)}; pg8::gemm_phase(lds, DM, S, E); SEAM(pb + 10); }
            if (INL(11)) { MoeOrder S; moe_order_init(S, a, 1, ws + WS_ACTM, ws + WS_MW2, (size_t)DM * DFF * 2, DFF, 4);
                pg8::EpiMoe2<true> E{a.out, (const int*)(ws + WS_SLOT + SL_TOK) + MOE_SLOTS, (const float*)(ws + WS_SLOT + SL_GATE) + MOE_SLOTS, DM, hbA, rssA}; pg8::gemm_phase(lds, DFF, S, E);
                if (pb + 13 < hi) xcd_barrier(bar); }
        }
        if (INL(13)) {
            { pg8::StaticOrder S; S.init((bf16*)(ws + WS_PB) + (size_t)l * MT * 256, (bf16*)(ws + WS_WP) + (size_t)l * DM * 256, MT, DM, 256, G, bx); pg8::EpiBf16Store E{(bf16*)(ws + WS_PP), DM, nullptr}; pg8::gemm_phase(lds, 256, S, E); }
            { pg8::StaticOrder S; S.init(hbA, (bf16*)(ws + WS_WG) + (size_t)l * DM * DM, MT, DM, DM, G, bx); fill_rs_table(lds, S, rssA, nullptr); pg8::EpiPle E{a.out, ws, (const LAS float*)(lds + RSTAB_OFF), WS_PP, WS_HB2, WS_RSS + (size_t)MT * 16 * 4}; pg8::gemm_phase(lds, DM, S, E); }
            SEAM(pb + 13); }
        if (INL(14)) { if (l == 1) phase_norm<2>(a, lds, INF(IN_GFINAL)); }

}

#undef ws
#undef ctl
#undef hbA
#undef hbB
#undef rssA
#undef rssB
#undef hb_in
#undef rss_in

__global__ void __launch_bounds__(NTHR, 2) hybrid_fwd(Args a) {
    extern __shared__ __attribute__((aligned(16))) unsigned char lds_raw[];
    LAS unsigned char* lds = (LAS unsigned char*)lds_raw;
    volatile LAS unsigned* MISC = (volatile LAS unsigned*)(lds + MISC_OFF);
    const int tid = opaque_tid();
    unsigned char* ws = ws_of(a); unsigned* ctl = (unsigned*)(ws + WS_CTL);
    for (int u = tid; u < (LDS_BYTES - MISC_OFF) / 4; u += NTHR) MISC[u] = 0u;
    __syncthreads();
    if (tid < N_INPUTS) *(LAS unsigned long long*)(lds + PTAB_OFF + 8 * tid) = (unsigned long long)a.in[tid];
    __syncthreads();
    const int lo = a.ph_lo, hi = a.ph_hi;
    const bool multi = (hi - lo) > 1;
    XcdBarrier bar; bar.bar = ctl + CW_BAR; bar.x = 0; bar.st = nullptr;
    if (multi) bar = xcd_barrier_post(ctl + CW_BAR, MISC + 8);
    const int G = gridDim.x, bx = blockIdx.x;

    if ((PHSEL == -1 || PHSEL == 100) && IN(0)) { for (int rep = 0; rep < REP_PRO; ++rep) { phase_prologue(a, lds); __syncthreads(); } SEAM(0); }

    run_layer<0>(a, lds, MISC, bar, lo, hi);
    run_layer<1>(a, lds, MISC, bar, lo, hi);
}

extern "C" void kernel_launch(void* const* d_in, const int* in_sizes, int n_in, void* d_out, int out_size, void* d_ws, size_t ws_size, hipStream_t stream) {
    static int grid = 0;
    if (grid == 0) {
        if (n_in != N_INPUTS || out_size != MT * DM || ws_size < WS_END) { fprintf(stderr, "kernel_launch: unexpected shapes (n_in %d, out %d, ws %zu)\n", n_in, out_size, ws_size); grid = -1; return; }
        int dev = 0, cus = 0, per_cu = 0;
        if (hipGetDevice(&dev) != hipSuccess || hipDeviceGetAttribute(&cus, hipDeviceAttributeMultiprocessorCount, dev) != hipSuccess) { grid = -1; return; }
        if (hipFuncSetAttribute((const void*)hybrid_fwd, hipFuncAttributeMaxDynamicSharedMemorySize, LDS_BYTES) != hipSuccess) { fprintf(stderr, "kernel_launch: hipFuncSetAttribute failed\n"); grid = -1; return; }
        if (hipOccupancyMaxActiveBlocksPerMultiprocessor(&per_cu, (const void*)hybrid_fwd, NTHR, LDS_BYTES) != hipSuccess || per_cu < 1) fprintf(stderr, "kernel_launch: occupancy query reports %d\n", per_cu);
        (void)hipGetLastError();
        grid = cus;
    }
    if (grid < 0) return;
    (void)hipMemsetAsync((char*)d_ws + WS_CTL, 0, CTL_ZERO_BYTES, stream);
    Args a{};
    for (int i = 0; i < N_INPUTS; ++i) a.in[i] = d_in[i];
    a.out = (float*)d_out; a.ws = (unsigned char*)d_ws;
#if MK_ONE_LAUNCH
    a.ph_lo = 0; a.ph_hi = NPHASES;
    hipLaunchKernelGGL(hybrid_fwd, dim3(grid), dim3(NTHR), LDS_BYTES, stream, a);
#else
    for (int k = 0; k < NPHASES; ++k) { if (phase_empty(k)) continue; a.ph_lo = k; a.ph_hi = k + 1;
        hipLaunchKernelGGL(hybrid_fwd, dim3(grid), dim3(NTHR), LDS_BYTES, stream, a); }
#endif
}
```
